# Optimizing an MI355X kernel written in HIP

```python
import math
import jax, jax.numpy as jnp
from jax import lax
import numpy as np

D_MODEL = 2048
BATCH = 4
SEQ = 4096
DEPTH = 2

EPS = 1e-6
NEG = -1e30
F32 = jnp.float32

A_HEADS = 8
A_HEAD_DIM = 128
A_BLOCK = 256
A_TOPK = 3
A_QCHUNK = 64
T5_BUCKETS = 32
T5_MAX_DIST = 128
B_HEADS = 4
B_QK_DIM = 128
B_V_DIM = 256
B_CONV = 4
B_CHUNK = 64
C_HEADS = 8
C_Q_RANK = 512
C_KV_RANK = 256
C_NOPE = 128
C_ROPE = 64
C_V_DIM = 128
C_QBLOCK = 128
ROPE_THETA = 10000.0

A_W = A_HEADS * A_HEAD_DIM
B_QK_W = B_HEADS * B_QK_DIM
B_V_W = B_HEADS * B_V_DIM
C_W = C_HEADS * C_V_DIM
BRANCH_WIDTH = 1024
N_BRANCH = 3

SPLIT_SIZES = (A_W, A_W, A_W, A_W,
               B_QK_W, B_QK_W, B_V_W, B_HEADS, B_HEADS,
               B_V_W, B_V_W,
               C_Q_RANK, C_KV_RANK, C_ROPE, C_W,
               N_BRANCH * D_MODEL)
D_IN = int(sum(SPLIT_SIZES))
SPLIT_POINTS = tuple(int(v) for v in np.cumsum(SPLIT_SIZES)[:-1])

kernel_name = 'hybrid_moba_mlstm_mla_block'


def rmsnorm(x, g):
    xf = x.astype(F32)
    y = xf * lax.rsqrt(jnp.mean(xf * xf, axis=-1, keepdims=True) + EPS)
    return (y * g.astype(F32)).astype(x.dtype)


def to_heads(t, n_heads):
    b, s, w = t.shape
    return t.reshape(b, s, n_heads, w // n_heads).transpose(0, 2, 1, 3)


def from_heads(t):
    b, h, s, d = t.shape
    return t.transpose(0, 2, 1, 3).reshape(b, s, h * d)


def t5_bucket(dist):
    max_exact = T5_BUCKETS // 2
    d = jnp.maximum(dist, 0)
    large = max_exact + (jnp.log(jnp.maximum(d, 1).astype(F32) / max_exact)
                         / math.log(T5_MAX_DIST / max_exact) * (T5_BUCKETS - max_exact)).astype(jnp.int32)
    large = jnp.minimum(large, T5_BUCKETS - 1)
    return jnp.where(d < max_exact, d, large)


def rope(x, pos):
    half = x.shape[-1] // 2
    inv = ROPE_THETA ** (-jnp.arange(half, dtype=F32) / half)
    ang = pos.astype(F32)[:, None] * inv[None, :]
    cos, sin = jnp.cos(ang), jnp.sin(ang)
    x1 = x[..., :half].astype(F32)
    x2 = x[..., half:].astype(F32)
    return jnp.concatenate([x1 * cos - x2 * sin, x1 * sin + x2 * cos], axis=-1).astype(x.dtype)


def causal_conv(x, w, b):
    k = w.shape[0]
    s = x.shape[1]
    xp = jnp.pad(x, ((0, 0), (k - 1, 0), (0, 0)))
    return sum(xp[:, j:j + s] * w[j] for j in range(k)) + b


def moba_attention(q, k, v, t5_table):
    bsz, h, s, hd = q.shape
    nb = -(-s // A_BLOCK)
    pad = nb * A_BLOCK - s
    padw = ((0, 0), (0, 0), (0, pad), (0, 0))
    kb = jnp.pad(k, padw).reshape(bsz, h, nb, A_BLOCK, hd)
    vb = jnp.pad(v, padw).reshape(bsz, h, nb, A_BLOCK, hd)
    k_mean = jnp.mean(kb.astype(F32), axis=3)
    q_block = jnp.arange(s) // A_BLOCK
    gate = jnp.einsum('bhsd,bhnd->bhsn', q.astype(F32), k_mean)
    is_past = jnp.arange(nb)[None, :] < q_block[:, None]
    gate = jnp.where(is_past, gate, NEG)
    n_sel = min(A_TOPK, nb)
    _, sel = lax.top_k(gate, n_sel)
    nc = s // A_QCHUNK
    q_c = q.reshape(bsz, h, nc, A_QCHUNK, hd).transpose(2, 0, 1, 3, 4)
    sel_c = sel.reshape(bsz, h, nc, A_QCHUNK, n_sel).transpose(2, 0, 1, 3, 4)
    bias_table = t5_table.T.astype(F32)
    b_idx = jnp.arange(bsz)[:, None, None, None]
    h_idx = jnp.arange(h)[None, :, None, None]
    offs = jnp.arange(A_BLOCK)
    scale = hd ** -0.5

    def one_chunk(args):
        ci, qq, ss = args
        qpos = ci * A_QCHUNK + jnp.arange(A_QCHUNK)
        own = (ci * A_QCHUNK) // A_BLOCK
        k_sel = kb[b_idx, h_idx, ss]
        v_sel = vb[b_idx, h_idx, ss]
        kpos_sel = ss[..., None] * A_BLOCK + offs
        bias_sel = bias_table[h_idx[..., None], t5_bucket(qpos[:, None, None] - kpos_sel)]
        valid = (jnp.arange(n_sel)[None, :] < (qpos // A_BLOCK)[:, None])[:, :, None]
        s_sel = jnp.einsum('bhqd,bhqnkd->bhqnk', qq, k_sel, preferred_element_type=F32) * scale + bias_sel
        s_sel = jnp.where(valid, s_sel, NEG)
        k_own = lax.dynamic_index_in_dim(kb, own, axis=2, keepdims=False)
        v_own = lax.dynamic_index_in_dim(vb, own, axis=2, keepdims=False)
        dist_own = qpos[:, None] - (own * A_BLOCK + offs)[None, :]
        s_own = (jnp.einsum('bhqd,bhkd->bhqk', qq, k_own, preferred_element_type=F32) * scale
                 + bias_table[:, t5_bucket(dist_own)])
        s_own = jnp.where(dist_own >= 0, s_own, NEG)
        s_all = jnp.concatenate([s_sel.reshape(bsz, h, A_QCHUNK, n_sel * A_BLOCK), s_own], axis=-1)
        p = jax.nn.softmax(s_all, axis=-1)
        p_sel = p[..., :n_sel * A_BLOCK].reshape(bsz, h, A_QCHUNK, n_sel, A_BLOCK).astype(v.dtype)
        p_own = p[..., n_sel * A_BLOCK:].astype(v.dtype)
        return (jnp.einsum('bhqnk,bhqnkd->bhqd', p_sel, v_sel, preferred_element_type=F32)
                + jnp.einsum('bhqk,bhkd->bhqd', p_own, v_own, preferred_element_type=F32))

    out = lax.map(one_chunk, (jnp.arange(nc), q_c, sel_c))
    return out.transpose(1, 2, 0, 3, 4).reshape(bsz, h, s, hd)


def mlstm_chunkwise(q, k, v, i_pre, f_pre):
    bsz, h, s, dk = q.shape
    dv = v.shape[-1]
    L = B_CHUNK
    nc = s // L

    def chunks(t):
        return jnp.moveaxis(t.reshape(bsz, h, nc, L, *t.shape[3:]), 2, 0)

    qc = chunks(q.astype(F32))
    kc = chunks(k.astype(F32) * (dk ** -0.5))
    vc = chunks(v.astype(F32))
    lic = chunks(i_pre.astype(F32))
    lfc = chunks(jax.nn.log_sigmoid(f_pre.astype(F32)))
    causal = jnp.tril(jnp.ones((L, L), dtype=bool))

    def step(carry, xs):
        C, n, m = carry
        qq, kk, vv, li, lf = xs
        b = jnp.cumsum(lf, axis=-1)
        a = b + m[..., None]
        D = jnp.where(causal, b[..., :, None] - b[..., None, :] + li[..., None, :], -jnp.inf)
        m_t = jnp.maximum(a, jnp.max(D, axis=-1))
        w_inter = jnp.exp(a - m_t)
        sc = jnp.einsum('bhld,bhsd->bhls', qq, kk) * jnp.exp(D - m_t[..., None])
        num = (w_inter[..., None] * jnp.einsum('bhld,bhde->bhle', qq, C)
               + jnp.einsum('bhls,bhse->bhle', sc, vv))
        den = w_inter * jnp.einsum('bhld,bhd->bhl', qq, n) + jnp.sum(sc, axis=-1)
        hh = num / jnp.maximum(jnp.abs(den), jnp.exp(-m_t))[..., None]
        b_last = b[..., -1]
        g = b_last[..., None] - b + li
        m_new = jnp.maximum(b_last + m, jnp.max(g, axis=-1))
        decay = jnp.exp(b_last + m - m_new)
        wk = jnp.exp(g - m_new[..., None])[..., None] * kk
        C_new = decay[..., None, None] * C + jnp.einsum('bhsd,bhse->bhde', wk, vv)
        n_new = decay[..., None] * n + jnp.sum(wk, axis=-2)
        return (C_new, n_new, m_new), hh

    init = (jnp.zeros((bsz, h, dk, dv), F32), jnp.zeros((bsz, h, dk), F32), jnp.zeros((bsz, h), F32))
    _, hs = lax.scan(step, init, (qc, kc, vc, lic, lfc))
    return jnp.moveaxis(hs, 0, 2).reshape(bsz, h, s, dv)


def head_layernorm(hh, g):
    t = hh.transpose(0, 2, 1, 3).astype(F32)
    mu = jnp.mean(t, axis=-1, keepdims=True)
    var = jnp.mean(jnp.square(t - mu), axis=-1, keepdims=True)
    t = (t - mu) * lax.rsqrt(var + EPS)
    b, s, h, d = t.shape
    return t.reshape(b, s, h * d) * g.astype(F32)


def causal_block_attention(q, k, v):
    bsz, h, s, dq = q.shape
    nq = s // C_QBLOCK
    qb = q.reshape(bsz, h, nq, C_QBLOCK, dq).transpose(2, 0, 1, 3, 4)
    kpos = jnp.arange(s)
    scale = dq ** -0.5

    def blk(args):
        bi, q_b = args
        qpos = bi * C_QBLOCK + jnp.arange(C_QBLOCK)
        logits = jnp.einsum('bhqd,bhkd->bhqk', q_b, k, preferred_element_type=F32) * scale
        logits = jnp.where(kpos[None, :] <= qpos[:, None], logits, NEG)
        p = jax.nn.softmax(logits, axis=-1).astype(v.dtype)
        return jnp.einsum('bhqk,bhkd->bhqd', p, v, preferred_element_type=F32)

    out = lax.map(blk, (jnp.arange(nq), qb))
    return out.transpose(1, 2, 0, 3, 4).reshape(bsz, h, s, -1)


def mla_attention(cq, ckv, kr, q_norm, kv_norm, w_uq, w_ukv, pos):
    bsz, s, _ = cq.shape
    q = jnp.einsum('bsr,re->bse', rmsnorm(cq, q_norm), w_uq)
    q = q.reshape(bsz, s, C_HEADS, C_NOPE + C_ROPE).transpose(0, 2, 1, 3)
    kv = jnp.einsum('bsr,re->bse', rmsnorm(ckv, kv_norm), w_ukv)
    kv = kv.reshape(bsz, s, C_HEADS, C_NOPE + C_V_DIM).transpose(0, 2, 1, 3)
    q = jnp.concatenate([q[..., :C_NOPE], rope(q[..., C_NOPE:], pos)], axis=-1)
    k_rope = rope(kr[:, None], pos)
    k = jnp.concatenate([kv[..., :C_NOPE], jnp.broadcast_to(k_rope, (bsz, C_HEADS, s, C_ROPE))], axis=-1)
    v = kv[..., C_NOPE:]
    return causal_block_attention(q, k, v)


def setup_inputs(seed: int = 0) -> dict:
    key = jax.random.key(seed)
    ks = jax.random.split(key, 17)
    nrm = jax.random.normal
    return {
        'x': nrm(ks[0], (BATCH, SEQ, D_MODEL), F32),
        'norm_gain': 1.0 + 0.02 * nrm(ks[1], (DEPTH, D_MODEL), F32),
        'w_in': nrm(ks[2], (DEPTH, D_MODEL, D_IN), F32) * D_MODEL ** -0.5,
        't5_table': 0.5 * nrm(ks[3], (T5_BUCKETS, A_HEADS), F32),
        'mlstm_conv_w': nrm(ks[4], (DEPTH, B_CONV, 2 * B_QK_W), F32) * B_CONV ** -0.5,
        'mlstm_conv_b': 0.01 * nrm(ks[5], (DEPTH, 2 * B_QK_W), F32),
        'mlstm_i_bias': 0.1 * nrm(ks[6], (DEPTH, B_HEADS), F32),
        'mlstm_f_bias': jnp.linspace(3.0, 6.0, B_HEADS, dtype=F32)[None, :] + 0.1 * nrm(ks[7], (DEPTH, B_HEADS), F32),
        'mlstm_out_norm': 1.0 + 0.02 * nrm(ks[8], (DEPTH, B_V_W), F32),
        'mla_q_norm': 1.0 + 0.02 * nrm(ks[9], (DEPTH, C_Q_RANK), F32),
        'mla_kv_norm': 1.0 + 0.02 * nrm(ks[10], (DEPTH, C_KV_RANK), F32),
        'mla_w_uq': nrm(ks[11], (DEPTH, C_Q_RANK, C_HEADS * (C_NOPE + C_ROPE)), F32) * C_Q_RANK ** -0.5,
        'mla_w_ukv': nrm(ks[12], (DEPTH, C_KV_RANK, C_HEADS * (C_NOPE + C_V_DIM)), F32) * C_KV_RANK ** -0.5,
        'w_branch': nrm(ks[13], (DEPTH, N_BRANCH, BRANCH_WIDTH, D_MODEL), F32) * BRANCH_WIDTH ** -0.5,
        'w_out': nrm(ks[14], (DEPTH, D_MODEL, D_MODEL), F32) * D_MODEL ** -0.5,
        'final_norm': 1.0 + 0.02 * nrm(ks[15], (D_MODEL,), F32),
    }


def reference(x, norm_gain, w_in, t5_table, mlstm_conv_w, mlstm_conv_b, mlstm_i_bias, mlstm_f_bias,
              mlstm_out_norm, mla_q_norm, mla_kv_norm, mla_w_uq, mla_w_ukv, w_branch, w_out, final_norm):
    bsz, s, _ = x.shape
    pos = jnp.arange(s, dtype=jnp.int32)
    for l in range(DEPTH):
        h = rmsnorm(x, norm_gain[l])
        proj = jnp.einsum('bsd,de->bse', h, w_in[l])
        (qa, ka, va, za, qb, kb, vb, ib, fb, ob, zb, cq, ckv, kr, zc, gt) = jnp.split(proj, SPLIT_POINTS, axis=-1)
        ya = moba_attention(to_heads(qa, A_HEADS), to_heads(ka, A_HEADS), to_heads(va, A_HEADS), t5_table)
        ya = from_heads(ya) * jax.nn.silu(za.astype(F32))
        qk = jax.nn.silu(causal_conv(jnp.concatenate([qb, kb], axis=-1), mlstm_conv_w[l], mlstm_conv_b[l]))
        qb2, kb2 = jnp.split(qk, 2, axis=-1)
        i_pre = (ib + mlstm_i_bias[l]).transpose(0, 2, 1)
        f_pre = (fb + mlstm_f_bias[l]).transpose(0, 2, 1)
        hb = mlstm_chunkwise(to_heads(qb2, B_HEADS), to_heads(kb2, B_HEADS), to_heads(vb, B_HEADS), i_pre, f_pre)
        yb = (head_layernorm(hb, mlstm_out_norm[l]) * jax.nn.sigmoid(ob.astype(F32))
              * jax.nn.silu(zb.astype(F32)))
        hc = mla_attention(cq, ckv, kr, mla_q_norm[l], mla_kv_norm[l], mla_w_uq[l], mla_w_ukv[l], pos)
        yc = from_heads(hc) * jax.nn.silu(zc.astype(F32))
        ys = jnp.stack([ya, yb, yc], axis=2).astype(h.dtype)
        branch = jnp.einsum('bsnw,nwd->bsnd', ys, w_branch[l])
        gates = jax.nn.sigmoid(gt.reshape(bsz, s, N_BRANCH, D_MODEL))
        merged = jnp.sum(gates * branch, axis=2)
        x = (x + jnp.einsum('bsd,de->bse', merged, w_out[l])).astype(x.dtype)
    return rmsnorm(x, final_norm)
```

```cpp
#include <hip/hip_runtime.h>
#include <hip/hip_cooperative_groups.h>
#include <cstdio>
#include <cstdint>
namespace cg = cooperative_groups;
__device__ __forceinline__ int tidx_opaque(int g_wv) { int l; asm volatile("v_mbcnt_lo_u32_b32 %0, -1, 0\n\tv_mbcnt_hi_u32_b32 %0, -1, %0" : "=v"(l)); return g_wv * 64 + l; }
#define TIDX tidx_opaque(g_wv)
__device__ __forceinline__ float shx(float v, int o, int lane) { return __int_as_float(__builtin_amdgcn_ds_bpermute(((lane ^ o) & 63) << 2, __float_as_int(v))); }
__device__ __forceinline__ int shxi(int v, int o, int lane) { return __builtin_amdgcn_ds_bpermute(((lane ^ o) & 63) << 2, v); }
__device__ __forceinline__ float shup(float v, int o, int lane) { return __int_as_float(__builtin_amdgcn_ds_bpermute(((lane - o) & 63) << 2, __float_as_int(v))); }

namespace pg8 {
#define PG8_LAS __attribute__((address_space(3)))
typedef unsigned short bf16_t;
typedef short bf16x8 __attribute__((ext_vector_type(8)));
typedef float f32x4 __attribute__((ext_vector_type(4)));
typedef unsigned u32x4 __attribute__((ext_vector_type(4)));
constexpr int BM = 256, BK = 64, HALF = 128, HTB = HALF * BK * 2  , STAGE_BYTES = 8 * HTB, NXCD = 8, WGM = 8;

__host__ __device__ __forceinline__ int lds_byte(int r, int c) { const int st = (r >> 4) * 2 + (c >> 5), rr = r & 15, cc = c & 31, ob = rr * 64 + cc * 2; return st * 1024 + (ob ^ (((ob >> 9) & 1) << 5)); }
__host__ __device__ __forceinline__ void stage_rc(int b, int& R, int& C) { const int st = b / 1024, sb = b % 1024, swz = sb ^ (((sb >> 9) & 1) << 5); R = (st >> 1) * 16 + swz / 64; C = (st & 1) * 32 + (swz % 64) / 2; }
__host__ __device__ __forceinline__ int perm32(int rho) { const int n = rho >> 4, i = rho & 15; return 8 * (i >> 2) + 4 * n + (i & 3); }

struct Unit { int pm, pn, pb; };
struct Gemm { const bf16_t* A; const bf16_t* Bt; int M, N, K, lda, ldb; };

struct StaticOrder {
    int nM, nN, nwg, G, c;
    __host__ __device__ void init(int M, int N, int G_, int c_) { nM = M / BM; nN = N / BM; nwg = nM * nN; G = G_; c = c_; }
    __host__ __device__ bool next(int i, Unit& u) const {
        const long L = (long)i * G + c; if (L >= nwg) return false;
        int wgid = (int)L; { const int q = nwg / NXCD, r = nwg % NXCD, xcd = wgid % NXCD, off = wgid / NXCD; wgid = (xcd < r ? xcd * (q + 1) : r * (q + 1) + (xcd - r) * q) + off; }
        const int nig = WGM * nN, gid = wgid / nig, fm = gid * WGM, gsz = (nM - fm) < WGM ? (nM - fm) : WGM;
        u.pm = fm + ((wgid % nig) % gsz); u.pn = (wgid % nig) / gsz; u.pb = u.pn; return true;
    }
    __device__ __forceinline__ void a_ready(const Unit&) const {}
    __device__ __forceinline__ void done(const Unit&) const {}
};

__device__ __forceinline__ unsigned cvt_pk_bf16(float lo, float hi) { unsigned r; asm volatile("s_nop 1\n\tv_cvt_pk_bf16_f32 %0, %1, %2\n\ts_nop 1" : "=v"(r) : "v"(lo), "v"(hi)); return r; }
template <class Epi, class Sched, bool ALIGN_EPI = false, bool SP2 = false>
__device__ __forceinline__ void gemm_phase(PG8_LAS unsigned char* lds, const Gemm g, const Sched& S, const Epi& E, const int g_wv) {
    int tid = TIDX; asm volatile("" : "+v"(tid)); const int wid = __builtin_amdgcn_readfirstlane(tid >> 6), lane = tid & 63, wr = wid >> 2, wc = wid & 3, fr = lane & 15, fq = lane >> 4;
    const int K = g.K, nt = K / BK;
    unsigned voffA[2], voffB[2];
#pragma unroll
    for (int i = 0; i < 2; ++i) { int R, C; stage_rc(tid * 16 + i * 8192, R, C); const int Rb = Epi::PERM ? ((R & ~31) + perm32(R & 31)) : R;
        voffA[i] = (unsigned)(R * K + C) * 2u; voffB[i] = (unsigned)(Rb * K + C) * 2u; }
    const size_t kstep = (size_t)(BK * 2);
    const size_t hstepA = (size_t)HALF * K * 2; const size_t hstepB = hstepA;
    const size_t tstepA = 2 * hstepA; const size_t tstepB = tstepA;
    const unsigned ldsw = (unsigned)wid * 1024u;
    const int aoff = lds_byte(wr * 64 + fr, fq * 8), boff = lds_byte(wc * 32 + fr, fq * 8);
#define PG8_SA(b, h) (((b) * 2 + (h)) * HTB)
#define PG8_SB(b, h) ((4 + (b) * 2 + (h)) * HTB)
#define PG8_STAGE(bufoff, gbase, voff) do { _Pragma("unroll") for (int _i = 0; _i < 2; ++_i) \
        __builtin_amdgcn_global_load_lds((const unsigned*)((const char*)(gbase) + (voff)[_i]), (PG8_LAS unsigned*)(lds + (bufoff) + ldsw + _i * 8192), 16, 0, 0); } while (0)
#define PG8_LDA(dst, b, h) do { _Pragma("unroll") for (int m = 0; m < 4; ++m) _Pragma("unroll") for (int k = 0; k < 2; ++k) dst[m][k] = *(const PG8_LAS bf16x8*)(lds + PG8_SA(b, h) + aoff + m * 2048 + k * 1024); } while (0)
#define PG8_LDB(dst, b, h) do { _Pragma("unroll") for (int n = 0; n < 2; ++n) _Pragma("unroll") for (int k = 0; k < 2; ++k) dst[n][k] = *(const PG8_LAS bf16x8*)(lds + PG8_SB(b, h) + boff + n * 2048 + k * 1024); } while (0)
#define PG8_MMA(ai, bj, At, Bt) do { __builtin_amdgcn_s_setprio(1); _Pragma("unroll") for (int m = 0; m < 4; ++m) _Pragma("unroll") for (int n = 0; n < 2; ++n) _Pragma("unroll") for (int k = 0; k < 2; ++k) \
        acc[ai][bj][m][n] = __builtin_amdgcn_mfma_f32_16x16x32_bf16(Bt[n][k], At[m][k], acc[ai][bj][m][n], 0, 0, 0); __builtin_amdgcn_s_setprio(0); } while (0)
#define PG8_WAIT_V(n) asm volatile("s_waitcnt vmcnt(" #n ")" ::: "memory")
#define PG8_WAIT_L(n) asm volatile("s_waitcnt lgkmcnt(" #n ")" ::: "memory")
#define PG8_BAR __builtin_amdgcn_s_barrier()
#define PG8_SCHED __builtin_amdgcn_sched_barrier(0)
    Unit cur, nxt; int ui = 0;
    if (!S.next(0, cur)) return;
    f32x4 acc[2][2][4][2];
#pragma unroll
    for (int a = 0; a < 2; ++a)
#pragma unroll
        for (int b = 0; b < 2; ++b)
#pragma unroll
            for (int m = 0; m < 4; ++m)
#pragma unroll
                for (int n = 0; n < 2; ++n) acc[a][b][m][n] = (f32x4){0.f, 0.f, 0.f, 0.f};
    bf16x8 At[4][2], B0[2][2], B1[2][2];
    const char* cA = (const char*)g.A + (size_t)cur.pm * tstepA; const char* cB = (const char*)g.Bt + (size_t)cur.pb * tstepB;
    S.a_ready(cur);
    if constexpr (SP2) {
        PG8_STAGE(PG8_SB(0, 0), cB, voffB); PG8_STAGE(PG8_SB(0, 1), cB + hstepB, voffB); PG8_STAGE(PG8_SA(0, 0), cA, voffA); PG8_STAGE(PG8_SA(0, 1), cA + hstepA, voffA);
        if (wr == 1) PG8_BAR;
        PG8_WAIT_V(2); PG8_BAR;
        PG8_STAGE(PG8_SB(1, 0), cB + kstep, voffB); PG8_STAGE(PG8_SA(1, 0), cA + kstep, voffA); PG8_STAGE(PG8_SB(1, 1), cB + hstepB + kstep, voffB);
        PG8_WAIT_V(6); PG8_BAR;
    } else {
        PG8_STAGE(PG8_SB(0, 0), cB, voffB); PG8_STAGE(PG8_SA(0, 0), cA, voffA); PG8_STAGE(PG8_SB(0, 1), cB + hstepB, voffB); PG8_STAGE(PG8_SA(0, 1), cA + hstepA, voffA);
        if (wr == 1) PG8_BAR;
        PG8_WAIT_V(4); PG8_BAR;
        PG8_STAGE(PG8_SB(1, 0), cB + kstep, voffB); PG8_STAGE(PG8_SA(1, 0), cA + kstep, voffA); PG8_STAGE(PG8_SB(1, 1), cB + hstepB + kstep, voffB);
        PG8_WAIT_V(6); PG8_BAR;
    }
    for (;;) {
        const bool has_next = S.next(ui + 1, nxt);
        const char* nA = has_next ? (const char*)g.A + (size_t)nxt.pm * tstepA : cA; const char* nB = has_next ? (const char*)g.Bt + (size_t)nxt.pb * tstepB : cB;
        for (int t = 0; t < nt; t += 2) {
            const bool last = (t == nt - 2);
            const char* a1 = cA + (size_t)(t + 1) * kstep;
            const char* a2 = last ? nA : cA + (size_t)(t + 2) * kstep; const char* b2 = last ? nB : cB + (size_t)(t + 2) * kstep;
            const char* a3 = a2 + kstep; const char* b3 = b2 + kstep;
            if (last && has_next) S.a_ready(nxt);
            if constexpr (SP2) {
            PG8_LDB(B0, 0, 0); PG8_LDB(B1, 0, 1); PG8_SCHED; PG8_LDA(At, 0, 0); PG8_STAGE(PG8_SA(1, 1), a1 + hstepA, voffA);
            PG8_WAIT_V(8); PG8_WAIT_L(0); PG8_BAR; PG8_MMA(0, 0, At, B0); PG8_MMA(0, 1, At, B1); PG8_BAR; PG8_SCHED;
            PG8_LDA(At, 0, 1); PG8_STAGE(PG8_SB(0, 0), b2, voffB); PG8_STAGE(PG8_SB(0, 1), b2 + hstepB, voffB); PG8_STAGE(PG8_SA(0, 0), a2, voffA);
            PG8_WAIT_V(8); PG8_WAIT_L(0); PG8_BAR; PG8_MMA(1, 0, At, B0); PG8_MMA(1, 1, At, B1); PG8_BAR; PG8_SCHED;
            PG8_LDB(B0, 1, 0); PG8_LDB(B1, 1, 1); PG8_SCHED; PG8_LDA(At, 1, 0); PG8_STAGE(PG8_SA(0, 1), a2 + hstepA, voffA);
            PG8_WAIT_V(8); PG8_WAIT_L(0); PG8_BAR; PG8_MMA(0, 0, At, B0); PG8_MMA(0, 1, At, B1); PG8_BAR; PG8_SCHED;
            PG8_LDA(At, 1, 1); PG8_STAGE(PG8_SB(1, 0), b3, voffB); PG8_STAGE(PG8_SB(1, 1), b3 + hstepB, voffB); PG8_STAGE(PG8_SA(1, 0), a3, voffA);
            PG8_WAIT_V(8); PG8_WAIT_L(0); PG8_BAR; PG8_MMA(1, 0, At, B0); PG8_MMA(1, 1, At, B1); PG8_BAR; PG8_SCHED;
            } else {
            PG8_LDB(B0, 0, 0); PG8_SCHED; PG8_LDA(At, 0, 0); PG8_STAGE(PG8_SA(1, 1), a1 + hstepA, voffA);
            PG8_WAIT_L(8); PG8_BAR; PG8_WAIT_L(0); PG8_MMA(0, 0, At, B0); PG8_BAR; PG8_SCHED;
            PG8_LDB(B1, 0, 1); PG8_STAGE(PG8_SB(0, 0), b2, voffB);
            PG8_BAR; PG8_WAIT_L(0); PG8_MMA(0, 1, At, B1); PG8_BAR;
            PG8_LDA(At, 0, 1); PG8_STAGE(PG8_SA(0, 0), a2, voffA);
            PG8_BAR; PG8_WAIT_L(0); PG8_MMA(1, 0, At, B0); PG8_BAR; PG8_SCHED;
            PG8_STAGE(PG8_SB(0, 1), b2 + hstepB, voffB);
            PG8_WAIT_V(6); PG8_BAR; PG8_MMA(1, 1, At, B1); PG8_BAR;
            PG8_LDB(B0, 1, 0); PG8_SCHED; PG8_LDA(At, 1, 0); PG8_STAGE(PG8_SA(0, 1), a2 + hstepA, voffA);
            PG8_WAIT_L(8); PG8_BAR; PG8_WAIT_L(0); PG8_MMA(0, 0, At, B0); PG8_BAR; PG8_SCHED;
            PG8_LDB(B1, 1, 1); PG8_STAGE(PG8_SB(1, 0), b3, voffB);
            PG8_BAR; PG8_WAIT_L(0); PG8_MMA(0, 1, At, B1); PG8_BAR;
            PG8_LDA(At, 1, 1); PG8_STAGE(PG8_SA(1, 0), a3, voffA);
            PG8_BAR; PG8_WAIT_L(0); PG8_MMA(1, 0, At, B0); PG8_BAR; PG8_SCHED;
            PG8_STAGE(PG8_SB(1, 1), b3 + hstepB, voffB);
            PG8_WAIT_V(6); PG8_BAR; PG8_MMA(1, 1, At, B1); PG8_BAR;
            }
        }
        if constexpr (ALIGN_EPI) { if (wr == 0) PG8_BAR; }
        if constexpr (!Epi::AFTER_DRAIN) { E(acc, cur, wr, wc, fr, fq); S.done(cur); }
        if (!has_next) break;
#pragma unroll
        for (int a = 0; a < 2; ++a)
#pragma unroll
            for (int b = 0; b < 2; ++b)
#pragma unroll
                for (int m = 0; m < 4; ++m)
#pragma unroll
                    for (int n = 0; n < 2; ++n) acc[a][b][m][n] = (f32x4){0.f, 0.f, 0.f, 0.f};
        cur = nxt; cA = nA; cB = nB; ++ui;
        if constexpr (ALIGN_EPI) { if (wr == 1) PG8_BAR; }
    }
    PG8_WAIT_V(0);
    if constexpr (!ALIGN_EPI) { if (wr == 0) PG8_BAR; }
    PG8_BAR;
    if constexpr (Epi::AFTER_DRAIN) { E.fused(acc, cur, wr, wc, fr, fq, lds, wid, lane); S.done(cur); }
#undef PG8_SA
#undef PG8_SB
#undef PG8_STAGE
#undef PG8_LDA
#undef PG8_LDB
#undef PG8_MMA
#undef PG8_WAIT_V
#undef PG8_WAIT_L
#undef PG8_BAR
#undef PG8_SCHED
}
}

using pg8::bf16_t; using pg8::bf16x8; using pg8::f32x4; using pg8::u32x4; using pg8::Unit; using pg8::cvt_pk_bf16;
typedef unsigned u32x2 __attribute__((ext_vector_type(2)));
typedef float f32x2 __attribute__((ext_vector_type(2)));
constexpr int T = 16384, SEQ = 4096, DM = 2048, DIN = 16200;
constexpr float EPS = 1e-6f, NEGV = -1e30f, LOG2E = 1.4426950408889634f;
constexpr float CA_SCALE = 0.12751743082459868f;
constexpr float CC_SCALE = 0.10411754627697264f;
constexpr int NTHR = 512;
constexpr int LDS_BYTES = 131072;

constexpr size_t MiB = 1ull << 20;
constexpr size_t WS_CS = 0;
constexpr size_t WS_SSQ = WS_CS + MiB;
constexpr size_t WS_SSKV = WS_SSQ + 65536;
constexpr size_t WS_GATES = WS_SSKV + 65536;
constexpr size_t WS_KM = WS_GATES + 524288;
constexpr size_t WS_BV = WS_KM + 131072;
constexpr size_t WS_LIV = WS_BV + 262144;
constexpr size_t WS_BLAST = WS_LIV + 262144;
constexpr size_t WS_GMAX = WS_BLAST + 4096;
constexpr size_t WS_MST = WS_GMAX + 4096;
constexpr size_t WS_NST = WS_MST + 4096;
constexpr size_t WS_W0 = WS_NST + 524288;
constexpr size_t WL_WIN = 0;
constexpr size_t WL_WB = WL_WIN + 64 * MiB;
constexpr size_t WL_WO = WL_WB + 12 * MiB;
constexpr size_t WL_WUQ = WL_WO + 8 * MiB;
constexpr size_t WL_WKN = WL_WUQ + 1536 * 1024;
constexpr size_t WL_WV = WL_WKN + 512 * 1024;
constexpr size_t WL_SIZE = WL_WV + 512 * 1024;
constexpr size_t WS_H = WS_W0 + 2 * WL_SIZE;
constexpr size_t WS_QA = WS_H + 64 * MiB;
constexpr size_t WS_KA = WS_QA + 32 * MiB;
constexpr size_t WS_VAT = WS_KA + 32 * MiB;
constexpr size_t WS_Z = WS_VAT + 32 * MiB;
constexpr size_t WS_QB = WS_Z + 96 * MiB;
constexpr size_t WS_KB = WS_QB + 16 * MiB;
constexpr size_t WS_VB = WS_KB + 16 * MiB;
constexpr size_t WS_OB = WS_VB + 32 * MiB;
constexpr size_t WS_Q2 = WS_OB + 32 * MiB;
constexpr size_t WS_K2 = WS_Q2 + 16 * MiB;
constexpr size_t WS_CST = WS_K2 + 16 * MiB;
constexpr size_t WS_CQ = WS_CST + 64 * MiB;
constexpr size_t WS_CKV = WS_CQ + 16 * MiB;
constexpr size_t WS_KR = WS_CKV + 8 * MiB;
constexpr size_t WS_QC = WS_KR + 2 * MiB;
constexpr size_t WS_KNC = WS_QC + 48 * MiB;
constexpr size_t WS_VCT = WS_KNC + 32 * MiB;
constexpr size_t WS_GT = WS_VCT + 32 * MiB;
constexpr size_t WS_SSP = WS_GT + 192 * MiB;
constexpr size_t WS_QAL = WS_SSP + MiB;
constexpr size_t WS_CTR = WS_QAL + 32 * MiB;
constexpr size_t WS_END = WS_CTR + 256;

struct Params {
    const float* x; const float* norm_gain; const float* w_in; const float* t5; const float* conv_w; const float* conv_b; const float* i_bias; const float* f_bias;
    const float* out_norm; const float* q_norm; const float* kv_norm; const float* w_uq; const float* w_ukv; const float* w_branch; const float* w_out; const float* final_norm;
    float* out; unsigned char* ws; int w_lo, w_hi;
};

__device__ __forceinline__ float bf2f(unsigned v16) { return __uint_as_float(v16 << 16); }
__device__ __forceinline__ float bflo(unsigned w) { return __uint_as_float(w << 16); }
__device__ __forceinline__ float bfhi(unsigned w) { return __uint_as_float(w & 0xffff0000u); }
__device__ __forceinline__ bf16_t f2bf(float f) { return (bf16_t)(cvt_pk_bf16(f, 0.f) & 0xffffu); }
__device__ __forceinline__ float fsigmoid(float v) { return __builtin_amdgcn_rcpf(1.0f + __expf(-v)); }
__device__ __forceinline__ float fsilu(float v) { return v * __builtin_amdgcn_rcpf(1.0f + __expf(-v)); }
__device__ __forceinline__ float fexp2(float v) { return __builtin_amdgcn_exp2f(v); }
__device__ __forceinline__ f32x4 zero4() { f32x4 z = (f32x4){0.f, 0.f, 0.f, 0.f}; asm volatile("" : "+v"(z)); return z; }
__device__ __forceinline__ f32x4 mfma16(bf16x8 a, bf16x8 b, f32x4 c) { return __builtin_amdgcn_mfma_f32_16x16x32_bf16(a, b, c, 0, 0, 0); }

struct EpiIn {
    static constexpr bool PERM = true, AFTER_DRAIN = false;
    unsigned char* ws;
    __device__ __forceinline__ void operator()(const f32x4 (&acc)[2][2][4][2], const Unit& u, int wr, int wc, int fr, int fq) const {
        const int pn = u.pn; const int row0 = u.pm * 256 + wr * 64 + fr;
        if (pn == 59) {
            const int cb = wc * 32 + 8 * fq;
            if (cb >= 72) return;
            float* gates = (float*)(ws + WS_GATES); bf16_t* kr = (bf16_t*)(ws + WS_KR); const f32x2* cs = (const f32x2*)(ws + WS_CS);
#pragma unroll
            for (int ai = 0; ai < 2; ++ai)
#pragma unroll
                for (int m = 0; m < 4; ++m) {
                    const int row = row0 + ai * 128 + m * 16; const f32x4 v0 = acc[ai][0][m][0], v1 = acc[ai][0][m][1];
                    if (cb == 0) { *(f32x4*)(gates + (size_t)row * 8) = v0; *(f32x4*)(gates + (size_t)row * 8 + 4) = v1; }
                    else {
                        const int j0 = (cb - 8) >> 1, pos = row & (SEQ - 1);
                        const f32x2 c0 = cs[pos * 32 + j0], c1 = cs[pos * 32 + j0 + 1], c2 = cs[pos * 32 + j0 + 2], c3 = cs[pos * 32 + j0 + 3];
                        u32x4 w;
                        w.x = cvt_pk_bf16(v0[0] * c0.x - v0[1] * c0.y, v0[0] * c0.y + v0[1] * c0.x);
                        w.y = cvt_pk_bf16(v0[2] * c1.x - v0[3] * c1.y, v0[2] * c1.y + v0[3] * c1.x);
                        w.z = cvt_pk_bf16(v1[0] * c2.x - v1[1] * c2.y, v1[0] * c2.y + v1[1] * c2.x);
                        w.w = cvt_pk_bf16(v1[2] * c3.x - v1[3] * c3.y, v1[2] * c3.y + v1[3] * c3.x);
                        *(u32x4*)(kr + (size_t)row * 64 + (cb - 8)) = w;
                    }
                }
            return;
        }
        size_t off; int ld, c0, act = 0, ssk = 0; float sc = 1.f;
        if (pn < 4) { off = WS_QA; ld = 1024; c0 = pn * 256; sc = CA_SCALE; }
        else if (pn < 8) { off = WS_KA; ld = 1024; c0 = (pn - 4) * 256; }
        else if (pn < 12) { off = WS_Z; ld = 1024; c0 = (pn - 8) * 256; act = 1; }
        else if (pn < 14) { off = WS_QB; ld = 512; c0 = (pn - 12) * 256; }
        else if (pn < 16) { off = WS_KB; ld = 512; c0 = (pn - 14) * 256; }
        else if (pn < 20) { off = WS_VB; ld = 1024; c0 = (pn - 16) * 256; }
        else if (pn < 24) { off = WS_OB; ld = 1024; c0 = (pn - 20) * 256; act = 2; }
        else if (pn < 28) { off = WS_Z + 32 * MiB; ld = 1024; c0 = (pn - 24) * 256; act = 1; }
        else if (pn < 30) { off = WS_CQ; ld = 512; c0 = (pn - 28) * 256; ssk = 1; }
        else if (pn < 31) { off = WS_CKV; ld = 256; c0 = 0; ssk = 2; }
        else if (pn < 35) { off = WS_Z + 64 * MiB; ld = 1024; c0 = (pn - 31) * 256; act = 1; }
        else { off = WS_GT; ld = 6144; c0 = (pn - 35) * 256; act = 2; }
        bf16_t* dst = (bf16_t*)(ws + off); float* ssp = (float*)(ws + WS_SSP) + (ssk == 2 ? 8 : (pn - 28) * 4) + wc;
        const int col0 = c0 + wc * 32 + 8 * fq;
#pragma unroll
        for (int ai = 0; ai < 2; ++ai)
#pragma unroll
            for (int m = 0; m < 4; ++m) {
                const int row = row0 + ai * 128 + m * 16; bf16_t* rowp = dst + (size_t)row * ld + col0; float ss = 0.f;
#pragma unroll
                for (int bj = 0; bj < 2; ++bj) {
                    f32x4 v0 = acc[ai][bj][m][0], v1 = acc[ai][bj][m][1];
                    if (act == 1) {
#pragma unroll
                        for (int i = 0; i < 4; ++i) { v0[i] = fsilu(v0[i]); v1[i] = fsilu(v1[i]); }
                    } else if (act == 2) {
#pragma unroll
                        for (int i = 0; i < 4; ++i) { v0[i] = fsigmoid(v0[i]); v1[i] = fsigmoid(v1[i]); }
                    } else { v0 = v0 * sc; v1 = v1 * sc; }
                    if (ssk) ss += (v0[0] * v0[0] + v0[1] * v0[1]) + (v0[2] * v0[2] + v0[3] * v0[3]) + (v1[0] * v1[0] + v1[1] * v1[1]) + (v1[2] * v1[2] + v1[3] * v1[3]);
                    u32x4 w; w.x = cvt_pk_bf16(v0[0], v0[1]); w.y = cvt_pk_bf16(v0[2], v0[3]); w.z = cvt_pk_bf16(v1[0], v1[1]); w.w = cvt_pk_bf16(v1[2], v1[3]);
                    *(u32x4*)(rowp + bj * 128) = w;
                    if (pn < 4) {
                        u32x4 wl; wl.x = cvt_pk_bf16(v0[0] - bflo(w.x), v0[1] - bfhi(w.x)); wl.y = cvt_pk_bf16(v0[2] - bflo(w.y), v0[3] - bfhi(w.y));
                        wl.z = cvt_pk_bf16(v1[0] - bflo(w.z), v1[1] - bfhi(w.z)); wl.w = cvt_pk_bf16(v1[2] - bflo(w.w), v1[3] - bfhi(w.w));
                        *(u32x4*)((bf16_t*)(ws + WS_QAL) + (size_t)row * 1024 + col0 + bj * 128) = wl; }
                }
                if (ssk) { const int ln = fq * 16 + fr; ss += shx(ss, 16, ln); ss += shx(ss, 32, ln); if (fq == 0) ssp[(size_t)row * 16] = ss; }
            }
    }
};

struct EpiVT {
    static constexpr bool PERM = true, AFTER_DRAIN = false;
    bf16_t* dst; int ld; const float* ss; float inv_n;
    __device__ __forceinline__ void operator()(const f32x4 (&acc)[2][2][4][2], const Unit& u, int wr, int wc, int fr, int fq) const {
        const int row0 = u.pm * 256 + wr * 64 + fr, col0 = u.pn * 256 + wc * 32 + 8 * fq;
        f32x4 s0[2], s1[2];
#pragma unroll
        for (int bj = 0; bj < 2; ++bj) {
            if (ss) { f32x4 a, b;
#pragma unroll
                for (int i = 0; i < 4; ++i) { const f32x4 pa = *(const f32x4*)(ss + (size_t)(col0 + bj * 128 + i) * 16 + 8), pb = *(const f32x4*)(ss + (size_t)(col0 + bj * 128 + 4 + i) * 16 + 8);
                    a[i] = rsqrtf(((pa[0] + pa[1]) + (pa[2] + pa[3])) * inv_n + EPS); b[i] = rsqrtf(((pb[0] + pb[1]) + (pb[2] + pb[3])) * inv_n + EPS); }
                s0[bj] = a; s1[bj] = b; }
            else { s0[bj] = (f32x4){1.f, 1.f, 1.f, 1.f}; s1[bj] = s0[bj]; }
        }
#pragma unroll
        for (int ai = 0; ai < 2; ++ai)
#pragma unroll
            for (int m = 0; m < 4; ++m) {
                bf16_t* rowp = dst + (size_t)(row0 + ai * 128 + m * 16) * ld + col0;
#pragma unroll
                for (int bj = 0; bj < 2; ++bj) {
                    const f32x4 v0 = acc[ai][bj][m][0] * s0[bj], v1 = acc[ai][bj][m][1] * s1[bj];
                    u32x4 w; w.x = cvt_pk_bf16(v0[0], v0[1]); w.y = cvt_pk_bf16(v0[2], v0[3]); w.z = cvt_pk_bf16(v1[0], v1[1]); w.w = cvt_pk_bf16(v1[2], v1[3]);
                    *(u32x4*)(rowp + bj * 128) = w;
                }
            }
    }
};

template <bool ROPE> struct EpiRow {
    static constexpr bool PERM = true, AFTER_DRAIN = false;
    bf16_t* dst; int ld; const float* ss; float inv_n, sc; const f32x2* cs;
    __device__ __forceinline__ void operator()(const f32x4 (&acc)[2][2][4][2], const Unit& u, int wr, int wc, int fr, int fq) const {
        const int row0 = u.pm * 256 + wr * 64 + fr, col0 = u.pn * 256 + wc * 32 + 8 * fq;
#pragma unroll
        for (int ai = 0; ai < 2; ++ai)
#pragma unroll
            for (int m = 0; m < 4; ++m) {
                const int row = row0 + ai * 128 + m * 16; float sq;
                if (ROPE) { const f32x4 pa = *(const f32x4*)(ss + (size_t)row * 16), pb = *(const f32x4*)(ss + (size_t)row * 16 + 4); sq = ((pa[0] + pa[1]) + (pa[2] + pa[3])) + ((pb[0] + pb[1]) + (pb[2] + pb[3])); }
                else { const f32x4 pa = *(const f32x4*)(ss + (size_t)row * 16 + 8); sq = (pa[0] + pa[1]) + (pa[2] + pa[3]); }
                const float rs = rsqrtf(sq * inv_n + EPS) * sc; bf16_t* rowp = dst + (size_t)row * ld + col0;
#pragma unroll
                for (int bj = 0; bj < 2; ++bj) {
                    f32x4 v0 = acc[ai][bj][m][0] * rs, v1 = acc[ai][bj][m][1] * rs; u32x4 w;
                    const int hc = (col0 + bj * 128) % 192;
                    if (ROPE && hc >= 128) {
                        const int j0 = (hc - 128) >> 1, pos = row & (SEQ - 1);
                        const f32x2 c0 = cs[pos * 32 + j0], c1 = cs[pos * 32 + j0 + 1], c2 = cs[pos * 32 + j0 + 2], c3 = cs[pos * 32 + j0 + 3];
                        w.x = cvt_pk_bf16(v0[0] * c0.x - v0[1] * c0.y, v0[0] * c0.y + v0[1] * c0.x);
                        w.y = cvt_pk_bf16(v0[2] * c1.x - v0[3] * c1.y, v0[2] * c1.y + v0[3] * c1.x);
                        w.z = cvt_pk_bf16(v1[0] * c2.x - v1[1] * c2.y, v1[0] * c2.y + v1[1] * c2.x);
                        w.w = cvt_pk_bf16(v1[2] * c3.x - v1[3] * c3.y, v1[2] * c3.y + v1[3] * c3.x);
                    } else { w.x = cvt_pk_bf16(v0[0], v0[1]); w.y = cvt_pk_bf16(v0[2], v0[3]); w.z = cvt_pk_bf16(v1[0], v1[1]); w.w = cvt_pk_bf16(v1[2], v1[3]); }
                    *(u32x4*)(rowp + bj * 128) = w;
                }
            }
    }
};

struct EpiMerge {
    static constexpr bool PERM = true, AFTER_DRAIN = false;
    bf16_t* merged; const bf16_t* gt;
    __device__ __forceinline__ void operator()(const f32x4 (&acc)[2][2][4][2], const Unit& u, int wr, int wc, int fr, int fq) const {
        const int n = u.pm >> 6, pmr = u.pm & 63; const int row0 = pmr * 256 + wr * 64 + fr, col0 = u.pn * 256 + wc * 32 + 8 * fq;
#pragma unroll
        for (int ai = 0; ai < 2; ++ai)
#pragma unroll
            for (int m = 0; m < 4; ++m) {
                const int row = row0 + ai * 128 + m * 16;
#pragma unroll
                for (int bj = 0; bj < 2; ++bj) {
                    const u32x4 gw = *(const u32x4*)(gt + (size_t)row * 6144 + n * 2048 + col0 + bj * 128);
                    bf16_t* mp = merged + (size_t)row * 2048 + col0 + bj * 128;
                    u32x4 pw = (u32x4){0u, 0u, 0u, 0u}; if (n > 0) pw = __builtin_nontemporal_load((const u32x4*)mp);
                    const f32x4 v0 = acc[ai][bj][m][0], v1 = acc[ai][bj][m][1]; u32x4 w;
                    w.x = cvt_pk_bf16(bflo(pw.x) + bflo(gw.x) * v0[0], bfhi(pw.x) + bfhi(gw.x) * v0[1]);
                    w.y = cvt_pk_bf16(bflo(pw.y) + bflo(gw.y) * v0[2], bfhi(pw.y) + bfhi(gw.y) * v0[3]);
                    w.z = cvt_pk_bf16(bflo(pw.z) + bflo(gw.z) * v1[0], bfhi(pw.z) + bfhi(gw.z) * v1[1]);
                    w.w = cvt_pk_bf16(bflo(pw.w) + bflo(gw.w) * v1[2], bfhi(pw.w) + bfhi(gw.w) * v1[3]);
                    *(u32x4*)mp = w;
                }
            }
        asm volatile("s_waitcnt vmcnt(0)" ::: "memory");
    }
};
struct MergeOrder {
    int G, c;
    __device__ bool next(int i, Unit& u) const {
        const int t3 = i / 3, n = i - 3 * t3; const long L = (long)t3 * G + c; if (L >= 512) return false;
        const int tm = (int)(L >> 3), tn = (int)(L & 7); u.pm = n * 64 + tm; u.pn = tn; u.pb = n * 8 + tn; return true;
    }
    __device__ __forceinline__ void a_ready(const Unit&) const {}
    __device__ __forceinline__ void done(const Unit&) const {}
};

struct EpiOut {
    static constexpr bool PERM = false, AFTER_DRAIN = false;
    const float* xin; float* xout;
    __device__ __forceinline__ void operator()(const f32x4 (&acc)[2][2][4][2], const Unit& u, int wr, int wc, int fr, int fq) const {
        const int row0 = u.pm * 256 + wr * 64 + fr, col0 = u.pn * 256 + wc * 32 + 4 * fq;
#pragma unroll
        for (int ai = 0; ai < 2; ++ai)
#pragma unroll
            for (int m = 0; m < 4; ++m) {
                const size_t ro = (size_t)(row0 + ai * 128 + m * 16) * DM + col0;
#pragma unroll
                for (int bj = 0; bj < 2; ++bj)
#pragma unroll
                    for (int n = 0; n < 2; ++n) { const f32x4 b = *(const f32x4*)(xin + ro + bj * 128 + n * 16); *(f32x4*)(xout + ro + bj * 128 + n * 16) = b + acc[ai][bj][m][n]; }
            }
    }
};

template <class F> __device__ __forceinline__ void tconv(unsigned char* lds, const float* src, int ldsrc, int K, bf16_t* dst, int N, const float* gain, F f, const int g_wv) {
    float* tile = (float*)lds; int tid = TIDX; asm volatile("" : "+v"(tid)); const int tilesK = K >> 6, ntile = tilesK * (N >> 8);
    const int nn4 = (tid & 63) * 4, kk0 = tid >> 6; f32x4 pre[8];
#define TCONV_LOAD(tt_) do { const int tn_ = (tt_) / tilesK, tk_ = (tt_) - tn_ * tilesK; const int c0 = f(tn_ * 256 + nn4), c1 = f(tn_ * 256 + nn4 + 1), c2 = f(tn_ * 256 + nn4 + 2), c3 = f(tn_ * 256 + nn4 + 3); \
        const bool vec = (c0 >= 0) && ((c0 & 3) == 0) && (c3 == c0 + 3); const float* sp = src + (size_t)(tk_ * 64 + kk0) * ldsrc; \
        _Pragma("unroll") for (int e = 0; e < 8; ++e) { const float* rp = sp + (size_t)(8 * e) * ldsrc; f32x4 v; \
            if (vec) v = *(const f32x4*)(rp + c0); \
            else { v[0] = c0 >= 0 ? rp[c0] : 0.f; v[1] = c1 >= 0 ? rp[c1] : 0.f; v[2] = c2 >= 0 ? rp[c2] : 0.f; v[3] = c3 >= 0 ? rp[c3] : 0.f; } \
            pre[e] = v; } } while (0)
    int t = blockIdx.x;
    if (t < ntile) TCONV_LOAD(t);
    for (; t < ntile; t += gridDim.x) {
        const int tn = t / tilesK, tk = t - tn * tilesK;
#pragma unroll
        for (int e = 0; e < 8; ++e) { f32x4 v = pre[e]; if (gain) v = v * gain[tk * 64 + kk0 + 8 * e]; *(f32x4*)(tile + (kk0 + 8 * e) * 260 + nn4) = v; }
        __syncthreads();
        { const int t2 = t + (int)gridDim.x; if (t2 < ntile) TCONV_LOAD(t2); }
        { const int nn = tid >> 1, kc = (tid & 1) * 32; bf16_t* dp = dst + (size_t)(tn * 256 + nn) * K + tk * 64 + kc;
#pragma unroll
          for (int q4 = 0; q4 < 4; ++q4) { float v[8];
#pragma unroll
              for (int i = 0; i < 8; ++i) v[i] = tile[(kc + q4 * 8 + i) * 260 + nn];
              u32x4 w; w.x = cvt_pk_bf16(v[0], v[1]); w.y = cvt_pk_bf16(v[2], v[3]); w.z = cvt_pk_bf16(v[4], v[5]); w.w = cvt_pk_bf16(v[6], v[7]);
              *(u32x4*)(dp + q4 * 8) = w; } }
        __syncthreads();
    }
#undef TCONV_LOAD
}
__device__ __forceinline__ int win_src_col(int n) {
    if (n < 1024) return n;
    if (n < 2048) return 1024 + (n - 1024);
    if (n < 3072) return 3072 + (n - 2048);
    if (n < 3584) return 4096 + (n - 3072);
    if (n < 4096) return 4608 + (n - 3584);
    if (n < 5120) return 5120 + (n - 4096);
    if (n < 6144) return 6152 + (n - 5120);
    if (n < 7168) return 7176 + (n - 6144);
    if (n < 7680) return 8200 + (n - 7168);
    if (n < 7936) return 8712 + (n - 7680);
    if (n < 8960) return 9032 + (n - 7936);
    if (n < 15104) return 10056 + (n - 8960);
    if (n < 15360) { const int r = n - 15104; if (r < 4) return 6144 + r; if (r < 8) return 6148 + (r - 4); if (r < 72) { const int j = (r - 8) >> 1, odd = (r - 8) & 1; return 8968 + j + 32 * odd; } return -1; }
    return 2048 + (n - 15360);
}
__device__ __forceinline__ void convert_weights(unsigned char* lds, const Params& p, int l, const int g_wv) {
    unsigned char* wl = p.ws + WS_W0 + (size_t)l * WL_SIZE;
    tconv(lds, p.w_in + (size_t)l * DM * DIN, DIN, DM, (bf16_t*)(wl + WL_WIN), 16384, nullptr, [](int n) { return win_src_col(n); }, g_wv);
#pragma unroll 1
    for (int n = 0; n < 3; ++n)
        tconv(lds, p.w_branch + ((size_t)l * 3 + n) * 1024 * DM, DM, 1024, (bf16_t*)(wl + WL_WB) + (size_t)n * 2048 * 1024, 2048, nullptr, [](int c) { return c; }, g_wv);
    tconv(lds, p.w_out + (size_t)l * DM * DM, DM, DM, (bf16_t*)(wl + WL_WO), DM, nullptr, [](int c) { return c; }, g_wv);
    tconv(lds, p.w_uq + (size_t)l * 512 * 1536, 1536, 512, (bf16_t*)(wl + WL_WUQ), 1536, p.q_norm + l * 512,
          [](int n) { const int h = n / 192, hc = n - h * 192; if (hc < 128) return n; const int r = hc - 128; return h * 192 + 128 + (r >> 1) + 32 * (r & 1); }, g_wv);
    tconv(lds, p.w_ukv + (size_t)l * 256 * 2048, 2048, 256, (bf16_t*)(wl + WL_WKN), 1024, p.kv_norm + l * 256, [](int n) { return (n >> 7) * 256 + (n & 127); }, g_wv);
    tconv(lds, p.w_ukv + (size_t)l * 256 * 2048, 2048, 256, (bf16_t*)(wl + WL_WV), 1024, p.kv_norm + l * 256, [](int n) { return (n >> 7) * 256 + 128 + (n & 127); }, g_wv);
}
__device__ __forceinline__ void sincos_acc(float ang, float& s, float& c) {
    const double x = (double)ang; const double q = rint(x * 0.63661977236758134308);
    double r = fma(-q, 1.57079632679489655800e+00, x); r = fma(-q, 6.12323399573676603587e-17, r);
    const int qi = ((int)q) & 3; const double r2 = r * r;
    const double sp = r + r * r2 * (-1.66666666666666324348e-01 + r2 * (8.33333333332248946124e-03 + r2 * (-1.98412698298579493134e-04 + r2 * (2.75573137070700676789e-06 + r2 * (-2.50507602534068634195e-08 + r2 * 1.58969099521155010221e-10)))));
    const double cp = 1.0 - 0.5 * r2 + r2 * r2 * (4.16666666666666019037e-02 + r2 * (-1.38888888888741095749e-03 + r2 * (2.48015872894767294178e-05 + r2 * (-2.75573143513906633035e-07 + r2 * (2.08757232129817482790e-09 + r2 * -1.13596475577881948265e-11)))));
    double ss, cc; if (qi == 0) { ss = sp; cc = cp; } else if (qi == 1) { ss = cp; cc = -sp; } else if (qi == 2) { ss = -sp; cc = -cp; } else { ss = -cp; cc = sp; }
    s = (float)ss; c = (float)cc;
}
__device__ __forceinline__ void build_cs(const Params& p, const int g_wv) {
    f32x2* cs = (f32x2*)(p.ws + WS_CS);
    int i0 = blockIdx.x * NTHR + TIDX; asm volatile("" : "+v"(i0));
    for (int i = i0; i < SEQ * 32; i += gridDim.x * NTHR) {
        const int pos = i >> 5, j = i & 31; double inv = 1.0; for (int k = 0; k < j; ++k) inv *= 0.7498942093324558;
        const float ang = (float)pos * (float)inv; float s, c; sincos_acc(ang, s, c); cs[i] = (f32x2){c, s};
    }
}
__device__ __forceinline__ void zero_ss(const Params& p, const int g_wv) {
    float* a = (float*)(p.ws + WS_SSQ);
    int i0 = blockIdx.x * NTHR + TIDX; asm volatile("" : "+v"(i0));
    for (int i = i0; i < 2 * T; i += gridDim.x * NTHR) a[i] = 0.f;
}
template <bool OUTBF> __device__ __forceinline__ void rmsnorm_rows(const float* x, const float* gain, bf16_t* hb, float* of, const int g_wv) {
    int tid = TIDX; asm volatile("" : "+v"(tid)); const int lane = tid & 63, gw = blockIdx.x * (NTHR / 64) + (tid >> 6), nw = gridDim.x * (NTHR / 64);
    for (int row = gw; row < T; row += nw) {
        const float* xr = x + (size_t)row * DM; f32x4 v[8]; float ss = 0.f;
#pragma unroll
        for (int i = 0; i < 8; ++i) { v[i] = *(const f32x4*)(xr + i * 256 + lane * 4); ss += (v[i][0] * v[i][0] + v[i][1] * v[i][1]) + (v[i][2] * v[i][2] + v[i][3] * v[i][3]); }
#pragma unroll
        for (int o = 1; o < 64; o <<= 1) ss += shx(ss, o, lane);
        const float rs = rsqrtf(ss * (1.0f / DM) + EPS);
#pragma unroll
        for (int i = 0; i < 8; ++i) {
            const f32x4 gn = *(const f32x4*)(gain + i * 256 + lane * 4); const f32x4 y = v[i] * rs * gn;
            if (OUTBF) { u32x2 w; w.x = cvt_pk_bf16(y[0], y[1]); w.y = cvt_pk_bf16(y[2], y[3]); *(u32x2*)(hb + (size_t)row * DM + i * 256 + lane * 4) = w; }
            else *(f32x4*)(of + (size_t)row * DM + i * 256 + lane * 4) = y;
        }
    }
}

__device__ __forceinline__ void kmean_phase(const Params& p, int l, const int g_wv) {
    const bf16_t* ka = (const bf16_t*)(p.ws + WS_KA); bf16_t* km = (bf16_t*)(p.ws + WS_KM); bf16_t* kml = (bf16_t*)(p.ws + WS_SSQ); int tid = TIDX; asm volatile("" : "+v"(tid));
    for (int u = blockIdx.x; u < 64; u += gridDim.x) {
        const int b = u >> 4, j = u & 15; const unsigned* src = (const unsigned*)(ka + ((size_t)b * SEQ + j * 256) * 1024) + tid; float a0 = 0.f, a1 = 0.f;
#pragma unroll 8
        for (int r = 0; r < 256; ++r) { const unsigned w = src[(size_t)r * 512]; a0 += bflo(w); a1 += bfhi(w); }
        const int col = tid * 2, h = col >> 7, d = col & 127;
        const float m0 = a0 * (1.0f / 256.0f), m1 = a1 * (1.0f / 256.0f); const unsigned hi = cvt_pk_bf16(m0, m1);
        *(unsigned*)(km + ((size_t)((b * 8 + h) * 16 + j)) * 128 + d) = hi;
        *(unsigned*)(kml + ((size_t)((b * 8 + h) * 16 + j)) * 128 + d) = cvt_pk_bf16(m0 - bflo(hi), m1 - bfhi(hi));
    }
}

template <int MODE> __device__ __forceinline__ void attn_phase(unsigned char* lds, const Params& p, int l, const int g_wv) {
    constexpr int DQK = MODE ? 192 : 128, NC = DQK / 32, NCH = DQK / 8, KRS = DQK * 2 + 32, KBUF = 64 * KRS, VRS = 144, VBUF = 128 * VRS;
    constexpr int OFF_V = 2 * KBUF, OFF_LUT = OFF_V + 2 * VBUF, OFF_KM = OFF_LUT + 512, NKL = (64 * NCH) / NTHR;
    int tid = TIDX; asm volatile("" : "+v"(tid)); const int lane = tid & 63, w = tid >> 6, lr = lane & 15, g = lane >> 4; const int G = gridDim.x, c = blockIdx.x;
    unsigned char* ws = p.ws;
    const bf16_t* Qp = (const bf16_t*)(ws + (MODE ? WS_QC : WS_QA)); constexpr int LDQ = MODE ? 1536 : 1024;
    const bf16_t* Kp = (const bf16_t*)(ws + (MODE ? WS_KNC : WS_KA)); const bf16_t* KRp = (const bf16_t*)(ws + WS_KR);
    const bf16_t* VTp = (const bf16_t*)(ws + (MODE ? WS_VCT : WS_VAT)); bf16_t* Zp = (bf16_t*)(ws + WS_Z + (MODE ? 64 * MiB : 0));
    float* lut = (float*)(lds + OFF_LUT);
    for (int rd = 0; rd * G < 512; ++rd) {
        int qblk, bh;
        if (G == 256) {
            const int xq = c & 7, iq = c >> 3, qq = iq >> 1;
            bh = 2 * xq + (iq & 1) + 16 * rd; qblk = rd ? qq : 15 - qq;
        } else { const int idx = rd * G + ((rd & 1) ? (G - 1 - c) : c); if (idx >= 512) continue; qblk = 15 - (idx >> 5); bh = idx & 31; }
        const int b = bh >> 3, h = bh & 7;
        const int q0 = qblk * 256 + w * 32; const size_t tq = (size_t)b * SEQ + q0; const int nt = (qblk + 1) * 4;
        bf16x8 qf[2][NC];
#pragma unroll
        for (int qb = 0; qb < 2; ++qb)
#pragma unroll
            for (int c2 = 0; c2 < NC; ++c2) qf[qb][c2] = *(const bf16x8*)(Qp + (tq + qb * 16 + lr) * LDQ + h * DQK + c2 * 32 + g * 8);
        u32x4 kreg[NKL];
#define ATT_LOADK(t_) do { const int t__ = (t_); \
        _Pragma("unroll") for (int i = 0; i < NKL; ++i) { const int id = tid + NTHR * i; const int key = id / NCH, ch = id - key * NCH; const size_t tk = (size_t)b * SEQ + t__ * 64 + key; \
            const bf16_t* s_ = (!MODE || ch < 16) ? (Kp + tk * 1024 + h * 128 + ch * 8) : (KRp + tk * 64 + (ch - 16) * 8); kreg[i] = *(const u32x4*)s_; } } while (0)
#define ATT_LOADV(t_) do { const int t__ = (t_); \
        _Pragma("unroll") for (int i = 0; i < 2; ++i) { const int id = tid + NTHR * i; const int row = id >> 3, ch = id & 7; \
            kreg[i] = *(const u32x4*)(VTp + (size_t)(h * 128 + row) * T + (size_t)b * SEQ + t__ * 64 + ch * 8); } } while (0)
#define ATT_STOREK(buf_) do { unsigned char* kb_ = lds + (buf_) * KBUF; \
        _Pragma("unroll") for (int i = 0; i < NKL; ++i) { const int id = tid + NTHR * i; const int key = id / NCH, ch = id - key * NCH; *(u32x4*)(kb_ + key * KRS + ch * 16) = kreg[i]; } } while (0)
#define ATT_STOREV(buf_) do { unsigned char* vb_ = lds + OFF_V + (buf_) * VBUF; \
        _Pragma("unroll") for (int i = 0; i < 2; ++i) { const int id = tid + NTHR * i; const int row = id >> 3, ch = id & 7; *(u32x4*)(vb_ + row * VRS + ch * 16) = kreg[i]; } } while (0)
        ATT_LOADK(0); ATT_STOREK(0); ATT_LOADV(0);
        unsigned sel[2] = {0u, 0u};
        if (MODE == 0) {
            if (tid < 128) { const int d = tid; int bk = d; if (d >= 16) { bk = 16 + (int)(logf((float)d * (1.0f / 16.0f)) / 2.0794415416798357f * 16.0f); bk = bk > 31 ? 31 : bk; } lut[d] = p.t5[bk * 8 + h] * LOG2E; }
            { const int half = tid >> 8, row = (tid >> 4) & 15, ch = tid & 15; *(u32x4*)(lds + OFF_KM + half * 4608 + row * 288 + ch * 16) = *(const u32x4*)((const bf16_t*)(ws + (half ? WS_SSQ : WS_KM)) + ((size_t)((b * 8 + h) * 16 + row)) * 128 + ch * 8); }
        }
        ATT_STOREV(0);
        __syncthreads();
        if (MODE == 0) {
            f32x4 ga[2] = {zero4(), zero4()};
#pragma unroll
            for (int c2 = 0; c2 < NC; ++c2) { const bf16x8 kf = *(const bf16x8*)(lds + OFF_KM + lr * 288 + c2 * 64 + g * 16), kfl = *(const bf16x8*)(lds + OFF_KM + 4608 + lr * 288 + c2 * 64 + g * 16);
#pragma unroll
                for (int qb = 0; qb < 2; ++qb) { const bf16x8 ql = *(const bf16x8*)((const bf16_t*)(ws + WS_QAL) + (tq + qb * 16 + lr) * 1024 + h * 128 + c2 * 32 + g * 8);
                    ga[qb] = mfma16(kfl, qf[qb][c2], ga[qb]); ga[qb] = mfma16(kf, ql, ga[qb]); ga[qb] = mfma16(kf, qf[qb][c2], ga[qb]); } }
#pragma unroll
            for (int qb = 0; qb < 2; ++qb) {
                float gv[4];
#pragma unroll
                for (int r = 0; r < 4; ++r) gv[r] = (g * 4 + r < qblk) ? ga[qb][r] : -INFINITY;
                unsigned s = 0u;
#pragma unroll
                for (int it = 0; it < 3; ++it) {
                    float bv = -INFINITY; int bi = 99;
#pragma unroll
                    for (int r = 0; r < 4; ++r) if (gv[r] > bv) { bv = gv[r]; bi = g * 4 + r; }
#pragma unroll
                    for (int o = 16; o <= 32; o <<= 1) { const float ov = shx(bv, o, lane); const int oi = shxi(bi, o, lane); if (ov > bv || (ov == bv && oi < bi)) { bv = ov; bi = oi; } }
                    if (bv > -INFINITY) s |= 1u << bi;
#pragma unroll
                    for (int r = 0; r < 4; ++r) if (g * 4 + r == bi) gv[r] = -INFINITY;
                }
                sel[qb] = s;
            }
        }
        f32x4 oacc[8][2];
#pragma unroll
        for (int i = 0; i < 8; ++i) { oacc[i][0] = zero4(); oacc[i][1] = zero4(); }
        float mrow[2] = {NEGV, NEGV}, lrow[2] = {0.f, 0.f};
        for (int t = 0; t < nt; ++t) {
            const int buf = t & 1; const bool more = (t + 1 < nt);
            if (more) ATT_LOADK(t + 1);
            const int k0 = t * 64;
            const unsigned char* kb_ = lds + buf * KBUF; const unsigned char* vb_ = lds + OFF_V + buf * VBUF;
#pragma unroll 1
            for (int hf = 0; hf < 2; ++hf) {
              const int kh = k0 + hf * 32;
              if (kh <= q0 + 31) {
                f32x4 sacc[2][2];
#pragma unroll
                for (int kb = 0; kb < 2; ++kb) { sacc[kb][0] = zero4(); sacc[kb][1] = zero4(); }
#pragma unroll
                for (int c2 = 0; c2 < NC; ++c2)
#pragma unroll
                    for (int kb = 0; kb < 2; ++kb) { const bf16x8 kf = *(const bf16x8*)(kb_ + (hf * 32 + kb * 16 + lr) * KRS + c2 * 64 + g * 16);
                        sacc[kb][0] = mfma16(kf, qf[0][c2], sacc[kb][0]); sacc[kb][1] = mfma16(kf, qf[1][c2], sacc[kb][1]); }
                if (MODE == 0) {
                    const int jblk = t >> 2; const bool far = (kh + 31 + 127 <= q0);
                    if (far) { const float bfar = lut[127];
#pragma unroll
                        for (int qb = 0; qb < 2; ++qb) { const bool al = (jblk < qblk) ? (((sel[qb] >> jblk) & 1u) != 0u) : true;
#pragma unroll
                            for (int kb = 0; kb < 2; ++kb)
#pragma unroll
                                for (int r = 0; r < 4; ++r) sacc[kb][qb][r] = al ? sacc[kb][qb][r] + bfar : NEGV; }
                    } else {
#pragma unroll
                        for (int qb = 0; qb < 2; ++qb) { const int qpos = q0 + qb * 16 + lr; const bool alp = (sel[qb] >> jblk) & 1u;
#pragma unroll
                            for (int kb = 0; kb < 2; ++kb)
#pragma unroll
                                for (int r = 0; r < 4; ++r) { const int d = qpos - (kh + kb * 16 + g * 4 + r); const int di = d < 0 ? 0 : (d > 127 ? 127 : d);
                                    const bool al = (jblk < qblk) ? alp : (d >= 0); sacc[kb][qb][r] = al ? sacc[kb][qb][r] + lut[di] : NEGV; } }
                    }
                } else {
                    if (kh + 31 > q0) {
#pragma unroll
                        for (int qb = 0; qb < 2; ++qb) { const int qpos = q0 + qb * 16 + lr;
#pragma unroll
                            for (int kb = 0; kb < 2; ++kb)
#pragma unroll
                                for (int r = 0; r < 4; ++r) if (kh + kb * 16 + g * 4 + r > qpos) sacc[kb][qb][r] = NEGV; }
                    }
                }
                bf16x8 pf[2];
#pragma unroll
                for (int qb = 0; qb < 2; ++qb) {
                    float mx = NEGV;
#pragma unroll
                    for (int kb = 0; kb < 2; ++kb)
#pragma unroll
                        for (int r = 0; r < 4; ++r) mx = fmaxf(mx, sacc[kb][qb][r]);
                    mx = fmaxf(mx, shx(mx, 16, lane)); mx = fmaxf(mx, shx(mx, 32, lane));
                    const float mnew = fmaxf(mrow[qb], mx), alpha = fexp2(mrow[qb] - mnew); mrow[qb] = mnew; float ps = 0.f;
#pragma unroll
                    for (int kb = 0; kb < 2; ++kb)
#pragma unroll
                        for (int r = 0; r < 4; ++r) { const float e = fexp2(sacc[kb][qb][r] - mnew); sacc[kb][qb][r] = e; ps += e; }
                    lrow[qb] = lrow[qb] * alpha + ps;
#pragma unroll
                    for (int i = 0; i < 8; ++i) oacc[i][qb] = oacc[i][qb] * alpha;
                    union { u32x4 u; bf16x8 v; } cvt;
                    cvt.u.x = cvt_pk_bf16(sacc[0][qb][0], sacc[0][qb][1]); cvt.u.y = cvt_pk_bf16(sacc[0][qb][2], sacc[0][qb][3]);
                    cvt.u.z = cvt_pk_bf16(sacc[1][qb][0], sacc[1][qb][1]); cvt.u.w = cvt_pk_bf16(sacc[1][qb][2], sacc[1][qb][3]); pf[qb] = cvt.v;
                }
#pragma unroll
                for (int dvb = 0; dvb < 8; ++dvb) { union { u32x2 u[2]; bf16x8 v; } vf; const unsigned char* vp = vb_ + (dvb * 16 + lr) * VRS + (hf * 32 + g * 4) * 2;
                    vf.u[0] = *(const u32x2*)vp; vf.u[1] = *(const u32x2*)(vp + 32);
                    oacc[dvb][0] = mfma16(vf.v, pf[0], oacc[dvb][0]); oacc[dvb][1] = mfma16(vf.v, pf[1], oacc[dvb][1]); }
              }
              if (more) { if (hf == 0) { ATT_STOREK(buf ^ 1); ATT_LOADV(t + 1); } else { ATT_STOREV(buf ^ 1); } }
            }
            __syncthreads();
        }
#pragma unroll
        for (int qb = 0; qb < 2; ++qb) {
            float l = lrow[qb]; l += shx(l, 16, lane); l += shx(l, 32, lane); const float inv = 1.0f / l;
            bf16_t* zr = Zp + (tq + qb * 16 + lr) * 1024 + h * 128 + g * 4;
#pragma unroll
            for (int dvb = 0; dvb < 8; ++dvb) { const u32x2 zw = *(const u32x2*)(zr + dvb * 16); const f32x4 o = oacc[dvb][qb] * inv; u32x2 ow;
                ow.x = cvt_pk_bf16(o[0] * bflo(zw.x), o[1] * bfhi(zw.x)); ow.y = cvt_pk_bf16(o[2] * bflo(zw.y), o[3] * bfhi(zw.y)); *(u32x2*)(zr + dvb * 16) = ow; }
        }
#undef ATT_LOADK
#undef ATT_LOADV
#undef ATT_STOREK
#undef ATT_STOREV
    }
}

__device__ __forceinline__ void mlstm_a(unsigned char* lds, const Params& p, int l, const int g_wv) {
    constexpr int K2RS = 272, TRS = 160; constexpr int OFF_K2 = 0, OFF_WKT = 64 * K2RS, OFF_VT = OFF_WKT + 128 * TRS, OFF_WG = OFF_VT + 256 * TRS;
    unsigned char* ws = p.ws; int tid = TIDX; asm volatile("" : "+v"(tid)); const int lane = tid & 63, w = tid >> 6, lr = lane & 15, g = lane >> 4;
    const bf16_t* QB = (const bf16_t*)(ws + WS_QB); const bf16_t* KB = (const bf16_t*)(ws + WS_KB); const bf16_t* VB = (const bf16_t*)(ws + WS_VB);
    bf16_t* Q2 = (bf16_t*)(ws + WS_Q2); bf16_t* K2 = (bf16_t*)(ws + WS_K2); const float* gates = (const float*)(ws + WS_GATES);
    const float* cw = p.conv_w + (size_t)l * 4 * 1024; const float* cb = p.conv_b + (size_t)l * 1024;
    float* wg = (float*)(lds + OFF_WG);
    for (int u = blockIdx.x; u < 1024; u += gridDim.x) {
        const int bh = u >> 6, c = u & 63, b = bh >> 2, h = bh & 3; const size_t t0 = (size_t)b * SEQ + c * 64;
#pragma unroll 1
        for (int it = 0; it < 4; ++it) {
            const int item = tid + NTHR * it, which = item >> 10, s = (item >> 4) & 63, grp = item & 15; const int ch0 = h * 128 + grp * 8, cc0 = which * 512 + ch0;
            const bf16_t* src = which ? KB : QB; float a[8];
            { const f32x4 b0 = *(const f32x4*)(cb + cc0), b1 = *(const f32x4*)(cb + cc0 + 4); a[0] = b0[0]; a[1] = b0[1]; a[2] = b0[2]; a[3] = b0[3]; a[4] = b1[0]; a[5] = b1[1]; a[6] = b1[2]; a[7] = b1[3]; }
#pragma unroll
            for (int j = 0; j < 4; ++j) { const int tp = c * 64 + s - 3 + j;
                if (tp >= 0) { const u32x4 xw = *(const u32x4*)(src + ((size_t)b * SEQ + tp) * 512 + ch0); const f32x4 w0 = *(const f32x4*)(cw + j * 1024 + cc0), w1 = *(const f32x4*)(cw + j * 1024 + cc0 + 4);
                    a[0] += bflo(xw.x) * w0[0]; a[1] += bfhi(xw.x) * w0[1]; a[2] += bflo(xw.y) * w0[2]; a[3] += bfhi(xw.y) * w0[3];
                    a[4] += bflo(xw.z) * w1[0]; a[5] += bfhi(xw.z) * w1[1]; a[6] += bflo(xw.w) * w1[2]; a[7] += bfhi(xw.w) * w1[3]; } }
            const float ksc = which ? 0.08838834764831845f : 1.0f;
#pragma unroll
            for (int i = 0; i < 8; ++i) a[i] = fsilu(a[i]) * ksc;
            u32x4 ow; ow.x = cvt_pk_bf16(a[0], a[1]); ow.y = cvt_pk_bf16(a[2], a[3]); ow.z = cvt_pk_bf16(a[4], a[5]); ow.w = cvt_pk_bf16(a[6], a[7]);
            *(u32x4*)((which ? K2 : Q2) + (t0 + s) * 512 + ch0) = ow;
            if (which) *(u32x4*)(lds + OFF_K2 + s * K2RS + grp * 16) = ow;
        }
        if (w == 0) {
            const float fpre = gates[(t0 + lane) * 8 + 4 + h] + p.f_bias[l * 4 + h]; const float li = gates[(t0 + lane) * 8 + h] + p.i_bias[l * 4 + h];
            const float lf = fminf(fpre, 0.f) - log1pf(__expf(-fabsf(fpre)));
            float bc = lf;
#pragma unroll
            for (int o = 1; o < 64; o <<= 1) { const float v = shup(bc, o, lane); if (lane >= o) bc += v; }
            const float blast = __int_as_float(__builtin_amdgcn_readlane(__float_as_int(bc), 63)); const float gg = blast - bc + li; float gm = gg;
#pragma unroll
            for (int o = 1; o < 64; o <<= 1) gm = fmaxf(gm, shx(gm, o, lane));
            wg[lane] = __expf(gg - gm);
            ((float*)(ws + WS_BV))[(size_t)u * 64 + lane] = bc; ((float*)(ws + WS_LIV))[(size_t)u * 64 + lane] = li;
            if (lane == 0) { ((float*)(ws + WS_BLAST))[u] = blast; ((float*)(ws + WS_GMAX))[u] = gm; }
        }
#pragma unroll
        for (int it = 0; it < 4; ++it) { const int item = tid + NTHR * it, s = item & 63, eg = item >> 6; const u32x4 vw = *(const u32x4*)(VB + (t0 + s) * 1024 + h * 256 + eg * 8);
            bf16_t* d = (bf16_t*)(lds + OFF_VT + (eg * 8) * TRS + s * 2); const unsigned vv[4] = {vw.x, vw.y, vw.z, vw.w};
#pragma unroll
            for (int i = 0; i < 4; ++i) { *(bf16_t*)((unsigned char*)d + (2 * i) * TRS) = (bf16_t)(vv[i] & 0xffffu); *(bf16_t*)((unsigned char*)d + (2 * i + 1) * TRS) = (bf16_t)(vv[i] >> 16); } }
        __syncthreads();
#pragma unroll 1
        for (int it = 0; it < 2; ++it) { const int item = tid + NTHR * it, s = item & 63, dg = item >> 6; const u32x4 kw = *(const u32x4*)(lds + OFF_K2 + s * K2RS + dg * 16); const float ww = wg[s];
            const unsigned kv[4] = {kw.x, kw.y, kw.z, kw.w}; unsigned char* d = lds + OFF_WKT + (dg * 8) * TRS + s * 2;
#pragma unroll
            for (int i = 0; i < 4; ++i) { *(bf16_t*)(d + (2 * i) * TRS) = f2bf(bflo(kv[i]) * ww); *(bf16_t*)(d + (2 * i + 1) * TRS) = f2bf(bfhi(kv[i]) * ww); } }
        __syncthreads();
#if defined(MK_DEBUG_HASH)
        { unsigned char* dbg = ws + WS_END + MiB + (size_t)u * 40960; for (int i = tid; i < 2560; i += NTHR) *(u32x4*)(dbg + i * 16) = *(const u32x4*)(lds + OFF_VT + i * 16); }
#endif
        if (tid < 128) { float a = 0.f; const unsigned char* r = lds + OFF_WKT + tid * TRS;
#pragma unroll
            for (int i = 0; i < 8; ++i) { const u32x4 x = *(const u32x4*)(r + i * 16); a += (bflo(x.x) + bfhi(x.x)) + (bflo(x.y) + bfhi(x.y)) + (bflo(x.z) + bfhi(x.z)) + (bflo(x.w) + bfhi(x.w)); }
            ((float*)(ws + WS_NST))[(size_t)u * 128 + tid] = a; }
        f32x4 acc[8][2];
#pragma unroll
        for (int i = 0; i < 8; ++i) { acc[i][0] = zero4(); acc[i][1] = zero4(); }
#pragma unroll
        for (int kc = 0; kc < 2; ++kc) {
            const bf16x8 v0 = *(const bf16x8*)(lds + OFF_VT + (w * 32 + lr) * TRS + kc * 64 + g * 16), v1 = *(const bf16x8*)(lds + OFF_VT + (w * 32 + 16 + lr) * TRS + kc * 64 + g * 16);
#pragma unroll
            for (int db = 0; db < 8; ++db) { const bf16x8 kf = *(const bf16x8*)(lds + OFF_WKT + (db * 16 + lr) * TRS + kc * 64 + g * 16); acc[db][0] = mfma16(kf, v0, acc[db][0]); acc[db][1] = mfma16(kf, v1, acc[db][1]); }
        }
        bf16_t* cst = (bf16_t*)(ws + WS_CST) + (size_t)u * 32768; float one = 1.0f; asm volatile("" : "+v"(one));
#pragma unroll
        for (int eb = 0; eb < 2; ++eb)
#pragma unroll
            for (int db = 0; db < 8; ++db) { const f32x4 av = acc[db][eb] * one; u32x2 o; o.x = cvt_pk_bf16(av[0], av[1]); o.y = cvt_pk_bf16(av[2], av[3]); *(u32x2*)(cst + (size_t)(w * 32 + eb * 16 + lr) * 128 + db * 16 + g * 4) = o; }
        __syncthreads();
    }
}
__device__ __forceinline__ void mlstm_b(const Params& p, const int g_wv) {
    unsigned char* ws = p.ws; int tid = TIDX; asm volatile("" : "+v"(tid)); const float* blast = (const float*)(ws + WS_BLAST); const float* gmax = (const float*)(ws + WS_GMAX);
    for (int u = blockIdx.x; u < 256; u += gridDim.x) {
        const int bh = u >> 4, eb = u & 15; bf16_t* base = (bf16_t*)(ws + WS_CST) + (size_t)bh * 64 * 32768 + eb * 2048 + tid * 4;
        float* nb = (float*)(ws + WS_NST) + (size_t)bh * 64 * 128 + tid; const bool don = (eb == 0 && tid < 128);
        float m = 0.f, c0 = 0.f, c1 = 0.f, c2 = 0.f, c3 = 0.f, nn = 0.f;
#pragma unroll 16
        for (int c = 0; c < 64; ++c) {
            const float bl = blast[bh * 64 + c], gm = gmax[bh * 64 + c]; const float mn = fmaxf(bl + m, gm); const float dec = __expf(bl + m - mn), inw = __expf(gm - mn);
            u32x2* sp = (u32x2*)(base + (size_t)c * 32768); const u32x2 uw = *sp; u32x2 o; o.x = cvt_pk_bf16(c0, c1); o.y = cvt_pk_bf16(c2, c3); *sp = o;
            c0 = dec * c0 + inw * bflo(uw.x); c1 = dec * c1 + inw * bfhi(uw.x); c2 = dec * c2 + inw * bflo(uw.y); c3 = dec * c3 + inw * bfhi(uw.y);
            if (don) { const float nu = nb[c * 128]; nb[c * 128] = nn; nn = dec * nn + inw * nu; }
            if (eb == 0 && tid == 0) ((float*)(ws + WS_MST))[bh * 64 + c] = m;
            m = mn;
        }
    }
}
__device__ __forceinline__ void mlstm_c(unsigned char* lds, const Params& p, int l, const int g_wv) {
    constexpr int QRS = 288, TRS = 160; constexpr int OFF_Q = 0, OFF_K = 64 * QRS, OFF_VT = 2 * 64 * QRS, OFF_P = OFF_VT + 256 * TRS, OFF_F = OFF_P + 64 * TRS;
    unsigned char* ws = p.ws; int tid = TIDX; asm volatile("" : "+v"(tid)); const int lane = tid & 63, w = tid >> 6, lr = lane & 15, g = lane >> 4;
    const bf16_t* Q2 = (const bf16_t*)(ws + WS_Q2); const bf16_t* K2 = (const bf16_t*)(ws + WS_K2); const bf16_t* VB = (const bf16_t*)(ws + WS_VB);
    const bf16_t* OB = (const bf16_t*)(ws + WS_OB); bf16_t* ZB = (bf16_t*)(ws + WS_Z + 32 * MiB); const float* gn = p.out_norm + (size_t)l * 1024;
    float* fb = (float*)(lds + OFF_F); float* bvec = fb; float* livec = fb + 64; float* mt = fb + 128; float* wint = fb + 192; float* denV = fb + 256; float* denC = fb + 320; float* lsum = fb + 384; float* lsq = fb + 448; float* nvec = fb + 512;
    for (int u = blockIdx.x; u < 1024; u += gridDim.x) {
        const int bh = u >> 6, c = u & 63, b = bh >> 2, h = bh & 3; const size_t t0 = (size_t)b * SEQ + c * 64; const float mc = ((const float*)(ws + WS_MST))[u];
#pragma unroll
        for (int it = 0; it < 2; ++it) { const int id = tid + NTHR * it, s = id >> 4, ch = id & 15;
            *(u32x4*)(lds + OFF_Q + s * QRS + ch * 16) = *(const u32x4*)(Q2 + (t0 + s) * 512 + h * 128 + ch * 8); *(u32x4*)(lds + OFF_K + s * QRS + ch * 16) = *(const u32x4*)(K2 + (t0 + s) * 512 + h * 128 + ch * 8); }
#pragma unroll 2
        for (int it = 0; it < 4; ++it) { const int item = tid + NTHR * it, s = item & 63, eg = item >> 6; const u32x4 vw = *(const u32x4*)(VB + (t0 + s) * 1024 + h * 256 + eg * 8);
            unsigned char* d = lds + OFF_VT + (eg * 8) * TRS + s * 2; const unsigned vv[4] = {vw.x, vw.y, vw.z, vw.w};
#pragma unroll
            for (int i = 0; i < 4; ++i) { *(bf16_t*)(d + (2 * i) * TRS) = (bf16_t)(vv[i] & 0xffffu); *(bf16_t*)(d + (2 * i + 1) * TRS) = (bf16_t)(vv[i] >> 16); } }
        if (tid < 64) { bvec[tid] = ((const float*)(ws + WS_BV))[(size_t)u * 64 + tid]; livec[tid] = ((const float*)(ws + WS_LIV))[(size_t)u * 64 + tid]; lsum[tid] = 0.f; lsq[tid] = 0.f; }
        else if (tid < 192) nvec[tid - 64] = ((const float*)(ws + WS_NST))[(size_t)u * 128 + tid - 64];
        __syncthreads();
        if (w == 0) { float x = livec[lane] - bvec[lane];
#pragma unroll
            for (int o = 1; o < 64; o <<= 1) { const float v = shup(x, o, lane); if (lane >= o) x = fmaxf(x, v); }
            const float mtl = bvec[lane] + fmaxf(mc, x); mt[lane] = mtl; wint[lane] = __expf(bvec[lane] + mc - mtl); }
        __syncthreads();
        { const int lb = w >> 1;
#pragma unroll
          for (int si = 0; si < 2; ++si) { const int sb = (w & 1) * 2 + si; f32x4 a = zero4();
            if (sb <= lb) {
#pragma unroll
                for (int kc = 0; kc < 4; ++kc) { const bf16x8 qf = *(const bf16x8*)(lds + OFF_Q + (lb * 16 + lr) * QRS + kc * 64 + g * 16), kf = *(const bf16x8*)(lds + OFF_K + (sb * 16 + lr) * QRS + kc * 64 + g * 16); a = mfma16(qf, kf, a); }
            }
            const int s = sb * 16 + lr; const float bs = bvec[s] - livec[s];
#pragma unroll
            for (int r = 0; r < 4; ++r) { const int ll = lb * 16 + g * 4 + r; float v = 0.f; if (s <= ll) v = a[r] * __expf(bvec[ll] - bs - mt[ll]); *(bf16_t*)(lds + OFF_P + ll * TRS + s * 2) = f2bf(v); } } }
        __syncthreads();
        if (w == 0) { float a = 0.f; const unsigned char* r = lds + OFF_P + lane * TRS;
#pragma unroll
            for (int i = 0; i < 8; ++i) { const u32x4 x = *(const u32x4*)(r + i * 16); a += (bflo(x.x) + bfhi(x.x)) + (bflo(x.y) + bfhi(x.y)) + (bflo(x.z) + bfhi(x.z)) + (bflo(x.w) + bfhi(x.w)); }
            denV[lane] = a; }
        else if (w == 1) { float a = 0.f; const unsigned char* r = lds + OFF_Q + lane * QRS;
#pragma unroll
            for (int i = 0; i < 16; ++i) { const u32x4 x = *(const u32x4*)(r + i * 16); const float* nv = nvec + i * 8;
                a += bflo(x.x) * nv[0] + bfhi(x.x) * nv[1] + bflo(x.y) * nv[2] + bfhi(x.y) * nv[3] + bflo(x.z) * nv[4] + bfhi(x.z) * nv[5] + bflo(x.w) * nv[6] + bfhi(x.w) * nv[7]; }
            denC[lane] = a; }
        f32x4 accV[2][4], accC[2][4];
#pragma unroll
        for (int i = 0; i < 2; ++i)
#pragma unroll
            for (int j = 0; j < 4; ++j) { accV[i][j] = zero4(); accC[i][j] = zero4(); }
        const bf16_t* cst = (const bf16_t*)(ws + WS_CST) + (size_t)u * 32768;
#pragma unroll
        for (int kp = 0; kp < 2; ++kp) {
        bf16x8 ctf[2][2];
#pragma unroll
        for (int k2 = 0; k2 < 2; ++k2) { const int kc = kp * 2 + k2; ctf[k2][0] = *(const bf16x8*)(cst + (size_t)(w * 32 + lr) * 128 + kc * 32 + g * 8); ctf[k2][1] = *(const bf16x8*)(cst + (size_t)(w * 32 + 16 + lr) * 128 + kc * 32 + g * 8); }
#pragma unroll
        for (int k2 = 0; k2 < 2; ++k2) { const int kc = kp * 2 + k2;
            const bf16x8 c0 = ctf[k2][0], c1 = ctf[k2][1];
#pragma unroll
            for (int lb = 0; lb < 4; ++lb) { const bf16x8 qf = *(const bf16x8*)(lds + OFF_Q + (lb * 16 + lr) * QRS + kc * 64 + g * 16); accC[0][lb] = mfma16(c0, qf, accC[0][lb]); accC[1][lb] = mfma16(c1, qf, accC[1][lb]); }
        }
        }
#pragma unroll
        for (int kc = 0; kc < 2; ++kc) {
            const bf16x8 v0 = *(const bf16x8*)(lds + OFF_VT + (w * 32 + lr) * TRS + kc * 64 + g * 16), v1 = *(const bf16x8*)(lds + OFF_VT + (w * 32 + 16 + lr) * TRS + kc * 64 + g * 16);
#pragma unroll
            for (int lb = 0; lb < 4; ++lb) { const bf16x8 pf = *(const bf16x8*)(lds + OFF_P + (lb * 16 + lr) * TRS + kc * 64 + g * 16); accV[0][lb] = mfma16(v0, pf, accV[0][lb]); accV[1][lb] = mfma16(v1, pf, accV[1][lb]); }
        }
        __syncthreads();
#pragma unroll
        for (int lb = 0; lb < 4; ++lb) { const int ll = lb * 16 + lr; const float wi = wint[ll]; const float den = wi * denC[ll] + denV[ll]; const float dn = 1.0f / fmaxf(fabsf(den), __expf(-mt[ll])); float s1 = 0.f, s2 = 0.f;
#pragma unroll
            for (int eb = 0; eb < 2; ++eb) { const f32x4 hv = (accC[eb][lb] * wi + accV[eb][lb]) * dn; accV[eb][lb] = hv; s1 += (hv[0] + hv[1]) + (hv[2] + hv[3]); s2 += (hv[0] * hv[0] + hv[1] * hv[1]) + (hv[2] * hv[2] + hv[3] * hv[3]); }
            s1 += shx(s1, 16, lane); s1 += shx(s1, 32, lane); s2 += shx(s2, 16, lane); s2 += shx(s2, 32, lane);
            if (g == 0) { fb[640 + w * 64 + ll] = s1; fb[1152 + w * 64 + ll] = s2; } }
        __syncthreads();
#pragma unroll
        for (int lb = 0; lb < 4; ++lb) { const int ll = lb * 16 + lr; float t1 = 0.f, t2 = 0.f;
#pragma unroll
            for (int ww = 0; ww < 8; ++ww) { t1 += fb[640 + ww * 64 + ll]; t2 += fb[1152 + ww * 64 + ll]; }
            const float mu = t1 * (1.0f / 256.0f); const float var = fmaxf(t2 * (1.0f / 256.0f) - mu * mu, 0.f); const float rstd = rsqrtf(var + EPS);
#pragma unroll
            for (int eb = 0; eb < 2; ++eb) { const int e = w * 32 + eb * 16 + g * 4; const size_t off = (t0 + ll) * 1024 + h * 256 + e; const f32x4 gv = *(const f32x4*)(gn + h * 256 + e);
                const u32x2 ow = *(const u32x2*)(OB + off), zw = *(const u32x2*)(ZB + off); const f32x4 hv = accV[eb][lb]; u32x2 o;
                o.x = cvt_pk_bf16((hv[0] - mu) * rstd * gv[0] * bflo(ow.x) * bflo(zw.x), (hv[1] - mu) * rstd * gv[1] * bfhi(ow.x) * bfhi(zw.x));
                o.y = cvt_pk_bf16((hv[2] - mu) * rstd * gv[2] * bflo(ow.y) * bflo(zw.y), (hv[3] - mu) * rstd * gv[3] * bfhi(ow.y) * bfhi(zw.y)); *(u32x2*)(ZB + off) = o; } }
        __syncthreads();
    }
}

#ifndef PHM
#define PHM 4095
#endif
typedef const __attribute__((address_space(4))) Params* KParams;
#if defined(__HIP_DEVICE_COMPILE__)
__device__ __forceinline__ Params load_params() { KParams k = (KParams)__builtin_amdgcn_kernarg_segment_ptr(); asm volatile("" : "+s"(k)); return *k; }
#else
__device__ __forceinline__ Params load_params() { return Params{}; }
#endif
#define PP load_params()
#define GSYNC() do { asm volatile("s_waitcnt vmcnt(0) lgkmcnt(0)" ::: "memory"); __builtin_amdgcn_fence(__ATOMIC_RELEASE, "agent"); asm volatile("s_waitcnt vmcnt(0)" ::: "memory"); grid.sync(); \
    __builtin_amdgcn_fence(__ATOMIC_ACQUIRE, "agent"); asm volatile("s_waitcnt vmcnt(0) lgkmcnt(0)" ::: "memory"); } while (0)
__device__ __forceinline__ void gbar(unsigned* ctr, unsigned target, const int g_wv) {
    asm volatile("s_waitcnt vmcnt(0) lgkmcnt(0)" ::: "memory");
    __syncthreads();
    if (TIDX == 0) {
        __builtin_amdgcn_fence(__ATOMIC_RELEASE, "agent"); asm volatile("s_waitcnt vmcnt(0)" ::: "memory");
        __hip_atomic_fetch_add(ctr, 1u, __ATOMIC_RELAXED, __HIP_MEMORY_SCOPE_AGENT);
        while (__hip_atomic_load(ctr, __ATOMIC_RELAXED, __HIP_MEMORY_SCOPE_AGENT) < target) __builtin_amdgcn_s_sleep(1);
        __builtin_amdgcn_fence(__ATOMIC_ACQUIRE, "agent"); asm volatile("s_waitcnt vmcnt(0)" ::: "memory");
    }
    __syncthreads();
}
template <bool AL = true, bool SP = true, class Epi, class Sched> __device__ __forceinline__ void run_gemm(unsigned char* lds, const bf16_t* A, const bf16_t* Bt, int M, int N, int K, int lda, int ldb, const Sched& S, const Epi& E, const int g_wv) {
    pg8::Gemm g{A, Bt, M, N, K, lda, ldb};
    pg8::gemm_phase<Epi, Sched, AL, SP>((PG8_LAS unsigned char*)lds, g, S, E, g_wv);
    __syncthreads();
}

__global__ void __launch_bounds__(NTHR, 2) mega(Params p_arg) {
    extern __shared__ __attribute__((aligned(16))) unsigned char lds[];
    cg::grid_group grid = cg::this_grid();
    const int g_wv = __builtin_amdgcn_readfirstlane((int)(__builtin_amdgcn_workitem_id_x() >> 6));
    const int G = gridDim.x, cb = blockIdx.x; const int w_lo = p_arg.w_lo, w_hi = p_arg.w_hi;
#define WIN(k_) (w_lo <= (k_) && (k_) < w_hi)
#define SEAM(k_) do { if (WIN(k_) && WIN((k_) + 1)) { if ((k_) == 0) GSYNC(); else gbar((unsigned*)(PP.ws + WS_CTR), (unsigned)(k_) * (unsigned)G, g_wv); } } while (0)
    if (WIN(0)) {
#if PHM & 1
    convert_weights(lds, PP, 0, g_wv); convert_weights(lds, PP, 1, g_wv);
#endif
#if PHM & 2
    build_cs(PP, g_wv);
    if (cb == 0 && TIDX == 0) __hip_atomic_store((unsigned*)(PP.ws + WS_CTR), 0u, __ATOMIC_RELAXED, __HIP_MEMORY_SCOPE_AGENT);
    { const Params p = PP; rmsnorm_rows<true>(p.x, p.norm_gain, (bf16_t*)(p.ws + WS_H), nullptr, g_wv); }
#endif
    }
    SEAM(0);
#pragma unroll 1
    for (int l = 0; l < 2; ++l) {
        const int wb = 1 + 7 * l;
        if (WIN(wb)) {
#if PHM & 4
        { unsigned char* ws = PP.ws; unsigned char* wl = ws + WS_W0 + (size_t)l * WL_SIZE; const f32x2* cs = (const f32x2*)(ws + WS_CS); (void)cs; (void)wl; pg8::StaticOrder S; S.init(T, 15360, G, cb); EpiIn E{ws}; run_gemm(lds, (const bf16_t*)(ws + WS_H), (const bf16_t*)(wl + WL_WIN), T, 15360, DM, DM, DM, S, E, g_wv); }
        { unsigned char* ws = PP.ws; unsigned char* wl = ws + WS_W0 + (size_t)l * WL_SIZE; const f32x2* cs = (const f32x2*)(ws + WS_CS); (void)cs; (void)wl; pg8::StaticOrder S; S.init(1024, T, G, cb); EpiVT E{(bf16_t*)(ws + WS_VAT), T, nullptr, 0.f}; run_gemm(lds, (const bf16_t*)(wl + WL_WIN) + (size_t)15360 * DM, (const bf16_t*)(ws + WS_H), 1024, T, DM, DM, DM, S, E, g_wv); }
#endif
        }
        SEAM(wb);
        if (WIN(wb + 1)) {
#if PHM & 32
        mlstm_a(lds, PP, l, g_wv);
#endif
#if PHM & 16
        kmean_phase(PP, l, g_wv);
#endif
#if PHM & 8
        { unsigned char* ws = PP.ws; unsigned char* wl = ws + WS_W0 + (size_t)l * WL_SIZE; const f32x2* cs = (const f32x2*)(ws + WS_CS); (void)cs; (void)wl; pg8::StaticOrder S; S.init(T, 1536, G, cb); EpiRow<true> E{(bf16_t*)(ws + WS_QC), 1536, (const float*)(ws + WS_SSP), 1.0f / 512.0f, CC_SCALE, cs}; run_gemm(lds, (const bf16_t*)(ws + WS_CQ), (const bf16_t*)(wl + WL_WUQ), T, 1536, 512, 512, 512, S, E, g_wv); }
        { unsigned char* ws = PP.ws; unsigned char* wl = ws + WS_W0 + (size_t)l * WL_SIZE; const f32x2* cs = (const f32x2*)(ws + WS_CS); (void)cs; (void)wl; pg8::StaticOrder S; S.init(T, 1024, G, cb); EpiRow<false> E{(bf16_t*)(ws + WS_KNC), 1024, (const float*)(ws + WS_SSP), 1.0f / 256.0f, 1.0f, cs}; run_gemm(lds, (const bf16_t*)(ws + WS_CKV), (const bf16_t*)(wl + WL_WKN), T, 1024, 256, 256, 256, S, E, g_wv); }
        { unsigned char* ws = PP.ws; unsigned char* wl = ws + WS_W0 + (size_t)l * WL_SIZE; const f32x2* cs = (const f32x2*)(ws + WS_CS); (void)cs; (void)wl; pg8::StaticOrder S; S.init(1024, T, G, cb); EpiVT E{(bf16_t*)(ws + WS_VCT), T, (const float*)(ws + WS_SSP), 1.0f / 256.0f}; run_gemm(lds, (const bf16_t*)(wl + WL_WV), (const bf16_t*)(ws + WS_CKV), 1024, T, 256, 256, 256, S, E, g_wv); }
#endif
        }
        SEAM(wb + 1);
        if (WIN(wb + 2)) {
#if PHM & 64
        attn_phase<0>(lds, PP, l, g_wv);
#endif
#if PHM & 128
        mlstm_b(PP, g_wv);
#endif
        }
        SEAM(wb + 2);
        if (WIN(wb + 3)) {
#if PHM & 256
        attn_phase<1>(lds, PP, l, g_wv);
#endif
#if PHM & 512
        mlstm_c(lds, PP, l, g_wv);
#endif
        }
        SEAM(wb + 3);
        if (WIN(wb + 4)) {
#if PHM & 1024
        { unsigned char* ws = PP.ws; unsigned char* wl = ws + WS_W0 + (size_t)l * WL_SIZE; MergeOrder S{G, cb}; EpiMerge E{(bf16_t*)(ws + WS_H), (const bf16_t*)(ws + WS_GT)}; run_gemm(lds, (const bf16_t*)(ws + WS_Z), (const bf16_t*)(wl + WL_WB), 3 * T, 2048, 1024, 1024, 1024, S, E, g_wv); }
#endif
        }
        SEAM(wb + 4);
        if (WIN(wb + 5)) {
#if PHM & 2048
        { unsigned char* ws = PP.ws; unsigned char* wl = ws + WS_W0 + (size_t)l * WL_SIZE; const f32x2* cs = (const f32x2*)(ws + WS_CS); (void)cs; (void)wl; pg8::StaticOrder S; S.init(T, DM, G, cb); const Params p = PP; EpiOut E{l == 0 ? p.x : p.out, p.out}; run_gemm(lds, (const bf16_t*)(ws + WS_H), (const bf16_t*)(wl + WL_WO), T, DM, DM, DM, DM, S, E, g_wv); }
#endif
        }
        SEAM(wb + 5);
        if (WIN(wb + 6)) {
            if (l == 0) { const Params p = PP; rmsnorm_rows<true>(p.out, p.norm_gain + DM, (bf16_t*)(p.ws + WS_H), nullptr, g_wv); }
            else { const Params p = PP; rmsnorm_rows<false>(p.out, p.final_norm, nullptr, p.out, g_wv); }
        }
        if (l == 0) SEAM(wb + 6);
    }
}


#if defined(MK_DEBUG_HASH)
__global__ void hash_buf(const unsigned* p, size_t nwords, unsigned long long* acc) {
    unsigned long long s = 0; const size_t stride = (size_t)gridDim.x * blockDim.x;
    for (size_t i = (size_t)blockIdx.x * blockDim.x + threadIdx.x; i < nwords; i += stride) s += (unsigned long long)p[i] * (unsigned long long)(((unsigned)i * 2654435761u) | 1u);
    atomicAdd(acc, s);
}
__global__ void dbg_final(float* out, size_t n, const unsigned long long* h, int R, int NK) {
    __shared__ float flag;
    if (threadIdx.x == 0) { float f = 1.0f; for (int k = NK - 1; k >= 0; --k) for (int r = 1; r < R; ++r) if (h[r * NK + k] != h[k]) { f = 100.0f; for (int q = 0; q < k; ++q) f *= 10.0f; } flag = f; }
    __syncthreads();
    for (size_t i = (size_t)blockIdx.x * blockDim.x + threadIdx.x; i < n; i += (size_t)gridDim.x * blockDim.x) out[i] = (i == 0) ? flag : 0.0f;
}
#endif
extern "C" void kernel_launch(void* const* d_in, const int* in_sizes, int n_in, void* d_out, int out_size, void* d_ws, size_t ws_size, hipStream_t stream) {
    static int grid = 0;
    if (grid == 0) {
        if (n_in != 16 || ws_size < WS_END) { fprintf(stderr, "kernel_launch: unexpected n_in %d or ws_size %zu < %zu\n", n_in, ws_size, (size_t)WS_END); grid = -1; return; }
        int dev = 0, cus = 0, per_cu = 0;
        hipGetDevice(&dev); hipDeviceGetAttribute(&cus, hipDeviceAttributeMultiprocessorCount, dev);
        if (hipFuncSetAttribute((const void*)mega, hipFuncAttributeMaxDynamicSharedMemorySize, LDS_BYTES) != hipSuccess) { fprintf(stderr, "kernel_launch: hipFuncSetAttribute failed\n"); grid = -1; return; }
        if (hipOccupancyMaxActiveBlocksPerMultiprocessor(&per_cu, (const void*)mega, NTHR, LDS_BYTES) != hipSuccess || per_cu < 1) { fprintf(stderr, "kernel_launch: occupancy query gave %d\n", per_cu); per_cu = 1; }
        (void)hipGetLastError();
        grid = cus * 1;
    }
    if (grid < 0) return;
    Params p{};
    p.x = (const float*)d_in[0]; p.norm_gain = (const float*)d_in[1]; p.w_in = (const float*)d_in[2]; p.t5 = (const float*)d_in[3]; p.conv_w = (const float*)d_in[4]; p.conv_b = (const float*)d_in[5];
    p.i_bias = (const float*)d_in[6]; p.f_bias = (const float*)d_in[7]; p.out_norm = (const float*)d_in[8]; p.q_norm = (const float*)d_in[9]; p.kv_norm = (const float*)d_in[10];
    p.w_uq = (const float*)d_in[11]; p.w_ukv = (const float*)d_in[12]; p.w_branch = (const float*)d_in[13]; p.w_out = (const float*)d_in[14]; p.final_norm = (const float*)d_in[15];
    p.out = (float*)d_out; p.ws = (unsigned char*)d_ws;
    void* args[] = {&p};
#if defined(MK_DEBUG_HASH)
    {
        constexpr int R = 4, NK = 9; unsigned char* W = (unsigned char*)d_ws; unsigned long long* H = (unsigned long long*)(W + WS_END);
        hipMemsetAsync(H, 0, R * NK * 8, stream);
        struct HB { int win; size_t off; size_t bytes; };
        const HB hb[NK] = { {3, WS_Z, 32 * MiB}, {3, WS_CST, 64 * MiB}, {3, WS_NST, 524288}, {3, WS_MST, 4096},
                            {4, WS_Z + 64 * MiB, 32 * MiB}, {4, WS_Z + 32 * MiB, 32 * MiB}, {5, WS_H, 64 * MiB}, {6, WS_H, 64 * MiB}, {2, WS_CST, 64 * MiB} };
        for (int r = 0; r < R; ++r)
            for (int w = 0; w < 7; ++w) { p.w_lo = w; p.w_hi = w + 1;
                hipError_t e = hipLaunchCooperativeKernel((const void*)mega, dim3(grid), dim3(NTHR), args, LDS_BYTES, stream);
                if (e != hipSuccess) fprintf(stderr, "kernel_launch: cooperative launch failed: %s\n", hipGetErrorString(e));
                for (int k = 0; k < NK; ++k) if (hb[k].win == w) {
                    if (k == 7) hash_buf<<<256, 256, 0, stream>>>((const unsigned*)d_out, (size_t)T * DM, H + r * NK + k);
                    else hash_buf<<<256, 256, 0, stream>>>((const unsigned*)(W + hb[k].off), hb[k].bytes / 4, H + r * NK + k); } }
        dbg_final<<<256, 256, 0, stream>>>((float*)d_out, (size_t)T * DM, H, R, NK);
    }
    if (false) {
#elif defined(MK_MULTI)
    for (int w = 0; w < 15; ++w) { p.w_lo = w; p.w_hi = w + 1;
#else
    { p.w_lo = 0; p.w_hi = 15;
#endif
        hipError_t e = hipLaunchCooperativeKernel((const void*)mega, dim3(grid), dim3(NTHR), args, LDS_BYTES, stream);
        if (e != hipSuccess) fprintf(stderr, "kernel_launch: cooperative launch failed: %s (grid %d)\n", hipGetErrorString(e), grid);
    }
}
```

```cpp
#include <hip/hip_runtime.h>
#include <hip/hip_cooperative_groups.h>
#include <cstdio>
#include <cstdint>
namespace cg = cooperative_groups;
__device__ __forceinline__ int tidx_opaque(int g_wv) { int l; asm volatile("v_mbcnt_lo_u32_b32 %0, -1, 0\n\tv_mbcnt_hi_u32_b32 %0, -1, %0" : "=v"(l)); return g_wv * 64 + l; }
#define TIDX tidx_opaque(g_wv)
__device__ __forceinline__ float shx(float v, int o, int lane) { return __int_as_float(__builtin_amdgcn_ds_bpermute(((lane ^ o) & 63) << 2, __float_as_int(v))); }
__device__ __forceinline__ int shxi(int v, int o, int lane) { return __builtin_amdgcn_ds_bpermute(((lane ^ o) & 63) << 2, v); }
__device__ __forceinline__ float shup(float v, int o, int lane) { return __int_as_float(__builtin_amdgcn_ds_bpermute(((lane - o) & 63) << 2, __float_as_int(v))); }

namespace pg8 {
#define PG8_LAS __attribute__((address_space(3)))
typedef unsigned short bf16_t;
typedef short bf16x8 __attribute__((ext_vector_type(8)));
typedef float f32x4 __attribute__((ext_vector_type(4)));
typedef unsigned u32x4 __attribute__((ext_vector_type(4)));
constexpr int BM = 256, BK = 64, HALF = 128, HTB = HALF * BK * 2  , STAGE_BYTES = 8 * HTB, NXCD = 8, WGM = 8;

__host__ __device__ __forceinline__ int lds_byte(int r, int c) { const int st = (r >> 4) * 2 + (c >> 5), rr = r & 15, cc = c & 31, ob = rr * 64 + cc * 2; return st * 1024 + (ob ^ (((ob >> 9) & 1) << 5)); }
__host__ __device__ __forceinline__ void stage_rc(int b, int& R, int& C) { const int st = b / 1024, sb = b % 1024, swz = sb ^ (((sb >> 9) & 1) << 5); R = (st >> 1) * 16 + swz / 64; C = (st & 1) * 32 + (swz % 64) / 2; }
__host__ __device__ __forceinline__ int perm32(int rho) { const int n = rho >> 4, i = rho & 15; return 8 * (i >> 2) + 4 * n + (i & 3); }

struct Unit { int pm, pn, pb; };
struct Gemm { const bf16_t* A; const bf16_t* Bt; int M, N, K, lda, ldb; };

struct StaticOrder {
    int nM, nN, nwg, G, c;
    __host__ __device__ void init(int M, int N, int G_, int c_) { nM = M / BM; nN = N / BM; nwg = nM * nN; G = G_; c = c_; }
    __host__ __device__ bool next(int i, Unit& u) const {
        const long L = (long)i * G + c; if (L >= nwg) return false;
        int wgid = (int)L; { const int q = nwg / NXCD, r = nwg % NXCD, xcd = wgid % NXCD, off = wgid / NXCD; wgid = (xcd < r ? xcd * (q + 1) : r * (q + 1) + (xcd - r) * q) + off; }
        const int nig = WGM * nN, gid = wgid / nig, fm = gid * WGM, gsz = (nM - fm) < WGM ? (nM - fm) : WGM;
        u.pm = fm + ((wgid % nig) % gsz); u.pn = (wgid % nig) / gsz; u.pb = u.pn; return true;
    }
    __device__ __forceinline__ void a_ready(const Unit&) const {}
    __device__ __forceinline__ void done(const Unit&) const {}
};

__device__ __forceinline__ unsigned cvt_pk_bf16(float lo, float hi) { unsigned r; asm volatile("s_nop 1\n\tv_cvt_pk_bf16_f32 %0, %1, %2\n\ts_nop 1" : "=v"(r) : "v"(lo), "v"(hi)); return r; }
template <class Epi, class Sched, bool ALIGN_EPI = false, bool SP2 = false>
__device__ __forceinline__ void gemm_phase(PG8_LAS unsigned char* lds, const Gemm g, const Sched& S, const Epi& E, const int g_wv) {
    int tid = TIDX; asm volatile("" : "+v"(tid)); const int wid = __builtin_amdgcn_readfirstlane(tid >> 6), lane = tid & 63, wr = wid >> 2, wc = wid & 3, fr = lane & 15, fq = lane >> 4;
    const int K = g.K, nt = K / BK;
    unsigned voffA[2], voffB[2];
#pragma unroll
    for (int i = 0; i < 2; ++i) { int R, C; stage_rc(tid * 16 + i * 8192, R, C); const int Rb = Epi::PERM ? ((R & ~31) + perm32(R & 31)) : R;
        voffA[i] = (unsigned)(R * K + C) * 2u; voffB[i] = (unsigned)(Rb * K + C) * 2u; }
    const size_t kstep = (size_t)(BK * 2);
    const size_t hstepA = (size_t)HALF * K * 2; const size_t hstepB = hstepA;
    const size_t tstepA = 2 * hstepA; const size_t tstepB = tstepA;
    const unsigned ldsw = (unsigned)wid * 1024u;
    const int aoff = lds_byte(wr * 64 + fr, fq * 8), boff = lds_byte(wc * 32 + fr, fq * 8);
#define PG8_SA(b, h) (((b) * 2 + (h)) * HTB)
#define PG8_SB(b, h) ((4 + (b) * 2 + (h)) * HTB)
#define PG8_STAGE(bufoff, gbase, voff) do { _Pragma("unroll") for (int _i = 0; _i < 2; ++_i) \
        __builtin_amdgcn_global_load_lds((const unsigned*)((const char*)(gbase) + (voff)[_i]), (PG8_LAS unsigned*)(lds + (bufoff) + ldsw + _i * 8192), 16, 0, 0); } while (0)
#define PG8_LDA(dst, b, h) do { _Pragma("unroll") for (int m = 0; m < 4; ++m) _Pragma("unroll") for (int k = 0; k < 2; ++k) dst[m][k] = *(const PG8_LAS bf16x8*)(lds + PG8_SA(b, h) + aoff + m * 2048 + k * 1024); } while (0)
#define PG8_LDB(dst, b, h) do { _Pragma("unroll") for (int n = 0; n < 2; ++n) _Pragma("unroll") for (int k = 0; k < 2; ++k) dst[n][k] = *(const PG8_LAS bf16x8*)(lds + PG8_SB(b, h) + boff + n * 2048 + k * 1024); } while (0)
#define PG8_MMA(ai, bj, At, Bt) do { __builtin_amdgcn_s_setprio(1); _Pragma("unroll") for (int m = 0; m < 4; ++m) _Pragma("unroll") for (int n = 0; n < 2; ++n) _Pragma("unroll") for (int k = 0; k < 2; ++k) \
        acc[ai][bj][m][n] = __builtin_amdgcn_mfma_f32_16x16x32_bf16(Bt[n][k], At[m][k], acc[ai][bj][m][n], 0, 0, 0); __builtin_amdgcn_s_setprio(0); } while (0)
#define PG8_WAIT_V(n) asm volatile("s_waitcnt vmcnt(" #n ")" ::: "memory")
#define PG8_WAIT_L(n) asm volatile("s_waitcnt lgkmcnt(" #n ")" ::: "memory")
#define PG8_BAR __builtin_amdgcn_s_barrier()
#define PG8_SCHED __builtin_amdgcn_sched_barrier(0)
    Unit cur, nxt; int ui = 0;
    if (!S.next(0, cur)) return;
    f32x4 acc[2][2][4][2];
#pragma unroll
    for (int a = 0; a < 2; ++a)
#pragma unroll
        for (int b = 0; b < 2; ++b)
#pragma unroll
            for (int m = 0; m < 4; ++m)
#pragma unroll
                for (int n = 0; n < 2; ++n) acc[a][b][m][n] = (f32x4){0.f, 0.f, 0.f, 0.f};
    bf16x8 At[4][2], B0[2][2], B1[2][2];
    const char* cA = (const char*)g.A + (size_t)cur.pm * tstepA; const char* cB = (const char*)g.Bt + (size_t)cur.pb * tstepB;
    S.a_ready(cur);
    if constexpr (SP2) {
        PG8_STAGE(PG8_SB(0, 0), cB, voffB); PG8_STAGE(PG8_SB(0, 1), cB + hstepB, voffB); PG8_STAGE(PG8_SA(0, 0), cA, voffA); PG8_STAGE(PG8_SA(0, 1), cA + hstepA, voffA);
        if (wr == 1) PG8_BAR;
        PG8_WAIT_V(2); PG8_BAR;
        PG8_STAGE(PG8_SB(1, 0), cB + kstep, voffB); PG8_STAGE(PG8_SA(1, 0), cA + kstep, voffA); PG8_STAGE(PG8_SB(1, 1), cB + hstepB + kstep, voffB);
        PG8_WAIT_V(6); PG8_BAR;
    } else {
        PG8_STAGE(PG8_SB(0, 0), cB, voffB); PG8_STAGE(PG8_SA(0, 0), cA, voffA); PG8_STAGE(PG8_SB(0, 1), cB + hstepB, voffB); PG8_STAGE(PG8_SA(0, 1), cA + hstepA, voffA);
        if (wr == 1) PG8_BAR;
        PG8_WAIT_V(4); PG8_BAR;
        PG8_STAGE(PG8_SB(1, 0), cB + kstep, voffB); PG8_STAGE(PG8_SA(1, 0), cA + kstep, voffA); PG8_STAGE(PG8_SB(1, 1), cB + hstepB + kstep, voffB);
        PG8_WAIT_V(6); PG8_BAR;
    }
    for (;;) {
        const bool has_next = S.next(ui + 1, nxt);
        const char* nA = has_next ? (const char*)g.A + (size_t)nxt.pm * tstepA : cA; const char* nB = has_next ? (const char*)g.Bt + (size_t)nxt.pb * tstepB : cB;
        for (int t = 0; t < nt; t += 2) {
            const bool last = (t == nt - 2);
            const char* a1 = cA + (size_t)(t + 1) * kstep;
            const char* a2 = last ? nA : cA + (size_t)(t + 2) * kstep; const char* b2 = last ? nB : cB + (size_t)(t + 2) * kstep;
            const char* a3 = a2 + kstep; const char* b3 = b2 + kstep;
            if (last && has_next) S.a_ready(nxt);
            if constexpr (SP2) {
            PG8_LDB(B0, 0, 0); PG8_LDB(B1, 0, 1); PG8_SCHED; PG8_LDA(At, 0, 0); PG8_STAGE(PG8_SA(1, 1), a1 + hstepA, voffA);
            PG8_WAIT_V(8); PG8_WAIT_L(0); PG8_BAR; PG8_MMA(0, 0, At, B0); PG8_MMA(0, 1, At, B1); PG8_BAR; PG8_SCHED;
            PG8_LDA(At, 0, 1); PG8_STAGE(PG8_SB(0, 0), b2, voffB); PG8_STAGE(PG8_SB(0, 1), b2 + hstepB, voffB); PG8_STAGE(PG8_SA(0, 0), a2, voffA);
            PG8_WAIT_V(8); PG8_WAIT_L(0); PG8_BAR; PG8_MMA(1, 0, At, B0); PG8_MMA(1, 1, At, B1); PG8_BAR; PG8_SCHED;
            PG8_LDB(B0, 1, 0); PG8_LDB(B1, 1, 1); PG8_SCHED; PG8_LDA(At, 1, 0); PG8_STAGE(PG8_SA(0, 1), a2 + hstepA, voffA);
            PG8_WAIT_V(8); PG8_WAIT_L(0); PG8_BAR; PG8_MMA(0, 0, At, B0); PG8_MMA(0, 1, At, B1); PG8_BAR; PG8_SCHED;
            PG8_LDA(At, 1, 1); PG8_STAGE(PG8_SB(1, 0), b3, voffB); PG8_STAGE(PG8_SB(1, 1), b3 + hstepB, voffB); PG8_STAGE(PG8_SA(1, 0), a3, voffA);
            PG8_WAIT_V(8); PG8_WAIT_L(0); PG8_BAR; PG8_MMA(1, 0, At, B0); PG8_MMA(1, 1, At, B1); PG8_BAR; PG8_SCHED;
            } else {
            PG8_LDB(B0, 0, 0); PG8_SCHED; PG8_LDA(At, 0, 0); PG8_STAGE(PG8_SA(1, 1), a1 + hstepA, voffA);
            PG8_WAIT_L(8); PG8_BAR; PG8_WAIT_L(0); PG8_MMA(0, 0, At, B0); PG8_BAR; PG8_SCHED;
            PG8_LDB(B1, 0, 1); PG8_STAGE(PG8_SB(0, 0), b2, voffB);
            PG8_BAR; PG8_WAIT_L(0); PG8_MMA(0, 1, At, B1); PG8_BAR;
            PG8_LDA(At, 0, 1); PG8_STAGE(PG8_SA(0, 0), a2, voffA);
            PG8_BAR; PG8_WAIT_L(0); PG8_MMA(1, 0, At, B0); PG8_BAR; PG8_SCHED;
            PG8_STAGE(PG8_SB(0, 1), b2 + hstepB, voffB);
            PG8_WAIT_V(6); PG8_BAR; PG8_MMA(1, 1, At, B1); PG8_BAR;
            PG8_LDB(B0, 1, 0); PG8_SCHED; PG8_LDA(At, 1, 0); PG8_STAGE(PG8_SA(0, 1), a2 + hstepA, voffA);
            PG8_WAIT_L(8); PG8_BAR; PG8_WAIT_L(0); PG8_MMA(0, 0, At, B0); PG8_BAR; PG8_SCHED;
            PG8_LDB(B1, 1, 1); PG8_STAGE(PG8_SB(1, 0), b3, voffB);
            PG8_BAR; PG8_WAIT_L(0); PG8_MMA(0, 1, At, B1); PG8_BAR;
            PG8_LDA(At, 1, 1); PG8_STAGE(PG8_SA(1, 0), a3, voffA);
            PG8_BAR; PG8_WAIT_L(0); PG8_MMA(1, 0, At, B0); PG8_BAR; PG8_SCHED;
            PG8_STAGE(PG8_SB(1, 1), b3 + hstepB, voffB);
            PG8_WAIT_V(6); PG8_BAR; PG8_MMA(1, 1, At, B1); PG8_BAR;
            }
        }
        if constexpr (ALIGN_EPI) { if (wr == 0) PG8_BAR; }
        if constexpr (!Epi::AFTER_DRAIN) { E(acc, cur, wr, wc, fr, fq); S.done(cur); }
        if (!has_next) break;
#pragma unroll
        for (int a = 0; a < 2; ++a)
#pragma unroll
            for (int b = 0; b < 2; ++b)
#pragma unroll
                for (int m = 0; m < 4; ++m)
#pragma unroll
                    for (int n = 0; n < 2; ++n) acc[a][b][m][n] = (f32x4){0.f, 0.f, 0.f, 0.f};
        cur = nxt; cA = nA; cB = nB; ++ui;
        if constexpr (ALIGN_EPI) { if (wr == 1) PG8_BAR; }
    }
    PG8_WAIT_V(0);
    if constexpr (!ALIGN_EPI) { if (wr == 0) PG8_BAR; }
    PG8_BAR;
    if constexpr (Epi::AFTER_DRAIN) { E.fused(acc, cur, wr, wc, fr, fq, lds, wid, lane); S.done(cur); }
#undef PG8_SA
#undef PG8_SB
#undef PG8_STAGE
#undef PG8_LDA
#undef PG8_LDB
#undef PG8_MMA
#undef PG8_WAIT_V
#undef PG8_WAIT_L
#undef PG8_BAR
#undef PG8_SCHED
}
}

using pg8::bf16_t; using pg8::bf16x8; using pg8::f32x4; using pg8::u32x4; using pg8::Unit; using pg8::cvt_pk_bf16;
typedef unsigned u32x2 __attribute__((ext_vector_type(2)));
typedef float f32x2 __attribute__((ext_vector_type(2)));
constexpr int T = 16384, SEQ = 4096, DM = 2048, DIN = 16200;
constexpr float EPS = 1e-6f, NEGV = -1e30f, LOG2E = 1.4426950408889634f;
constexpr float CA_SCALE = 0.12751743082459868f;
constexpr float CC_SCALE = 0.10411754627697264f;
constexpr int NTHR = 512;
constexpr int LDS_BYTES = 131072;

constexpr size_t MiB = 1ull << 20;
constexpr size_t WS_CS = 0;
constexpr size_t WS_SSQ = WS_CS + MiB;
constexpr size_t WS_SSKV = WS_SSQ + 65536;
constexpr size_t WS_GATES = WS_SSKV + 65536;
constexpr size_t WS_KM = WS_GATES + 524288;
constexpr size_t WS_BV = WS_KM + 131072;
constexpr size_t WS_LIV = WS_BV + 262144;
constexpr size_t WS_BLAST = WS_LIV + 262144;
constexpr size_t WS_GMAX = WS_BLAST + 4096;
constexpr size_t WS_MST = WS_GMAX + 4096;
constexpr size_t WS_NST = WS_MST + 4096;
constexpr size_t WS_W0 = WS_NST + 524288;
constexpr size_t WL_WIN = 0;
constexpr size_t WL_WB = WL_WIN + 64 * MiB;
constexpr size_t WL_WO = WL_WB + 12 * MiB;
constexpr size_t WL_WUQ = WL_WO + 8 * MiB;
constexpr size_t WL_WKN = WL_WUQ + 1536 * 1024;
constexpr size_t WL_WV = WL_WKN + 512 * 1024;
constexpr size_t WL_SIZE = WL_WV + 512 * 1024;
constexpr size_t WS_H = WS_W0 + 2 * WL_SIZE;
constexpr size_t WS_QA = WS_H + 64 * MiB;
constexpr size_t WS_KA = WS_QA + 32 * MiB;
constexpr size_t WS_VAT = WS_KA + 32 * MiB;
constexpr size_t WS_Z = WS_VAT + 32 * MiB;
constexpr size_t WS_QB = WS_Z + 96 * MiB;
constexpr size_t WS_KB = WS_QB + 16 * MiB;
constexpr size_t WS_VB = WS_KB + 16 * MiB;
constexpr size_t WS_OB = WS_VB + 32 * MiB;
constexpr size_t WS_Q2 = WS_OB + 32 * MiB;
constexpr size_t WS_K2 = WS_Q2 + 16 * MiB;
constexpr size_t WS_CST = WS_K2 + 16 * MiB;
constexpr size_t WS_CQ = WS_CST + 64 * MiB;
constexpr size_t WS_CKV = WS_CQ + 16 * MiB;
constexpr size_t WS_KR = WS_CKV + 8 * MiB;
constexpr size_t WS_QC = WS_KR + 2 * MiB;
constexpr size_t WS_KNC = WS_QC + 48 * MiB;
constexpr size_t WS_VCT = WS_KNC + 32 * MiB;
constexpr size_t WS_GT = WS_VCT + 32 * MiB;
constexpr size_t WS_SSP = WS_GT + 192 * MiB;
constexpr size_t WS_QAL = WS_SSP + MiB;
constexpr size_t WS_CTR = WS_QAL + 32 * MiB;
constexpr size_t WS_END = WS_CTR + 256;

struct Params {
    const float* x; const float* norm_gain; const float* w_in; const float* t5; const float* conv_w; const float* conv_b; const float* i_bias; const float* f_bias;
    const float* out_norm; const float* q_norm; const float* kv_norm; const float* w_uq; const float* w_ukv; const float* w_branch; const float* w_out; const float* final_norm;
    float* out; unsigned char* ws; int w_lo, w_hi;
};

__device__ __forceinline__ float bf2f(unsigned v16) { return __uint_as_float(v16 << 16); }
__device__ __forceinline__ float bflo(unsigned w) { return __uint_as_float(w << 16); }
__device__ __forceinline__ float bfhi(unsigned w) { return __uint_as_float(w & 0xffff0000u); }
__device__ __forceinline__ bf16_t f2bf(float f) { return (bf16_t)(cvt_pk_bf16(f, 0.f) & 0xffffu); }
__device__ __forceinline__ float fsigmoid(float v) { return __builtin_amdgcn_rcpf(1.0f + __expf(-v)); }
__device__ __forceinline__ float fsilu(float v) { return v * __builtin_amdgcn_rcpf(1.0f + __expf(-v)); }
__device__ __forceinline__ float fexp2(float v) { return __builtin_amdgcn_exp2f(v); }
__device__ __forceinline__ f32x4 zero4() { f32x4 z = (f32x4){0.f, 0.f, 0.f, 0.f}; asm volatile("" : "+v"(z)); return z; }
__device__ __forceinline__ f32x4 mfma16(bf16x8 a, bf16x8 b, f32x4 c) { return __builtin_amdgcn_mfma_f32_16x16x32_bf16(a, b, c, 0, 0, 0); }

struct EpiIn {
    static constexpr bool PERM = true, AFTER_DRAIN = false;
    unsigned char* ws;
    __device__ __forceinline__ void operator()(const f32x4 (&acc)[2][2][4][2], const Unit& u, int wr, int wc, int fr, int fq) const {
        const int pn = u.pn; const int row0 = u.pm * 256 + wr * 64 + fr;
        if (pn == 59) {
            const int cb = wc * 32 + 8 * fq;
            if (cb >= 72) return;
            float* gates = (float*)(ws + WS_GATES); bf16_t* kr = (bf16_t*)(ws + WS_KR); const f32x2* cs = (const f32x2*)(ws + WS_CS);
#pragma unroll
            for (int ai = 0; ai < 2; ++ai)
#pragma unroll
                for (int m = 0; m < 4; ++m) {
                    const int row = row0 + ai * 128 + m * 16; const f32x4 v0 = acc[ai][0][m][0], v1 = acc[ai][0][m][1];
                    if (cb == 0) { *(f32x4*)(gates + (size_t)row * 8) = v0; *(f32x4*)(gates + (size_t)row * 8 + 4) = v1; }
                    else {
                        const int j0 = (cb - 8) >> 1, pos = row & (SEQ - 1);
                        const f32x2 c0 = cs[pos * 32 + j0], c1 = cs[pos * 32 + j0 + 1], c2 = cs[pos * 32 + j0 + 2], c3 = cs[pos * 32 + j0 + 3];
                        u32x4 w;
                        w.x = cvt_pk_bf16(v0[0] * c0.x - v0[1] * c0.y, v0[0] * c0.y + v0[1] * c0.x);
                        w.y = cvt_pk_bf16(v0[2] * c1.x - v0[3] * c1.y, v0[2] * c1.y + v0[3] * c1.x);
                        w.z = cvt_pk_bf16(v1[0] * c2.x - v1[1] * c2.y, v1[0] * c2.y + v1[1] * c2.x);
                        w.w = cvt_pk_bf16(v1[2] * c3.x - v1[3] * c3.y, v1[2] * c3.y + v1[3] * c3.x);
                        *(u32x4*)(kr + (size_t)row * 64 + (cb - 8)) = w;
                    }
                }
            return;
        }
        size_t off; int ld, c0, act = 0, ssk = 0; float sc = 1.f;
        if (pn < 4) { off = WS_QA; ld = 1024; c0 = pn * 256; sc = CA_SCALE; }
        else if (pn < 8) { off = WS_KA; ld = 1024; c0 = (pn - 4) * 256; }
        else if (pn < 12) { off = WS_Z; ld = 1024; c0 = (pn - 8) * 256; act = 1; }
        else if (pn < 14) { off = WS_QB; ld = 512; c0 = (pn - 12) * 256; }
        else if (pn < 16) { off = WS_KB; ld = 512; c0 = (pn - 14) * 256; }
        else if (pn < 20) { off = WS_VB; ld = 1024; c0 = (pn - 16) * 256; }
        else if (pn < 24) { off = WS_OB; ld = 1024; c0 = (pn - 20) * 256; act = 2; }
        else if (pn < 28) { off = WS_Z + 32 * MiB; ld = 1024; c0 = (pn - 24) * 256; act = 1; }
        else if (pn < 30) { off = WS_CQ; ld = 512; c0 = (pn - 28) * 256; ssk = 1; }
        else if (pn < 31) { off = WS_CKV; ld = 256; c0 = 0; ssk = 2; }
        else if (pn < 35) { off = WS_Z + 64 * MiB; ld = 1024; c0 = (pn - 31) * 256; act = 1; }
        else { off = WS_GT; ld = 6144; c0 = (pn - 35) * 256; act = 2; }
        bf16_t* dst = (bf16_t*)(ws + off); float* ssp = (float*)(ws + WS_SSP) + (ssk == 2 ? 8 : (pn - 28) * 4) + wc;
        const int col0 = c0 + wc * 32 + 8 * fq;
#pragma unroll
        for (int ai = 0; ai < 2; ++ai)
#pragma unroll
            for (int m = 0; m < 4; ++m) {
                const int row = row0 + ai * 128 + m * 16; bf16_t* rowp = dst + (size_t)row * ld + col0; float ss = 0.f;
#pragma unroll
                for (int bj = 0; bj < 2; ++bj) {
                    f32x4 v0 = acc[ai][bj][m][0], v1 = acc[ai][bj][m][1];
                    if (act == 1) {
#pragma unroll
                        for (int i = 0; i < 4; ++i) { v0[i] = fsilu(v0[i]); v1[i] = fsilu(v1[i]); }
                    } else if (act == 2) {
#pragma unroll
                        for (int i = 0; i < 4; ++i) { v0[i] = fsigmoid(v0[i]); v1[i] = fsigmoid(v1[i]); }
                    } else { v0 = v0 * sc; v1 = v1 * sc; }
                    if (ssk) ss += (v0[0] * v0[0] + v0[1] * v0[1]) + (v0[2] * v0[2] + v0[3] * v0[3]) + (v1[0] * v1[0] + v1[1] * v1[1]) + (v1[2] * v1[2] + v1[3] * v1[3]);
                    u32x4 w; w.x = cvt_pk_bf16(v0[0], v0[1]); w.y = cvt_pk_bf16(v0[2], v0[3]); w.z = cvt_pk_bf16(v1[0], v1[1]); w.w = cvt_pk_bf16(v1[2], v1[3]);
                    *(u32x4*)(rowp + bj * 128) = w;
                    if (pn < 4) {
                        u32x4 wl; wl.x = cvt_pk_bf16(v0[0] - bflo(w.x), v0[1] - bfhi(w.x)); wl.y = cvt_pk_bf16(v0[2] - bflo(w.y), v0[3] - bfhi(w.y));
                        wl.z = cvt_pk_bf16(v1[0] - bflo(w.z), v1[1] - bfhi(w.z)); wl.w = cvt_pk_bf16(v1[2] - bflo(w.w), v1[3] - bfhi(w.w));
                        *(u32x4*)((bf16_t*)(ws + WS_QAL) + (size_t)row * 1024 + col0 + bj * 128) = wl; }
                }
                if (ssk) { const int ln = fq * 16 + fr; ss += shx(ss, 16, ln); ss += shx(ss, 32, ln); if (fq == 0) ssp[(size_t)row * 16] = ss; }
            }
    }
};

struct EpiVT {
    static constexpr bool PERM = true, AFTER_DRAIN = false;
    bf16_t* dst; int ld; const float* ss; float inv_n;
    __device__ __forceinline__ void operator()(const f32x4 (&acc)[2][2][4][2], const Unit& u, int wr, int wc, int fr, int fq) const {
        const int row0 = u.pm * 256 + wr * 64 + fr, col0 = u.pn * 256 + wc * 32 + 8 * fq;
        f32x4 s0[2], s1[2];
#pragma unroll
        for (int bj = 0; bj < 2; ++bj) {
            if (ss) { f32x4 a, b;
#pragma unroll
                for (int i = 0; i < 4; ++i) { const f32x4 pa = *(const f32x4*)(ss + (size_t)(col0 + bj * 128 + i) * 16 + 8), pb = *(const f32x4*)(ss + (size_t)(col0 + bj * 128 + 4 + i) * 16 + 8);
                    a[i] = rsqrtf(((pa[0] + pa[1]) + (pa[2] + pa[3])) * inv_n + EPS); b[i] = rsqrtf(((pb[0] + pb[1]) + (pb[2] + pb[3])) * inv_n + EPS); }
                s0[bj] = a; s1[bj] = b; }
            else { s0[bj] = (f32x4){1.f, 1.f, 1.f, 1.f}; s1[bj] = s0[bj]; }
        }
#pragma unroll
        for (int ai = 0; ai < 2; ++ai)
#pragma unroll
            for (int m = 0; m < 4; ++m) {
                bf16_t* rowp = dst + (size_t)(row0 + ai * 128 + m * 16) * ld + col0;
#pragma unroll
                for (int bj = 0; bj < 2; ++bj) {
                    const f32x4 v0 = acc[ai][bj][m][0] * s0[bj], v1 = acc[ai][bj][m][1] * s1[bj];
                    u32x4 w; w.x = cvt_pk_bf16(v0[0], v0[1]); w.y = cvt_pk_bf16(v0[2], v0[3]); w.z = cvt_pk_bf16(v1[0], v1[1]); w.w = cvt_pk_bf16(v1[2], v1[3]);
                    *(u32x4*)(rowp + bj * 128) = w;
                }
            }
    }
};

template <bool ROPE> struct EpiRow {
    static constexpr bool PERM = true, AFTER_DRAIN = false;
    bf16_t* dst; int ld; const float* ss; float inv_n, sc; const f32x2* cs;
    __device__ __forceinline__ void operator()(const f32x4 (&acc)[2][2][4][2], const Unit& u, int wr, int wc, int fr, int fq) const {
        const int row0 = u.pm * 256 + wr * 64 + fr, col0 = u.pn * 256 + wc * 32 + 8 * fq;
#pragma unroll
        for (int ai = 0; ai < 2; ++ai)
#pragma unroll
            for (int m = 0; m < 4; ++m) {
                const int row = row0 + ai * 128 + m * 16; float sq;
                if (ROPE) { const f32x4 pa = *(const f32x4*)(ss + (size_t)row * 16), pb = *(const f32x4*)(ss + (size_t)row * 16 + 4); sq = ((pa[0] + pa[1]) + (pa[2] + pa[3])) + ((pb[0] + pb[1]) + (pb[2] + pb[3])); }
                else { const f32x4 pa = *(const f32x4*)(ss + (size_t)row * 16 + 8); sq = (pa[0] + pa[1]) + (pa[2] + pa[3]); }
                const float rs = rsqrtf(sq * inv_n + EPS) * sc; bf16_t* rowp = dst + (size_t)row * ld + col0;
#pragma unroll
                for (int bj = 0; bj < 2; ++bj) {
                    f32x4 v0 = acc[ai][bj][m][0] * rs, v1 = acc[ai][bj][m][1] * rs; u32x4 w;
                    const int hc = (col0 + bj * 128) % 192;
                    if (ROPE && hc >= 128) {
                        const int j0 = (hc - 128) >> 1, pos = row & (SEQ - 1);
                        const f32x2 c0 = cs[pos * 32 + j0], c1 = cs[pos * 32 + j0 + 1], c2 = cs[pos * 32 + j0 + 2], c3 = cs[pos * 32 + j0 + 3];
                        w.x = cvt_pk_bf16(v0[0] * c0.x - v0[1] * c0.y, v0[0] * c0.y + v0[1] * c0.x);
                        w.y = cvt_pk_bf16(v0[2] * c1.x - v0[3] * c1.y, v0[2] * c1.y + v0[3] * c1.x);
                        w.z = cvt_pk_bf16(v1[0] * c2.x - v1[1] * c2.y, v1[0] * c2.y + v1[1] * c2.x);
                        w.w = cvt_pk_bf16(v1[2] * c3.x - v1[3] * c3.y, v1[2] * c3.y + v1[3] * c3.x);
                    } else { w.x = cvt_pk_bf16(v0[0], v0[1]); w.y = cvt_pk_bf16(v0[2], v0[3]); w.z = cvt_pk_bf16(v1[0], v1[1]); w.w = cvt_pk_bf16(v1[2], v1[3]); }
                    *(u32x4*)(rowp + bj * 128) = w;
                }
            }
    }
};

struct EpiMerge {
    static constexpr bool PERM = true, AFTER_DRAIN = false;
    bf16_t* merged; const bf16_t* gt;
    __device__ __forceinline__ void operator()(const f32x4 (&acc)[2][2][4][2], const Unit& u, int wr, int wc, int fr, int fq) const {
        const int n = u.pm >> 6, pmr = u.pm & 63; const int row0 = pmr * 256 + wr * 64 + fr, col0 = u.pn * 256 + wc * 32 + 8 * fq;
#pragma unroll
        for (int ai = 0; ai < 2; ++ai)
#pragma unroll
            for (int m = 0; m < 4; ++m) {
                const int row = row0 + ai * 128 + m * 16;
#pragma unroll
                for (int bj = 0; bj < 2; ++bj) {
                    const u32x4 gw = *(const u32x4*)(gt + (size_t)row * 6144 + n * 2048 + col0 + bj * 128);
                    bf16_t* mp = merged + (size_t)row * 2048 + col0 + bj * 128;
                    u32x4 pw = (u32x4){0u, 0u, 0u, 0u}; if (n > 0) pw = __builtin_nontemporal_load((const u32x4*)mp);
                    const f32x4 v0 = acc[ai][bj][m][0], v1 = acc[ai][bj][m][1]; u32x4 w;
                    w.x = cvt_pk_bf16(bflo(pw.x) + bflo(gw.x) * v0[0], bfhi(pw.x) + bfhi(gw.x) * v0[1]);
                    w.y = cvt_pk_bf16(bflo(pw.y) + bflo(gw.y) * v0[2], bfhi(pw.y) + bfhi(gw.y) * v0[3]);
                    w.z = cvt_pk_bf16(bflo(pw.z) + bflo(gw.z) * v1[0], bfhi(pw.z) + bfhi(gw.z) * v1[1]);
                    w.w = cvt_pk_bf16(bflo(pw.w) + bflo(gw.w) * v1[2], bfhi(pw.w) + bfhi(gw.w) * v1[3]);
                    *(u32x4*)mp = w;
                }
            }
        asm volatile("s_waitcnt vmcnt(0)" ::: "memory");
    }
};
struct MergeOrder {
    int G, c;
    __device__ bool next(int i, Unit& u) const {
        const int t3 = i / 3, n = i - 3 * t3; const long L = (long)t3 * G + c; if (L >= 512) return false;
        const int tm = (int)(L >> 3), tn = (int)(L & 7); u.pm = n * 64 + tm; u.pn = tn; u.pb = n * 8 + tn; return true;
    }
    __device__ __forceinline__ void a_ready(const Unit&) const {}
    __device__ __forceinline__ void done(const Unit&) const {}
};

struct EpiOut {
    static constexpr bool PERM = false, AFTER_DRAIN = false;
    const float* xin; float* xout;
    __device__ __forceinline__ void operator()(const f32x4 (&acc)[2][2][4][2], const Unit& u, int wr, int wc, int fr, int fq) const {
        const int row0 = u.pm * 256 + wr * 64 + fr, col0 = u.pn * 256 + wc * 32 + 4 * fq;
#pragma unroll
        for (int ai = 0; ai < 2; ++ai)
#pragma unroll
            for (int m = 0; m < 4; ++m) {
                const size_t ro = (size_t)(row0 + ai * 128 + m * 16) * DM + col0;
#pragma unroll
                for (int bj = 0; bj < 2; ++bj)
#pragma unroll
                    for (int n = 0; n < 2; ++n) { const f32x4 b = *(const f32x4*)(xin + ro + bj * 128 + n * 16); *(f32x4*)(xout + ro + bj * 128 + n * 16) = b + acc[ai][bj][m][n]; }
            }
    }
};

template <class F> __device__ __forceinline__ void tconv(unsigned char* lds, const float* src, int ldsrc, int K, bf16_t* dst, int N, const float* gain, F f, const int g_wv) {
    float* tile = (float*)lds; int tid = TIDX; asm volatile("" : "+v"(tid)); const int tilesK = K >> 6, ntile = tilesK * (N >> 8);
    const int nn4 = (tid & 63) * 4, kk0 = tid >> 6; f32x4 pre[8];
#define TCONV_LOAD(tt_) do { const int tn_ = (tt_) / tilesK, tk_ = (tt_) - tn_ * tilesK; const int c0 = f(tn_ * 256 + nn4), c1 = f(tn_ * 256 + nn4 + 1), c2 = f(tn_ * 256 + nn4 + 2), c3 = f(tn_ * 256 + nn4 + 3); \
        const bool vec = (c0 >= 0) && ((c0 & 3) == 0) && (c3 == c0 + 3); const float* sp = src + (size_t)(tk_ * 64 + kk0) * ldsrc; \
        _Pragma("unroll") for (int e = 0; e < 8; ++e) { const float* rp = sp + (size_t)(8 * e) * ldsrc; f32x4 v; \
            if (vec) v = *(const f32x4*)(rp + c0); \
            else { v[0] = c0 >= 0 ? rp[c0] : 0.f; v[1] = c1 >= 0 ? rp[c1] : 0.f; v[2] = c2 >= 0 ? rp[c2] : 0.f; v[3] = c3 >= 0 ? rp[c3] : 0.f; } \
            pre[e] = v; } } while (0)
    int t = blockIdx.x;
    if (t < ntile) TCONV_LOAD(t);
    for (; t < ntile; t += gridDim.x) {
        const int tn = t / tilesK, tk = t - tn * tilesK;
#pragma unroll
        for (int e = 0; e < 8; ++e) { f32x4 v = pre[e]; if (gain) v = v * gain[tk * 64 + kk0 + 8 * e]; *(f32x4*)(tile + (kk0 + 8 * e) * 260 + nn4) = v; }
        __syncthreads();
        { const int t2 = t + (int)gridDim.x; if (t2 < ntile) TCONV_LOAD(t2); }
        { const int nn = tid >> 1, kc = (tid & 1) * 32; bf16_t* dp = dst + (size_t)(tn * 256 + nn) * K + tk * 64 + kc;
#pragma unroll
          for (int q4 = 0; q4 < 4; ++q4) { float v[8];
#pragma unroll
              for (int i = 0; i < 8; ++i) v[i] = tile[(kc + q4 * 8 + i) * 260 + nn];
              u32x4 w; w.x = cvt_pk_bf16(v[0], v[1]); w.y = cvt_pk_bf16(v[2], v[3]); w.z = cvt_pk_bf16(v[4], v[5]); w.w = cvt_pk_bf16(v[6], v[7]);
              *(u32x4*)(dp + q4 * 8) = w; } }
        __syncthreads();
    }
#undef TCONV_LOAD
}
__device__ __forceinline__ int win_src_col(int n) {
    if (n < 1024) return n;
    if (n < 2048) return 1024 + (n - 1024);
    if (n < 3072) return 3072 + (n - 2048);
    if (n < 3584) return 4096 + (n - 3072);
    if (n < 4096) return 4608 + (n - 3584);
    if (n < 5120) return 5120 + (n - 4096);
    if (n < 6144) return 6152 + (n - 5120);
    if (n < 7168) return 7176 + (n - 6144);
    if (n < 7680) return 8200 + (n - 7168);
    if (n < 7936) return 8712 + (n - 7680);
    if (n < 8960) return 9032 + (n - 7936);
    if (n < 15104) return 10056 + (n - 8960);
    if (n < 15360) { const int r = n - 15104; if (r < 4) return 6144 + r; if (r < 8) return 6148 + (r - 4); if (r < 72) { const int j = (r - 8) >> 1, odd = (r - 8) & 1; return 8968 + j + 32 * odd; } return -1; }
    return 2048 + (n - 15360);
}
__device__ __forceinline__ void convert_weights(unsigned char* lds, const Params& p, int l, const int g_wv) {
    unsigned char* wl = p.ws + WS_W0 + (size_t)l * WL_SIZE;
    tconv(lds, p.w_in + (size_t)l * DM * DIN, DIN, DM, (bf16_t*)(wl + WL_WIN), 16384, nullptr, [](int n) { return win_src_col(n); }, g_wv);
#pragma unroll 1
    for (int n = 0; n < 3; ++n)
        tconv(lds, p.w_branch + ((size_t)l * 3 + n) * 1024 * DM, DM, 1024, (bf16_t*)(wl + WL_WB) + (size_t)n * 2048 * 1024, 2048, nullptr, [](int c) { return c; }, g_wv);
    tconv(lds, p.w_out + (size_t)l * DM * DM, DM, DM, (bf16_t*)(wl + WL_WO), DM, nullptr, [](int c) { return c; }, g_wv);
    tconv(lds, p.w_uq + (size_t)l * 512 * 1536, 1536, 512, (bf16_t*)(wl + WL_WUQ), 1536, p.q_norm + l * 512,
          [](int n) { const int h = n / 192, hc = n - h * 192; if (hc < 128) return n; const int r = hc - 128; return h * 192 + 128 + (r >> 1) + 32 * (r & 1); }, g_wv);
    tconv(lds, p.w_ukv + (size_t)l * 256 * 2048, 2048, 256, (bf16_t*)(wl + WL_WKN), 1024, p.kv_norm + l * 256, [](int n) { return (n >> 7) * 256 + (n & 127); }, g_wv);
    tconv(lds, p.w_ukv + (size_t)l * 256 * 2048, 2048, 256, (bf16_t*)(wl + WL_WV), 1024, p.kv_norm + l * 256, [](int n) { return (n >> 7) * 256 + 128 + (n & 127); }, g_wv);
}
__device__ __forceinline__ void sincos_acc(float ang, float& s, float& c) {
    const double x = (double)ang; const double q = rint(x * 0.63661977236758134308);
    double r = fma(-q, 1.57079632679489655800e+00, x); r = fma(-q, 6.12323399573676603587e-17, r);
    const int qi = ((int)q) & 3; const double r2 = r * r;
    const double sp = r + r * r2 * (-1.66666666666666324348e-01 + r2 * (8.33333333332248946124e-03 + r2 * (-1.98412698298579493134e-04 + r2 * (2.75573137070700676789e-06 + r2 * (-2.50507602534068634195e-08 + r2 * 1.58969099521155010221e-10)))));
    const double cp = 1.0 - 0.5 * r2 + r2 * r2 * (4.16666666666666019037e-02 + r2 * (-1.38888888888741095749e-03 + r2 * (2.48015872894767294178e-05 + r2 * (-2.75573143513906633035e-07 + r2 * (2.08757232129817482790e-09 + r2 * -1.13596475577881948265e-11)))));
    double ss, cc; if (qi == 0) { ss = sp; cc = cp; } else if (qi == 1) { ss = cp; cc = -sp; } else if (qi == 2) { ss = -sp; cc = -cp; } else { ss = -cp; cc = sp; }
    s = (float)ss; c = (float)cc;
}
__device__ __forceinline__ void build_cs(const Params& p, const int g_wv) {
    f32x2* cs = (f32x2*)(p.ws + WS_CS);
    int i0 = blockIdx.x * NTHR + TIDX; asm volatile("" : "+v"(i0));
    for (int i = i0; i < SEQ * 32; i += gridDim.x * NTHR) {
        const int pos = i >> 5, j = i & 31; double inv = 1.0; for (int k = 0; k < j; ++k) inv *= 0.7498942093324558;
        const float ang = (float)pos * (float)inv; float s, c; sincos_acc(ang, s, c); cs[i] = (f32x2){c, s};
    }
}
__device__ __forceinline__ void zero_ss(const Params& p, const int g_wv) {
    float* a = (float*)(p.ws + WS_SSQ);
    int i0 = blockIdx.x * NTHR + TIDX; asm volatile("" : "+v"(i0));
    for (int i = i0; i < 2 * T; i += gridDim.x * NTHR) a[i] = 0.f;
}
template <bool OUTBF> __device__ __forceinline__ void rmsnorm_rows(const float* x, const float* gain, bf16_t* hb, float* of, const int g_wv) {
    int tid = TIDX; asm volatile("" : "+v"(tid)); const int lane = tid & 63, gw = blockIdx.x * (NTHR / 64) + (tid >> 6), nw = gridDim.x * (NTHR / 64);
    for (int row = gw; row < T; row += nw) {
        const float* xr = x + (size_t)row * DM; f32x4 v[8]; float ss = 0.f;
#pragma unroll
        for (int i = 0; i < 8; ++i) { v[i] = *(const f32x4*)(xr + i * 256 + lane * 4); ss += (v[i][0] * v[i][0] + v[i][1] * v[i][1]) + (v[i][2] * v[i][2] + v[i][3] * v[i][3]); }
#pragma unroll
        for (int o = 1; o < 64; o <<= 1) ss += shx(ss, o, lane);
        const float rs = rsqrtf(ss * (1.0f / DM) + EPS);
#pragma unroll
        for (int i = 0; i < 8; ++i) {
            const f32x4 gn = *(const f32x4*)(gain + i * 256 + lane * 4); const f32x4 y = v[i] * rs * gn;
            if (OUTBF) { u32x2 w; w.x = cvt_pk_bf16(y[0], y[1]); w.y = cvt_pk_bf16(y[2], y[3]); *(u32x2*)(hb + (size_t)row * DM + i * 256 + lane * 4) = w; }
            else *(f32x4*)(of + (size_t)row * DM + i * 256 + lane * 4) = y;
        }
    }
}

__device__ __forceinline__ void kmean_phase(const Params& p, int l, const int g_wv) {
    const bf16_t* ka = (const bf16_t*)(p.ws + WS_KA); bf16_t* km = (bf16_t*)(p.ws + WS_KM); bf16_t* kml = (bf16_t*)(p.ws + WS_SSQ); int tid = TIDX; asm volatile("" : "+v"(tid));
    for (int u = blockIdx.x; u < 64; u += gridDim.x) {
        const int b = u >> 4, j = u & 15; const unsigned* src = (const unsigned*)(ka + ((size_t)b * SEQ + j * 256) * 1024) + tid; float a0 = 0.f, a1 = 0.f;
#pragma unroll 8
        for (int r = 0; r < 256; ++r) { const unsigned w = src[(size_t)r * 512]; a0 += bflo(w); a1 += bfhi(w); }
        const int col = tid * 2, h = col >> 7, d = col & 127;
        const float m0 = a0 * (1.0f / 256.0f), m1 = a1 * (1.0f / 256.0f); const unsigned hi = cvt_pk_bf16(m0, m1);
        *(unsigned*)(km + ((size_t)((b * 8 + h) * 16 + j)) * 128 + d) = hi;
        *(unsigned*)(kml + ((size_t)((b * 8 + h) * 16 + j)) * 128 + d) = cvt_pk_bf16(m0 - bflo(hi), m1 - bfhi(hi));
    }
}

template <int MODE> __device__ __forceinline__ void attn_phase(unsigned char* lds, const Params& p, int l, const int g_wv) {
    constexpr int DQK = MODE ? 192 : 128, NC = DQK / 32, NCH = DQK / 8, KRS = DQK * 2 + 32, KBUF = 64 * KRS, VRS = 144, VBUF = 128 * VRS;
    constexpr int OFF_V = 2 * KBUF, OFF_LUT = OFF_V + 2 * VBUF, OFF_KM = OFF_LUT + 512, NKL = (64 * NCH) / NTHR;
    int tid = TIDX; asm volatile("" : "+v"(tid)); const int lane = tid & 63, w = tid >> 6, lr = lane & 15, g = lane >> 4; const int G = gridDim.x, c = blockIdx.x;
    unsigned char* ws = p.ws;
    const bf16_t* Qp = (const bf16_t*)(ws + (MODE ? WS_QC : WS_QA)); constexpr int LDQ = MODE ? 1536 : 1024;
    const bf16_t* Kp = (const bf16_t*)(ws + (MODE ? WS_KNC : WS_KA)); const bf16_t* KRp = (const bf16_t*)(ws + WS_KR);
    const bf16_t* VTp = (const bf16_t*)(ws + (MODE ? WS_VCT : WS_VAT)); bf16_t* Zp = (bf16_t*)(ws + WS_Z + (MODE ? 64 * MiB : 0));
    float* lut = (float*)(lds + OFF_LUT);
    for (int rd = 0; rd * G < 512; ++rd) {
        int qblk, bh;
        if (G == 256) {
            const int xq = c & 7, iq = c >> 3, qq = iq >> 1;
            bh = 2 * xq + (iq & 1) + 16 * rd; qblk = rd ? qq : 15 - qq;
        } else { const int idx = rd * G + ((rd & 1) ? (G - 1 - c) : c); if (idx >= 512) continue; qblk = 15 - (idx >> 5); bh = idx & 31; }
        const int b = bh >> 3, h = bh & 7;
        const int q0 = qblk * 256 + w * 32; const size_t tq = (size_t)b * SEQ + q0; const int nt = (qblk + 1) * 4;
        bf16x8 qf[2][NC];
#pragma unroll
        for (int qb = 0; qb < 2; ++qb)
#pragma unroll
            for (int c2 = 0; c2 < NC; ++c2) qf[qb][c2] = *(const bf16x8*)(Qp + (tq + qb * 16 + lr) * LDQ + h * DQK + c2 * 32 + g * 8);
        u32x4 kreg[NKL];
#define ATT_LOADK(t_) do { const int t__ = (t_); \
        _Pragma("unroll") for (int i = 0; i < NKL; ++i) { const int id = tid + NTHR * i; const int key = id / NCH, ch = id - key * NCH; const size_t tk = (size_t)b * SEQ + t__ * 64 + key; \
            const bf16_t* s_ = (!MODE || ch < 16) ? (Kp + tk * 1024 + h * 128 + ch * 8) : (KRp + tk * 64 + (ch - 16) * 8); kreg[i] = *(const u32x4*)s_; } } while (0)
#define ATT_LOADV(t_) do { const int t__ = (t_); \
        _Pragma("unroll") for (int i = 0; i < 2; ++i) { const int id = tid + NTHR * i; const int row = id >> 3, ch = id & 7; \
            kreg[i] = *(const u32x4*)(VTp + (size_t)(h * 128 + row) * T + (size_t)b * SEQ + t__ * 64 + ch * 8); } } while (0)
#define ATT_STOREK(buf_) do { unsigned char* kb_ = lds + (buf_) * KBUF; \
        _Pragma("unroll") for (int i = 0; i < NKL; ++i) { const int id = tid + NTHR * i; const int key = id / NCH, ch = id - key * NCH; *(u32x4*)(kb_ + key * KRS + ch * 16) = kreg[i]; } } while (0)
#define ATT_STOREV(buf_) do { unsigned char* vb_ = lds + OFF_V + (buf_) * VBUF; \
        _Pragma("unroll") for (int i = 0; i < 2; ++i) { const int id = tid + NTHR * i; const int row = id >> 3, ch = id & 7; *(u32x4*)(vb_ + row * VRS + ch * 16) = kreg[i]; } } while (0)
        ATT_LOADK(0); ATT_STOREK(0); ATT_LOADV(0);
        unsigned sel[2] = {0u, 0u};
        if (MODE == 0) {
            if (tid < 128) { const int d = tid; int bk = d; if (d >= 16) { bk = 16 + (int)(logf((float)d * (1.0f / 16.0f)) / 2.0794415416798357f * 16.0f); bk = bk > 31 ? 31 : bk; } lut[d] = p.t5[bk * 8 + h] * LOG2E; }
            { const int half = tid >> 8, row = (tid >> 4) & 15, ch = tid & 15; *(u32x4*)(lds + OFF_KM + half * 4608 + row * 288 + ch * 16) = *(const u32x4*)((const bf16_t*)(ws + (half ? WS_SSQ : WS_KM)) + ((size_t)((b * 8 + h) * 16 + row)) * 128 + ch * 8); }
        }
        ATT_STOREV(0);
        __syncthreads();
        if (MODE == 0) {
            f32x4 ga[2] = {zero4(), zero4()};
#pragma unroll
            for (int c2 = 0; c2 < NC; ++c2) { const bf16x8 kf = *(const bf16x8*)(lds + OFF_KM + lr * 288 + c2 * 64 + g * 16), kfl = *(const bf16x8*)(lds + OFF_KM + 4608 + lr * 288 + c2 * 64 + g * 16);
#pragma unroll
                for (int qb = 0; qb < 2; ++qb) { const bf16x8 ql = *(const bf16x8*)((const bf16_t*)(ws + WS_QAL) + (tq + qb * 16 + lr) * 1024 + h * 128 + c2 * 32 + g * 8);
                    ga[qb] = mfma16(kfl, qf[qb][c2], ga[qb]); ga[qb] = mfma16(kf, ql, ga[qb]); ga[qb] = mfma16(kf, qf[qb][c2], ga[qb]); } }
#pragma unroll
            for (int qb = 0; qb < 2; ++qb) {
                float gv[4];
#pragma unroll
                for (int r = 0; r < 4; ++r) gv[r] = (g * 4 + r < qblk) ? ga[qb][r] : -INFINITY;
                unsigned s = 0u;
#pragma unroll
                for (int it = 0; it < 3; ++it) {
                    float bv = -INFINITY; int bi = 99;
#pragma unroll
                    for (int r = 0; r < 4; ++r) if (gv[r] > bv) { bv = gv[r]; bi = g * 4 + r; }
#pragma unroll
                    for (int o = 16; o <= 32; o <<= 1) { const float ov = shx(bv, o, lane); const int oi = shxi(bi, o, lane); if (ov > bv || (ov == bv && oi < bi)) { bv = ov; bi = oi; } }
                    if (bv > -INFINITY) s |= 1u << bi;
#pragma unroll
                    for (int r = 0; r < 4; ++r) if (g * 4 + r == bi) gv[r] = -INFINITY;
                }
                sel[qb] = s;
            }
        }
        f32x4 oacc[8][2];
#pragma unroll
        for (int i = 0; i < 8; ++i) { oacc[i][0] = zero4(); oacc[i][1] = zero4(); }
        float mrow[2] = {NEGV, NEGV}, lrow[2] = {0.f, 0.f};
        for (int t = 0; t < nt; ++t) {
            const int buf = t & 1; const bool more = (t + 1 < nt);
            if (more) ATT_LOADK(t + 1);
            const int k0 = t * 64;
            const unsigned char* kb_ = lds + buf * KBUF; const unsigned char* vb_ = lds + OFF_V + buf * VBUF;
#pragma unroll 1
            for (int hf = 0; hf < 2; ++hf) {
              const int kh = k0 + hf * 32;
              if (kh <= q0 + 31) {
                f32x4 sacc[2][2];
#pragma unroll
                for (int kb = 0; kb < 2; ++kb) { sacc[kb][0] = zero4(); sacc[kb][1] = zero4(); }
#pragma unroll
                for (int c2 = 0; c2 < NC; ++c2)
#pragma unroll
                    for (int kb = 0; kb < 2; ++kb) { const bf16x8 kf = *(const bf16x8*)(kb_ + (hf * 32 + kb * 16 + lr) * KRS + c2 * 64 + g * 16);
                        sacc[kb][0] = mfma16(kf, qf[0][c2], sacc[kb][0]); sacc[kb][1] = mfma16(kf, qf[1][c2], sacc[kb][1]); }
                if (MODE == 0) {
                    const int jblk = t >> 2; const bool far = (kh + 31 + 127 <= q0);
                    if (far) { const float bfar = lut[127];
#pragma unroll
                        for (int qb = 0; qb < 2; ++qb) { const bool al = (jblk < qblk) ? (((sel[qb] >> jblk) & 1u) != 0u) : true;
#pragma unroll
                            for (int kb = 0; kb < 2; ++kb)
#pragma unroll
                                for (int r = 0; r < 4; ++r) sacc[kb][qb][r] = al ? sacc[kb][qb][r] + bfar : NEGV; }
                    } else {
#pragma unroll
                        for (int qb = 0; qb < 2; ++qb) { const int qpos = q0 + qb * 16 + lr; const bool alp = (sel[qb] >> jblk) & 1u;
#pragma unroll
                            for (int kb = 0; kb < 2; ++kb)
#pragma unroll
                                for (int r = 0; r < 4; ++r) { const int d = qpos - (kh + kb * 16 + g * 4 + r); const int di = d < 0 ? 0 : (d > 127 ? 127 : d);
                                    const bool al = (jblk < qblk) ? alp : (d >= 0); sacc[kb][qb][r] = al ? sacc[kb][qb][r] + lut[di] : NEGV; } }
                    }
                } else {
                    if (kh + 31 > q0) {
#pragma unroll
                        for (int qb = 0; qb < 2; ++qb) { const int qpos = q0 + qb * 16 + lr;
#pragma unroll
                            for (int kb = 0; kb < 2; ++kb)
#pragma unroll
                                for (int r = 0; r < 4; ++r) if (kh + kb * 16 + g * 4 + r > qpos) sacc[kb][qb][r] = NEGV; }
                    }
                }
                bf16x8 pf[2];
#pragma unroll
                for (int qb = 0; qb < 2; ++qb) {
                    float mx = NEGV;
#pragma unroll
                    for (int kb = 0; kb < 2; ++kb)
#pragma unroll
                        for (int r = 0; r < 4; ++r) mx = fmaxf(mx, sacc[kb][qb][r]);
                    mx = fmaxf(mx, shx(mx, 16, lane)); mx = fmaxf(mx, shx(mx, 32, lane));
                    const float mnew = fmaxf(mrow[qb], mx), alpha = fexp2(mrow[qb] - mnew); mrow[qb] = mnew; float ps = 0.f;
#pragma unroll
                    for (int kb = 0; kb < 2; ++kb)
#pragma unroll
                        for (int r = 0; r < 4; ++r) { const float e = fexp2(sacc[kb][qb][r] - mnew); sacc[kb][qb][r] = e; ps += e; }
                    lrow[qb] = lrow[qb] * alpha + ps;
#pragma unroll
                    for (int i = 0; i < 8; ++i) oacc[i][qb] = oacc[i][qb] * alpha;
                    union { u32x4 u; bf16x8 v; } cvt;
                    cvt.u.x = cvt_pk_bf16(sacc[0][qb][0], sacc[0][qb][1]); cvt.u.y = cvt_pk_bf16(sacc[0][qb][2], sacc[0][qb][3]);
                    cvt.u.z = cvt_pk_bf16(sacc[1][qb][0], sacc[1][qb][1]); cvt.u.w = cvt_pk_bf16(sacc[1][qb][2], sacc[1][qb][3]); pf[qb] = cvt.v;
                }
#pragma unroll
                for (int dvb = 0; dvb < 8; ++dvb) { union { u32x2 u[2]; bf16x8 v; } vf; const unsigned char* vp = vb_ + (dvb * 16 + lr) * VRS + (hf * 32 + g * 4) * 2;
                    vf.u[0] = *(const u32x2*)vp; vf.u[1] = *(const u32x2*)(vp + 32);
                    oacc[dvb][0] = mfma16(vf.v, pf[0], oacc[dvb][0]); oacc[dvb][1] = mfma16(vf.v, pf[1], oacc[dvb][1]); }
              }
              if (more) { if (hf == 0) { ATT_STOREK(buf ^ 1); ATT_LOADV(t + 1); } else { ATT_STOREV(buf ^ 1); } }
            }
            __syncthreads();
        }
#pragma unroll
        for (int qb = 0; qb < 2; ++qb) {
            float l = lrow[qb]; l += shx(l, 16, lane); l += shx(l, 32, lane); const float inv = 1.0f / l;
            bf16_t* zr = Zp + (tq + qb * 16 + lr) * 1024 + h * 128 + g * 4;
#pragma unroll
            for (int dvb = 0; dvb < 8; ++dvb) { const u32x2 zw = *(const u32x2*)(zr + dvb * 16); const f32x4 o = oacc[dvb][qb] * inv; u32x2 ow;
                ow.x = cvt_pk_bf16(o[0] * bflo(zw.x), o[1] * bfhi(zw.x)); ow.y = cvt_pk_bf16(o[2] * bflo(zw.y), o[3] * bfhi(zw.y)); *(u32x2*)(zr + dvb * 16) = ow; }
        }
#undef ATT_LOADK
#undef ATT_LOADV
#undef ATT_STOREK
#undef ATT_STOREV
    }
}

__device__ __forceinline__ void mlstm_a(unsigned char* lds, const Params& p, int l, const int g_wv) {
    constexpr int K2RS = 272, TRS = 160; constexpr int OFF_K2 = 0, OFF_WKT = 64 * K2RS, OFF_VT = OFF_WKT + 128 * TRS, OFF_WG = OFF_VT + 256 * TRS;
    unsigned char* ws = p.ws; int tid = TIDX; asm volatile("" : "+v"(tid)); const int lane = tid & 63, w = tid >> 6, lr = lane & 15, g = lane >> 4;
    const bf16_t* QB = (const bf16_t*)(ws + WS_QB); const bf16_t* KB = (const bf16_t*)(ws + WS_KB); const bf16_t* VB = (const bf16_t*)(ws + WS_VB);
    bf16_t* Q2 = (bf16_t*)(ws + WS_Q2); bf16_t* K2 = (bf16_t*)(ws + WS_K2); const float* gates = (const float*)(ws + WS_GATES);
    const float* cw = p.conv_w + (size_t)l * 4 * 1024; const float* cb = p.conv_b + (size_t)l * 1024;
    float* wg = (float*)(lds + OFF_WG);
    for (int u = blockIdx.x; u < 1024; u += gridDim.x) {
        const int bh = u >> 6, c = u & 63, b = bh >> 2, h = bh & 3; const size_t t0 = (size_t)b * SEQ + c * 64;
#pragma unroll 1
        for (int it = 0; it < 4; ++it) {
            const int item = tid + NTHR * it, which = item >> 10, s = (item >> 4) & 63, grp = item & 15; const int ch0 = h * 128 + grp * 8, cc0 = which * 512 + ch0;
            const bf16_t* src = which ? KB : QB; float a[8];
            { const f32x4 b0 = *(const f32x4*)(cb + cc0), b1 = *(const f32x4*)(cb + cc0 + 4); a[0] = b0[0]; a[1] = b0[1]; a[2] = b0[2]; a[3] = b0[3]; a[4] = b1[0]; a[5] = b1[1]; a[6] = b1[2]; a[7] = b1[3]; }
#pragma unroll
            for (int j = 0; j < 4; ++j) { const int tp = c * 64 + s - 3 + j;
                if (tp >= 0) { const u32x4 xw = *(const u32x4*)(src + ((size_t)b * SEQ + tp) * 512 + ch0); const f32x4 w0 = *(const f32x4*)(cw + j * 1024 + cc0), w1 = *(const f32x4*)(cw + j * 1024 + cc0 + 4);
                    a[0] += bflo(xw.x) * w0[0]; a[1] += bfhi(xw.x) * w0[1]; a[2] += bflo(xw.y) * w0[2]; a[3] += bfhi(xw.y) * w0[3];
                    a[4] += bflo(xw.z) * w1[0]; a[5] += bfhi(xw.z) * w1[1]; a[6] += bflo(xw.w) * w1[2]; a[7] += bfhi(xw.w) * w1[3]; } }
            const float ksc = which ? 0.08838834764831845f : 1.0f;
#pragma unroll
            for (int i = 0; i < 8; ++i) a[i] = fsilu(a[i]) * ksc;
            u32x4 ow; ow.x = cvt_pk_bf16(a[0], a[1]); ow.y = cvt_pk_bf16(a[2], a[3]); ow.z = cvt_pk_bf16(a[4], a[5]); ow.w = cvt_pk_bf16(a[6], a[7]);
            *(u32x4*)((which ? K2 : Q2) + (t0 + s) * 512 + ch0) = ow;
            if (which) *(u32x4*)(lds + OFF_K2 + s * K2RS + grp * 16) = ow;
        }
        if (w == 0) {
            const float fpre = gates[(t0 + lane) * 8 + 4 + h] + p.f_bias[l * 4 + h]; const float li = gates[(t0 + lane) * 8 + h] + p.i_bias[l * 4 + h];
            const float lf = fminf(fpre, 0.f) - log1pf(__expf(-fabsf(fpre)));
            float bc = lf;
#pragma unroll
            for (int o = 1; o < 64; o <<= 1) { const float v = shup(bc, o, lane); if (lane >= o) bc += v; }
            const float blast = __int_as_float(__builtin_amdgcn_readlane(__float_as_int(bc), 63)); const float gg = blast - bc + li; float gm = gg;
#pragma unroll
            for (int o = 1; o < 64; o <<= 1) gm = fmaxf(gm, shx(gm, o, lane));
            wg[lane] = __expf(gg - gm);
            ((float*)(ws + WS_BV))[(size_t)u * 64 + lane] = bc; ((float*)(ws + WS_LIV))[(size_t)u * 64 + lane] = li;
            if (lane == 0) { ((float*)(ws + WS_BLAST))[u] = blast; ((float*)(ws + WS_GMAX))[u] = gm; }
        }
#pragma unroll
        for (int it = 0; it < 4; ++it) { const int item = tid + NTHR * it, s = item & 63, eg = item >> 6; const u32x4 vw = *(const u32x4*)(VB + (t0 + s) * 1024 + h * 256 + eg * 8);
            bf16_t* d = (bf16_t*)(lds + OFF_VT + (eg * 8) * TRS + s * 2); const unsigned vv[4] = {vw.x, vw.y, vw.z, vw.w};
#pragma unroll
            for (int i = 0; i < 4; ++i) { *(bf16_t*)((unsigned char*)d + (2 * i) * TRS) = (bf16_t)(vv[i] & 0xffffu); *(bf16_t*)((unsigned char*)d + (2 * i + 1) * TRS) = (bf16_t)(vv[i] >> 16); } }
        __syncthreads();
#pragma unroll 1
        for (int it = 0; it < 2; ++it) { const int item = tid + NTHR * it, s = item & 63, dg = item >> 6; const u32x4 kw = *(const u32x4*)(lds + OFF_K2 + s * K2RS + dg * 16); const float ww = wg[s];
            const unsigned kv[4] = {kw.x, kw.y, kw.z, kw.w}; unsigned char* d = lds + OFF_WKT + (dg * 8) * TRS + s * 2;
#pragma unroll
            for (int i = 0; i < 4; ++i) { *(bf16_t*)(d + (2 * i) * TRS) = f2bf(bflo(kv[i]) * ww); *(bf16_t*)(d + (2 * i + 1) * TRS) = f2bf(bfhi(kv[i]) * ww); } }
        __syncthreads();
#if defined(MK_DEBUG_HASH)
        { unsigned char* dbg = ws + WS_END + MiB + (size_t)u * 40960; for (int i = tid; i < 2560; i += NTHR) *(u32x4*)(dbg + i * 16) = *(const u32x4*)(lds + OFF_VT + i * 16); }
#endif
        if (tid < 128) { float a = 0.f; const unsigned char* r = lds + OFF_WKT + tid * TRS;
#pragma unroll
            for (int i = 0; i < 8; ++i) { const u32x4 x = *(const u32x4*)(r + i * 16); a += (bflo(x.x) + bfhi(x.x)) + (bflo(x.y) + bfhi(x.y)) + (bflo(x.z) + bfhi(x.z)) + (bflo(x.w) + bfhi(x.w)); }
            ((float*)(ws + WS_NST))[(size_t)u * 128 + tid] = a; }
        f32x4 acc[8][2];
#pragma unroll
        for (int i = 0; i < 8; ++i) { acc[i][0] = zero4(); acc[i][1] = zero4(); }
#pragma unroll
        for (int kc = 0; kc < 2; ++kc) {
            const bf16x8 v0 = *(const bf16x8*)(lds + OFF_VT + (w * 32 + lr) * TRS + kc * 64 + g * 16), v1 = *(const bf16x8*)(lds + OFF_VT + (w * 32 + 16 + lr) * TRS + kc * 64 + g * 16);
#pragma unroll
            for (int db = 0; db < 8; ++db) { const bf16x8 kf = *(const bf16x8*)(lds + OFF_WKT + (db * 16 + lr) * TRS + kc * 64 + g * 16); acc[db][0] = mfma16(kf, v0, acc[db][0]); acc[db][1] = mfma16(kf, v1, acc[db][1]); }
        }
        bf16_t* cst = (bf16_t*)(ws + WS_CST) + (size_t)u * 32768; float one = 1.0f; asm volatile("" : "+v"(one));
#pragma unroll
        for (int eb = 0; eb < 2; ++eb)
#pragma unroll
            for (int db = 0; db < 8; ++db) { const f32x4 av = acc[db][eb] * one; u32x2 o; o.x = cvt_pk_bf16(av[0], av[1]); o.y = cvt_pk_bf16(av[2], av[3]); *(u32x2*)(cst + (size_t)(w * 32 + eb * 16 + lr) * 128 + db * 16 + g * 4) = o; }
        __syncthreads();
    }
}
__device__ __forceinline__ void mlstm_b(const Params& p, const int g_wv) {
    unsigned char* ws = p.ws; int tid = TIDX; asm volatile("" : "+v"(tid)); const float* blast = (const float*)(ws + WS_BLAST); const float* gmax = (const float*)(ws + WS_GMAX);
    for (int u = blockIdx.x; u < 256; u += gridDim.x) {
        const int bh = u >> 4, eb = u & 15; bf16_t* base = (bf16_t*)(ws + WS_CST) + (size_t)bh * 64 * 32768 + eb * 2048 + tid * 4;
        float* nb = (float*)(ws + WS_NST) + (size_t)bh * 64 * 128 + tid; const bool don = (eb == 0 && tid < 128);
        float m = 0.f, c0 = 0.f, c1 = 0.f, c2 = 0.f, c3 = 0.f, nn = 0.f;
#pragma unroll 16
        for (int c = 0; c < 64; ++c) {
            const float bl = blast[bh * 64 + c], gm = gmax[bh * 64 + c]; const float mn = fmaxf(bl + m, gm); const float dec = __expf(bl + m - mn), inw = __expf(gm - mn);
            u32x2* sp = (u32x2*)(base + (size_t)c * 32768); const u32x2 uw = *sp; u32x2 o; o.x = cvt_pk_bf16(c0, c1); o.y = cvt_pk_bf16(c2, c3); *sp = o;
            c0 = dec * c0 + inw * bflo(uw.x); c1 = dec * c1 + inw * bfhi(uw.x); c2 = dec * c2 + inw * bflo(uw.y); c3 = dec * c3 + inw * bfhi(uw.y);
            if (don) { const float nu = nb[c * 128]; nb[c * 128] = nn; nn = dec * nn + inw * nu; }
            if (eb == 0 && tid == 0) ((float*)(ws + WS_MST))[bh * 64 + c] = m;
            m = mn;
        }
        asm volatile("s_waitcnt vmcnt(0)" ::: "memory"); __syncthreads();
        if (tid == 0) { __builtin_amdgcn_fence(__ATOMIC_RELEASE, "agent"); asm volatile("s_waitcnt vmcnt(0)" ::: "memory");
            __hip_atomic_fetch_add((unsigned*)(ws + WS_CTR) + 16 + bh, 1u, __ATOMIC_RELAXED, __HIP_MEMORY_SCOPE_AGENT); }
    }
}
__device__ __forceinline__ void mlstm_c(unsigned char* lds, const Params& p, int l, const int g_wv) {
    constexpr int QRS = 288, TRS = 160; constexpr int OFF_Q = 0, OFF_K = 64 * QRS, OFF_VT = 2 * 64 * QRS, OFF_P = OFF_VT + 256 * TRS, OFF_F = OFF_P + 64 * TRS;
    unsigned char* ws = p.ws; int tid = TIDX; asm volatile("" : "+v"(tid)); const int lane = tid & 63, w = tid >> 6, lr = lane & 15, g = lane >> 4;
    const bf16_t* Q2 = (const bf16_t*)(ws + WS_Q2); const bf16_t* K2 = (const bf16_t*)(ws + WS_K2); const bf16_t* VB = (const bf16_t*)(ws + WS_VB);
    const bf16_t* OB = (const bf16_t*)(ws + WS_OB); bf16_t* ZB = (bf16_t*)(ws + WS_Z + 32 * MiB); const float* gn = p.out_norm + (size_t)l * 1024;
    float* fb = (float*)(lds + OFF_F); float* bvec = fb; float* livec = fb + 64; float* mt = fb + 128; float* wint = fb + 192; float* denV = fb + 256; float* denC = fb + 320; float* lsum = fb + 384; float* lsq = fb + 448; float* nvec = fb + 512;
    for (int u = blockIdx.x; u < 1024; u += gridDim.x) {
        const int bh = u >> 6, c = u & 63, b = bh >> 2, h = bh & 3; const size_t t0 = (size_t)b * SEQ + c * 64;
        if (tid == 0) { const unsigned want = 16u * (unsigned)(l + 1); while (__hip_atomic_load((unsigned*)(ws + WS_CTR) + 16 + bh, __ATOMIC_RELAXED, __HIP_MEMORY_SCOPE_AGENT) < want) __builtin_amdgcn_s_sleep(1);
            __builtin_amdgcn_fence(__ATOMIC_ACQUIRE, "agent"); asm volatile("s_waitcnt vmcnt(0)" ::: "memory"); }
        __syncthreads();
        const float mc = ((const float*)(ws + WS_MST))[u];
#pragma unroll
        for (int it = 0; it < 2; ++it) { const int id = tid + NTHR * it, s = id >> 4, ch = id & 15;
            *(u32x4*)(lds + OFF_Q + s * QRS + ch * 16) = *(const u32x4*)(Q2 + (t0 + s) * 512 + h * 128 + ch * 8); *(u32x4*)(lds + OFF_K + s * QRS + ch * 16) = *(const u32x4*)(K2 + (t0 + s) * 512 + h * 128 + ch * 8); }
#pragma unroll 2
        for (int it = 0; it < 4; ++it) { const int item = tid + NTHR * it, s = item & 63, eg = item >> 6; const u32x4 vw = *(const u32x4*)(VB + (t0 + s) * 1024 + h * 256 + eg * 8);
            unsigned char* d = lds + OFF_VT + (eg * 8) * TRS + s * 2; const unsigned vv[4] = {vw.x, vw.y, vw.z, vw.w};
#pragma unroll
            for (int i = 0; i < 4; ++i) { *(bf16_t*)(d + (2 * i) * TRS) = (bf16_t)(vv[i] & 0xffffu); *(bf16_t*)(d + (2 * i + 1) * TRS) = (bf16_t)(vv[i] >> 16); } }
        if (tid < 64) { bvec[tid] = ((const float*)(ws + WS_BV))[(size_t)u * 64 + tid]; livec[tid] = ((const float*)(ws + WS_LIV))[(size_t)u * 64 + tid]; lsum[tid] = 0.f; lsq[tid] = 0.f; }
        else if (tid < 192) nvec[tid - 64] = ((const float*)(ws + WS_NST))[(size_t)u * 128 + tid - 64];
        __syncthreads();
        if (w == 0) { float x = livec[lane] - bvec[lane];
#pragma unroll
            for (int o = 1; o < 64; o <<= 1) { const float v = shup(x, o, lane); if (lane >= o) x = fmaxf(x, v); }
            const float mtl = bvec[lane] + fmaxf(mc, x); mt[lane] = mtl; wint[lane] = __expf(bvec[lane] + mc - mtl); }
        __syncthreads();
        { const int lb = w >> 1;
#pragma unroll
          for (int si = 0; si < 2; ++si) { const int sb = (w & 1) * 2 + si; f32x4 a = zero4();
            if (sb <= lb) {
#pragma unroll
                for (int kc = 0; kc < 4; ++kc) { const bf16x8 qf = *(const bf16x8*)(lds + OFF_Q + (lb * 16 + lr) * QRS + kc * 64 + g * 16), kf = *(const bf16x8*)(lds + OFF_K + (sb * 16 + lr) * QRS + kc * 64 + g * 16); a = mfma16(qf, kf, a); }
            }
            const int s = sb * 16 + lr; const float bs = bvec[s] - livec[s];
#pragma unroll
            for (int r = 0; r < 4; ++r) { const int ll = lb * 16 + g * 4 + r; float v = 0.f; if (s <= ll) v = a[r] * __expf(bvec[ll] - bs - mt[ll]); *(bf16_t*)(lds + OFF_P + ll * TRS + s * 2) = f2bf(v); } } }
        __syncthreads();
        if (w == 0) { float a = 0.f; const unsigned char* r = lds + OFF_P + lane * TRS;
#pragma unroll
            for (int i = 0; i < 8; ++i) { const u32x4 x = *(const u32x4*)(r + i * 16); a += (bflo(x.x) + bfhi(x.x)) + (bflo(x.y) + bfhi(x.y)) + (bflo(x.z) + bfhi(x.z)) + (bflo(x.w) + bfhi(x.w)); }
            denV[lane] = a; }
        else if (w == 1) { float a = 0.f; const unsigned char* r = lds + OFF_Q + lane * QRS;
#pragma unroll
            for (int i = 0; i < 16; ++i) { const u32x4 x = *(const u32x4*)(r + i * 16); const float* nv = nvec + i * 8;
                a += bflo(x.x) * nv[0] + bfhi(x.x) * nv[1] + bflo(x.y) * nv[2] + bfhi(x.y) * nv[3] + bflo(x.z) * nv[4] + bfhi(x.z) * nv[5] + bflo(x.w) * nv[6] + bfhi(x.w) * nv[7]; }
            denC[lane] = a; }
        f32x4 accV[2][4], accC[2][4];
#pragma unroll
        for (int i = 0; i < 2; ++i)
#pragma unroll
            for (int j = 0; j < 4; ++j) { accV[i][j] = zero4(); accC[i][j] = zero4(); }
        const bf16_t* cst = (const bf16_t*)(ws + WS_CST) + (size_t)u * 32768;
#pragma unroll
        for (int kp = 0; kp < 2; ++kp) {
        bf16x8 ctf[2][2];
#pragma unroll
        for (int k2 = 0; k2 < 2; ++k2) { const int kc = kp * 2 + k2; ctf[k2][0] = *(const bf16x8*)(cst + (size_t)(w * 32 + lr) * 128 + kc * 32 + g * 8); ctf[k2][1] = *(const bf16x8*)(cst + (size_t)(w * 32 + 16 + lr) * 128 + kc * 32 + g * 8); }
#pragma unroll
        for (int k2 = 0; k2 < 2; ++k2) { const int kc = kp * 2 + k2;
            const bf16x8 c0 = ctf[k2][0], c1 = ctf[k2][1];
#pragma unroll
            for (int lb = 0; lb < 4; ++lb) { const bf16x8 qf = *(const bf16x8*)(lds + OFF_Q + (lb * 16 + lr) * QRS + kc * 64 + g * 16); accC[0][lb] = mfma16(c0, qf, accC[0][lb]); accC[1][lb] = mfma16(c1, qf, accC[1][lb]); }
        }
        }
#pragma unroll
        for (int kc = 0; kc < 2; ++kc) {
            const bf16x8 v0 = *(const bf16x8*)(lds + OFF_VT + (w * 32 + lr) * TRS + kc * 64 + g * 16), v1 = *(const bf16x8*)(lds + OFF_VT + (w * 32 + 16 + lr) * TRS + kc * 64 + g * 16);
#pragma unroll
            for (int lb = 0; lb < 4; ++lb) { const bf16x8 pf = *(const bf16x8*)(lds + OFF_P + (lb * 16 + lr) * TRS + kc * 64 + g * 16); accV[0][lb] = mfma16(v0, pf, accV[0][lb]); accV[1][lb] = mfma16(v1, pf, accV[1][lb]); }
        }
        __syncthreads();
#pragma unroll
        for (int lb = 0; lb < 4; ++lb) { const int ll = lb * 16 + lr; const float wi = wint[ll]; const float den = wi * denC[ll] + denV[ll]; const float dn = 1.0f / fmaxf(fabsf(den), __expf(-mt[ll])); float s1 = 0.f, s2 = 0.f;
#pragma unroll
            for (int eb = 0; eb < 2; ++eb) { const f32x4 hv = (accC[eb][lb] * wi + accV[eb][lb]) * dn; accV[eb][lb] = hv; s1 += (hv[0] + hv[1]) + (hv[2] + hv[3]); s2 += (hv[0] * hv[0] + hv[1] * hv[1]) + (hv[2] * hv[2] + hv[3] * hv[3]); }
            s1 += shx(s1, 16, lane); s1 += shx(s1, 32, lane); s2 += shx(s2, 16, lane); s2 += shx(s2, 32, lane);
            if (g == 0) { fb[640 + w * 64 + ll] = s1; fb[1152 + w * 64 + ll] = s2; } }
        __syncthreads();
#pragma unroll
        for (int lb = 0; lb < 4; ++lb) { const int ll = lb * 16 + lr; float t1 = 0.f, t2 = 0.f;
#pragma unroll
            for (int ww = 0; ww < 8; ++ww) { t1 += fb[640 + ww * 64 + ll]; t2 += fb[1152 + ww * 64 + ll]; }
            const float mu = t1 * (1.0f / 256.0f); const float var = fmaxf(t2 * (1.0f / 256.0f) - mu * mu, 0.f); const float rstd = rsqrtf(var + EPS);
#pragma unroll
            for (int eb = 0; eb < 2; ++eb) { const int e = w * 32 + eb * 16 + g * 4; const size_t off = (t0 + ll) * 1024 + h * 256 + e; const f32x4 gv = *(const f32x4*)(gn + h * 256 + e);
                const u32x2 ow = *(const u32x2*)(OB + off), zw = *(const u32x2*)(ZB + off); const f32x4 hv = accV[eb][lb]; u32x2 o;
                o.x = cvt_pk_bf16((hv[0] - mu) * rstd * gv[0] * bflo(ow.x) * bflo(zw.x), (hv[1] - mu) * rstd * gv[1] * bfhi(ow.x) * bfhi(zw.x));
                o.y = cvt_pk_bf16((hv[2] - mu) * rstd * gv[2] * bflo(ow.y) * bflo(zw.y), (hv[3] - mu) * rstd * gv[3] * bfhi(ow.y) * bfhi(zw.y)); *(u32x2*)(ZB + off) = o; } }
        __syncthreads();
    }
}

#ifndef PHM
#define PHM 4095
#endif
typedef const __attribute__((address_space(4))) Params* KParams;
#if defined(__HIP_DEVICE_COMPILE__)
__device__ __forceinline__ Params load_params() { KParams k = (KParams)__builtin_amdgcn_kernarg_segment_ptr(); asm volatile("" : "+s"(k)); return *k; }
#else
__device__ __forceinline__ Params load_params() { return Params{}; }
#endif
#define PP load_params()
#define GSYNC() do { asm volatile("s_waitcnt vmcnt(0) lgkmcnt(0)" ::: "memory"); __builtin_amdgcn_fence(__ATOMIC_RELEASE, "agent"); asm volatile("s_waitcnt vmcnt(0)" ::: "memory"); grid.sync(); \
    __builtin_amdgcn_fence(__ATOMIC_ACQUIRE, "agent"); asm volatile("s_waitcnt vmcnt(0) lgkmcnt(0)" ::: "memory"); } while (0)
__device__ __forceinline__ void gbar(unsigned* ctr, unsigned target, const int g_wv) {
    asm volatile("s_waitcnt vmcnt(0) lgkmcnt(0)" ::: "memory");
    __syncthreads();
    if (TIDX == 0) {
        __builtin_amdgcn_fence(__ATOMIC_RELEASE, "agent"); asm volatile("s_waitcnt vmcnt(0)" ::: "memory");
        __hip_atomic_fetch_add(ctr, 1u, __ATOMIC_RELAXED, __HIP_MEMORY_SCOPE_AGENT);
        while (__hip_atomic_load(ctr, __ATOMIC_RELAXED, __HIP_MEMORY_SCOPE_AGENT) < target) __builtin_amdgcn_s_sleep(1);
        __builtin_amdgcn_fence(__ATOMIC_ACQUIRE, "agent"); asm volatile("s_waitcnt vmcnt(0)" ::: "memory");
    }
    __syncthreads();
}
template <bool AL = true, bool SP = true, class Epi, class Sched> __device__ __forceinline__ void run_gemm(unsigned char* lds, const bf16_t* A, const bf16_t* Bt, int M, int N, int K, int lda, int ldb, const Sched& S, const Epi& E, const int g_wv) {
    pg8::Gemm g{A, Bt, M, N, K, lda, ldb};
    pg8::gemm_phase<Epi, Sched, AL, SP>((PG8_LAS unsigned char*)lds, g, S, E, g_wv);
    __syncthreads();
}

__global__ void __launch_bounds__(NTHR, 2) mega(Params p_arg) {
    extern __shared__ __attribute__((aligned(16))) unsigned char lds[];
    cg::grid_group grid = cg::this_grid();
    const int g_wv = __builtin_amdgcn_readfirstlane((int)(__builtin_amdgcn_workitem_id_x() >> 6));
    const int G = gridDim.x, cb = blockIdx.x; const int w_lo = p_arg.w_lo, w_hi = p_arg.w_hi;
#define WIN(k_) (w_lo <= (k_) && (k_) < w_hi)
    unsigned nbar = 0;
#define SEAM(k_) do { if (WIN(k_) && WIN((k_) + 1)) { if ((k_) == 0) GSYNC(); else { ++nbar; gbar((unsigned*)(PP.ws + WS_CTR), nbar * (unsigned)G, g_wv); } } } while (0)
    if (WIN(0)) {
#if PHM & 1
    convert_weights(lds, PP, 0, g_wv); convert_weights(lds, PP, 1, g_wv);
#endif
#if PHM & 2
    build_cs(PP, g_wv);
    if (cb == 0 && TIDX < 32) __hip_atomic_store((unsigned*)(PP.ws + WS_CTR) + TIDX, 0u, __ATOMIC_RELAXED, __HIP_MEMORY_SCOPE_AGENT);
    { const Params p = PP; rmsnorm_rows<true>(p.x, p.norm_gain, (bf16_t*)(p.ws + WS_H), nullptr, g_wv); }
#endif
    }
    SEAM(0);
#pragma unroll 1
    for (int l = 0; l < 2; ++l) {
        const int wb = 1 + 7 * l;
        if (WIN(wb)) {
#if PHM & 4
        { unsigned char* ws = PP.ws; unsigned char* wl = ws + WS_W0 + (size_t)l * WL_SIZE; const f32x2* cs = (const f32x2*)(ws + WS_CS); (void)cs; (void)wl; pg8::StaticOrder S; S.init(T, 15360, G, cb); EpiIn E{ws}; run_gemm(lds, (const bf16_t*)(ws + WS_H), (const bf16_t*)(wl + WL_WIN), T, 15360, DM, DM, DM, S, E, g_wv); }
        { unsigned char* ws = PP.ws; unsigned char* wl = ws + WS_W0 + (size_t)l * WL_SIZE; const f32x2* cs = (const f32x2*)(ws + WS_CS); (void)cs; (void)wl; pg8::StaticOrder S; S.init(1024, T, G, cb); EpiVT E{(bf16_t*)(ws + WS_VAT), T, nullptr, 0.f}; run_gemm(lds, (const bf16_t*)(wl + WL_WIN) + (size_t)15360 * DM, (const bf16_t*)(ws + WS_H), 1024, T, DM, DM, DM, S, E, g_wv); }
#endif
        }
        SEAM(wb);
        if (WIN(wb + 1)) {
#if PHM & 32
        mlstm_a(lds, PP, l, g_wv);
#endif
#if PHM & 16
        kmean_phase(PP, l, g_wv);
#endif
#if PHM & 8
        { unsigned char* ws = PP.ws; unsigned char* wl = ws + WS_W0 + (size_t)l * WL_SIZE; const f32x2* cs = (const f32x2*)(ws + WS_CS); (void)cs; (void)wl; pg8::StaticOrder S; S.init(T, 1536, G, cb); EpiRow<true> E{(bf16_t*)(ws + WS_QC), 1536, (const float*)(ws + WS_SSP), 1.0f / 512.0f, CC_SCALE, cs}; run_gemm(lds, (const bf16_t*)(ws + WS_CQ), (const bf16_t*)(wl + WL_WUQ), T, 1536, 512, 512, 512, S, E, g_wv); }
        { unsigned char* ws = PP.ws; unsigned char* wl = ws + WS_W0 + (size_t)l * WL_SIZE; const f32x2* cs = (const f32x2*)(ws + WS_CS); (void)cs; (void)wl; pg8::StaticOrder S; S.init(T, 1024, G, cb); EpiRow<false> E{(bf16_t*)(ws + WS_KNC), 1024, (const float*)(ws + WS_SSP), 1.0f / 256.0f, 1.0f, cs}; run_gemm(lds, (const bf16_t*)(ws + WS_CKV), (const bf16_t*)(wl + WL_WKN), T, 1024, 256, 256, 256, S, E, g_wv); }
        { unsigned char* ws = PP.ws; unsigned char* wl = ws + WS_W0 + (size_t)l * WL_SIZE; const f32x2* cs = (const f32x2*)(ws + WS_CS); (void)cs; (void)wl; pg8::StaticOrder S; S.init(1024, T, G, cb); EpiVT E{(bf16_t*)(ws + WS_VCT), T, (const float*)(ws + WS_SSP), 1.0f / 256.0f}; run_gemm(lds, (const bf16_t*)(wl + WL_WV), (const bf16_t*)(ws + WS_CKV), 1024, T, 256, 256, 256, S, E, g_wv); }
#endif
        }
        SEAM(wb + 1);
        if (WIN(wb + 2)) {
#if PHM & 128
        mlstm_b(PP, g_wv);
#endif
#if PHM & 64
        attn_phase<0>(lds, PP, l, g_wv);
#endif
        }
        if (WIN(wb + 3)) {
#if PHM & 256
        attn_phase<1>(lds, PP, l, g_wv);
#endif
#if PHM & 512
        mlstm_c(lds, PP, l, g_wv);
#endif
        }
        SEAM(wb + 3);
        if (WIN(wb + 4)) {
#if PHM & 1024
        { unsigned char* ws = PP.ws; unsigned char* wl = ws + WS_W0 + (size_t)l * WL_SIZE; MergeOrder S{G, cb}; EpiMerge E{(bf16_t*)(ws + WS_H), (const bf16_t*)(ws + WS_GT)}; run_gemm(lds, (const bf16_t*)(ws + WS_Z), (const bf16_t*)(wl + WL_WB), 3 * T, 2048, 1024, 1024, 1024, S, E, g_wv); }
#endif
        }
        SEAM(wb + 4);
        if (WIN(wb + 5)) {
#if PHM & 2048
        { unsigned char* ws = PP.ws; unsigned char* wl = ws + WS_W0 + (size_t)l * WL_SIZE; const f32x2* cs = (const f32x2*)(ws + WS_CS); (void)cs; (void)wl; pg8::StaticOrder S; S.init(T, DM, G, cb); const Params p = PP; EpiOut E{l == 0 ? p.x : p.out, p.out}; run_gemm(lds, (const bf16_t*)(ws + WS_H), (const bf16_t*)(wl + WL_WO), T, DM, DM, DM, DM, S, E, g_wv); }
#endif
        }
        SEAM(wb + 5);
        if (WIN(wb + 6)) {
            if (l == 0) { const Params p = PP; rmsnorm_rows<true>(p.out, p.norm_gain + DM, (bf16_t*)(p.ws + WS_H), nullptr, g_wv); }
            else { const Params p = PP; rmsnorm_rows<false>(p.out, p.final_norm, nullptr, p.out, g_wv); }
        }
        if (l == 0) SEAM(wb + 6);
    }
}


#if defined(MK_DEBUG_HASH)
__global__ void hash_buf(const unsigned* p, size_t nwords, unsigned long long* acc) {
    unsigned long long s = 0; const size_t stride = (size_t)gridDim.x * blockDim.x;
    for (size_t i = (size_t)blockIdx.x * blockDim.x + threadIdx.x; i < nwords; i += stride) s += (unsigned long long)p[i] * (unsigned long long)(((unsigned)i * 2654435761u) | 1u);
    atomicAdd(acc, s);
}
__global__ void dbg_final(float* out, size_t n, const unsigned long long* h, int R, int NK) {
    __shared__ float flag;
    if (threadIdx.x == 0) { float f = 1.0f; for (int k = NK - 1; k >= 0; --k) for (int r = 1; r < R; ++r) if (h[r * NK + k] != h[k]) { f = 100.0f; for (int q = 0; q < k; ++q) f *= 10.0f; } flag = f; }
    __syncthreads();
    for (size_t i = (size_t)blockIdx.x * blockDim.x + threadIdx.x; i < n; i += (size_t)gridDim.x * blockDim.x) out[i] = (i == 0) ? flag : 0.0f;
}
#endif
extern "C" void kernel_launch(void* const* d_in, const int* in_sizes, int n_in, void* d_out, int out_size, void* d_ws, size_t ws_size, hipStream_t stream) {
    static int grid = 0;
    if (grid == 0) {
        if (n_in != 16 || ws_size < WS_END) { fprintf(stderr, "kernel_launch: unexpected n_in %d or ws_size %zu < %zu\n", n_in, ws_size, (size_t)WS_END); grid = -1; return; }
        int dev = 0, cus = 0, per_cu = 0;
        hipGetDevice(&dev); hipDeviceGetAttribute(&cus, hipDeviceAttributeMultiprocessorCount, dev);
        if (hipFuncSetAttribute((const void*)mega, hipFuncAttributeMaxDynamicSharedMemorySize, LDS_BYTES) != hipSuccess) { fprintf(stderr, "kernel_launch: hipFuncSetAttribute failed\n"); grid = -1; return; }
        if (hipOccupancyMaxActiveBlocksPerMultiprocessor(&per_cu, (const void*)mega, NTHR, LDS_BYTES) != hipSuccess || per_cu < 1) { fprintf(stderr, "kernel_launch: occupancy query gave %d\n", per_cu); per_cu = 1; }
        (void)hipGetLastError();
        grid = cus * 1;
    }
    if (grid < 0) return;
    Params p{};
    p.x = (const float*)d_in[0]; p.norm_gain = (const float*)d_in[1]; p.w_in = (const float*)d_in[2]; p.t5 = (const float*)d_in[3]; p.conv_w = (const float*)d_in[4]; p.conv_b = (const float*)d_in[5];
    p.i_bias = (const float*)d_in[6]; p.f_bias = (const float*)d_in[7]; p.out_norm = (const float*)d_in[8]; p.q_norm = (const float*)d_in[9]; p.kv_norm = (const float*)d_in[10];
    p.w_uq = (const float*)d_in[11]; p.w_ukv = (const float*)d_in[12]; p.w_branch = (const float*)d_in[13]; p.w_out = (const float*)d_in[14]; p.final_norm = (const float*)d_in[15];
    p.out = (float*)d_out; p.ws = (unsigned char*)d_ws;
    void* args[] = {&p};
#if defined(MK_DEBUG_HASH)
    {
        constexpr int R = 4, NK = 9; unsigned char* W = (unsigned char*)d_ws; unsigned long long* H = (unsigned long long*)(W + WS_END);
        hipMemsetAsync(H, 0, R * NK * 8, stream);
        struct HB { int win; size_t off; size_t bytes; };
        const HB hb[NK] = { {3, WS_Z, 32 * MiB}, {3, WS_CST, 64 * MiB}, {3, WS_NST, 524288}, {3, WS_MST, 4096},
                            {4, WS_Z + 64 * MiB, 32 * MiB}, {4, WS_Z + 32 * MiB, 32 * MiB}, {5, WS_H, 64 * MiB}, {6, WS_H, 64 * MiB}, {2, WS_CST, 64 * MiB} };
        for (int r = 0; r < R; ++r)
            for (int w = 0; w < 7; ++w) { p.w_lo = w; p.w_hi = w + 1;
                hipError_t e = hipLaunchCooperativeKernel((const void*)mega, dim3(grid), dim3(NTHR), args, LDS_BYTES, stream);
                if (e != hipSuccess) fprintf(stderr, "kernel_launch: cooperative launch failed: %s\n", hipGetErrorString(e));
                for (int k = 0; k < NK; ++k) if (hb[k].win == w) {
                    if (k == 7) hash_buf<<<256, 256, 0, stream>>>((const unsigned*)d_out, (size_t)T * DM, H + r * NK + k);
                    else hash_buf<<<256, 256, 0, stream>>>((const unsigned*)(W + hb[k].off), hb[k].bytes / 4, H + r * NK + k); } }
        dbg_final<<<256, 256, 0, stream>>>((float*)d_out, (size_t)T * DM, H, R, NK);
    }
    if (false) {
#elif defined(MK_MULTI)
    for (int w = 0; w < 15; ++w) { p.w_lo = w; p.w_hi = w + 1;
#else
    { p.w_lo = 0; p.w_hi = 15;
#endif
        hipError_t e = hipLaunchCooperativeKernel((const void*)mega, dim3(grid), dim3(NTHR), args, LDS_BYTES, stream);
        if (e != hipSuccess) fprintf(stderr, "kernel_launch: cooperative launch failed: %s (grid %d)\n", hipGetErrorString(e), grid);
    }
}
```

```cpp
#include <hip/hip_runtime.h>
#include <hip/hip_cooperative_groups.h>
#include <cstdio>
#include <cstdint>
namespace cg = cooperative_groups;
__device__ __forceinline__ int tidx_opaque(int g_wv) { int l; asm volatile("v_mbcnt_lo_u32_b32 %0, -1, 0\n\tv_mbcnt_hi_u32_b32 %0, -1, %0" : "=v"(l)); return g_wv * 64 + l; }
#define TIDX tidx_opaque(g_wv)
__device__ __forceinline__ float shx(float v, int o, int lane) { return __int_as_float(__builtin_amdgcn_ds_bpermute(((lane ^ o) & 63) << 2, __float_as_int(v))); }
__device__ __forceinline__ int shxi(int v, int o, int lane) { return __builtin_amdgcn_ds_bpermute(((lane ^ o) & 63) << 2, v); }
__device__ __forceinline__ float shup(float v, int o, int lane) { return __int_as_float(__builtin_amdgcn_ds_bpermute(((lane - o) & 63) << 2, __float_as_int(v))); }

namespace pg8 {
#define PG8_LAS __attribute__((address_space(3)))
typedef unsigned short bf16_t;
typedef short bf16x8 __attribute__((ext_vector_type(8)));
typedef float f32x4 __attribute__((ext_vector_type(4)));
typedef unsigned u32x4 __attribute__((ext_vector_type(4)));
constexpr int BM = 256, BK = 64, HALF = 128, HTB = HALF * BK * 2  , STAGE_BYTES = 8 * HTB, NXCD = 8, WGM = 8;

__host__ __device__ __forceinline__ int lds_byte(int r, int c) { const int st = (r >> 4) * 2 + (c >> 5), rr = r & 15, cc = c & 31, ob = rr * 64 + cc * 2; return st * 1024 + (ob ^ (((ob >> 9) & 1) << 5)); }
__host__ __device__ __forceinline__ void stage_rc(int b, int& R, int& C) { const int st = b / 1024, sb = b % 1024, swz = sb ^ (((sb >> 9) & 1) << 5); R = (st >> 1) * 16 + swz / 64; C = (st & 1) * 32 + (swz % 64) / 2; }
__host__ __device__ __forceinline__ int perm32(int rho) { const int n = rho >> 4, i = rho & 15; return 8 * (i >> 2) + 4 * n + (i & 3); }

struct Unit { int pm, pn, pb; };
struct Gemm { const bf16_t* A; const bf16_t* Bt; int M, N, K, lda, ldb; };

struct StaticOrder {
    int nM, nN, nwg, G, c;
    __host__ __device__ void init(int M, int N, int G_, int c_) { nM = M / BM; nN = N / BM; nwg = nM * nN; G = G_; c = c_; }
    __host__ __device__ bool next(int i, Unit& u) const {
        const long L = (long)i * G + c; if (L >= nwg) return false;
        int wgid = (int)L; { const int q = nwg / NXCD, r = nwg % NXCD, xcd = wgid % NXCD, off = wgid / NXCD; wgid = (xcd < r ? xcd * (q + 1) : r * (q + 1) + (xcd - r) * q) + off; }
        const int nig = WGM * nN, gid = wgid / nig, fm = gid * WGM, gsz = (nM - fm) < WGM ? (nM - fm) : WGM;
        u.pm = fm + ((wgid % nig) % gsz); u.pn = (wgid % nig) / gsz; u.pb = u.pn; return true;
    }
    __device__ __forceinline__ void a_ready(const Unit&) const {}
    __device__ __forceinline__ void done(const Unit&) const {}
};

__device__ __forceinline__ unsigned cvt_pk_bf16(float lo, float hi) { unsigned r; asm volatile("s_nop 1\n\tv_cvt_pk_bf16_f32 %0, %1, %2\n\ts_nop 1" : "=v"(r) : "v"(lo), "v"(hi)); return r; }
template <class Epi, class Sched, bool ALIGN_EPI = false, bool SP2 = false>
__device__ __forceinline__ void gemm_phase(PG8_LAS unsigned char* lds, const Gemm g, const Sched& S, const Epi& E, const int g_wv) {
    int tid = TIDX; asm volatile("" : "+v"(tid)); const int wid = __builtin_amdgcn_readfirstlane(tid >> 6), lane = tid & 63, wr = wid >> 2, wc = wid & 3, fr = lane & 15, fq = lane >> 4;
    const int K = g.K, nt = K / BK;
    unsigned voffA[2], voffB[2];
#pragma unroll
    for (int i = 0; i < 2; ++i) { int R, C; stage_rc(tid * 16 + i * 8192, R, C); const int Rb = Epi::PERM ? ((R & ~31) + perm32(R & 31)) : R;
        voffA[i] = (unsigned)(R * K + C) * 2u; voffB[i] = (unsigned)(Rb * K + C) * 2u; }
    const size_t kstep = (size_t)(BK * 2);
    const size_t hstepA = (size_t)HALF * K * 2; const size_t hstepB = hstepA;
    const size_t tstepA = 2 * hstepA; const size_t tstepB = tstepA;
    const unsigned ldsw = (unsigned)wid * 1024u;
    const int aoff = lds_byte(wr * 64 + fr, fq * 8), boff = lds_byte(wc * 32 + fr, fq * 8);
#define PG8_SA(b, h) (((b) * 2 + (h)) * HTB)
#define PG8_SB(b, h) ((4 + (b) * 2 + (h)) * HTB)
#define PG8_STAGE(bufoff, gbase, voff) do { _Pragma("unroll") for (int _i = 0; _i < 2; ++_i) \
        __builtin_amdgcn_global_load_lds((const unsigned*)((const char*)(gbase) + (voff)[_i]), (PG8_LAS unsigned*)(lds + (bufoff) + ldsw + _i * 8192), 16, 0, 0); } while (0)
#define PG8_LDA(dst, b, h) do { _Pragma("unroll") for (int m = 0; m < 4; ++m) _Pragma("unroll") for (int k = 0; k < 2; ++k) dst[m][k] = *(const PG8_LAS bf16x8*)(lds + PG8_SA(b, h) + aoff + m * 2048 + k * 1024); } while (0)
#define PG8_LDB(dst, b, h) do { _Pragma("unroll") for (int n = 0; n < 2; ++n) _Pragma("unroll") for (int k = 0; k < 2; ++k) dst[n][k] = *(const PG8_LAS bf16x8*)(lds + PG8_SB(b, h) + boff + n * 2048 + k * 1024); } while (0)
#define PG8_MMA(ai, bj, At, Bt) do { __builtin_amdgcn_s_setprio(1); _Pragma("unroll") for (int m = 0; m < 4; ++m) _Pragma("unroll") for (int n = 0; n < 2; ++n) _Pragma("unroll") for (int k = 0; k < 2; ++k) \
        acc[ai][bj][m][n] = __builtin_amdgcn_mfma_f32_16x16x32_bf16(Bt[n][k], At[m][k], acc[ai][bj][m][n], 0, 0, 0); __builtin_amdgcn_s_setprio(0); } while (0)
#define PG8_WAIT_V(n) asm volatile("s_waitcnt vmcnt(" #n ")" ::: "memory")
#define PG8_WAIT_L(n) asm volatile("s_waitcnt lgkmcnt(" #n ")" ::: "memory")
#define PG8_BAR __builtin_amdgcn_s_barrier()
#define PG8_SCHED __builtin_amdgcn_sched_barrier(0)
    Unit cur, nxt; int ui = 0;
    if (!S.next(0, cur)) return;
    f32x4 acc[2][2][4][2];
#pragma unroll
    for (int a = 0; a < 2; ++a)
#pragma unroll
        for (int b = 0; b < 2; ++b)
#pragma unroll
            for (int m = 0; m < 4; ++m)
#pragma unroll
                for (int n = 0; n < 2; ++n) acc[a][b][m][n] = (f32x4){0.f, 0.f, 0.f, 0.f};
    bf16x8 At[4][2], B0[2][2], B1[2][2];
    const char* cA = (const char*)g.A + (size_t)cur.pm * tstepA; const char* cB = (const char*)g.Bt + (size_t)cur.pb * tstepB;
    S.a_ready(cur);
    if constexpr (SP2) {
        PG8_STAGE(PG8_SB(0, 0), cB, voffB); PG8_STAGE(PG8_SB(0, 1), cB + hstepB, voffB); PG8_STAGE(PG8_SA(0, 0), cA, voffA); PG8_STAGE(PG8_SA(0, 1), cA + hstepA, voffA);
        if (wr == 1) PG8_BAR;
        PG8_WAIT_V(2); PG8_BAR;
        PG8_STAGE(PG8_SB(1, 0), cB + kstep, voffB); PG8_STAGE(PG8_SA(1, 0), cA + kstep, voffA); PG8_STAGE(PG8_SB(1, 1), cB + hstepB + kstep, voffB);
        PG8_WAIT_V(6); PG8_BAR;
    } else {
        PG8_STAGE(PG8_SB(0, 0), cB, voffB); PG8_STAGE(PG8_SA(0, 0), cA, voffA); PG8_STAGE(PG8_SB(0, 1), cB + hstepB, voffB); PG8_STAGE(PG8_SA(0, 1), cA + hstepA, voffA);
        if (wr == 1) PG8_BAR;
        PG8_WAIT_V(4); PG8_BAR;
        PG8_STAGE(PG8_SB(1, 0), cB + kstep, voffB); PG8_STAGE(PG8_SA(1, 0), cA + kstep, voffA); PG8_STAGE(PG8_SB(1, 1), cB + hstepB + kstep, voffB);
        PG8_WAIT_V(6); PG8_BAR;
    }
    for (;;) {
        const bool has_next = S.next(ui + 1, nxt);
        const char* nA = has_next ? (const char*)g.A + (size_t)nxt.pm * tstepA : cA; const char* nB = has_next ? (const char*)g.Bt + (size_t)nxt.pb * tstepB : cB;
        for (int t = 0; t < nt; t += 2) {
            const bool last = (t == nt - 2);
            const char* a1 = cA + (size_t)(t + 1) * kstep;
            const char* a2 = last ? nA : cA + (size_t)(t + 2) * kstep; const char* b2 = last ? nB : cB + (size_t)(t + 2) * kstep;
            const char* a3 = a2 + kstep; const char* b3 = b2 + kstep;
            if (last && has_next) S.a_ready(nxt);
            if constexpr (SP2) {
            PG8_LDB(B0, 0, 0); PG8_LDB(B1, 0, 1); PG8_SCHED; PG8_LDA(At, 0, 0); PG8_STAGE(PG8_SA(1, 1), a1 + hstepA, voffA);
            PG8_WAIT_V(8); PG8_WAIT_L(0); PG8_BAR; PG8_MMA(0, 0, At, B0); PG8_MMA(0, 1, At, B1); PG8_BAR; PG8_SCHED;
            PG8_LDA(At, 0, 1); PG8_STAGE(PG8_SB(0, 0), b2, voffB); PG8_STAGE(PG8_SB(0, 1), b2 + hstepB, voffB); PG8_STAGE(PG8_SA(0, 0), a2, voffA);
            PG8_WAIT_V(8); PG8_WAIT_L(0); PG8_BAR; PG8_MMA(1, 0, At, B0); PG8_MMA(1, 1, At, B1); PG8_BAR; PG8_SCHED;
            PG8_LDB(B0, 1, 0); PG8_LDB(B1, 1, 1); PG8_SCHED; PG8_LDA(At, 1, 0); PG8_STAGE(PG8_SA(0, 1), a2 + hstepA, voffA);
            PG8_WAIT_V(8); PG8_WAIT_L(0); PG8_BAR; PG8_MMA(0, 0, At, B0); PG8_MMA(0, 1, At, B1); PG8_BAR; PG8_SCHED;
            PG8_LDA(At, 1, 1); PG8_STAGE(PG8_SB(1, 0), b3, voffB); PG8_STAGE(PG8_SB(1, 1), b3 + hstepB, voffB); PG8_STAGE(PG8_SA(1, 0), a3, voffA);
            PG8_WAIT_V(8); PG8_WAIT_L(0); PG8_BAR; PG8_MMA(1, 0, At, B0); PG8_MMA(1, 1, At, B1); PG8_BAR; PG8_SCHED;
            } else {
            PG8_LDB(B0, 0, 0); PG8_SCHED; PG8_LDA(At, 0, 0); PG8_STAGE(PG8_SA(1, 1), a1 + hstepA, voffA);
            PG8_WAIT_L(8); PG8_BAR; PG8_WAIT_L(0); PG8_MMA(0, 0, At, B0); PG8_BAR; PG8_SCHED;
            PG8_LDB(B1, 0, 1); PG8_STAGE(PG8_SB(0, 0), b2, voffB);
            PG8_BAR; PG8_WAIT_L(0); PG8_MMA(0, 1, At, B1); PG8_BAR;
            PG8_LDA(At, 0, 1); PG8_STAGE(PG8_SA(0, 0), a2, voffA);
            PG8_BAR; PG8_WAIT_L(0); PG8_MMA(1, 0, At, B0); PG8_BAR; PG8_SCHED;
            PG8_STAGE(PG8_SB(0, 1), b2 + hstepB, voffB);
            PG8_WAIT_V(6); PG8_BAR; PG8_MMA(1, 1, At, B1); PG8_BAR;
            PG8_LDB(B0, 1, 0); PG8_SCHED; PG8_LDA(At, 1, 0); PG8_STAGE(PG8_SA(0, 1), a2 + hstepA, voffA);
            PG8_WAIT_L(8); PG8_BAR; PG8_WAIT_L(0); PG8_MMA(0, 0, At, B0); PG8_BAR; PG8_SCHED;
            PG8_LDB(B1, 1, 1); PG8_STAGE(PG8_SB(1, 0), b3, voffB);
            PG8_BAR; PG8_WAIT_L(0); PG8_MMA(0, 1, At, B1); PG8_BAR;
            PG8_LDA(At, 1, 1); PG8_STAGE(PG8_SA(1, 0), a3, voffA);
            PG8_BAR; PG8_WAIT_L(0); PG8_MMA(1, 0, At, B0); PG8_BAR; PG8_SCHED;
            PG8_STAGE(PG8_SB(1, 1), b3 + hstepB, voffB);
            PG8_WAIT_V(6); PG8_BAR; PG8_MMA(1, 1, At, B1); PG8_BAR;
            }
        }
        if constexpr (ALIGN_EPI) { if (wr == 0) PG8_BAR; }
        if constexpr (!Epi::AFTER_DRAIN) { E(acc, cur, wr, wc, fr, fq); S.done(cur); }
        if (!has_next) break;
#pragma unroll
        for (int a = 0; a < 2; ++a)
#pragma unroll
            for (int b = 0; b < 2; ++b)
#pragma unroll
                for (int m = 0; m < 4; ++m)
#pragma unroll
                    for (int n = 0; n < 2; ++n) acc[a][b][m][n] = (f32x4){0.f, 0.f, 0.f, 0.f};
        cur = nxt; cA = nA; cB = nB; ++ui;
        if constexpr (ALIGN_EPI) { if (wr == 1) PG8_BAR; }
    }
    PG8_WAIT_V(0);
    if constexpr (!ALIGN_EPI) { if (wr == 0) PG8_BAR; }
    PG8_BAR;
    if constexpr (Epi::AFTER_DRAIN) { E.fused(acc, cur, wr, wc, fr, fq, lds, wid, lane); S.done(cur); }
#undef PG8_SA
#undef PG8_SB
#undef PG8_STAGE
#undef PG8_LDA
#undef PG8_LDB
#undef PG8_MMA
#undef PG8_WAIT_V
#undef PG8_WAIT_L
#undef PG8_BAR
#undef PG8_SCHED
}
}

using pg8::bf16_t; using pg8::bf16x8; using pg8::f32x4; using pg8::u32x4; using pg8::Unit; using pg8::cvt_pk_bf16;
typedef unsigned u32x2 __attribute__((ext_vector_type(2)));
typedef float f32x2 __attribute__((ext_vector_type(2)));
constexpr int T = 16384, SEQ = 4096, DM = 2048, DIN = 16200;
constexpr float EPS = 1e-6f, NEGV = -1e30f, LOG2E = 1.4426950408889634f;
constexpr float CA_SCALE = 0.12751743082459868f;
constexpr float CC_SCALE = 0.10411754627697264f;
constexpr int NTHR = 512;
constexpr int LDS_BYTES = 131072;

constexpr size_t MiB = 1ull << 20;
constexpr size_t WS_CS = 0;
constexpr size_t WS_SSQ = WS_CS + MiB;
constexpr size_t WS_SSKV = WS_SSQ + 65536;
constexpr size_t WS_GATES = WS_SSKV + 65536;
constexpr size_t WS_KM = WS_GATES + 524288;
constexpr size_t WS_BV = WS_KM + 131072;
constexpr size_t WS_LIV = WS_BV + 262144;
constexpr size_t WS_BLAST = WS_LIV + 262144;
constexpr size_t WS_GMAX = WS_BLAST + 4096;
constexpr size_t WS_MST = WS_GMAX + 4096;
constexpr size_t WS_NST = WS_MST + 4096;
constexpr size_t WS_W0 = WS_NST + 524288;
constexpr size_t WL_WIN = 0;
constexpr size_t WL_WB = WL_WIN + 64 * MiB;
constexpr size_t WL_WO = WL_WB + 12 * MiB;
constexpr size_t WL_WUQ = WL_WO + 8 * MiB;
constexpr size_t WL_WKN = WL_WUQ + 1536 * 1024;
constexpr size_t WL_WV = WL_WKN + 512 * 1024;
constexpr size_t WL_SIZE = WL_WV + 512 * 1024;
constexpr size_t WS_H = WS_W0 + 2 * WL_SIZE;
constexpr size_t WS_QA = WS_H + 64 * MiB;
constexpr size_t WS_KA = WS_QA + 32 * MiB;
constexpr size_t WS_VAT = WS_KA + 32 * MiB;
constexpr size_t WS_Z = WS_VAT + 32 * MiB;
constexpr size_t WS_QB = WS_Z + 96 * MiB;
constexpr size_t WS_KB = WS_QB + 16 * MiB;
constexpr size_t WS_VB = WS_KB + 16 * MiB;
constexpr size_t WS_OB = WS_VB + 32 * MiB;
constexpr size_t WS_Q2 = WS_OB + 32 * MiB;
constexpr size_t WS_K2 = WS_Q2 + 16 * MiB;
constexpr size_t WS_CST = WS_K2 + 16 * MiB;
constexpr size_t WS_CQ = WS_CST + 64 * MiB;
constexpr size_t WS_CKV = WS_CQ + 16 * MiB;
constexpr size_t WS_KR = WS_CKV + 8 * MiB;
constexpr size_t WS_QC = WS_KR + 2 * MiB;
constexpr size_t WS_KNC = WS_QC + 48 * MiB;
constexpr size_t WS_VCT = WS_KNC + 32 * MiB;
constexpr size_t WS_GT = WS_VCT + 32 * MiB;
constexpr size_t WS_SSP = WS_GT + 192 * MiB;
constexpr size_t WS_QAL = WS_SSP + MiB;
constexpr size_t WS_CTR = WS_QAL + 32 * MiB;
constexpr size_t WS_END = WS_CTR + 256;

struct Params {
    const float* x; const float* norm_gain; const float* w_in; const float* t5; const float* conv_w; const float* conv_b; const float* i_bias; const float* f_bias;
    const float* out_norm; const float* q_norm; const float* kv_norm; const float* w_uq; const float* w_ukv; const float* w_branch; const float* w_out; const float* final_norm;
    float* out; unsigned char* ws; int w_lo, w_hi;
};

__device__ __forceinline__ float bf2f(unsigned v16) { return __uint_as_float(v16 << 16); }
__device__ __forceinline__ float bflo(unsigned w) { return __uint_as_float(w << 16); }
__device__ __forceinline__ float bfhi(unsigned w) { return __uint_as_float(w & 0xffff0000u); }
__device__ __forceinline__ bf16_t f2bf(float f) { return (bf16_t)(cvt_pk_bf16(f, 0.f) & 0xffffu); }
__device__ __forceinline__ float fsigmoid(float v) { return __builtin_amdgcn_rcpf(1.0f + __expf(-v)); }
__device__ __forceinline__ float fsilu(float v) { return v * __builtin_amdgcn_rcpf(1.0f + __expf(-v)); }
__device__ __forceinline__ float fexp2(float v) { return __builtin_amdgcn_exp2f(v); }
__device__ __forceinline__ f32x4 zero4() { f32x4 z = (f32x4){0.f, 0.f, 0.f, 0.f}; asm volatile("" : "+v"(z)); return z; }
__device__ __forceinline__ f32x4 mfma16(bf16x8 a, bf16x8 b, f32x4 c) { return __builtin_amdgcn_mfma_f32_16x16x32_bf16(a, b, c, 0, 0, 0); }

struct EpiIn {
    static constexpr bool PERM = true, AFTER_DRAIN = false;
    unsigned char* ws;
    __device__ __forceinline__ void operator()(const f32x4 (&acc)[2][2][4][2], const Unit& u, int wr, int wc, int fr, int fq) const {
        const int pn = u.pn; const int row0 = u.pm * 256 + wr * 64 + fr;
        if (pn == 59) {
            const int cb = wc * 32 + 8 * fq;
            if (cb >= 72) return;
            float* gates = (float*)(ws + WS_GATES); bf16_t* kr = (bf16_t*)(ws + WS_KR); const f32x2* cs = (const f32x2*)(ws + WS_CS);
#pragma unroll
            for (int ai = 0; ai < 2; ++ai)
#pragma unroll
                for (int m = 0; m < 4; ++m) {
                    const int row = row0 + ai * 128 + m * 16; const f32x4 v0 = acc[ai][0][m][0], v1 = acc[ai][0][m][1];
                    if (cb == 0) { *(f32x4*)(gates + (size_t)row * 8) = v0; *(f32x4*)(gates + (size_t)row * 8 + 4) = v1; }
                    else {
                        const int j0 = (cb - 8) >> 1, pos = row & (SEQ - 1);
                        const f32x2 c0 = cs[pos * 32 + j0], c1 = cs[pos * 32 + j0 + 1], c2 = cs[pos * 32 + j0 + 2], c3 = cs[pos * 32 + j0 + 3];
                        u32x4 w;
                        w.x = cvt_pk_bf16(v0[0] * c0.x - v0[1] * c0.y, v0[0] * c0.y + v0[1] * c0.x);
                        w.y = cvt_pk_bf16(v0[2] * c1.x - v0[3] * c1.y, v0[2] * c1.y + v0[3] * c1.x);
                        w.z = cvt_pk_bf16(v1[0] * c2.x - v1[1] * c2.y, v1[0] * c2.y + v1[1] * c2.x);
                        w.w = cvt_pk_bf16(v1[2] * c3.x - v1[3] * c3.y, v1[2] * c3.y + v1[3] * c3.x);
                        *(u32x4*)(kr + (size_t)row * 64 + (cb - 8)) = w;
                    }
                }
            return;
        }
        size_t off; int ld, c0, act = 0, ssk = 0; float sc = 1.f;
        if (pn < 4) { off = WS_QA; ld = 1024; c0 = pn * 256; sc = CA_SCALE; }
        else if (pn < 8) { off = WS_KA; ld = 1024; c0 = (pn - 4) * 256; }
        else if (pn < 12) { off = WS_Z; ld = 1024; c0 = (pn - 8) * 256; act = 1; }
        else if (pn < 14) { off = WS_QB; ld = 512; c0 = (pn - 12) * 256; }
        else if (pn < 16) { off = WS_KB; ld = 512; c0 = (pn - 14) * 256; }
        else if (pn < 20) { off = WS_VB; ld = 1024; c0 = (pn - 16) * 256; }
        else if (pn < 24) { off = WS_OB; ld = 1024; c0 = (pn - 20) * 256; act = 2; }
        else if (pn < 28) { off = WS_Z + 32 * MiB; ld = 1024; c0 = (pn - 24) * 256; act = 1; }
        else if (pn < 30) { off = WS_CQ; ld = 512; c0 = (pn - 28) * 256; ssk = 1; }
        else if (pn < 31) { off = WS_CKV; ld = 256; c0 = 0; ssk = 2; }
        else if (pn < 35) { off = WS_Z + 64 * MiB; ld = 1024; c0 = (pn - 31) * 256; act = 1; }
        else { off = WS_GT; ld = 6144; c0 = (pn - 35) * 256; act = 2; }
        bf16_t* dst = (bf16_t*)(ws + off); float* ssp = (float*)(ws + WS_SSP) + (ssk == 2 ? 8 : (pn - 28) * 4) + wc;
        const int col0 = c0 + wc * 32 + 8 * fq;
#pragma unroll
        for (int ai = 0; ai < 2; ++ai)
#pragma unroll
            for (int m = 0; m < 4; ++m) {
                const int row = row0 + ai * 128 + m * 16; bf16_t* rowp = dst + (size_t)row * ld + col0; float ss = 0.f;
#pragma unroll
                for (int bj = 0; bj < 2; ++bj) {
                    f32x4 v0 = acc[ai][bj][m][0], v1 = acc[ai][bj][m][1];
                    if (act == 1) {
#pragma unroll
                        for (int i = 0; i < 4; ++i) { v0[i] = fsilu(v0[i]); v1[i] = fsilu(v1[i]); }
                    } else if (act == 2) {
#pragma unroll
                        for (int i = 0; i < 4; ++i) { v0[i] = fsigmoid(v0[i]); v1[i] = fsigmoid(v1[i]); }
                    } else { v0 = v0 * sc; v1 = v1 * sc; }
                    if (ssk) ss += (v0[0] * v0[0] + v0[1] * v0[1]) + (v0[2] * v0[2] + v0[3] * v0[3]) + (v1[0] * v1[0] + v1[1] * v1[1]) + (v1[2] * v1[2] + v1[3] * v1[3]);
                    u32x4 w; w.x = cvt_pk_bf16(v0[0], v0[1]); w.y = cvt_pk_bf16(v0[2], v0[3]); w.z = cvt_pk_bf16(v1[0], v1[1]); w.w = cvt_pk_bf16(v1[2], v1[3]);
                    *(u32x4*)(rowp + bj * 128) = w;
                    if (pn < 4) {
                        u32x4 wl; wl.x = cvt_pk_bf16(v0[0] - bflo(w.x), v0[1] - bfhi(w.x)); wl.y = cvt_pk_bf16(v0[2] - bflo(w.y), v0[3] - bfhi(w.y));
                        wl.z = cvt_pk_bf16(v1[0] - bflo(w.z), v1[1] - bfhi(w.z)); wl.w = cvt_pk_bf16(v1[2] - bflo(w.w), v1[3] - bfhi(w.w));
                        *(u32x4*)((bf16_t*)(ws + WS_QAL) + (size_t)row * 1024 + col0 + bj * 128) = wl; }
                }
                if (ssk) { const int ln = fq * 16 + fr; ss += shx(ss, 16, ln); ss += shx(ss, 32, ln); if (fq == 0) ssp[(size_t)row * 16] = ss; }
            }
    }
};

struct EpiVT {
    static constexpr bool PERM = true, AFTER_DRAIN = false;
    bf16_t* dst; int ld; const float* ss; float inv_n;
    __device__ __forceinline__ void operator()(const f32x4 (&acc)[2][2][4][2], const Unit& u, int wr, int wc, int fr, int fq) const {
        const int row0 = u.pm * 256 + wr * 64 + fr, col0 = u.pn * 256 + wc * 32 + 8 * fq;
        f32x4 s0[2], s1[2];
#pragma unroll
        for (int bj = 0; bj < 2; ++bj) {
            if (ss) { f32x4 a, b;
#pragma unroll
                for (int i = 0; i < 4; ++i) { const f32x4 pa = *(const f32x4*)(ss + (size_t)(col0 + bj * 128 + i) * 16 + 8), pb = *(const f32x4*)(ss + (size_t)(col0 + bj * 128 + 4 + i) * 16 + 8);
                    a[i] = rsqrtf(((pa[0] + pa[1]) + (pa[2] + pa[3])) * inv_n + EPS); b[i] = rsqrtf(((pb[0] + pb[1]) + (pb[2] + pb[3])) * inv_n + EPS); }
                s0[bj] = a; s1[bj] = b; }
            else { s0[bj] = (f32x4){1.f, 1.f, 1.f, 1.f}; s1[bj] = s0[bj]; }
        }
#pragma unroll
        for (int ai = 0; ai < 2; ++ai)
#pragma unroll
            for (int m = 0; m < 4; ++m) {
                bf16_t* rowp = dst + (size_t)(row0 + ai * 128 + m * 16) * ld + col0;
#pragma unroll
                for (int bj = 0; bj < 2; ++bj) {
                    const f32x4 v0 = acc[ai][bj][m][0] * s0[bj], v1 = acc[ai][bj][m][1] * s1[bj];
                    u32x4 w; w.x = cvt_pk_bf16(v0[0], v0[1]); w.y = cvt_pk_bf16(v0[2], v0[3]); w.z = cvt_pk_bf16(v1[0], v1[1]); w.w = cvt_pk_bf16(v1[2], v1[3]);
                    *(u32x4*)(rowp + bj * 128) = w;
                }
            }
    }
};

template <bool ROPE> struct EpiRow {
    static constexpr bool PERM = true, AFTER_DRAIN = false;
    bf16_t* dst; int ld; const float* ss; float inv_n, sc; const f32x2* cs;
    __device__ __forceinline__ void operator()(const f32x4 (&acc)[2][2][4][2], const Unit& u, int wr, int wc, int fr, int fq) const {
        const int row0 = u.pm * 256 + wr * 64 + fr, col0 = u.pn * 256 + wc * 32 + 8 * fq;
#pragma unroll
        for (int ai = 0; ai < 2; ++ai)
#pragma unroll
            for (int m = 0; m < 4; ++m) {
                const int row = row0 + ai * 128 + m * 16; float sq;
                if (ROPE) { const f32x4 pa = *(const f32x4*)(ss + (size_t)row * 16), pb = *(const f32x4*)(ss + (size_t)row * 16 + 4); sq = ((pa[0] + pa[1]) + (pa[2] + pa[3])) + ((pb[0] + pb[1]) + (pb[2] + pb[3])); }
                else { const f32x4 pa = *(const f32x4*)(ss + (size_t)row * 16 + 8); sq = (pa[0] + pa[1]) + (pa[2] + pa[3]); }
                const float rs = rsqrtf(sq * inv_n + EPS) * sc; bf16_t* rowp = dst + (size_t)row * ld + col0;
#pragma unroll
                for (int bj = 0; bj < 2; ++bj) {
                    f32x4 v0 = acc[ai][bj][m][0] * rs, v1 = acc[ai][bj][m][1] * rs; u32x4 w;
                    const int hc = (col0 + bj * 128) % 192;
                    if (ROPE && hc >= 128) {
                        const int j0 = (hc - 128) >> 1, pos = row & (SEQ - 1);
                        const f32x2 c0 = cs[pos * 32 + j0], c1 = cs[pos * 32 + j0 + 1], c2 = cs[pos * 32 + j0 + 2], c3 = cs[pos * 32 + j0 + 3];
                        w.x = cvt_pk_bf16(v0[0] * c0.x - v0[1] * c0.y, v0[0] * c0.y + v0[1] * c0.x);
                        w.y = cvt_pk_bf16(v0[2] * c1.x - v0[3] * c1.y, v0[2] * c1.y + v0[3] * c1.x);
                        w.z = cvt_pk_bf16(v1[0] * c2.x - v1[1] * c2.y, v1[0] * c2.y + v1[1] * c2.x);
                        w.w = cvt_pk_bf16(v1[2] * c3.x - v1[3] * c3.y, v1[2] * c3.y + v1[3] * c3.x);
                    } else { w.x = cvt_pk_bf16(v0[0], v0[1]); w.y = cvt_pk_bf16(v0[2], v0[3]); w.z = cvt_pk_bf16(v1[0], v1[1]); w.w = cvt_pk_bf16(v1[2], v1[3]); }
                    *(u32x4*)(rowp + bj * 128) = w;
                }
            }
    }
};

struct EpiMerge {
    static constexpr bool PERM = true, AFTER_DRAIN = false;
    bf16_t* merged; const bf16_t* gt;
    __device__ __forceinline__ void operator()(const f32x4 (&acc)[2][2][4][2], const Unit& u, int wr, int wc, int fr, int fq) const {
        const int n = u.pm >> 6, pmr = u.pm & 63; const int row0 = pmr * 256 + wr * 64 + fr, col0 = u.pn * 256 + wc * 32 + 8 * fq;
#pragma unroll
        for (int ai = 0; ai < 2; ++ai)
#pragma unroll
            for (int m = 0; m < 4; ++m) {
                const int row = row0 + ai * 128 + m * 16;
#pragma unroll
                for (int bj = 0; bj < 2; ++bj) {
                    const u32x4 gw = *(const u32x4*)(gt + (size_t)row * 6144 + n * 2048 + col0 + bj * 128);
                    bf16_t* mp = merged + (size_t)row * 2048 + col0 + bj * 128;
                    u32x4 pw = (u32x4){0u, 0u, 0u, 0u}; if (n > 0) pw = __builtin_nontemporal_load((const u32x4*)mp);
                    const f32x4 v0 = acc[ai][bj][m][0], v1 = acc[ai][bj][m][1]; u32x4 w;
                    w.x = cvt_pk_bf16(bflo(pw.x) + bflo(gw.x) * v0[0], bfhi(pw.x) + bfhi(gw.x) * v0[1]);
                    w.y = cvt_pk_bf16(bflo(pw.y) + bflo(gw.y) * v0[2], bfhi(pw.y) + bfhi(gw.y) * v0[3]);
                    w.z = cvt_pk_bf16(bflo(pw.z) + bflo(gw.z) * v1[0], bfhi(pw.z) + bfhi(gw.z) * v1[1]);
                    w.w = cvt_pk_bf16(bflo(pw.w) + bflo(gw.w) * v1[2], bfhi(pw.w) + bfhi(gw.w) * v1[3]);
                    *(u32x4*)mp = w;
                }
            }
        asm volatile("s_waitcnt vmcnt(0)" ::: "memory");
    }
};
struct MergeOrder {
    int G, c;
    __device__ bool next(int i, Unit& u) const {
        const int t3 = i / 3, n = i - 3 * t3; const long L = (long)t3 * G + c; if (L >= 512) return false;
        const int tm = (int)(L >> 3), tn = (int)(L & 7); u.pm = n * 64 + tm; u.pn = tn; u.pb = n * 8 + tn; return true;
    }
    __device__ __forceinline__ void a_ready(const Unit&) const {}
    __device__ __forceinline__ void done(const Unit&) const {}
};

struct EpiOut {
    static constexpr bool PERM = false, AFTER_DRAIN = false;
    const float* xin; float* xout;
    __device__ __forceinline__ void operator()(const f32x4 (&acc)[2][2][4][2], const Unit& u, int wr, int wc, int fr, int fq) const {
        const int row0 = u.pm * 256 + wr * 64 + fr, col0 = u.pn * 256 + wc * 32 + 4 * fq;
#pragma unroll
        for (int ai = 0; ai < 2; ++ai)
#pragma unroll
            for (int m = 0; m < 4; ++m) {
                const size_t ro = (size_t)(row0 + ai * 128 + m * 16) * DM + col0;
#pragma unroll
                for (int bj = 0; bj < 2; ++bj)
#pragma unroll
                    for (int n = 0; n < 2; ++n) { const f32x4 b = *(const f32x4*)(xin + ro + bj * 128 + n * 16); *(f32x4*)(xout + ro + bj * 128 + n * 16) = b + acc[ai][bj][m][n]; }
            }
    }
};

template <class F> __device__ __forceinline__ void tconv(unsigned char* lds, const float* src, int ldsrc, int K, bf16_t* dst, int N, const float* gain, F f, const int g_wv) {
    float* tile = (float*)lds; int tid = TIDX; asm volatile("" : "+v"(tid)); const int tilesK = K >> 6, ntile = tilesK * (N >> 8);
    const int nn4 = (tid & 63) * 4, kk0 = tid >> 6; f32x4 pre[8];
#define TCONV_LOAD(tt_) do { const int tn_ = (tt_) / tilesK, tk_ = (tt_) - tn_ * tilesK; const int c0 = f(tn_ * 256 + nn4), c1 = f(tn_ * 256 + nn4 + 1), c2 = f(tn_ * 256 + nn4 + 2), c3 = f(tn_ * 256 + nn4 + 3); \
        const bool vec = (c0 >= 0) && ((c0 & 3) == 0) && (c3 == c0 + 3); const float* sp = src + (size_t)(tk_ * 64 + kk0) * ldsrc; \
        _Pragma("unroll") for (int e = 0; e < 8; ++e) { const float* rp = sp + (size_t)(8 * e) * ldsrc; f32x4 v; \
            if (vec) v = *(const f32x4*)(rp + c0); \
            else { v[0] = c0 >= 0 ? rp[c0] : 0.f; v[1] = c1 >= 0 ? rp[c1] : 0.f; v[2] = c2 >= 0 ? rp[c2] : 0.f; v[3] = c3 >= 0 ? rp[c3] : 0.f; } \
            pre[e] = v; } } while (0)
    int t = blockIdx.x;
    if (t < ntile) TCONV_LOAD(t);
    for (; t < ntile; t += gridDim.x) {
        const int tn = t / tilesK, tk = t - tn * tilesK;
#pragma unroll
        for (int e = 0; e < 8; ++e) { f32x4 v = pre[e]; if (gain) v = v * gain[tk * 64 + kk0 + 8 * e]; *(f32x4*)(tile + (kk0 + 8 * e) * 260 + nn4) = v; }
        __syncthreads();
        { const int t2 = t + (int)gridDim.x; if (t2 < ntile) TCONV_LOAD(t2); }
        { const int nn = tid >> 1, kc = (tid & 1) * 32; bf16_t* dp = dst + (size_t)(tn * 256 + nn) * K + tk * 64 + kc;
#pragma unroll
          for (int q4 = 0; q4 < 4; ++q4) { float v[8];
#pragma unroll
              for (int i = 0; i < 8; ++i) v[i] = tile[(kc + q4 * 8 + i) * 260 + nn];
              u32x4 w; w.x = cvt_pk_bf16(v[0], v[1]); w.y = cvt_pk_bf16(v[2], v[3]); w.z = cvt_pk_bf16(v[4], v[5]); w.w = cvt_pk_bf16(v[6], v[7]);
              *(u32x4*)(dp + q4 * 8) = w; } }
        __syncthreads();
    }
#undef TCONV_LOAD
}
__device__ __forceinline__ int win_src_col(int n) {
    if (n < 1024) return n;
    if (n < 2048) return 1024 + (n - 1024);
    if (n < 3072) return 3072 + (n - 2048);
    if (n < 3584) return 4096 + (n - 3072);
    if (n < 4096) return 4608 + (n - 3584);
    if (n < 5120) return 5120 + (n - 4096);
    if (n < 6144) return 6152 + (n - 5120);
    if (n < 7168) return 7176 + (n - 6144);
    if (n < 7680) return 8200 + (n - 7168);
    if (n < 7936) return 8712 + (n - 7680);
    if (n < 8960) return 9032 + (n - 7936);
    if (n < 15104) return 10056 + (n - 8960);
    if (n < 15360) { const int r = n - 15104; if (r < 4) return 6144 + r; if (r < 8) return 6148 + (r - 4); if (r < 72) { const int j = (r - 8) >> 1, odd = (r - 8) & 1; return 8968 + j + 32 * odd; } return -1; }
    return 2048 + (n - 15360);
}
__device__ __forceinline__ void convert_weights(unsigned char* lds, const Params& p, int l, const int g_wv) {
    unsigned char* wl = p.ws + WS_W0 + (size_t)l * WL_SIZE;
    tconv(lds, p.w_in + (size_t)l * DM * DIN, DIN, DM, (bf16_t*)(wl + WL_WIN), 16384, nullptr, [](int n) { return win_src_col(n); }, g_wv);
#pragma unroll 1
    for (int n = 0; n < 3; ++n)
        tconv(lds, p.w_branch + ((size_t)l * 3 + n) * 1024 * DM, DM, 1024, (bf16_t*)(wl + WL_WB) + (size_t)n * 2048 * 1024, 2048, nullptr, [](int c) { return c; }, g_wv);
    tconv(lds, p.w_out + (size_t)l * DM * DM, DM, DM, (bf16_t*)(wl + WL_WO), DM, nullptr, [](int c) { return c; }, g_wv);
    tconv(lds, p.w_uq + (size_t)l * 512 * 1536, 1536, 512, (bf16_t*)(wl + WL_WUQ), 1536, p.q_norm + l * 512,
          [](int n) { const int h = n / 192, hc = n - h * 192; if (hc < 128) return n; const int r = hc - 128; return h * 192 + 128 + (r >> 1) + 32 * (r & 1); }, g_wv);
    tconv(lds, p.w_ukv + (size_t)l * 256 * 2048, 2048, 256, (bf16_t*)(wl + WL_WKN), 1024, p.kv_norm + l * 256, [](int n) { return (n >> 7) * 256 + (n & 127); }, g_wv);
    tconv(lds, p.w_ukv + (size_t)l * 256 * 2048, 2048, 256, (bf16_t*)(wl + WL_WV), 1024, p.kv_norm + l * 256, [](int n) { return (n >> 7) * 256 + 128 + (n & 127); }, g_wv);
}
__device__ __forceinline__ void sincos_acc(float ang, float& s, float& c) {
    const double x = (double)ang; const double q = rint(x * 0.63661977236758134308);
    double r = fma(-q, 1.57079632679489655800e+00, x); r = fma(-q, 6.12323399573676603587e-17, r);
    const int qi = ((int)q) & 3; const double r2 = r * r;
    const double sp = r + r * r2 * (-1.66666666666666324348e-01 + r2 * (8.33333333332248946124e-03 + r2 * (-1.98412698298579493134e-04 + r2 * (2.75573137070700676789e-06 + r2 * (-2.50507602534068634195e-08 + r2 * 1.58969099521155010221e-10)))));
    const double cp = 1.0 - 0.5 * r2 + r2 * r2 * (4.16666666666666019037e-02 + r2 * (-1.38888888888741095749e-03 + r2 * (2.48015872894767294178e-05 + r2 * (-2.75573143513906633035e-07 + r2 * (2.08757232129817482790e-09 + r2 * -1.13596475577881948265e-11)))));
    double ss, cc; if (qi == 0) { ss = sp; cc = cp; } else if (qi == 1) { ss = cp; cc = -sp; } else if (qi == 2) { ss = -sp; cc = -cp; } else { ss = -cp; cc = sp; }
    s = (float)ss; c = (float)cc;
}
__device__ __forceinline__ void build_cs(const Params& p, const int g_wv) {
    f32x2* cs = (f32x2*)(p.ws + WS_CS);
    int i0 = blockIdx.x * NTHR + TIDX; asm volatile("" : "+v"(i0));
    for (int i = i0; i < SEQ * 32; i += gridDim.x * NTHR) {
        const int pos = i >> 5, j = i & 31; double inv = 1.0; for (int k = 0; k < j; ++k) inv *= 0.7498942093324558;
        const float ang = (float)pos * (float)inv; float s, c; sincos_acc(ang, s, c); cs[i] = (f32x2){c, s};
    }
}
__device__ __forceinline__ void zero_ss(const Params& p, const int g_wv) {
    float* a = (float*)(p.ws + WS_SSQ);
    int i0 = blockIdx.x * NTHR + TIDX; asm volatile("" : "+v"(i0));
    for (int i = i0; i < 2 * T; i += gridDim.x * NTHR) a[i] = 0.f;
}
template <bool OUTBF> __device__ __forceinline__ void rmsnorm_rows(const float* x, const float* gain, bf16_t* hb, float* of, const int g_wv) {
    int tid = TIDX; asm volatile("" : "+v"(tid)); const int lane = tid & 63, gw = blockIdx.x * (NTHR / 64) + (tid >> 6), nw = gridDim.x * (NTHR / 64);
    for (int row = gw; row < T; row += nw) {
        const float* xr = x + (size_t)row * DM; f32x4 v[8]; float ss = 0.f;
#pragma unroll
        for (int i = 0; i < 8; ++i) { v[i] = *(const f32x4*)(xr + i * 256 + lane * 4); ss += (v[i][0] * v[i][0] + v[i][1] * v[i][1]) + (v[i][2] * v[i][2] + v[i][3] * v[i][3]); }
#pragma unroll
        for (int o = 1; o < 64; o <<= 1) ss += shx(ss, o, lane);
        const float rs = rsqrtf(ss * (1.0f / DM) + EPS);
#pragma unroll
        for (int i = 0; i < 8; ++i) {
            const f32x4 gn = *(const f32x4*)(gain + i * 256 + lane * 4); const f32x4 y = v[i] * rs * gn;
            if (OUTBF) { u32x2 w; w.x = cvt_pk_bf16(y[0], y[1]); w.y = cvt_pk_bf16(y[2], y[3]); *(u32x2*)(hb + (size_t)row * DM + i * 256 + lane * 4) = w; }
            else *(f32x4*)(of + (size_t)row * DM + i * 256 + lane * 4) = y;
        }
    }
}

__device__ __forceinline__ void kmean_phase(const Params& p, int l, const int g_wv) {
    const bf16_t* ka = (const bf16_t*)(p.ws + WS_KA); bf16_t* km = (bf16_t*)(p.ws + WS_KM); bf16_t* kml = (bf16_t*)(p.ws + WS_SSQ); int tid = TIDX; asm volatile("" : "+v"(tid));
    for (int u = (gridDim.x == 256) ? (int)blockIdx.x - 192 : (int)blockIdx.x; u < 64; u += gridDim.x) { if (u < 0) continue;
        const int b = u >> 4, j = u & 15; const unsigned* src = (const unsigned*)(ka + ((size_t)b * SEQ + j * 256) * 1024) + tid; float a0 = 0.f, a1 = 0.f;
#pragma unroll 8
        for (int r = 0; r < 256; ++r) { const unsigned w = src[(size_t)r * 512]; a0 += bflo(w); a1 += bfhi(w); }
        const int col = tid * 2, h = col >> 7, d = col & 127;
        const float m0 = a0 * (1.0f / 256.0f), m1 = a1 * (1.0f / 256.0f); const unsigned hi = cvt_pk_bf16(m0, m1);
        *(unsigned*)(km + ((size_t)((b * 8 + h) * 16 + j)) * 128 + d) = hi;
        *(unsigned*)(kml + ((size_t)((b * 8 + h) * 16 + j)) * 128 + d) = cvt_pk_bf16(m0 - bflo(hi), m1 - bfhi(hi));
    }
}

template <int MODE> __device__ __forceinline__ void attn_phase(unsigned char* lds, const Params& p, int l, const int g_wv) {
    constexpr int DQK = MODE ? 192 : 128, NC = DQK / 32, NCH = DQK / 8, KRS = DQK * 2 + 32, KBUF = 64 * KRS, VRS = 144, VBUF = 128 * VRS;
    constexpr int OFF_V = 2 * KBUF, OFF_LUT = OFF_V + 2 * VBUF, OFF_KM = OFF_LUT + 512, NKL = (64 * NCH) / NTHR;
    int tid = TIDX; asm volatile("" : "+v"(tid)); const int lane = tid & 63, w = tid >> 6, lr = lane & 15, g = lane >> 4; const int G = gridDim.x, c = blockIdx.x;
    unsigned char* ws = p.ws;
    const bf16_t* Qp = (const bf16_t*)(ws + (MODE ? WS_QC : WS_QA)); constexpr int LDQ = MODE ? 1536 : 1024;
    const bf16_t* Kp = (const bf16_t*)(ws + (MODE ? WS_KNC : WS_KA)); const bf16_t* KRp = (const bf16_t*)(ws + WS_KR);
    const bf16_t* VTp = (const bf16_t*)(ws + (MODE ? WS_VCT : WS_VAT)); bf16_t* Zp = (bf16_t*)(ws + WS_Z + (MODE ? 64 * MiB : 0));
    float* lut = (float*)(lds + OFF_LUT);
    for (int rd = 0; rd * G < 512; ++rd) {
        int qblk, bh;
        if (G == 256) {
            const int xq = c & 7, iq = c >> 3, qq = iq >> 1;
            bh = 2 * xq + (iq & 1) + 16 * rd; qblk = rd ? qq : 15 - qq;
        } else { const int idx = rd * G + ((rd & 1) ? (G - 1 - c) : c); if (idx >= 512) continue; qblk = 15 - (idx >> 5); bh = idx & 31; }
        const int b = bh >> 3, h = bh & 7;
        const int q0 = qblk * 256 + w * 32; const size_t tq = (size_t)b * SEQ + q0; const int nt = (qblk + 1) * 4;
        bf16x8 qf[2][NC];
#pragma unroll
        for (int qb = 0; qb < 2; ++qb)
#pragma unroll
            for (int c2 = 0; c2 < NC; ++c2) qf[qb][c2] = *(const bf16x8*)(Qp + (tq + qb * 16 + lr) * LDQ + h * DQK + c2 * 32 + g * 8);
        u32x4 kreg[NKL];
#define ATT_LOADK(t_) do { const int t__ = (t_); \
        _Pragma("unroll") for (int i = 0; i < NKL; ++i) { const int id = tid + NTHR * i; const int key = id / NCH, ch = id - key * NCH; const size_t tk = (size_t)b * SEQ + t__ * 64 + key; \
            const bf16_t* s_ = (!MODE || ch < 16) ? (Kp + tk * 1024 + h * 128 + ch * 8) : (KRp + tk * 64 + (ch - 16) * 8); kreg[i] = *(const u32x4*)s_; } } while (0)
#define ATT_LOADV(t_) do { const int t__ = (t_); \
        _Pragma("unroll") for (int i = 0; i < 2; ++i) { const int id = tid + NTHR * i; const int row = id >> 3, ch = id & 7; \
            kreg[i] = *(const u32x4*)(VTp + (size_t)(h * 128 + row) * T + (size_t)b * SEQ + t__ * 64 + ch * 8); } } while (0)
#define ATT_STOREK(buf_) do { unsigned char* kb_ = lds + (buf_) * KBUF; \
        _Pragma("unroll") for (int i = 0; i < NKL; ++i) { const int id = tid + NTHR * i; const int key = id / NCH, ch = id - key * NCH; *(u32x4*)(kb_ + key * KRS + ch * 16) = kreg[i]; } } while (0)
#define ATT_STOREV(buf_) do { unsigned char* vb_ = lds + OFF_V + (buf_) * VBUF; \
        _Pragma("unroll") for (int i = 0; i < 2; ++i) { const int id = tid + NTHR * i; const int row = id >> 3, ch = id & 7; *(u32x4*)(vb_ + row * VRS + ch * 16) = kreg[i]; } } while (0)
        ATT_LOADK(0); ATT_STOREK(0); ATT_LOADV(0);
        unsigned sel[2] = {0u, 0u};
        if (MODE == 0) {
            if (tid < 128) { const int d = tid; int bk = d; if (d >= 16) { bk = 16 + (int)(logf((float)d * (1.0f / 16.0f)) / 2.0794415416798357f * 16.0f); bk = bk > 31 ? 31 : bk; } lut[d] = p.t5[bk * 8 + h] * LOG2E; }
            { const int half = tid >> 8, row = (tid >> 4) & 15, ch = tid & 15; *(u32x4*)(lds + OFF_KM + half * 4608 + row * 288 + ch * 16) = *(const u32x4*)((const bf16_t*)(ws + (half ? WS_SSQ : WS_KM)) + ((size_t)((b * 8 + h) * 16 + row)) * 128 + ch * 8); }
        }
        ATT_STOREV(0);
        __syncthreads();
        if (MODE == 0) {
            f32x4 ga[2] = {zero4(), zero4()};
#pragma unroll
            for (int c2 = 0; c2 < NC; ++c2) { const bf16x8 kf = *(const bf16x8*)(lds + OFF_KM + lr * 288 + c2 * 64 + g * 16), kfl = *(const bf16x8*)(lds + OFF_KM + 4608 + lr * 288 + c2 * 64 + g * 16);
#pragma unroll
                for (int qb = 0; qb < 2; ++qb) { const bf16x8 ql = *(const bf16x8*)((const bf16_t*)(ws + WS_QAL) + (tq + qb * 16 + lr) * 1024 + h * 128 + c2 * 32 + g * 8);
                    ga[qb] = mfma16(kfl, qf[qb][c2], ga[qb]); ga[qb] = mfma16(kf, ql, ga[qb]); ga[qb] = mfma16(kf, qf[qb][c2], ga[qb]); } }
#pragma unroll
            for (int qb = 0; qb < 2; ++qb) {
                float gv[4];
#pragma unroll
                for (int r = 0; r < 4; ++r) gv[r] = (g * 4 + r < qblk) ? ga[qb][r] : -INFINITY;
                unsigned s = 0u;
#pragma unroll
                for (int it = 0; it < 3; ++it) {
                    float bv = -INFINITY; int bi = 99;
#pragma unroll
                    for (int r = 0; r < 4; ++r) if (gv[r] > bv) { bv = gv[r]; bi = g * 4 + r; }
#pragma unroll
                    for (int o = 16; o <= 32; o <<= 1) { const float ov = shx(bv, o, lane); const int oi = shxi(bi, o, lane); if (ov > bv || (ov == bv && oi < bi)) { bv = ov; bi = oi; } }
                    if (bv > -INFINITY) s |= 1u << bi;
#pragma unroll
                    for (int r = 0; r < 4; ++r) if (g * 4 + r == bi) gv[r] = -INFINITY;
                }
                sel[qb] = s;
            }
        }
        f32x4 oacc[8][2];
#pragma unroll
        for (int i = 0; i < 8; ++i) { oacc[i][0] = zero4(); oacc[i][1] = zero4(); }
        float mrow[2] = {NEGV, NEGV}, lrow[2] = {0.f, 0.f};
        for (int t = 0; t < nt; ++t) {
            const int buf = t & 1; const bool more = (t + 1 < nt);
            if (more) ATT_LOADK(t + 1);
            const int k0 = t * 64;
            const unsigned char* kb_ = lds + buf * KBUF; const unsigned char* vb_ = lds + OFF_V + buf * VBUF;
#pragma unroll 1
            for (int hf = 0; hf < 2; ++hf) {
              const int kh = k0 + hf * 32;
              if (kh <= q0 + 31) {
                f32x4 sacc[2][2];
#pragma unroll
                for (int kb = 0; kb < 2; ++kb) { sacc[kb][0] = zero4(); sacc[kb][1] = zero4(); }
#pragma unroll
                for (int c2 = 0; c2 < NC; ++c2)
#pragma unroll
                    for (int kb = 0; kb < 2; ++kb) { const bf16x8 kf = *(const bf16x8*)(kb_ + (hf * 32 + kb * 16 + lr) * KRS + c2 * 64 + g * 16);
                        sacc[kb][0] = mfma16(kf, qf[0][c2], sacc[kb][0]); sacc[kb][1] = mfma16(kf, qf[1][c2], sacc[kb][1]); }
                if (MODE == 0) {
                    const int jblk = t >> 2; const bool far = (kh + 31 + 127 <= q0);
                    if (far) { const float bfar = lut[127];
#pragma unroll
                        for (int qb = 0; qb < 2; ++qb) { const bool al = (jblk < qblk) ? (((sel[qb] >> jblk) & 1u) != 0u) : true;
#pragma unroll
                            for (int kb = 0; kb < 2; ++kb)
#pragma unroll
                                for (int r = 0; r < 4; ++r) sacc[kb][qb][r] = al ? sacc[kb][qb][r] + bfar : NEGV; }
                    } else {
#pragma unroll
                        for (int qb = 0; qb < 2; ++qb) { const int qpos = q0 + qb * 16 + lr; const bool alp = (sel[qb] >> jblk) & 1u;
#pragma unroll
                            for (int kb = 0; kb < 2; ++kb)
#pragma unroll
                                for (int r = 0; r < 4; ++r) { const int d = qpos - (kh + kb * 16 + g * 4 + r); const int di = d < 0 ? 0 : (d > 127 ? 127 : d);
                                    const bool al = (jblk < qblk) ? alp : (d >= 0); sacc[kb][qb][r] = al ? sacc[kb][qb][r] + lut[di] : NEGV; } }
                    }
                } else {
                    if (kh + 31 > q0) {
#pragma unroll
                        for (int qb = 0; qb < 2; ++qb) { const int qpos = q0 + qb * 16 + lr;
#pragma unroll
                            for (int kb = 0; kb < 2; ++kb)
#pragma unroll
                                for (int r = 0; r < 4; ++r) if (kh + kb * 16 + g * 4 + r > qpos) sacc[kb][qb][r] = NEGV; }
                    }
                }
                bf16x8 pf[2];
#pragma unroll
                for (int qb = 0; qb < 2; ++qb) {
                    float mx = NEGV;
#pragma unroll
                    for (int kb = 0; kb < 2; ++kb)
#pragma unroll
                        for (int r = 0; r < 4; ++r) mx = fmaxf(mx, sacc[kb][qb][r]);
                    mx = fmaxf(mx, shx(mx, 16, lane)); mx = fmaxf(mx, shx(mx, 32, lane));
                    const float mnew = fmaxf(mrow[qb], mx), alpha = fexp2(mrow[qb] - mnew); mrow[qb] = mnew; float ps = 0.f;
#pragma unroll
                    for (int kb = 0; kb < 2; ++kb)
#pragma unroll
                        for (int r = 0; r < 4; ++r) { const float e = fexp2(sacc[kb][qb][r] - mnew); sacc[kb][qb][r] = e; ps += e; }
                    lrow[qb] = lrow[qb] * alpha + ps;
#pragma unroll
                    for (int i = 0; i < 8; ++i) oacc[i][qb] = oacc[i][qb] * alpha;
                    union { u32x4 u; bf16x8 v; } cvt;
                    cvt.u.x = cvt_pk_bf16(sacc[0][qb][0], sacc[0][qb][1]); cvt.u.y = cvt_pk_bf16(sacc[0][qb][2], sacc[0][qb][3]);
                    cvt.u.z = cvt_pk_bf16(sacc[1][qb][0], sacc[1][qb][1]); cvt.u.w = cvt_pk_bf16(sacc[1][qb][2], sacc[1][qb][3]); pf[qb] = cvt.v;
                }
#pragma unroll
                for (int dvb = 0; dvb < 8; ++dvb) { union { u32x2 u[2]; bf16x8 v; } vf; const unsigned char* vp = vb_ + (dvb * 16 + lr) * VRS + (hf * 32 + g * 4) * 2;
                    vf.u[0] = *(const u32x2*)vp; vf.u[1] = *(const u32x2*)(vp + 32);
                    oacc[dvb][0] = mfma16(vf.v, pf[0], oacc[dvb][0]); oacc[dvb][1] = mfma16(vf.v, pf[1], oacc[dvb][1]); }
              }
              if (more) { if (hf == 0) { ATT_STOREK(buf ^ 1); ATT_LOADV(t + 1); } else { ATT_STOREV(buf ^ 1); } }
            }
            __syncthreads();
        }
#pragma unroll
        for (int qb = 0; qb < 2; ++qb) {
            float l = lrow[qb]; l += shx(l, 16, lane); l += shx(l, 32, lane); const float inv = 1.0f / l;
            bf16_t* zr = Zp + (tq + qb * 16 + lr) * 1024 + h * 128 + g * 4;
#pragma unroll
            for (int dvb = 0; dvb < 8; ++dvb) { const u32x2 zw = *(const u32x2*)(zr + dvb * 16); const f32x4 o = oacc[dvb][qb] * inv; u32x2 ow;
                ow.x = cvt_pk_bf16(o[0] * bflo(zw.x), o[1] * bfhi(zw.x)); ow.y = cvt_pk_bf16(o[2] * bflo(zw.y), o[3] * bfhi(zw.y)); *(u32x2*)(zr + dvb * 16) = ow; }
        }
#undef ATT_LOADK
#undef ATT_LOADV
#undef ATT_STOREK
#undef ATT_STOREV
    }
}

__device__ __forceinline__ void mlstm_a(unsigned char* lds, const Params& p, int l, const int g_wv) {
    constexpr int K2RS = 272, TRS = 160; constexpr int OFF_K2 = 0, OFF_WKT = 64 * K2RS, OFF_VT = OFF_WKT + 128 * TRS, OFF_WG = OFF_VT + 256 * TRS;
    unsigned char* ws = p.ws; int tid = TIDX; asm volatile("" : "+v"(tid)); const int lane = tid & 63, w = tid >> 6, lr = lane & 15, g = lane >> 4;
    const bf16_t* QB = (const bf16_t*)(ws + WS_QB); const bf16_t* KB = (const bf16_t*)(ws + WS_KB); const bf16_t* VB = (const bf16_t*)(ws + WS_VB);
    bf16_t* Q2 = (bf16_t*)(ws + WS_Q2); bf16_t* K2 = (bf16_t*)(ws + WS_K2); const float* gates = (const float*)(ws + WS_GATES);
    const float* cw = p.conv_w + (size_t)l * 4 * 1024; const float* cb = p.conv_b + (size_t)l * 1024;
    float* wg = (float*)(lds + OFF_WG);
    for (int ku = 0; ; ++ku) { int u; { const int cb_ = blockIdx.x; if (gridDim.x == 256) { if (ku >= (cb_ < 128 ? 3 : 5)) break; u = cb_ < 128 ? cb_ + 128 * ku : 384 + (cb_ - 128) + 128 * ku; } else { u = cb_ + ku * (int)gridDim.x; if (u >= 1024) break; } }
        const int bh = u >> 6, c = u & 63, b = bh >> 2, h = bh & 3; const size_t t0 = (size_t)b * SEQ + c * 64;
#pragma unroll 1
        for (int it = 0; it < 4; ++it) {
            const int item = tid + NTHR * it, which = item >> 10, s = (item >> 4) & 63, grp = item & 15; const int ch0 = h * 128 + grp * 8, cc0 = which * 512 + ch0;
            const bf16_t* src = which ? KB : QB; float a[8];
            { const f32x4 b0 = *(const f32x4*)(cb + cc0), b1 = *(const f32x4*)(cb + cc0 + 4); a[0] = b0[0]; a[1] = b0[1]; a[2] = b0[2]; a[3] = b0[3]; a[4] = b1[0]; a[5] = b1[1]; a[6] = b1[2]; a[7] = b1[3]; }
#pragma unroll
            for (int j = 0; j < 4; ++j) { const int tp = c * 64 + s - 3 + j;
                if (tp >= 0) { const u32x4 xw = *(const u32x4*)(src + ((size_t)b * SEQ + tp) * 512 + ch0); const f32x4 w0 = *(const f32x4*)(cw + j * 1024 + cc0), w1 = *(const f32x4*)(cw + j * 1024 + cc0 + 4);
                    a[0] += bflo(xw.x) * w0[0]; a[1] += bfhi(xw.x) * w0[1]; a[2] += bflo(xw.y) * w0[2]; a[3] += bfhi(xw.y) * w0[3];
                    a[4] += bflo(xw.z) * w1[0]; a[5] += bfhi(xw.z) * w1[1]; a[6] += bflo(xw.w) * w1[2]; a[7] += bfhi(xw.w) * w1[3]; } }
            const float ksc = which ? 0.08838834764831845f : 1.0f;
#pragma unroll
            for (int i = 0; i < 8; ++i) a[i] = fsilu(a[i]) * ksc;
            u32x4 ow; ow.x = cvt_pk_bf16(a[0], a[1]); ow.y = cvt_pk_bf16(a[2], a[3]); ow.z = cvt_pk_bf16(a[4], a[5]); ow.w = cvt_pk_bf16(a[6], a[7]);
            *(u32x4*)((which ? K2 : Q2) + (t0 + s) * 512 + ch0) = ow;
            if (which) *(u32x4*)(lds + OFF_K2 + s * K2RS + grp * 16) = ow;
        }
        if (w == 0) {
            const float fpre = gates[(t0 + lane) * 8 + 4 + h] + p.f_bias[l * 4 + h]; const float li = gates[(t0 + lane) * 8 + h] + p.i_bias[l * 4 + h];
            const float lf = fminf(fpre, 0.f) - log1pf(__expf(-fabsf(fpre)));
            float bc = lf;
#pragma unroll
            for (int o = 1; o < 64; o <<= 1) { const float v = shup(bc, o, lane); if (lane >= o) bc += v; }
            const float blast = __int_as_float(__builtin_amdgcn_readlane(__float_as_int(bc), 63)); const float gg = blast - bc + li; float gm = gg;
#pragma unroll
            for (int o = 1; o < 64; o <<= 1) gm = fmaxf(gm, shx(gm, o, lane));
            wg[lane] = __expf(gg - gm);
            ((float*)(ws + WS_BV))[(size_t)u * 64 + lane] = bc; ((float*)(ws + WS_LIV))[(size_t)u * 64 + lane] = li;
            if (lane == 0) { ((float*)(ws + WS_BLAST))[u] = blast; ((float*)(ws + WS_GMAX))[u] = gm; }
        }
#pragma unroll
        for (int it = 0; it < 4; ++it) { const int item = tid + NTHR * it, s = item & 63, eg = item >> 6; const u32x4 vw = *(const u32x4*)(VB + (t0 + s) * 1024 + h * 256 + eg * 8);
            bf16_t* d = (bf16_t*)(lds + OFF_VT + (eg * 8) * TRS + s * 2); const unsigned vv[4] = {vw.x, vw.y, vw.z, vw.w};
#pragma unroll
            for (int i = 0; i < 4; ++i) { *(bf16_t*)((unsigned char*)d + (2 * i) * TRS) = (bf16_t)(vv[i] & 0xffffu); *(bf16_t*)((unsigned char*)d + (2 * i + 1) * TRS) = (bf16_t)(vv[i] >> 16); } }
        __syncthreads();
#pragma unroll 1
        for (int it = 0; it < 2; ++it) { const int item = tid + NTHR * it, s = item & 63, dg = item >> 6; const u32x4 kw = *(const u32x4*)(lds + OFF_K2 + s * K2RS + dg * 16); const float ww = wg[s];
            const unsigned kv[4] = {kw.x, kw.y, kw.z, kw.w}; unsigned char* d = lds + OFF_WKT + (dg * 8) * TRS + s * 2;
#pragma unroll
            for (int i = 0; i < 4; ++i) { *(bf16_t*)(d + (2 * i) * TRS) = f2bf(bflo(kv[i]) * ww); *(bf16_t*)(d + (2 * i + 1) * TRS) = f2bf(bfhi(kv[i]) * ww); } }
        __syncthreads();
#if defined(MK_DEBUG_HASH)
        { unsigned char* dbg = ws + WS_END + MiB + (size_t)u * 40960; for (int i = tid; i < 2560; i += NTHR) *(u32x4*)(dbg + i * 16) = *(const u32x4*)(lds + OFF_VT + i * 16); }
#endif
        if (tid < 128) { float a = 0.f; const unsigned char* r = lds + OFF_WKT + tid * TRS;
#pragma unroll
            for (int i = 0; i < 8; ++i) { const u32x4 x = *(const u32x4*)(r + i * 16); a += (bflo(x.x) + bfhi(x.x)) + (bflo(x.y) + bfhi(x.y)) + (bflo(x.z) + bfhi(x.z)) + (bflo(x.w) + bfhi(x.w)); }
            ((float*)(ws + WS_NST))[(size_t)u * 128 + tid] = a; }
        f32x4 acc[8][2];
#pragma unroll
        for (int i = 0; i < 8; ++i) { acc[i][0] = zero4(); acc[i][1] = zero4(); }
#pragma unroll
        for (int kc = 0; kc < 2; ++kc) {
            const bf16x8 v0 = *(const bf16x8*)(lds + OFF_VT + (w * 32 + lr) * TRS + kc * 64 + g * 16), v1 = *(const bf16x8*)(lds + OFF_VT + (w * 32 + 16 + lr) * TRS + kc * 64 + g * 16);
#pragma unroll
            for (int db = 0; db < 8; ++db) { const bf16x8 kf = *(const bf16x8*)(lds + OFF_WKT + (db * 16 + lr) * TRS + kc * 64 + g * 16); acc[db][0] = mfma16(kf, v0, acc[db][0]); acc[db][1] = mfma16(kf, v1, acc[db][1]); }
        }
        bf16_t* cst = (bf16_t*)(ws + WS_CST) + (size_t)u * 32768; float one = 1.0f; asm volatile("" : "+v"(one));
#pragma unroll
        for (int eb = 0; eb < 2; ++eb)
#pragma unroll
            for (int db = 0; db < 8; ++db) { const f32x4 av = acc[db][eb] * one; u32x2 o; o.x = cvt_pk_bf16(av[0], av[1]); o.y = cvt_pk_bf16(av[2], av[3]); *(u32x2*)(cst + (size_t)(w * 32 + eb * 16 + lr) * 128 + db * 16 + g * 4) = o; }
        __syncthreads();
    }
}
__device__ __forceinline__ void mlstm_b(const Params& p, const int g_wv) {
    unsigned char* ws = p.ws; int tid = TIDX; asm volatile("" : "+v"(tid)); const float* blast = (const float*)(ws + WS_BLAST); const float* gmax = (const float*)(ws + WS_GMAX);
    for (int u = blockIdx.x; u < 256; u += gridDim.x) {
        const int bh = u >> 4, eb = u & 15; bf16_t* base = (bf16_t*)(ws + WS_CST) + (size_t)bh * 64 * 32768 + eb * 2048 + tid * 4;
        float* nb = (float*)(ws + WS_NST) + (size_t)bh * 64 * 128 + tid; const bool don = (eb == 0 && tid < 128);
        float m = 0.f, c0 = 0.f, c1 = 0.f, c2 = 0.f, c3 = 0.f, nn = 0.f;
#pragma unroll 16
        for (int c = 0; c < 64; ++c) {
            const float bl = blast[bh * 64 + c], gm = gmax[bh * 64 + c]; const float mn = fmaxf(bl + m, gm); const float dec = __expf(bl + m - mn), inw = __expf(gm - mn);
            u32x2* sp = (u32x2*)(base + (size_t)c * 32768); const u32x2 uw = *sp; u32x2 o; o.x = cvt_pk_bf16(c0, c1); o.y = cvt_pk_bf16(c2, c3); *sp = o;
            c0 = dec * c0 + inw * bflo(uw.x); c1 = dec * c1 + inw * bfhi(uw.x); c2 = dec * c2 + inw * bflo(uw.y); c3 = dec * c3 + inw * bfhi(uw.y);
            if (don) { const float nu = nb[c * 128]; nb[c * 128] = nn; nn = dec * nn + inw * nu; }
            if (eb == 0 && tid == 0) ((float*)(ws + WS_MST))[bh * 64 + c] = m;
            m = mn;
        }
        asm volatile("s_waitcnt vmcnt(0)" ::: "memory"); __syncthreads();
        if (tid == 0) { __builtin_amdgcn_fence(__ATOMIC_RELEASE, "agent"); asm volatile("s_waitcnt vmcnt(0)" ::: "memory");
            __hip_atomic_fetch_add((unsigned*)(ws + WS_CTR) + 16 + bh, 1u, __ATOMIC_RELAXED, __HIP_MEMORY_SCOPE_AGENT); }
    }
}
__device__ __forceinline__ void mlstm_c(unsigned char* lds, const Params& p, int l, const int g_wv) {
    constexpr int QRS = 288, TRS = 160; constexpr int OFF_Q = 0, OFF_K = 64 * QRS, OFF_VT = 2 * 64 * QRS, OFF_P = OFF_VT + 256 * TRS, OFF_F = OFF_P + 64 * TRS;
    unsigned char* ws = p.ws; int tid = TIDX; asm volatile("" : "+v"(tid)); const int lane = tid & 63, w = tid >> 6, lr = lane & 15, g = lane >> 4;
    const bf16_t* Q2 = (const bf16_t*)(ws + WS_Q2); const bf16_t* K2 = (const bf16_t*)(ws + WS_K2); const bf16_t* VB = (const bf16_t*)(ws + WS_VB);
    const bf16_t* OB = (const bf16_t*)(ws + WS_OB); bf16_t* ZB = (bf16_t*)(ws + WS_Z + 32 * MiB); const float* gn = p.out_norm + (size_t)l * 1024;
    float* fb = (float*)(lds + OFF_F); float* bvec = fb; float* livec = fb + 64; float* mt = fb + 128; float* wint = fb + 192; float* denV = fb + 256; float* denC = fb + 320; float* lsum = fb + 384; float* lsq = fb + 448; float* nvec = fb + 512;
    for (int u = blockIdx.x; u < 1024; u += gridDim.x) {
        const int bh = u >> 6, c = u & 63, b = bh >> 2, h = bh & 3; const size_t t0 = (size_t)b * SEQ + c * 64;
        if (tid == 0) { const unsigned want = 16u * (unsigned)(l + 1); while (__hip_atomic_load((unsigned*)(ws + WS_CTR) + 16 + bh, __ATOMIC_RELAXED, __HIP_MEMORY_SCOPE_AGENT) < want) __builtin_amdgcn_s_sleep(1);
            __builtin_amdgcn_fence(__ATOMIC_ACQUIRE, "agent"); asm volatile("s_waitcnt vmcnt(0)" ::: "memory"); }
        __syncthreads();
        const float mc = ((const float*)(ws + WS_MST))[u];
#pragma unroll
        for (int it = 0; it < 2; ++it) { const int id = tid + NTHR * it, s = id >> 4, ch = id & 15;
            *(u32x4*)(lds + OFF_Q + s * QRS + ch * 16) = *(const u32x4*)(Q2 + (t0 + s) * 512 + h * 128 + ch * 8); *(u32x4*)(lds + OFF_K + s * QRS + ch * 16) = *(const u32x4*)(K2 + (t0 + s) * 512 + h * 128 + ch * 8); }
#pragma unroll 2
        for (int it = 0; it < 4; ++it) { const int item = tid + NTHR * it, s = item & 63, eg = item >> 6; const u32x4 vw = *(const u32x4*)(VB + (t0 + s) * 1024 + h * 256 + eg * 8);
            unsigned char* d = lds + OFF_VT + (eg * 8) * TRS + s * 2; const unsigned vv[4] = {vw.x, vw.y, vw.z, vw.w};
#pragma unroll
            for (int i = 0; i < 4; ++i) { *(bf16_t*)(d + (2 * i) * TRS) = (bf16_t)(vv[i] & 0xffffu); *(bf16_t*)(d + (2 * i + 1) * TRS) = (bf16_t)(vv[i] >> 16); } }
        if (tid < 64) { bvec[tid] = ((const float*)(ws + WS_BV))[(size_t)u * 64 + tid]; livec[tid] = ((const float*)(ws + WS_LIV))[(size_t)u * 64 + tid]; lsum[tid] = 0.f; lsq[tid] = 0.f; }
        else if (tid < 192) nvec[tid - 64] = ((const float*)(ws + WS_NST))[(size_t)u * 128 + tid - 64];
        __syncthreads();
        if (w == 0) { float x = livec[lane] - bvec[lane];
#pragma unroll
            for (int o = 1; o < 64; o <<= 1) { const float v = shup(x, o, lane); if (lane >= o) x = fmaxf(x, v); }
            const float mtl = bvec[lane] + fmaxf(mc, x); mt[lane] = mtl; wint[lane] = __expf(bvec[lane] + mc - mtl); }
        __syncthreads();
        { const int lb = w >> 1;
#pragma unroll
          for (int si = 0; si < 2; ++si) { const int sb = (w & 1) * 2 + si; f32x4 a = zero4();
            if (sb <= lb) {
#pragma unroll
                for (int kc = 0; kc < 4; ++kc) { const bf16x8 qf = *(const bf16x8*)(lds + OFF_Q + (lb * 16 + lr) * QRS + kc * 64 + g * 16), kf = *(const bf16x8*)(lds + OFF_K + (sb * 16 + lr) * QRS + kc * 64 + g * 16); a = mfma16(qf, kf, a); }
            }
            const int s = sb * 16 + lr; const float bs = bvec[s] - livec[s];
#pragma unroll
            for (int r = 0; r < 4; ++r) { const int ll = lb * 16 + g * 4 + r; float v = 0.f; if (s <= ll) v = a[r] * __expf(bvec[ll] - bs - mt[ll]); *(bf16_t*)(lds + OFF_P + ll * TRS + s * 2) = f2bf(v); } } }
        __syncthreads();
        if (w == 0) { float a = 0.f; const unsigned char* r = lds + OFF_P + lane * TRS;
#pragma unroll
            for (int i = 0; i < 8; ++i) { const u32x4 x = *(const u32x4*)(r + i * 16); a += (bflo(x.x) + bfhi(x.x)) + (bflo(x.y) + bfhi(x.y)) + (bflo(x.z) + bfhi(x.z)) + (bflo(x.w) + bfhi(x.w)); }
            denV[lane] = a; }
        else if (w == 1) { float a = 0.f; const unsigned char* r = lds + OFF_Q + lane * QRS;
#pragma unroll
            for (int i = 0; i < 16; ++i) { const u32x4 x = *(const u32x4*)(r + i * 16); const float* nv = nvec + i * 8;
                a += bflo(x.x) * nv[0] + bfhi(x.x) * nv[1] + bflo(x.y) * nv[2] + bfhi(x.y) * nv[3] + bflo(x.z) * nv[4] + bfhi(x.z) * nv[5] + bflo(x.w) * nv[6] + bfhi(x.w) * nv[7]; }
            denC[lane] = a; }
        f32x4 accV[2][4], accC[2][4];
#pragma unroll
        for (int i = 0; i < 2; ++i)
#pragma unroll
            for (int j = 0; j < 4; ++j) { accV[i][j] = zero4(); accC[i][j] = zero4(); }
        const bf16_t* cst = (const bf16_t*)(ws + WS_CST) + (size_t)u * 32768;
#pragma unroll
        for (int kp = 0; kp < 2; ++kp) {
        bf16x8 ctf[2][2];
#pragma unroll
        for (int k2 = 0; k2 < 2; ++k2) { const int kc = kp * 2 + k2; ctf[k2][0] = *(const bf16x8*)(cst + (size_t)(w * 32 + lr) * 128 + kc * 32 + g * 8); ctf[k2][1] = *(const bf16x8*)(cst + (size_t)(w * 32 + 16 + lr) * 128 + kc * 32 + g * 8); }
#pragma unroll
        for (int k2 = 0; k2 < 2; ++k2) { const int kc = kp * 2 + k2;
            const bf16x8 c0 = ctf[k2][0], c1 = ctf[k2][1];
#pragma unroll
            for (int lb = 0; lb < 4; ++lb) { const bf16x8 qf = *(const bf16x8*)(lds + OFF_Q + (lb * 16 + lr) * QRS + kc * 64 + g * 16); accC[0][lb] = mfma16(c0, qf, accC[0][lb]); accC[1][lb] = mfma16(c1, qf, accC[1][lb]); }
        }
        }
#pragma unroll
        for (int kc = 0; kc < 2; ++kc) {
            const bf16x8 v0 = *(const bf16x8*)(lds + OFF_VT + (w * 32 + lr) * TRS + kc * 64 + g * 16), v1 = *(const bf16x8*)(lds + OFF_VT + (w * 32 + 16 + lr) * TRS + kc * 64 + g * 16);
#pragma unroll
            for (int lb = 0; lb < 4; ++lb) { const bf16x8 pf = *(const bf16x8*)(lds + OFF_P + (lb * 16 + lr) * TRS + kc * 64 + g * 16); accV[0][lb] = mfma16(v0, pf, accV[0][lb]); accV[1][lb] = mfma16(v1, pf, accV[1][lb]); }
        }
        __syncthreads();
#pragma unroll
        for (int lb = 0; lb < 4; ++lb) { const int ll = lb * 16 + lr; const float wi = wint[ll]; const float den = wi * denC[ll] + denV[ll]; const float dn = 1.0f / fmaxf(fabsf(den), __expf(-mt[ll])); float s1 = 0.f, s2 = 0.f;
#pragma unroll
            for (int eb = 0; eb < 2; ++eb) { const f32x4 hv = (accC[eb][lb] * wi + accV[eb][lb]) * dn; accV[eb][lb] = hv; s1 += (hv[0] + hv[1]) + (hv[2] + hv[3]); s2 += (hv[0] * hv[0] + hv[1] * hv[1]) + (hv[2] * hv[2] + hv[3] * hv[3]); }
            s1 += shx(s1, 16, lane); s1 += shx(s1, 32, lane); s2 += shx(s2, 16, lane); s2 += shx(s2, 32, lane);
            if (g == 0) { fb[640 + w * 64 + ll] = s1; fb[1152 + w * 64 + ll] = s2; } }
        __syncthreads();
#pragma unroll
        for (int lb = 0; lb < 4; ++lb) { const int ll = lb * 16 + lr; float t1 = 0.f, t2 = 0.f;
#pragma unroll
            for (int ww = 0; ww < 8; ++ww) { t1 += fb[640 + ww * 64 + ll]; t2 += fb[1152 + ww * 64 + ll]; }
            const float mu = t1 * (1.0f / 256.0f); const float var = fmaxf(t2 * (1.0f / 256.0f) - mu * mu, 0.f); const float rstd = rsqrtf(var + EPS);
#pragma unroll
            for (int eb = 0; eb < 2; ++eb) { const int e = w * 32 + eb * 16 + g * 4; const size_t off = (t0 + ll) * 1024 + h * 256 + e; const f32x4 gv = *(const f32x4*)(gn + h * 256 + e);
                const u32x2 ow = *(const u32x2*)(OB + off), zw = *(const u32x2*)(ZB + off); const f32x4 hv = accV[eb][lb]; u32x2 o;
                o.x = cvt_pk_bf16((hv[0] - mu) * rstd * gv[0] * bflo(ow.x) * bflo(zw.x), (hv[1] - mu) * rstd * gv[1] * bfhi(ow.x) * bfhi(zw.x));
                o.y = cvt_pk_bf16((hv[2] - mu) * rstd * gv[2] * bflo(ow.y) * bflo(zw.y), (hv[3] - mu) * rstd * gv[3] * bfhi(ow.y) * bfhi(zw.y)); *(u32x2*)(ZB + off) = o; } }
        __syncthreads();
    }
}

#ifndef PHM
#define PHM 4095
#endif
typedef const __attribute__((address_space(4))) Params* KParams;
#if defined(__HIP_DEVICE_COMPILE__)
__device__ __forceinline__ Params load_params() { KParams k = (KParams)__builtin_amdgcn_kernarg_segment_ptr(); asm volatile("" : "+s"(k)); return *k; }
#else
__device__ __forceinline__ Params load_params() { return Params{}; }
#endif
#define PP load_params()
#define GSYNC() do { asm volatile("s_waitcnt vmcnt(0) lgkmcnt(0)" ::: "memory"); __builtin_amdgcn_fence(__ATOMIC_RELEASE, "agent"); asm volatile("s_waitcnt vmcnt(0)" ::: "memory"); grid.sync(); \
    __builtin_amdgcn_fence(__ATOMIC_ACQUIRE, "agent"); asm volatile("s_waitcnt vmcnt(0) lgkmcnt(0)" ::: "memory"); } while (0)
__device__ __forceinline__ void gbar(unsigned* ctr, unsigned target, const int g_wv) {
    asm volatile("s_waitcnt vmcnt(0) lgkmcnt(0)" ::: "memory");
    __syncthreads();
    if (TIDX == 0) {
        __builtin_amdgcn_fence(__ATOMIC_RELEASE, "agent"); asm volatile("s_waitcnt vmcnt(0)" ::: "memory");
        __hip_atomic_fetch_add(ctr, 1u, __ATOMIC_RELAXED, __HIP_MEMORY_SCOPE_AGENT);
        while (__hip_atomic_load(ctr, __ATOMIC_RELAXED, __HIP_MEMORY_SCOPE_AGENT) < target) __builtin_amdgcn_s_sleep(1);
        __builtin_amdgcn_fence(__ATOMIC_ACQUIRE, "agent"); asm volatile("s_waitcnt vmcnt(0)" ::: "memory");
    }
    __syncthreads();
}
template <bool AL = true, bool SP = true, class Epi, class Sched> __device__ __forceinline__ void run_gemm(unsigned char* lds, const bf16_t* A, const bf16_t* Bt, int M, int N, int K, int lda, int ldb, const Sched& S, const Epi& E, const int g_wv) {
    pg8::Gemm g{A, Bt, M, N, K, lda, ldb};
    pg8::gemm_phase<Epi, Sched, AL, SP>((PG8_LAS unsigned char*)lds, g, S, E, g_wv);
    __syncthreads();
}

__global__ void __launch_bounds__(NTHR, 2) mega(Params p_arg) {
    extern __shared__ __attribute__((aligned(16))) unsigned char lds[];
    cg::grid_group grid = cg::this_grid();
    const int g_wv = __builtin_amdgcn_readfirstlane((int)(__builtin_amdgcn_workitem_id_x() >> 6));
    const int G = gridDim.x, cb = blockIdx.x; const int w_lo = p_arg.w_lo, w_hi = p_arg.w_hi;
#define WIN(k_) (w_lo <= (k_) && (k_) < w_hi)
    unsigned nbar = 0;
#define SEAM(k_) do { if (WIN(k_) && WIN((k_) + 1)) { ++nbar; gbar((unsigned*)(PP.ws + WS_CTR), nbar * (unsigned)G, g_wv); } } while (0)
    if (w_lo > 1000) GSYNC();
    if (WIN(0)) {
#if PHM & 1
    convert_weights(lds, PP, 0, g_wv); convert_weights(lds, PP, 1, g_wv);
#endif
#if PHM & 2
    build_cs(PP, g_wv);
    { const Params p = PP; rmsnorm_rows<true>(p.x, p.norm_gain, (bf16_t*)(p.ws + WS_H), nullptr, g_wv); }
#endif
    }
    SEAM(0);
#pragma unroll 1
    for (int l = 0; l < 2; ++l) {
        const int wb = 1 + 7 * l;
        if (WIN(wb)) {
#if PHM & 4
        { unsigned char* ws = PP.ws; unsigned char* wl = ws + WS_W0 + (size_t)l * WL_SIZE; const f32x2* cs = (const f32x2*)(ws + WS_CS); (void)cs; (void)wl; pg8::StaticOrder S; S.init(T, 15360, G, cb); EpiIn E{ws}; run_gemm(lds, (const bf16_t*)(ws + WS_H), (const bf16_t*)(wl + WL_WIN), T, 15360, DM, DM, DM, S, E, g_wv); }
        { unsigned char* ws = PP.ws; unsigned char* wl = ws + WS_W0 + (size_t)l * WL_SIZE; const f32x2* cs = (const f32x2*)(ws + WS_CS); (void)cs; (void)wl; pg8::StaticOrder S; S.init(1024, T, G, cb); EpiVT E{(bf16_t*)(ws + WS_VAT), T, nullptr, 0.f}; run_gemm(lds, (const bf16_t*)(wl + WL_WIN) + (size_t)15360 * DM, (const bf16_t*)(ws + WS_H), 1024, T, DM, DM, DM, S, E, g_wv); }
#endif
        }
        SEAM(wb);
        if (WIN(wb + 1)) {
#if PHM & 32
        mlstm_a(lds, PP, l, g_wv);
#endif
#if PHM & 16
        kmean_phase(PP, l, g_wv);
#endif
#if PHM & 8
        { unsigned char* ws = PP.ws; unsigned char* wl = ws + WS_W0 + (size_t)l * WL_SIZE; const f32x2* cs = (const f32x2*)(ws + WS_CS); (void)cs; (void)wl; pg8::StaticOrder S; S.init(T, 1536, G, cb); EpiRow<true> E{(bf16_t*)(ws + WS_QC), 1536, (const float*)(ws + WS_SSP), 1.0f / 512.0f, CC_SCALE, cs}; run_gemm(lds, (const bf16_t*)(ws + WS_CQ), (const bf16_t*)(wl + WL_WUQ), T, 1536, 512, 512, 512, S, E, g_wv); }
        { unsigned char* ws = PP.ws; unsigned char* wl = ws + WS_W0 + (size_t)l * WL_SIZE; const f32x2* cs = (const f32x2*)(ws + WS_CS); (void)cs; (void)wl; pg8::StaticOrder S; S.init(T, 1024, G, cb); EpiRow<false> E{(bf16_t*)(ws + WS_KNC), 1024, (const float*)(ws + WS_SSP), 1.0f / 256.0f, 1.0f, cs}; run_gemm(lds, (const bf16_t*)(ws + WS_CKV), (const bf16_t*)(wl + WL_WKN), T, 1024, 256, 256, 256, S, E, g_wv); }
        { unsigned char* ws = PP.ws; unsigned char* wl = ws + WS_W0 + (size_t)l * WL_SIZE; const f32x2* cs = (const f32x2*)(ws + WS_CS); (void)cs; (void)wl; pg8::StaticOrder S; S.init(1024, T, G, cb); EpiVT E{(bf16_t*)(ws + WS_VCT), T, (const float*)(ws + WS_SSP), 1.0f / 256.0f}; run_gemm(lds, (const bf16_t*)(wl + WL_WV), (const bf16_t*)(ws + WS_CKV), 1024, T, 256, 256, 256, S, E, g_wv); }
#endif
        }
        SEAM(wb + 1);
        if (WIN(wb + 2)) {
#if PHM & 128
        mlstm_b(PP, g_wv);
#endif
#if PHM & 64
        attn_phase<0>(lds, PP, l, g_wv);
#endif
        }
        if (WIN(wb + 3)) {
#if PHM & 256
        attn_phase<1>(lds, PP, l, g_wv);
#endif
#if PHM & 512
        mlstm_c(lds, PP, l, g_wv);
#endif
        }
        SEAM(wb + 3);
        if (WIN(wb + 4)) {
#if PHM & 1024
        { unsigned char* ws = PP.ws; unsigned char* wl = ws + WS_W0 + (size_t)l * WL_SIZE; MergeOrder S{G, cb}; EpiMerge E{(bf16_t*)(ws + WS_H), (const bf16_t*)(ws + WS_GT)}; run_gemm(lds, (const bf16_t*)(ws + WS_Z), (const bf16_t*)(wl + WL_WB), 3 * T, 2048, 1024, 1024, 1024, S, E, g_wv); }
#endif
        }
        SEAM(wb + 4);
        if (WIN(wb + 5)) {
#if PHM & 2048
        { unsigned char* ws = PP.ws; unsigned char* wl = ws + WS_W0 + (size_t)l * WL_SIZE; const f32x2* cs = (const f32x2*)(ws + WS_CS); (void)cs; (void)wl; pg8::StaticOrder S; S.init(T, DM, G, cb); const Params p = PP; EpiOut E{l == 0 ? p.x : p.out, p.out}; run_gemm(lds, (const bf16_t*)(ws + WS_H), (const bf16_t*)(wl + WL_WO), T, DM, DM, DM, DM, S, E, g_wv); }
#endif
        }
        SEAM(wb + 5);
        if (WIN(wb + 6)) {
            if (l == 0) { const Params p = PP; rmsnorm_rows<true>(p.out, p.norm_gain + DM, (bf16_t*)(p.ws + WS_H), nullptr, g_wv); }
            else { const Params p = PP; rmsnorm_rows<false>(p.out, p.final_norm, nullptr, p.out, g_wv); }
        }
        if (l == 0) SEAM(wb + 6);
    }
}


#if defined(MK_DEBUG_HASH)
__global__ void hash_buf(const unsigned* p, size_t nwords, unsigned long long* acc) {
    unsigned long long s = 0; const size_t stride = (size_t)gridDim.x * blockDim.x;
    for (size_t i = (size_t)blockIdx.x * blockDim.x + threadIdx.x; i < nwords; i += stride) s += (unsigned long long)p[i] * (unsigned long long)(((unsigned)i * 2654435761u) | 1u);
    atomicAdd(acc, s);
}
__global__ void dbg_final(float* out, size_t n, const unsigned long long* h, int R, int NK) {
    __shared__ float flag;
    if (threadIdx.x == 0) { float f = 1.0f; for (int k = NK - 1; k >= 0; --k) for (int r = 1; r < R; ++r) if (h[r * NK + k] != h[k]) { f = 100.0f; for (int q = 0; q < k; ++q) f *= 10.0f; } flag = f; }
    __syncthreads();
    for (size_t i = (size_t)blockIdx.x * blockDim.x + threadIdx.x; i < n; i += (size_t)gridDim.x * blockDim.x) out[i] = (i == 0) ? flag : 0.0f;
}
#endif
extern "C" void kernel_launch(void* const* d_in, const int* in_sizes, int n_in, void* d_out, int out_size, void* d_ws, size_t ws_size, hipStream_t stream) {
    static int grid = 0;
    if (grid == 0) {
        if (n_in != 16 || ws_size < WS_END) { fprintf(stderr, "kernel_launch: unexpected n_in %d or ws_size %zu < %zu\n", n_in, ws_size, (size_t)WS_END); grid = -1; return; }
        int dev = 0, cus = 0, per_cu = 0;
        hipGetDevice(&dev); hipDeviceGetAttribute(&cus, hipDeviceAttributeMultiprocessorCount, dev);
        if (hipFuncSetAttribute((const void*)mega, hipFuncAttributeMaxDynamicSharedMemorySize, LDS_BYTES) != hipSuccess) { fprintf(stderr, "kernel_launch: hipFuncSetAttribute failed\n"); grid = -1; return; }
        if (hipOccupancyMaxActiveBlocksPerMultiprocessor(&per_cu, (const void*)mega, NTHR, LDS_BYTES) != hipSuccess || per_cu < 1) { fprintf(stderr, "kernel_launch: occupancy query gave %d\n", per_cu); per_cu = 1; }
        (void)hipGetLastError();
        grid = cus * 1;
    }
    if (grid < 0) return;
    Params p{};
    p.x = (const float*)d_in[0]; p.norm_gain = (const float*)d_in[1]; p.w_in = (const float*)d_in[2]; p.t5 = (const float*)d_in[3]; p.conv_w = (const float*)d_in[4]; p.conv_b = (const float*)d_in[5];
    p.i_bias = (const float*)d_in[6]; p.f_bias = (const float*)d_in[7]; p.out_norm = (const float*)d_in[8]; p.q_norm = (const float*)d_in[9]; p.kv_norm = (const float*)d_in[10];
    p.w_uq = (const float*)d_in[11]; p.w_ukv = (const float*)d_in[12]; p.w_branch = (const float*)d_in[13]; p.w_out = (const float*)d_in[14]; p.final_norm = (const float*)d_in[15];
    p.out = (float*)d_out; p.ws = (unsigned char*)d_ws;
    (void)hipMemsetAsync((unsigned char*)d_ws + WS_CTR, 0, 256, stream);
    void* args[] = {&p};
#if defined(MK_DEBUG_HASH)
    {
        constexpr int R = 4, NK = 9; unsigned char* W = (unsigned char*)d_ws; unsigned long long* H = (unsigned long long*)(W + WS_END);
        hipMemsetAsync(H, 0, R * NK * 8, stream);
        struct HB { int win; size_t off; size_t bytes; };
        const HB hb[NK] = { {3, WS_Z, 32 * MiB}, {3, WS_CST, 64 * MiB}, {3, WS_NST, 524288}, {3, WS_MST, 4096},
                            {4, WS_Z + 64 * MiB, 32 * MiB}, {4, WS_Z + 32 * MiB, 32 * MiB}, {5, WS_H, 64 * MiB}, {6, WS_H, 64 * MiB}, {2, WS_CST, 64 * MiB} };
        for (int r = 0; r < R; ++r)
            for (int w = 0; w < 7; ++w) { p.w_lo = w; p.w_hi = w + 1;
                hipError_t e = hipLaunchCooperativeKernel((const void*)mega, dim3(grid), dim3(NTHR), args, LDS_BYTES, stream);
                if (e != hipSuccess) fprintf(stderr, "kernel_launch: cooperative launch failed: %s\n", hipGetErrorString(e));
                for (int k = 0; k < NK; ++k) if (hb[k].win == w) {
                    if (k == 7) hash_buf<<<256, 256, 0, stream>>>((const unsigned*)d_out, (size_t)T * DM, H + r * NK + k);
                    else hash_buf<<<256, 256, 0, stream>>>((const unsigned*)(W + hb[k].off), hb[k].bytes / 4, H + r * NK + k); } }
        dbg_final<<<256, 256, 0, stream>>>((float*)d_out, (size_t)T * DM, H, R, NK);
    }
    if (false) {
#elif defined(MK_MULTI)
    for (int w = 0; w < 15; ++w) { p.w_lo = w; p.w_hi = w + 1;
#else
    { p.w_lo = 0; p.w_hi = 15;
#endif
        hipError_t e = hipLaunchCooperativeKernel((const void*)mega, dim3(grid), dim3(NTHR), args, LDS_BYTES, stream);
        if (e != hipSuccess) fprintf(stderr, "kernel_launch: cooperative launch failed: %s (grid %d)\n", hipGetErrorString(e), grid);
    }
}
```

```cpp
#include <hip/hip_runtime.h>
#include <hip/hip_cooperative_groups.h>
#include <cstdio>
#include <cstdint>
namespace cg = cooperative_groups;
__device__ __forceinline__ int tidx_opaque(int g_wv) { int l; asm volatile("v_mbcnt_lo_u32_b32 %0, -1, 0\n\tv_mbcnt_hi_u32_b32 %0, -1, %0" : "=v"(l)); return g_wv * 64 + l; }
#define TIDX tidx_opaque(g_wv)
__device__ __forceinline__ float shx(float v, int o, int lane) { return __int_as_float(__builtin_amdgcn_ds_bpermute(((lane ^ o) & 63) << 2, __float_as_int(v))); }
__device__ __forceinline__ int shxi(int v, int o, int lane) { return __builtin_amdgcn_ds_bpermute(((lane ^ o) & 63) << 2, v); }
__device__ __forceinline__ float shup(float v, int o, int lane) { return __int_as_float(__builtin_amdgcn_ds_bpermute(((lane - o) & 63) << 2, __float_as_int(v))); }

namespace pg8 {
#define PG8_LAS __attribute__((address_space(3)))
typedef unsigned short bf16_t;
typedef short bf16x8 __attribute__((ext_vector_type(8)));
typedef float f32x4 __attribute__((ext_vector_type(4)));
typedef unsigned u32x4 __attribute__((ext_vector_type(4)));
constexpr int BM = 256, BK = 64, HALF = 128, HTB = HALF * BK * 2  , STAGE_BYTES = 8 * HTB, NXCD = 8, WGM = 8;

__host__ __device__ __forceinline__ int lds_byte(int r, int c) { const int st = (r >> 4) * 2 + (c >> 5), rr = r & 15, cc = c & 31, ob = rr * 64 + cc * 2; return st * 1024 + (ob ^ (((ob >> 9) & 1) << 5)); }
__host__ __device__ __forceinline__ void stage_rc(int b, int& R, int& C) { const int st = b / 1024, sb = b % 1024, swz = sb ^ (((sb >> 9) & 1) << 5); R = (st >> 1) * 16 + swz / 64; C = (st & 1) * 32 + (swz % 64) / 2; }
__host__ __device__ __forceinline__ int perm32(int rho) { const int n = rho >> 4, i = rho & 15; return 8 * (i >> 2) + 4 * n + (i & 3); }

struct Unit { int pm, pn, pb; };
struct Gemm { const bf16_t* A; const bf16_t* Bt; int M, N, K, lda, ldb; };

struct StaticOrder {
    int nM, nN, nwg, G, c;
    __host__ __device__ void init(int M, int N, int G_, int c_) { nM = M / BM; nN = N / BM; nwg = nM * nN; G = G_; c = c_; }
    __host__ __device__ bool next(int i, Unit& u) const {
        const long L = (long)i * G + c; if (L >= nwg) return false;
        int wgid = (int)L; { const int q = nwg / NXCD, r = nwg % NXCD, xcd = wgid % NXCD, off = wgid / NXCD; wgid = (xcd < r ? xcd * (q + 1) : r * (q + 1) + (xcd - r) * q) + off; }
        const int nig = WGM * nN, gid = wgid / nig, fm = gid * WGM, gsz = (nM - fm) < WGM ? (nM - fm) : WGM;
        u.pm = fm + ((wgid % nig) % gsz); u.pn = (wgid % nig) / gsz; u.pb = u.pn; return true;
    }
    __device__ __forceinline__ void a_ready(const Unit&) const {}
    __device__ __forceinline__ void done(const Unit&) const {}
};

__device__ __forceinline__ unsigned cvt_pk_bf16(float lo, float hi) { unsigned r; asm volatile("s_nop 1\n\tv_cvt_pk_bf16_f32 %0, %1, %2\n\ts_nop 1" : "=v"(r) : "v"(lo), "v"(hi)); return r; }
template <class Epi, class Sched, bool ALIGN_EPI = false, bool SP2 = false>
__device__ __forceinline__ void gemm_phase(PG8_LAS unsigned char* lds, const Gemm g, const Sched& S, const Epi& E, const int g_wv) {
    int tid = TIDX; asm volatile("" : "+v"(tid)); const int wid = __builtin_amdgcn_readfirstlane(tid >> 6), lane = tid & 63, wr = wid >> 2, wc = wid & 3, fr = lane & 15, fq = lane >> 4;
    const int K = g.K, nt = K / BK;
    unsigned voffA[2], voffB[2];
#pragma unroll
    for (int i = 0; i < 2; ++i) { int R, C; stage_rc(tid * 16 + i * 8192, R, C); const int Rb = Epi::PERM ? ((R & ~31) + perm32(R & 31)) : R;
        voffA[i] = (unsigned)(R * K + C) * 2u; voffB[i] = (unsigned)(Rb * K + C) * 2u; }
    const size_t kstep = (size_t)(BK * 2);
    const size_t hstepA = (size_t)HALF * K * 2; const size_t hstepB = hstepA;
    const size_t tstepA = 2 * hstepA; const size_t tstepB = tstepA;
    const unsigned ldsw = (unsigned)wid * 1024u;
    const int aoff = lds_byte(wr * 64 + fr, fq * 8), boff = lds_byte(wc * 32 + fr, fq * 8);
#define PG8_SA(b, h) (((b) * 2 + (h)) * HTB)
#define PG8_SB(b, h) ((4 + (b) * 2 + (h)) * HTB)
#define PG8_STAGE(bufoff, gbase, voff) do { _Pragma("unroll") for (int _i = 0; _i < 2; ++_i) \
        __builtin_amdgcn_global_load_lds((const unsigned*)((const char*)(gbase) + (voff)[_i]), (PG8_LAS unsigned*)(lds + (bufoff) + ldsw + _i * 8192), 16, 0, 0); } while (0)
#define PG8_LDA(dst, b, h) do { _Pragma("unroll") for (int m = 0; m < 4; ++m) _Pragma("unroll") for (int k = 0; k < 2; ++k) dst[m][k] = *(const PG8_LAS bf16x8*)(lds + PG8_SA(b, h) + aoff + m * 2048 + k * 1024); } while (0)
#define PG8_LDB(dst, b, h) do { _Pragma("unroll") for (int n = 0; n < 2; ++n) _Pragma("unroll") for (int k = 0; k < 2; ++k) dst[n][k] = *(const PG8_LAS bf16x8*)(lds + PG8_SB(b, h) + boff + n * 2048 + k * 1024); } while (0)
#define PG8_MMA(ai, bj, At, Bt) do { __builtin_amdgcn_s_setprio(1); _Pragma("unroll") for (int m = 0; m < 4; ++m) _Pragma("unroll") for (int n = 0; n < 2; ++n) _Pragma("unroll") for (int k = 0; k < 2; ++k) \
        acc[ai][bj][m][n] = __builtin_amdgcn_mfma_f32_16x16x32_bf16(Bt[n][k], At[m][k], acc[ai][bj][m][n], 0, 0, 0); __builtin_amdgcn_s_setprio(0); } while (0)
#define PG8_WAIT_V(n) asm volatile("s_waitcnt vmcnt(" #n ")" ::: "memory")
#define PG8_WAIT_L(n) asm volatile("s_waitcnt lgkmcnt(" #n ")" ::: "memory")
#define PG8_BAR __builtin_amdgcn_s_barrier()
#define PG8_SCHED __builtin_amdgcn_sched_barrier(0)
    Unit cur, nxt; int ui = 0;
    if (!S.next(0, cur)) return;
    f32x4 acc[2][2][4][2];
#pragma unroll
    for (int a = 0; a < 2; ++a)
#pragma unroll
        for (int b = 0; b < 2; ++b)
#pragma unroll
            for (int m = 0; m < 4; ++m)
#pragma unroll
                for (int n = 0; n < 2; ++n) acc[a][b][m][n] = (f32x4){0.f, 0.f, 0.f, 0.f};
    bf16x8 At[4][2], B0[2][2], B1[2][2];
    const char* cA = (const char*)g.A + (size_t)cur.pm * tstepA; const char* cB = (const char*)g.Bt + (size_t)cur.pb * tstepB;
    S.a_ready(cur);
    if constexpr (SP2) {
        PG8_STAGE(PG8_SB(0, 0), cB, voffB); PG8_STAGE(PG8_SB(0, 1), cB + hstepB, voffB); PG8_STAGE(PG8_SA(0, 0), cA, voffA); PG8_STAGE(PG8_SA(0, 1), cA + hstepA, voffA);
        if (wr == 1) PG8_BAR;
        PG8_WAIT_V(2); PG8_BAR;
        PG8_STAGE(PG8_SB(1, 0), cB + kstep, voffB); PG8_STAGE(PG8_SA(1, 0), cA + kstep, voffA); PG8_STAGE(PG8_SB(1, 1), cB + hstepB + kstep, voffB);
        PG8_WAIT_V(6); PG8_BAR;
    } else {
        PG8_STAGE(PG8_SB(0, 0), cB, voffB); PG8_STAGE(PG8_SA(0, 0), cA, voffA); PG8_STAGE(PG8_SB(0, 1), cB + hstepB, voffB); PG8_STAGE(PG8_SA(0, 1), cA + hstepA, voffA);
        if (wr == 1) PG8_BAR;
        PG8_WAIT_V(4); PG8_BAR;
        PG8_STAGE(PG8_SB(1, 0), cB + kstep, voffB); PG8_STAGE(PG8_SA(1, 0), cA + kstep, voffA); PG8_STAGE(PG8_SB(1, 1), cB + hstepB + kstep, voffB);
        PG8_WAIT_V(6); PG8_BAR;
    }
    for (;;) {
        const bool has_next = S.next(ui + 1, nxt);
        const char* nA = has_next ? (const char*)g.A + (size_t)nxt.pm * tstepA : cA; const char* nB = has_next ? (const char*)g.Bt + (size_t)nxt.pb * tstepB : cB;
        for (int t = 0; t < nt; t += 2) {
            const bool last = (t == nt - 2);
            const char* a1 = cA + (size_t)(t + 1) * kstep;
            const char* a2 = last ? nA : cA + (size_t)(t + 2) * kstep; const char* b2 = last ? nB : cB + (size_t)(t + 2) * kstep;
            const char* a3 = a2 + kstep; const char* b3 = b2 + kstep;
            if (last && has_next) S.a_ready(nxt);
            if constexpr (SP2) {
            PG8_LDB(B0, 0, 0); PG8_LDB(B1, 0, 1); PG8_SCHED; PG8_LDA(At, 0, 0); PG8_STAGE(PG8_SA(1, 1), a1 + hstepA, voffA);
            PG8_WAIT_V(8); PG8_WAIT_L(0); PG8_BAR; PG8_MMA(0, 0, At, B0); PG8_MMA(0, 1, At, B1); PG8_BAR; PG8_SCHED;
            PG8_LDA(At, 0, 1); PG8_STAGE(PG8_SB(0, 0), b2, voffB); PG8_STAGE(PG8_SB(0, 1), b2 + hstepB, voffB); PG8_STAGE(PG8_SA(0, 0), a2, voffA);
            PG8_WAIT_V(8); PG8_WAIT_L(0); PG8_BAR; PG8_MMA(1, 0, At, B0); PG8_MMA(1, 1, At, B1); PG8_BAR; PG8_SCHED;
            PG8_LDB(B0, 1, 0); PG8_LDB(B1, 1, 1); PG8_SCHED; PG8_LDA(At, 1, 0); PG8_STAGE(PG8_SA(0, 1), a2 + hstepA, voffA);
            PG8_WAIT_V(8); PG8_WAIT_L(0); PG8_BAR; PG8_MMA(0, 0, At, B0); PG8_MMA(0, 1, At, B1); PG8_BAR; PG8_SCHED;
            PG8_LDA(At, 1, 1); PG8_STAGE(PG8_SB(1, 0), b3, voffB); PG8_STAGE(PG8_SB(1, 1), b3 + hstepB, voffB); PG8_STAGE(PG8_SA(1, 0), a3, voffA);
            PG8_WAIT_V(8); PG8_WAIT_L(0); PG8_BAR; PG8_MMA(1, 0, At, B0); PG8_MMA(1, 1, At, B1); PG8_BAR; PG8_SCHED;
            } else {
            PG8_LDB(B0, 0, 0); PG8_SCHED; PG8_LDA(At, 0, 0); PG8_STAGE(PG8_SA(1, 1), a1 + hstepA, voffA);
            PG8_WAIT_L(8); PG8_BAR; PG8_WAIT_L(0); PG8_MMA(0, 0, At, B0); PG8_BAR; PG8_SCHED;
            PG8_LDB(B1, 0, 1); PG8_STAGE(PG8_SB(0, 0), b2, voffB);
            PG8_BAR; PG8_WAIT_L(0); PG8_MMA(0, 1, At, B1); PG8_BAR;
            PG8_LDA(At, 0, 1); PG8_STAGE(PG8_SA(0, 0), a2, voffA);
            PG8_BAR; PG8_WAIT_L(0); PG8_MMA(1, 0, At, B0); PG8_BAR; PG8_SCHED;
            PG8_STAGE(PG8_SB(0, 1), b2 + hstepB, voffB);
            PG8_WAIT_V(6); PG8_BAR; PG8_MMA(1, 1, At, B1); PG8_BAR;
            PG8_LDB(B0, 1, 0); PG8_SCHED; PG8_LDA(At, 1, 0); PG8_STAGE(PG8_SA(0, 1), a2 + hstepA, voffA);
            PG8_WAIT_L(8); PG8_BAR; PG8_WAIT_L(0); PG8_MMA(0, 0, At, B0); PG8_BAR; PG8_SCHED;
            PG8_LDB(B1, 1, 1); PG8_STAGE(PG8_SB(1, 0), b3, voffB);
            PG8_BAR; PG8_WAIT_L(0); PG8_MMA(0, 1, At, B1); PG8_BAR;
            PG8_LDA(At, 1, 1); PG8_STAGE(PG8_SA(1, 0), a3, voffA);
            PG8_BAR; PG8_WAIT_L(0); PG8_MMA(1, 0, At, B0); PG8_BAR; PG8_SCHED;
            PG8_STAGE(PG8_SB(1, 1), b3 + hstepB, voffB);
            PG8_WAIT_V(6); PG8_BAR; PG8_MMA(1, 1, At, B1); PG8_BAR;
            }
        }
        if constexpr (ALIGN_EPI) { if (wr == 0) PG8_BAR; }
        if constexpr (!Epi::AFTER_DRAIN) { E(acc, cur, wr, wc, fr, fq); S.done(cur); }
        if (!has_next) break;
#pragma unroll
        for (int a = 0; a < 2; ++a)
#pragma unroll
            for (int b = 0; b < 2; ++b)
#pragma unroll
                for (int m = 0; m < 4; ++m)
#pragma unroll
                    for (int n = 0; n < 2; ++n) acc[a][b][m][n] = (f32x4){0.f, 0.f, 0.f, 0.f};
        cur = nxt; cA = nA; cB = nB; ++ui;
        if constexpr (ALIGN_EPI) { if (wr == 1) PG8_BAR; }
    }
    PG8_WAIT_V(0);
    if constexpr (!ALIGN_EPI) { if (wr == 0) PG8_BAR; }
    PG8_BAR;
    if constexpr (Epi::AFTER_DRAIN) { E.fused(acc, cur, wr, wc, fr, fq, lds, wid, lane); S.done(cur); }
#undef PG8_SA
#undef PG8_SB
#undef PG8_STAGE
#undef PG8_LDA
#undef PG8_LDB
#undef PG8_MMA
#undef PG8_WAIT_V
#undef PG8_WAIT_L
#undef PG8_BAR
#undef PG8_SCHED
}
}

using pg8::bf16_t; using pg8::bf16x8; using pg8::f32x4; using pg8::u32x4; using pg8::Unit; using pg8::cvt_pk_bf16;
typedef unsigned u32x2 __attribute__((ext_vector_type(2)));
typedef float f32x2 __attribute__((ext_vector_type(2)));
constexpr int T = 16384, SEQ = 4096, DM = 2048, DIN = 16200;
constexpr float EPS = 1e-6f, NEGV = -1e30f, LOG2E = 1.4426950408889634f;
constexpr float CA_SCALE = 0.12751743082459868f;
constexpr float CC_SCALE = 0.10411754627697264f;
constexpr int NTHR = 512;
constexpr int LDS_BYTES = 131072;

constexpr size_t MiB = 1ull << 20;
constexpr size_t WS_CS = 0;
constexpr size_t WS_SSQ = WS_CS + MiB;
constexpr size_t WS_SSKV = WS_SSQ + 65536;
constexpr size_t WS_GATES = WS_SSKV + 65536;
constexpr size_t WS_KM = WS_GATES + 524288;
constexpr size_t WS_BV = WS_KM + 131072;
constexpr size_t WS_LIV = WS_BV + 262144;
constexpr size_t WS_BLAST = WS_LIV + 262144;
constexpr size_t WS_GMAX = WS_BLAST + 4096;
constexpr size_t WS_MST = WS_GMAX + 4096;
constexpr size_t WS_NST = WS_MST + 4096;
constexpr size_t WS_W0 = WS_NST + 524288;
constexpr size_t WL_WIN = 0;
constexpr size_t WL_WB = WL_WIN + 64 * MiB;
constexpr size_t WL_WO = WL_WB + 12 * MiB;
constexpr size_t WL_WUQ = WL_WO + 8 * MiB;
constexpr size_t WL_WKN = WL_WUQ + 1536 * 1024;
constexpr size_t WL_WV = WL_WKN + 512 * 1024;
constexpr size_t WL_SIZE = WL_WV + 512 * 1024;
constexpr size_t WS_H = WS_W0 + 2 * WL_SIZE;
constexpr size_t WS_QA = WS_H + 64 * MiB;
constexpr size_t WS_KA = WS_QA + 32 * MiB;
constexpr size_t WS_VAT = WS_KA + 32 * MiB;
constexpr size_t WS_Z = WS_VAT + 32 * MiB;
constexpr size_t WS_QB = WS_Z + 96 * MiB;
constexpr size_t WS_KB = WS_QB + 16 * MiB;
constexpr size_t WS_VB = WS_KB + 16 * MiB;
constexpr size_t WS_OB = WS_VB + 32 * MiB;
constexpr size_t WS_Q2 = WS_OB + 32 * MiB;
constexpr size_t WS_K2 = WS_Q2 + 16 * MiB;
constexpr size_t WS_CST = WS_K2 + 16 * MiB;
constexpr size_t WS_CQ = WS_CST + 64 * MiB;
constexpr size_t WS_CKV = WS_CQ + 16 * MiB;
constexpr size_t WS_KR = WS_CKV + 8 * MiB;
constexpr size_t WS_QC = WS_KR + 2 * MiB;
constexpr size_t WS_KNC = WS_QC + 48 * MiB;
constexpr size_t WS_VCT = WS_KNC + 32 * MiB;
constexpr size_t WS_GT = WS_VCT + 32 * MiB;
constexpr size_t WS_SSP = WS_GT + 192 * MiB;
constexpr size_t WS_QAL = WS_SSP + MiB;
constexpr size_t WS_CTR = WS_QAL + 32 * MiB;
constexpr size_t WS_END = WS_CTR + 256;

struct Params {
    const float* x; const float* norm_gain; const float* w_in; const float* t5; const float* conv_w; const float* conv_b; const float* i_bias; const float* f_bias;
    const float* out_norm; const float* q_norm; const float* kv_norm; const float* w_uq; const float* w_ukv; const float* w_branch; const float* w_out; const float* final_norm;
    float* out; unsigned char* ws; int w_lo, w_hi;
};

__device__ __forceinline__ float bf2f(unsigned v16) { return __uint_as_float(v16 << 16); }
__device__ __forceinline__ float bflo(unsigned w) { return __uint_as_float(w << 16); }
__device__ __forceinline__ float bfhi(unsigned w) { return __uint_as_float(w & 0xffff0000u); }
__device__ __forceinline__ bf16_t f2bf(float f) { return (bf16_t)(cvt_pk_bf16(f, 0.f) & 0xffffu); }
__device__ __forceinline__ float fsigmoid(float v) { return __builtin_amdgcn_rcpf(1.0f + __expf(-v)); }
__device__ __forceinline__ float fsilu(float v) { return v * __builtin_amdgcn_rcpf(1.0f + __expf(-v)); }
__device__ __forceinline__ float fexp2(float v) { return __builtin_amdgcn_exp2f(v); }
__device__ __forceinline__ f32x4 zero4() { f32x4 z = (f32x4){0.f, 0.f, 0.f, 0.f}; asm volatile("" : "+v"(z)); return z; }
__device__ __forceinline__ f32x4 mfma16(bf16x8 a, bf16x8 b, f32x4 c) { return __builtin_amdgcn_mfma_f32_16x16x32_bf16(a, b, c, 0, 0, 0); }

struct EpiIn {
    static constexpr bool PERM = true, AFTER_DRAIN = false;
    unsigned char* ws;
    __device__ __forceinline__ void operator()(const f32x4 (&acc)[2][2][4][2], const Unit& u, int wr, int wc, int fr, int fq) const {
        const int pn = u.pn; const int row0 = u.pm * 256 + wr * 64 + fr;
        if (pn == 59) {
            const int cb = wc * 32 + 8 * fq;
            if (cb >= 72) return;
            float* gates = (float*)(ws + WS_GATES); bf16_t* kr = (bf16_t*)(ws + WS_KR); const f32x2* cs = (const f32x2*)(ws + WS_CS);
#pragma unroll
            for (int ai = 0; ai < 2; ++ai)
#pragma unroll
                for (int m = 0; m < 4; ++m) {
                    const int row = row0 + ai * 128 + m * 16; const f32x4 v0 = acc[ai][0][m][0], v1 = acc[ai][0][m][1];
                    if (cb == 0) { *(f32x4*)(gates + (size_t)row * 8) = v0; *(f32x4*)(gates + (size_t)row * 8 + 4) = v1; }
                    else {
                        const int j0 = (cb - 8) >> 1, pos = row & (SEQ - 1);
                        const f32x2 c0 = cs[pos * 32 + j0], c1 = cs[pos * 32 + j0 + 1], c2 = cs[pos * 32 + j0 + 2], c3 = cs[pos * 32 + j0 + 3];
                        u32x4 w;
                        w.x = cvt_pk_bf16(v0[0] * c0.x - v0[1] * c0.y, v0[0] * c0.y + v0[1] * c0.x);
                        w.y = cvt_pk_bf16(v0[2] * c1.x - v0[3] * c1.y, v0[2] * c1.y + v0[3] * c1.x);
                        w.z = cvt_pk_bf16(v1[0] * c2.x - v1[1] * c2.y, v1[0] * c2.y + v1[1] * c2.x);
                        w.w = cvt_pk_bf16(v1[2] * c3.x - v1[3] * c3.y, v1[2] * c3.y + v1[3] * c3.x);
                        *(u32x4*)(kr + (size_t)row * 64 + (cb - 8)) = w;
                    }
                }
            return;
        }
        size_t off; int ld, c0, act = 0, ssk = 0; float sc = 1.f;
        if (pn < 4) { off = WS_QA; ld = 1024; c0 = pn * 256; sc = CA_SCALE; }
        else if (pn < 8) { off = WS_KA; ld = 1024; c0 = (pn - 4) * 256; }
        else if (pn < 12) { off = WS_Z; ld = 1024; c0 = (pn - 8) * 256; act = 1; }
        else if (pn < 14) { off = WS_QB; ld = 512; c0 = (pn - 12) * 256; }
        else if (pn < 16) { off = WS_KB; ld = 512; c0 = (pn - 14) * 256; }
        else if (pn < 20) { off = WS_VB; ld = 1024; c0 = (pn - 16) * 256; }
        else if (pn < 24) { off = WS_OB; ld = 1024; c0 = (pn - 20) * 256; act = 2; }
        else if (pn < 28) { off = WS_Z + 32 * MiB; ld = 1024; c0 = (pn - 24) * 256; act = 1; }
        else if (pn < 30) { off = WS_CQ; ld = 512; c0 = (pn - 28) * 256; ssk = 1; }
        else if (pn < 31) { off = WS_CKV; ld = 256; c0 = 0; ssk = 2; }
        else if (pn < 35) { off = WS_Z + 64 * MiB; ld = 1024; c0 = (pn - 31) * 256; act = 1; }
        else { off = WS_GT; ld = 6144; c0 = (pn - 35) * 256; act = 2; }
        bf16_t* dst = (bf16_t*)(ws + off); float* ssp = (float*)(ws + WS_SSP) + (ssk == 2 ? 8 : (pn - 28) * 4) + wc;
        const int col0 = c0 + wc * 32 + 8 * fq;
#pragma unroll
        for (int ai = 0; ai < 2; ++ai)
#pragma unroll
            for (int m = 0; m < 4; ++m) {
                const int row = row0 + ai * 128 + m * 16; bf16_t* rowp = dst + (size_t)row * ld + col0; float ss = 0.f;
#pragma unroll
                for (int bj = 0; bj < 2; ++bj) {
                    f32x4 v0 = acc[ai][bj][m][0], v1 = acc[ai][bj][m][1];
                    if (act == 1) {
#pragma unroll
                        for (int i = 0; i < 4; ++i) { v0[i] = fsilu(v0[i]); v1[i] = fsilu(v1[i]); }
                    } else if (act == 2) {
#pragma unroll
                        for (int i = 0; i < 4; ++i) { v0[i] = fsigmoid(v0[i]); v1[i] = fsigmoid(v1[i]); }
                    } else { v0 = v0 * sc; v1 = v1 * sc; }
                    if (ssk) ss += (v0[0] * v0[0] + v0[1] * v0[1]) + (v0[2] * v0[2] + v0[3] * v0[3]) + (v1[0] * v1[0] + v1[1] * v1[1]) + (v1[2] * v1[2] + v1[3] * v1[3]);
                    u32x4 w; w.x = cvt_pk_bf16(v0[0], v0[1]); w.y = cvt_pk_bf16(v0[2], v0[3]); w.z = cvt_pk_bf16(v1[0], v1[1]); w.w = cvt_pk_bf16(v1[2], v1[3]);
                    *(u32x4*)(rowp + bj * 128) = w;
                    if (pn < 4) {
                        u32x4 wl; wl.x = cvt_pk_bf16(v0[0] - bflo(w.x), v0[1] - bfhi(w.x)); wl.y = cvt_pk_bf16(v0[2] - bflo(w.y), v0[3] - bfhi(w.y));
                        wl.z = cvt_pk_bf16(v1[0] - bflo(w.z), v1[1] - bfhi(w.z)); wl.w = cvt_pk_bf16(v1[2] - bflo(w.w), v1[3] - bfhi(w.w));
                        *(u32x4*)((bf16_t*)(ws + WS_QAL) + (size_t)row * 1024 + col0 + bj * 128) = wl; }
                }
                if (ssk) { const int ln = fq * 16 + fr; ss += shx(ss, 16, ln); ss += shx(ss, 32, ln); if (fq == 0) ssp[(size_t)row * 16] = ss; }
            }
    }
};

struct EpiVT {
    static constexpr bool PERM = true, AFTER_DRAIN = false;
    bf16_t* dst; int ld; const float* ss; float inv_n;
    __device__ __forceinline__ void operator()(const f32x4 (&acc)[2][2][4][2], const Unit& u, int wr, int wc, int fr, int fq) const {
        const int row0 = u.pm * 256 + wr * 64 + fr, col0 = u.pn * 256 + wc * 32 + 8 * fq;
        f32x4 s0[2], s1[2];
#pragma unroll
        for (int bj = 0; bj < 2; ++bj) {
            if (ss) { f32x4 a, b;
#pragma unroll
                for (int i = 0; i < 4; ++i) { const f32x4 pa = *(const f32x4*)(ss + (size_t)(col0 + bj * 128 + i) * 16 + 8), pb = *(const f32x4*)(ss + (size_t)(col0 + bj * 128 + 4 + i) * 16 + 8);
                    a[i] = rsqrtf(((pa[0] + pa[1]) + (pa[2] + pa[3])) * inv_n + EPS); b[i] = rsqrtf(((pb[0] + pb[1]) + (pb[2] + pb[3])) * inv_n + EPS); }
                s0[bj] = a; s1[bj] = b; }
            else { s0[bj] = (f32x4){1.f, 1.f, 1.f, 1.f}; s1[bj] = s0[bj]; }
        }
#pragma unroll
        for (int ai = 0; ai < 2; ++ai)
#pragma unroll
            for (int m = 0; m < 4; ++m) {
                bf16_t* rowp = dst + (size_t)(row0 + ai * 128 + m * 16) * ld + col0;
#pragma unroll
                for (int bj = 0; bj < 2; ++bj) {
                    const f32x4 v0 = acc[ai][bj][m][0] * s0[bj], v1 = acc[ai][bj][m][1] * s1[bj];
                    u32x4 w; w.x = cvt_pk_bf16(v0[0], v0[1]); w.y = cvt_pk_bf16(v0[2], v0[3]); w.z = cvt_pk_bf16(v1[0], v1[1]); w.w = cvt_pk_bf16(v1[2], v1[3]);
                    *(u32x4*)(rowp + bj * 128) = w;
                }
            }
    }
};

template <bool ROPE> struct EpiRow {
    static constexpr bool PERM = true, AFTER_DRAIN = false;
    bf16_t* dst; int ld; const float* ss; float inv_n, sc; const f32x2* cs;
    __device__ __forceinline__ void operator()(const f32x4 (&acc)[2][2][4][2], const Unit& u, int wr, int wc, int fr, int fq) const {
        const int row0 = u.pm * 256 + wr * 64 + fr, col0 = u.pn * 256 + wc * 32 + 8 * fq;
#pragma unroll
        for (int ai = 0; ai < 2; ++ai)
#pragma unroll
            for (int m = 0; m < 4; ++m) {
                const int row = row0 + ai * 128 + m * 16; float sq;
                if (ROPE) { const f32x4 pa = *(const f32x4*)(ss + (size_t)row * 16), pb = *(const f32x4*)(ss + (size_t)row * 16 + 4); sq = ((pa[0] + pa[1]) + (pa[2] + pa[3])) + ((pb[0] + pb[1]) + (pb[2] + pb[3])); }
                else { const f32x4 pa = *(const f32x4*)(ss + (size_t)row * 16 + 8); sq = (pa[0] + pa[1]) + (pa[2] + pa[3]); }
                const float rs = rsqrtf(sq * inv_n + EPS) * sc; bf16_t* rowp = dst + (size_t)row * ld + col0;
#pragma unroll
                for (int bj = 0; bj < 2; ++bj) {
                    f32x4 v0 = acc[ai][bj][m][0] * rs, v1 = acc[ai][bj][m][1] * rs; u32x4 w;
                    const int hc = (col0 + bj * 128) % 192;
                    if (ROPE && hc >= 128) {
                        const int j0 = (hc - 128) >> 1, pos = row & (SEQ - 1);
                        const f32x2 c0 = cs[pos * 32 + j0], c1 = cs[pos * 32 + j0 + 1], c2 = cs[pos * 32 + j0 + 2], c3 = cs[pos * 32 + j0 + 3];
                        w.x = cvt_pk_bf16(v0[0] * c0.x - v0[1] * c0.y, v0[0] * c0.y + v0[1] * c0.x);
                        w.y = cvt_pk_bf16(v0[2] * c1.x - v0[3] * c1.y, v0[2] * c1.y + v0[3] * c1.x);
                        w.z = cvt_pk_bf16(v1[0] * c2.x - v1[1] * c2.y, v1[0] * c2.y + v1[1] * c2.x);
                        w.w = cvt_pk_bf16(v1[2] * c3.x - v1[3] * c3.y, v1[2] * c3.y + v1[3] * c3.x);
                    } else { w.x = cvt_pk_bf16(v0[0], v0[1]); w.y = cvt_pk_bf16(v0[2], v0[3]); w.z = cvt_pk_bf16(v1[0], v1[1]); w.w = cvt_pk_bf16(v1[2], v1[3]); }
                    *(u32x4*)(rowp + bj * 128) = w;
                }
            }
    }
};

struct EpiMerge {
    static constexpr bool PERM = true, AFTER_DRAIN = false;
    bf16_t* merged; const bf16_t* gt;
    __device__ __forceinline__ void operator()(const f32x4 (&acc)[2][2][4][2], const Unit& u, int wr, int wc, int fr, int fq) const {
        const int n = u.pm >> 6, pmr = u.pm & 63; const int row0 = pmr * 256 + wr * 64 + fr, col0 = u.pn * 256 + wc * 32 + 8 * fq;
#pragma unroll
        for (int ai = 0; ai < 2; ++ai)
#pragma unroll
            for (int m = 0; m < 4; ++m) {
                const int row = row0 + ai * 128 + m * 16;
#pragma unroll
                for (int bj = 0; bj < 2; ++bj) {
                    const u32x4 gw = *(const u32x4*)(gt + (size_t)row * 6144 + n * 2048 + col0 + bj * 128);
                    bf16_t* mp = merged + (size_t)row * 2048 + col0 + bj * 128;
                    u32x4 pw = (u32x4){0u, 0u, 0u, 0u}; if (n > 0) pw = __builtin_nontemporal_load((const u32x4*)mp);
                    const f32x4 v0 = acc[ai][bj][m][0], v1 = acc[ai][bj][m][1]; u32x4 w;
                    w.x = cvt_pk_bf16(bflo(pw.x) + bflo(gw.x) * v0[0], bfhi(pw.x) + bfhi(gw.x) * v0[1]);
                    w.y = cvt_pk_bf16(bflo(pw.y) + bflo(gw.y) * v0[2], bfhi(pw.y) + bfhi(gw.y) * v0[3]);
                    w.z = cvt_pk_bf16(bflo(pw.z) + bflo(gw.z) * v1[0], bfhi(pw.z) + bfhi(gw.z) * v1[1]);
                    w.w = cvt_pk_bf16(bflo(pw.w) + bflo(gw.w) * v1[2], bfhi(pw.w) + bfhi(gw.w) * v1[3]);
                    *(u32x4*)mp = w;
                }
            }
        asm volatile("s_waitcnt vmcnt(0)" ::: "memory");
    }
};
struct MergeOrder {
    int G, c;
    __device__ bool next(int i, Unit& u) const {
        const int t3 = i / 3, n = i - 3 * t3; const long L = (long)t3 * G + c; if (L >= 512) return false;
        const int tm = (int)(L >> 3), tn = (int)(L & 7); u.pm = n * 64 + tm; u.pn = tn; u.pb = n * 8 + tn; return true;
    }
    __device__ __forceinline__ void a_ready(const Unit&) const {}
    __device__ __forceinline__ void done(const Unit&) const {}
};

struct EpiOut {
    static constexpr bool PERM = false, AFTER_DRAIN = false;
    const float* xin; float* xout;
    __device__ __forceinline__ void operator()(const f32x4 (&acc)[2][2][4][2], const Unit& u, int wr, int wc, int fr, int fq) const {
        const int row0 = u.pm * 256 + wr * 64 + fr, col0 = u.pn * 256 + wc * 32 + 4 * fq;
#pragma unroll
        for (int ai = 0; ai < 2; ++ai)
#pragma unroll
            for (int m = 0; m < 4; ++m) {
                const size_t ro = (size_t)(row0 + ai * 128 + m * 16) * DM + col0;
#pragma unroll
                for (int bj = 0; bj < 2; ++bj)
#pragma unroll
                    for (int n = 0; n < 2; ++n) { const f32x4 b = *(const f32x4*)(xin + ro + bj * 128 + n * 16); *(f32x4*)(xout + ro + bj * 128 + n * 16) = b + acc[ai][bj][m][n]; }
            }
    }
};

template <class F> __device__ __forceinline__ void tconv(unsigned char* lds, const float* src, int ldsrc, int K, bf16_t* dst, int N, const float* gain, F f, const int g_wv) {
    float* tile = (float*)lds; int tid = TIDX; asm volatile("" : "+v"(tid)); const int tilesK = K >> 6, ntile = tilesK * (N >> 8);
    const int nn4 = (tid & 63) * 4, kk0 = tid >> 6; f32x4 pre[8];
#define TCONV_LOAD(tt_) do { const int tn_ = (tt_) / tilesK, tk_ = (tt_) - tn_ * tilesK; const int c0 = f(tn_ * 256 + nn4), c1 = f(tn_ * 256 + nn4 + 1), c2 = f(tn_ * 256 + nn4 + 2), c3 = f(tn_ * 256 + nn4 + 3); \
        const bool vec = (c0 >= 0) && ((c0 & 3) == 0) && (c3 == c0 + 3); const float* sp = src + (size_t)(tk_ * 64 + kk0) * ldsrc; \
        _Pragma("unroll") for (int e = 0; e < 8; ++e) { const float* rp = sp + (size_t)(8 * e) * ldsrc; f32x4 v; \
            if (vec) v = *(const f32x4*)(rp + c0); \
            else { v[0] = c0 >= 0 ? rp[c0] : 0.f; v[1] = c1 >= 0 ? rp[c1] : 0.f; v[2] = c2 >= 0 ? rp[c2] : 0.f; v[3] = c3 >= 0 ? rp[c3] : 0.f; } \
            pre[e] = v; } } while (0)
    int t = blockIdx.x;
    if (t < ntile) TCONV_LOAD(t);
    for (; t < ntile; t += gridDim.x) {
        const int tn = t / tilesK, tk = t - tn * tilesK;
#pragma unroll
        for (int e = 0; e < 8; ++e) { f32x4 v = pre[e]; if (gain) v = v * gain[tk * 64 + kk0 + 8 * e]; *(f32x4*)(tile + (kk0 + 8 * e) * 260 + nn4) = v; }
        __syncthreads();
        { const int t2 = t + (int)gridDim.x; if (t2 < ntile) TCONV_LOAD(t2); }
        { const int nn = tid >> 1, kc = (tid & 1) * 32; bf16_t* dp = dst + (size_t)(tn * 256 + nn) * K + tk * 64 + kc;
#pragma unroll
          for (int q4 = 0; q4 < 4; ++q4) { float v[8];
#pragma unroll
              for (int i = 0; i < 8; ++i) v[i] = tile[(kc + q4 * 8 + i) * 260 + nn];
              u32x4 w; w.x = cvt_pk_bf16(v[0], v[1]); w.y = cvt_pk_bf16(v[2], v[3]); w.z = cvt_pk_bf16(v[4], v[5]); w.w = cvt_pk_bf16(v[6], v[7]);
              *(u32x4*)(dp + q4 * 8) = w; } }
        __syncthreads();
    }
#undef TCONV_LOAD
}
__device__ __forceinline__ int win_src_col(int n) {
    if (n < 1024) return n;
    if (n < 2048) return 1024 + (n - 1024);
    if (n < 3072) return 3072 + (n - 2048);
    if (n < 3584) return 4096 + (n - 3072);
    if (n < 4096) return 4608 + (n - 3584);
    if (n < 5120) return 5120 + (n - 4096);
    if (n < 6144) return 6152 + (n - 5120);
    if (n < 7168) return 7176 + (n - 6144);
    if (n < 7680) return 8200 + (n - 7168);
    if (n < 7936) return 8712 + (n - 7680);
    if (n < 8960) return 9032 + (n - 7936);
    if (n < 15104) return 10056 + (n - 8960);
    if (n < 15360) { const int r = n - 15104; if (r < 4) return 6144 + r; if (r < 8) return 6148 + (r - 4); if (r < 72) { const int j = (r - 8) >> 1, odd = (r - 8) & 1; return 8968 + j + 32 * odd; } return -1; }
    return 2048 + (n - 15360);
}
__device__ __forceinline__ void convert_weights(unsigned char* lds, const Params& p, int l, const int g_wv) {
    unsigned char* wl = p.ws + WS_W0 + (size_t)l * WL_SIZE;
    tconv(lds, p.w_in + (size_t)l * DM * DIN, DIN, DM, (bf16_t*)(wl + WL_WIN), 16384, nullptr, [](int n) { return win_src_col(n); }, g_wv);
#pragma unroll 1
    for (int n = 0; n < 3; ++n)
        tconv(lds, p.w_branch + ((size_t)l * 3 + n) * 1024 * DM, DM, 1024, (bf16_t*)(wl + WL_WB) + (size_t)n * 2048 * 1024, 2048, nullptr, [](int c) { return c; }, g_wv);
    tconv(lds, p.w_out + (size_t)l * DM * DM, DM, DM, (bf16_t*)(wl + WL_WO), DM, nullptr, [](int c) { return c; }, g_wv);
    tconv(lds, p.w_uq + (size_t)l * 512 * 1536, 1536, 512, (bf16_t*)(wl + WL_WUQ), 1536, p.q_norm + l * 512,
          [](int n) { const int h = n / 192, hc = n - h * 192; if (hc < 128) return n; const int r = hc - 128; return h * 192 + 128 + (r >> 1) + 32 * (r & 1); }, g_wv);
    tconv(lds, p.w_ukv + (size_t)l * 256 * 2048, 2048, 256, (bf16_t*)(wl + WL_WKN), 1024, p.kv_norm + l * 256, [](int n) { return (n >> 7) * 256 + (n & 127); }, g_wv);
    tconv(lds, p.w_ukv + (size_t)l * 256 * 2048, 2048, 256, (bf16_t*)(wl + WL_WV), 1024, p.kv_norm + l * 256, [](int n) { return (n >> 7) * 256 + 128 + (n & 127); }, g_wv);
}
__device__ __forceinline__ void sincos_acc(float ang, float& s, float& c) {
    const double x = (double)ang; const double q = rint(x * 0.63661977236758134308);
    double r = fma(-q, 1.57079632679489655800e+00, x); r = fma(-q, 6.12323399573676603587e-17, r);
    const int qi = ((int)q) & 3; const double r2 = r * r;
    const double sp = r + r * r2 * (-1.66666666666666324348e-01 + r2 * (8.33333333332248946124e-03 + r2 * (-1.98412698298579493134e-04 + r2 * (2.75573137070700676789e-06 + r2 * (-2.50507602534068634195e-08 + r2 * 1.58969099521155010221e-10)))));
    const double cp = 1.0 - 0.5 * r2 + r2 * r2 * (4.16666666666666019037e-02 + r2 * (-1.38888888888741095749e-03 + r2 * (2.48015872894767294178e-05 + r2 * (-2.75573143513906633035e-07 + r2 * (2.08757232129817482790e-09 + r2 * -1.13596475577881948265e-11)))));
    double ss, cc; if (qi == 0) { ss = sp; cc = cp; } else if (qi == 1) { ss = cp; cc = -sp; } else if (qi == 2) { ss = -sp; cc = -cp; } else { ss = -cp; cc = sp; }
    s = (float)ss; c = (float)cc;
}
__device__ __forceinline__ void build_cs(const Params& p, const int g_wv) {
    f32x2* cs = (f32x2*)(p.ws + WS_CS);
    int i0 = blockIdx.x * NTHR + TIDX; asm volatile("" : "+v"(i0));
    for (int i = i0; i < SEQ * 32; i += gridDim.x * NTHR) {
        const int pos = i >> 5, j = i & 31; double inv = 1.0; for (int k = 0; k < j; ++k) inv *= 0.7498942093324558;
        const float ang = (float)pos * (float)inv; float s, c; sincos_acc(ang, s, c); cs[i] = (f32x2){c, s};
    }
}
__device__ __forceinline__ void zero_ss(const Params& p, const int g_wv) {
    float* a = (float*)(p.ws + WS_SSQ);
    int i0 = blockIdx.x * NTHR + TIDX; asm volatile("" : "+v"(i0));
    for (int i = i0; i < 2 * T; i += gridDim.x * NTHR) a[i] = 0.f;
}
template <bool OUTBF> __device__ __forceinline__ void rmsnorm_rows(const float* x, const float* gain, bf16_t* hb, float* of, const int g_wv) {
    int tid = TIDX; asm volatile("" : "+v"(tid)); const int lane = tid & 63, gw = blockIdx.x * (NTHR / 64) + (tid >> 6), nw = gridDim.x * (NTHR / 64);
    for (int row = gw; row < T; row += nw) {
        const float* xr = x + (size_t)row * DM; f32x4 v[8]; float ss = 0.f;
#pragma unroll
        for (int i = 0; i < 8; ++i) { v[i] = *(const f32x4*)(xr + i * 256 + lane * 4); ss += (v[i][0] * v[i][0] + v[i][1] * v[i][1]) + (v[i][2] * v[i][2] + v[i][3] * v[i][3]); }
#pragma unroll
        for (int o = 1; o < 64; o <<= 1) ss += shx(ss, o, lane);
        const float rs = rsqrtf(ss * (1.0f / DM) + EPS);
#pragma unroll
        for (int i = 0; i < 8; ++i) {
            const f32x4 gn = *(const f32x4*)(gain + i * 256 + lane * 4); const f32x4 y = v[i] * rs * gn;
            if (OUTBF) { u32x2 w; w.x = cvt_pk_bf16(y[0], y[1]); w.y = cvt_pk_bf16(y[2], y[3]); *(u32x2*)(hb + (size_t)row * DM + i * 256 + lane * 4) = w; }
            else *(f32x4*)(of + (size_t)row * DM + i * 256 + lane * 4) = y;
        }
    }
}

__device__ __forceinline__ void kmean_phase(const Params& p, int l, const int g_wv) {
    const bf16_t* ka = (const bf16_t*)(p.ws + WS_KA); bf16_t* km = (bf16_t*)(p.ws + WS_KM); bf16_t* kml = (bf16_t*)(p.ws + WS_SSQ); int tid = TIDX; asm volatile("" : "+v"(tid));
    for (int u = (gridDim.x == 256) ? (int)blockIdx.x - 192 : (int)blockIdx.x; u < 64; u += gridDim.x) { if (u < 0) continue;
        const int b = u >> 4, j = u & 15; const unsigned* src = (const unsigned*)(ka + ((size_t)b * SEQ + j * 256) * 1024) + tid; float a0 = 0.f, a1 = 0.f;
#pragma unroll 8
        for (int r = 0; r < 256; ++r) { const unsigned w = src[(size_t)r * 512]; a0 += bflo(w); a1 += bfhi(w); }
        const int col = tid * 2, h = col >> 7, d = col & 127;
        const float m0 = a0 * (1.0f / 256.0f), m1 = a1 * (1.0f / 256.0f); const unsigned hi = cvt_pk_bf16(m0, m1);
        *(unsigned*)(km + ((size_t)((b * 8 + h) * 16 + j)) * 128 + d) = hi;
        *(unsigned*)(kml + ((size_t)((b * 8 + h) * 16 + j)) * 128 + d) = cvt_pk_bf16(m0 - bflo(hi), m1 - bfhi(hi));
    }
}

template <int MODE> __device__ __forceinline__ void attn_phase(unsigned char* lds, const Params& p, int l, const int g_wv) {
    constexpr int DQK = MODE ? 192 : 128, NC = DQK / 32, NCH = DQK / 8, KRS = DQK * 2 + 32, KBUF = 64 * KRS, VRS = 144, VBUF = 128 * VRS;
    constexpr int OFF_V = 2 * KBUF, OFF_LUT = OFF_V + 2 * VBUF, OFF_KM = OFF_LUT + 512, NKL = (64 * NCH) / NTHR;
    int tid = TIDX; asm volatile("" : "+v"(tid)); const int lane = tid & 63, w = tid >> 6, lr = lane & 15, g = lane >> 4; const int G = gridDim.x, c = blockIdx.x;
    unsigned char* ws = p.ws;
    const bf16_t* Qp = (const bf16_t*)(ws + (MODE ? WS_QC : WS_QA)); constexpr int LDQ = MODE ? 1536 : 1024;
    const bf16_t* Kp = (const bf16_t*)(ws + (MODE ? WS_KNC : WS_KA)); const bf16_t* KRp = (const bf16_t*)(ws + WS_KR);
    const bf16_t* VTp = (const bf16_t*)(ws + (MODE ? WS_VCT : WS_VAT)); bf16_t* Zp = (bf16_t*)(ws + WS_Z + (MODE ? 64 * MiB : 0));
    float* lut = (float*)(lds + OFF_LUT);
    for (int rd = 0; rd * G < 512; ++rd) {
        int qblk, bh;
        if (G == 256) {
            const int xq = c & 7, iq = c >> 3, qq = iq >> 1;
            bh = 2 * xq + (iq & 1) + 16 * rd; qblk = rd ? qq : 15 - qq;
        } else { const int idx = rd * G + ((rd & 1) ? (G - 1 - c) : c); if (idx >= 512) continue; qblk = 15 - (idx >> 5); bh = idx & 31; }
        const int b = bh >> 3, h = bh & 7;
        const int q0 = qblk * 256 + w * 32; const size_t tq = (size_t)b * SEQ + q0; const int nt = (qblk + 1) * 4;
        bf16x8 qf[2][NC];
#pragma unroll
        for (int qb = 0; qb < 2; ++qb)
#pragma unroll
            for (int c2 = 0; c2 < NC; ++c2) qf[qb][c2] = *(const bf16x8*)(Qp + (tq + qb * 16 + lr) * LDQ + h * DQK + c2 * 32 + g * 8);
        u32x4 kreg[NKL];
#define ATT_LOADK(t_) do { const int t__ = (t_); \
        _Pragma("unroll") for (int i = 0; i < NKL; ++i) { const int id = tid + NTHR * i; const int key = id / NCH, ch = id - key * NCH; const size_t tk = (size_t)b * SEQ + t__ * 64 + key; \
            const bf16_t* s_ = (!MODE || ch < 16) ? (Kp + tk * 1024 + h * 128 + ch * 8) : (KRp + tk * 64 + (ch - 16) * 8); kreg[i] = *(const u32x4*)s_; } } while (0)
#define ATT_LOADV(t_) do { const int t__ = (t_); \
        _Pragma("unroll") for (int i = 0; i < 2; ++i) { const int id = tid + NTHR * i; const int row = id >> 3, ch = id & 7; \
            kreg[i] = *(const u32x4*)(VTp + (size_t)(h * 128 + row) * T + (size_t)b * SEQ + t__ * 64 + ch * 8); } } while (0)
#define ATT_STOREK(buf_) do { unsigned char* kb_ = lds + (buf_) * KBUF; \
        _Pragma("unroll") for (int i = 0; i < NKL; ++i) { const int id = tid + NTHR * i; const int key = id / NCH, ch = id - key * NCH; *(u32x4*)(kb_ + key * KRS + ch * 16) = kreg[i]; } } while (0)
#define ATT_STOREV(buf_) do { unsigned char* vb_ = lds + OFF_V + (buf_) * VBUF; \
        _Pragma("unroll") for (int i = 0; i < 2; ++i) { const int id = tid + NTHR * i; const int row = id >> 3, ch = id & 7; *(u32x4*)(vb_ + row * VRS + ch * 16) = kreg[i]; } } while (0)
        ATT_LOADK(0); ATT_STOREK(0); ATT_LOADV(0);
        unsigned sel[2] = {0u, 0u};
        if (MODE == 0) {
            if (tid < 128) { const int d = tid; int bk = d; if (d >= 16) { bk = 16 + (int)(logf((float)d * (1.0f / 16.0f)) / 2.0794415416798357f * 16.0f); bk = bk > 31 ? 31 : bk; } lut[d] = p.t5[bk * 8 + h] * LOG2E; }
            { const int half = tid >> 8, row = (tid >> 4) & 15, ch = tid & 15; *(u32x4*)(lds + OFF_KM + half * 4608 + row * 288 + ch * 16) = *(const u32x4*)((const bf16_t*)(ws + (half ? WS_SSQ : WS_KM)) + ((size_t)((b * 8 + h) * 16 + row)) * 128 + ch * 8); }
        }
        ATT_STOREV(0);
        __syncthreads();
        if (MODE == 0) {
            f32x4 ga[2] = {zero4(), zero4()};
#pragma unroll
            for (int c2 = 0; c2 < NC; ++c2) { const bf16x8 kf = *(const bf16x8*)(lds + OFF_KM + lr * 288 + c2 * 64 + g * 16), kfl = *(const bf16x8*)(lds + OFF_KM + 4608 + lr * 288 + c2 * 64 + g * 16);
#pragma unroll
                for (int qb = 0; qb < 2; ++qb) { const bf16x8 ql = *(const bf16x8*)((const bf16_t*)(ws + WS_QAL) + (tq + qb * 16 + lr) * 1024 + h * 128 + c2 * 32 + g * 8);
                    ga[qb] = mfma16(kfl, qf[qb][c2], ga[qb]); ga[qb] = mfma16(kf, ql, ga[qb]); ga[qb] = mfma16(kf, qf[qb][c2], ga[qb]); } }
#pragma unroll
            for (int qb = 0; qb < 2; ++qb) {
                float gv[4];
#pragma unroll
                for (int r = 0; r < 4; ++r) gv[r] = (g * 4 + r < qblk) ? ga[qb][r] : -INFINITY;
                unsigned s = 0u;
#pragma unroll
                for (int it = 0; it < 3; ++it) {
                    float bv = -INFINITY; int bi = 99;
#pragma unroll
                    for (int r = 0; r < 4; ++r) if (gv[r] > bv) { bv = gv[r]; bi = g * 4 + r; }
#pragma unroll
                    for (int o = 16; o <= 32; o <<= 1) { const float ov = shx(bv, o, lane); const int oi = shxi(bi, o, lane); if (ov > bv || (ov == bv && oi < bi)) { bv = ov; bi = oi; } }
                    if (bv > -INFINITY) s |= 1u << bi;
#pragma unroll
                    for (int r = 0; r < 4; ++r) if (g * 4 + r == bi) gv[r] = -INFINITY;
                }
                sel[qb] = s;
            }
        }
        f32x4 oacc[8][2];
#pragma unroll
        for (int i = 0; i < 8; ++i) { oacc[i][0] = zero4(); oacc[i][1] = zero4(); }
        float mrow[2] = {NEGV, NEGV}, lrow[2] = {0.f, 0.f};
        for (int t = 0; t < nt; ++t) {
            const int buf = t & 1; const bool more = (t + 1 < nt);
            if (more) ATT_LOADK(t + 1);
            const int k0 = t * 64;
            const unsigned char* kb_ = lds + buf * KBUF; const unsigned char* vb_ = lds + OFF_V + buf * VBUF;
#pragma unroll 1
            for (int hf = 0; hf < 2; ++hf) {
              const int kh = k0 + hf * 32;
              if (kh <= q0 + 31) {
                f32x4 sacc[2][2];
#pragma unroll
                for (int kb = 0; kb < 2; ++kb) { sacc[kb][0] = zero4(); sacc[kb][1] = zero4(); }
#pragma unroll
                for (int c2 = 0; c2 < NC; ++c2)
#pragma unroll
                    for (int kb = 0; kb < 2; ++kb) { const bf16x8 kf = *(const bf16x8*)(kb_ + (hf * 32 + kb * 16 + lr) * KRS + c2 * 64 + g * 16);
                        sacc[kb][0] = mfma16(kf, qf[0][c2], sacc[kb][0]); sacc[kb][1] = mfma16(kf, qf[1][c2], sacc[kb][1]); }
                if (MODE == 0) {
                    const int jblk = t >> 2; const bool far = (kh + 31 + 127 <= q0);
                    if (far) { const float bfar = lut[127];
#pragma unroll
                        for (int qb = 0; qb < 2; ++qb) { const bool al = (jblk < qblk) ? (((sel[qb] >> jblk) & 1u) != 0u) : true;
#pragma unroll
                            for (int kb = 0; kb < 2; ++kb)
#pragma unroll
                                for (int r = 0; r < 4; ++r) sacc[kb][qb][r] = al ? sacc[kb][qb][r] + bfar : NEGV; }
                    } else {
#pragma unroll
                        for (int qb = 0; qb < 2; ++qb) { const int qpos = q0 + qb * 16 + lr; const bool alp = (sel[qb] >> jblk) & 1u;
#pragma unroll
                            for (int kb = 0; kb < 2; ++kb)
#pragma unroll
                                for (int r = 0; r < 4; ++r) { const int d = qpos - (kh + kb * 16 + g * 4 + r); const int di = d < 0 ? 0 : (d > 127 ? 127 : d);
                                    const bool al = (jblk < qblk) ? alp : (d >= 0); sacc[kb][qb][r] = al ? sacc[kb][qb][r] + lut[di] : NEGV; } }
                    }
                } else {
                    if (kh + 31 > q0) {
#pragma unroll
                        for (int qb = 0; qb < 2; ++qb) { const int qpos = q0 + qb * 16 + lr;
#pragma unroll
                            for (int kb = 0; kb < 2; ++kb)
#pragma unroll
                                for (int r = 0; r < 4; ++r) if (kh + kb * 16 + g * 4 + r > qpos) sacc[kb][qb][r] = NEGV; }
                    }
                }
                bf16x8 pf[2];
#pragma unroll
                for (int qb = 0; qb < 2; ++qb) {
                    float mx = NEGV;
#pragma unroll
                    for (int kb = 0; kb < 2; ++kb)
#pragma unroll
                        for (int r = 0; r < 4; ++r) mx = fmaxf(mx, sacc[kb][qb][r]);
                    mx = fmaxf(mx, shx(mx, 16, lane)); mx = fmaxf(mx, shx(mx, 32, lane));
                    float mnew = mrow[qb];
                    if (__builtin_amdgcn_ballot_w64(mx > mrow[qb] + 8.0f) != 0ull) {
                        mnew = fmaxf(mrow[qb], mx); const float alpha = fexp2(mrow[qb] - mnew); mrow[qb] = mnew; lrow[qb] *= alpha;
#pragma unroll
                        for (int i = 0; i < 8; ++i) oacc[i][qb] = oacc[i][qb] * alpha;
                    }
                    float ps = 0.f;
#pragma unroll
                    for (int kb = 0; kb < 2; ++kb)
#pragma unroll
                        for (int r = 0; r < 4; ++r) { const float e = fexp2(sacc[kb][qb][r] - mnew); sacc[kb][qb][r] = e; ps += e; }
                    lrow[qb] += ps;
                    union { u32x4 u; bf16x8 v; } cvt;
                    cvt.u.x = cvt_pk_bf16(sacc[0][qb][0], sacc[0][qb][1]); cvt.u.y = cvt_pk_bf16(sacc[0][qb][2], sacc[0][qb][3]);
                    cvt.u.z = cvt_pk_bf16(sacc[1][qb][0], sacc[1][qb][1]); cvt.u.w = cvt_pk_bf16(sacc[1][qb][2], sacc[1][qb][3]); pf[qb] = cvt.v;
                }
#pragma unroll
                for (int dvb = 0; dvb < 8; ++dvb) { union { u32x2 u[2]; bf16x8 v; } vf; const unsigned char* vp = vb_ + (dvb * 16 + lr) * VRS + (hf * 32 + g * 4) * 2;
                    vf.u[0] = *(const u32x2*)vp; vf.u[1] = *(const u32x2*)(vp + 32);
                    oacc[dvb][0] = mfma16(vf.v, pf[0], oacc[dvb][0]); oacc[dvb][1] = mfma16(vf.v, pf[1], oacc[dvb][1]); }
              }
              if (more) { if (hf == 0) { ATT_STOREK(buf ^ 1); ATT_LOADV(t + 1); } else { ATT_STOREV(buf ^ 1); } }
            }
            __syncthreads();
        }
#pragma unroll
        for (int qb = 0; qb < 2; ++qb) {
            float l = lrow[qb]; l += shx(l, 16, lane); l += shx(l, 32, lane); const float inv = 1.0f / l;
            bf16_t* zr = Zp + (tq + qb * 16 + lr) * 1024 + h * 128 + g * 4;
#pragma unroll
            for (int dvb = 0; dvb < 8; ++dvb) { const u32x2 zw = *(const u32x2*)(zr + dvb * 16); const f32x4 o = oacc[dvb][qb] * inv; u32x2 ow;
                ow.x = cvt_pk_bf16(o[0] * bflo(zw.x), o[1] * bfhi(zw.x)); ow.y = cvt_pk_bf16(o[2] * bflo(zw.y), o[3] * bfhi(zw.y)); *(u32x2*)(zr + dvb * 16) = ow; }
        }
#undef ATT_LOADK
#undef ATT_LOADV
#undef ATT_STOREK
#undef ATT_STOREV
    }
}

__device__ __forceinline__ void mlstm_a(unsigned char* lds, const Params& p, int l, const int g_wv) {
    constexpr int K2RS = 272, TRS = 160; constexpr int OFF_K2 = 0, OFF_WKT = 64 * K2RS, OFF_VT = OFF_WKT + 128 * TRS, OFF_WG = OFF_VT + 256 * TRS;
    unsigned char* ws = p.ws; int tid = TIDX; asm volatile("" : "+v"(tid)); const int lane = tid & 63, w = tid >> 6, lr = lane & 15, g = lane >> 4;
    const bf16_t* QB = (const bf16_t*)(ws + WS_QB); const bf16_t* KB = (const bf16_t*)(ws + WS_KB); const bf16_t* VB = (const bf16_t*)(ws + WS_VB);
    bf16_t* Q2 = (bf16_t*)(ws + WS_Q2); bf16_t* K2 = (bf16_t*)(ws + WS_K2); const float* gates = (const float*)(ws + WS_GATES);
    const float* cw = p.conv_w + (size_t)l * 4 * 1024; const float* cb = p.conv_b + (size_t)l * 1024;
    float* wg = (float*)(lds + OFF_WG);
    for (int ku = 0; ; ++ku) { int u; { const int cb_ = blockIdx.x; if (gridDim.x == 256) { if (ku >= (cb_ < 128 ? 3 : 5)) break; u = cb_ < 128 ? cb_ + 128 * ku : 384 + (cb_ - 128) + 128 * ku; } else { u = cb_ + ku * (int)gridDim.x; if (u >= 1024) break; } }
        const int bh = u >> 6, c = u & 63, b = bh >> 2, h = bh & 3; const size_t t0 = (size_t)b * SEQ + c * 64;
#pragma unroll 1
        for (int it = 0; it < 4; ++it) {
            const int item = tid + NTHR * it, which = item >> 10, s = (item >> 4) & 63, grp = item & 15; const int ch0 = h * 128 + grp * 8, cc0 = which * 512 + ch0;
            const bf16_t* src = which ? KB : QB; float a[8];
            { const f32x4 b0 = *(const f32x4*)(cb + cc0), b1 = *(const f32x4*)(cb + cc0 + 4); a[0] = b0[0]; a[1] = b0[1]; a[2] = b0[2]; a[3] = b0[3]; a[4] = b1[0]; a[5] = b1[1]; a[6] = b1[2]; a[7] = b1[3]; }
#pragma unroll
            for (int j = 0; j < 4; ++j) { const int tp = c * 64 + s - 3 + j;
                if (tp >= 0) { const u32x4 xw = *(const u32x4*)(src + ((size_t)b * SEQ + tp) * 512 + ch0); const f32x4 w0 = *(const f32x4*)(cw + j * 1024 + cc0), w1 = *(const f32x4*)(cw + j * 1024 + cc0 + 4);
                    a[0] += bflo(xw.x) * w0[0]; a[1] += bfhi(xw.x) * w0[1]; a[2] += bflo(xw.y) * w0[2]; a[3] += bfhi(xw.y) * w0[3];
                    a[4] += bflo(xw.z) * w1[0]; a[5] += bfhi(xw.z) * w1[1]; a[6] += bflo(xw.w) * w1[2]; a[7] += bfhi(xw.w) * w1[3]; } }
            const float ksc = which ? 0.08838834764831845f : 1.0f;
#pragma unroll
            for (int i = 0; i < 8; ++i) a[i] = fsilu(a[i]) * ksc;
            u32x4 ow; ow.x = cvt_pk_bf16(a[0], a[1]); ow.y = cvt_pk_bf16(a[2], a[3]); ow.z = cvt_pk_bf16(a[4], a[5]); ow.w = cvt_pk_bf16(a[6], a[7]);
            *(u32x4*)((which ? K2 : Q2) + (t0 + s) * 512 + ch0) = ow;
            if (which) *(u32x4*)(lds + OFF_K2 + s * K2RS + grp * 16) = ow;
        }
        if (w == 0) {
            const float fpre = gates[(t0 + lane) * 8 + 4 + h] + p.f_bias[l * 4 + h]; const float li = gates[(t0 + lane) * 8 + h] + p.i_bias[l * 4 + h];
            const float lf = fminf(fpre, 0.f) - log1pf(__expf(-fabsf(fpre)));
            float bc = lf;
#pragma unroll
            for (int o = 1; o < 64; o <<= 1) { const float v = shup(bc, o, lane); if (lane >= o) bc += v; }
            const float blast = __int_as_float(__builtin_amdgcn_readlane(__float_as_int(bc), 63)); const float gg = blast - bc + li; float gm = gg;
#pragma unroll
            for (int o = 1; o < 64; o <<= 1) gm = fmaxf(gm, shx(gm, o, lane));
            wg[lane] = __expf(gg - gm);
            ((float*)(ws + WS_BV))[(size_t)u * 64 + lane] = bc; ((float*)(ws + WS_LIV))[(size_t)u * 64 + lane] = li;
            if (lane == 0) { ((float*)(ws + WS_BLAST))[u] = blast; ((float*)(ws + WS_GMAX))[u] = gm; }
        }
#pragma unroll
        for (int it = 0; it < 4; ++it) { const int item = tid + NTHR * it, s = item & 63, eg = item >> 6; const u32x4 vw = *(const u32x4*)(VB + (t0 + s) * 1024 + h * 256 + eg * 8);
            bf16_t* d = (bf16_t*)(lds + OFF_VT + (eg * 8) * TRS + s * 2); const unsigned vv[4] = {vw.x, vw.y, vw.z, vw.w};
#pragma unroll
            for (int i = 0; i < 4; ++i) { *(bf16_t*)((unsigned char*)d + (2 * i) * TRS) = (bf16_t)(vv[i] & 0xffffu); *(bf16_t*)((unsigned char*)d + (2 * i + 1) * TRS) = (bf16_t)(vv[i] >> 16); } }
        __syncthreads();
#pragma unroll 1
        for (int it = 0; it < 2; ++it) { const int item = tid + NTHR * it, s = item & 63, dg = item >> 6; const u32x4 kw = *(const u32x4*)(lds + OFF_K2 + s * K2RS + dg * 16); const float ww = wg[s];
            const unsigned kv[4] = {kw.x, kw.y, kw.z, kw.w}; unsigned char* d = lds + OFF_WKT + (dg * 8) * TRS + s * 2;
#pragma unroll
            for (int i = 0; i < 4; ++i) { *(bf16_t*)(d + (2 * i) * TRS) = f2bf(bflo(kv[i]) * ww); *(bf16_t*)(d + (2 * i + 1) * TRS) = f2bf(bfhi(kv[i]) * ww); } }
        __syncthreads();
#if defined(MK_DEBUG_HASH)
        { unsigned char* dbg = ws + WS_END + MiB + (size_t)u * 40960; for (int i = tid; i < 2560; i += NTHR) *(u32x4*)(dbg + i * 16) = *(const u32x4*)(lds + OFF_VT + i * 16); }
#endif
        if (tid < 128) { float a = 0.f; const unsigned char* r = lds + OFF_WKT + tid * TRS;
#pragma unroll
            for (int i = 0; i < 8; ++i) { const u32x4 x = *(const u32x4*)(r + i * 16); a += (bflo(x.x) + bfhi(x.x)) + (bflo(x.y) + bfhi(x.y)) + (bflo(x.z) + bfhi(x.z)) + (bflo(x.w) + bfhi(x.w)); }
            ((float*)(ws + WS_NST))[(size_t)u * 128 + tid] = a; }
        f32x4 acc[8][2];
#pragma unroll
        for (int i = 0; i < 8; ++i) { acc[i][0] = zero4(); acc[i][1] = zero4(); }
#pragma unroll
        for (int kc = 0; kc < 2; ++kc) {
            const bf16x8 v0 = *(const bf16x8*)(lds + OFF_VT + (w * 32 + lr) * TRS + kc * 64 + g * 16), v1 = *(const bf16x8*)(lds + OFF_VT + (w * 32 + 16 + lr) * TRS + kc * 64 + g * 16);
#pragma unroll
            for (int db = 0; db < 8; ++db) { const bf16x8 kf = *(const bf16x8*)(lds + OFF_WKT + (db * 16 + lr) * TRS + kc * 64 + g * 16); acc[db][0] = mfma16(kf, v0, acc[db][0]); acc[db][1] = mfma16(kf, v1, acc[db][1]); }
        }
        bf16_t* cst = (bf16_t*)(ws + WS_CST) + (size_t)u * 32768; float one = 1.0f; asm volatile("" : "+v"(one));
#pragma unroll
        for (int eb = 0; eb < 2; ++eb)
#pragma unroll
            for (int db = 0; db < 8; ++db) { const f32x4 av = acc[db][eb] * one; u32x2 o; o.x = cvt_pk_bf16(av[0], av[1]); o.y = cvt_pk_bf16(av[2], av[3]); *(u32x2*)(cst + (size_t)(w * 32 + eb * 16 + lr) * 128 + db * 16 + g * 4) = o; }
        __syncthreads();
    }
}
__device__ __forceinline__ void mlstm_b(const Params& p, const int g_wv) {
    unsigned char* ws = p.ws; int tid = TIDX; asm volatile("" : "+v"(tid)); const float* blast = (const float*)(ws + WS_BLAST); const float* gmax = (const float*)(ws + WS_GMAX);
    for (int u = blockIdx.x; u < 256; u += gridDim.x) {
        const int bh = u >> 4, eb = u & 15; bf16_t* base = (bf16_t*)(ws + WS_CST) + (size_t)bh * 64 * 32768 + eb * 2048 + tid * 4;
        float* nb = (float*)(ws + WS_NST) + (size_t)bh * 64 * 128 + tid; const bool don = (eb == 0 && tid < 128);
        float m = 0.f, c0 = 0.f, c1 = 0.f, c2 = 0.f, c3 = 0.f, nn = 0.f;
#pragma unroll 16
        for (int c = 0; c < 64; ++c) {
            const float bl = blast[bh * 64 + c], gm = gmax[bh * 64 + c]; const float mn = fmaxf(bl + m, gm); const float dec = __expf(bl + m - mn), inw = __expf(gm - mn);
            u32x2* sp = (u32x2*)(base + (size_t)c * 32768); const u32x2 uw = *sp; u32x2 o; o.x = cvt_pk_bf16(c0, c1); o.y = cvt_pk_bf16(c2, c3); *sp = o;
            c0 = dec * c0 + inw * bflo(uw.x); c1 = dec * c1 + inw * bfhi(uw.x); c2 = dec * c2 + inw * bflo(uw.y); c3 = dec * c3 + inw * bfhi(uw.y);
            if (don) { const float nu = nb[c * 128]; nb[c * 128] = nn; nn = dec * nn + inw * nu; }
            if (eb == 0 && tid == 0) ((float*)(ws + WS_MST))[bh * 64 + c] = m;
            m = mn;
        }
        asm volatile("s_waitcnt vmcnt(0)" ::: "memory"); __syncthreads();
        if (tid == 0) { __builtin_amdgcn_fence(__ATOMIC_RELEASE, "agent"); asm volatile("s_waitcnt vmcnt(0)" ::: "memory");
            __hip_atomic_fetch_add((unsigned*)(ws + WS_CTR) + 16 + bh, 1u, __ATOMIC_RELAXED, __HIP_MEMORY_SCOPE_AGENT); }
    }
}
__device__ __forceinline__ void mlstm_c(unsigned char* lds, const Params& p, int l, const int g_wv) {
    constexpr int QRS = 288, TRS = 160; constexpr int OFF_Q = 0, OFF_K = 64 * QRS, OFF_VT = 2 * 64 * QRS, OFF_P = OFF_VT + 256 * TRS, OFF_F = OFF_P + 64 * TRS;
    unsigned char* ws = p.ws; int tid = TIDX; asm volatile("" : "+v"(tid)); const int lane = tid & 63, w = tid >> 6, lr = lane & 15, g = lane >> 4;
    const bf16_t* Q2 = (const bf16_t*)(ws + WS_Q2); const bf16_t* K2 = (const bf16_t*)(ws + WS_K2); const bf16_t* VB = (const bf16_t*)(ws + WS_VB);
    const bf16_t* OB = (const bf16_t*)(ws + WS_OB); bf16_t* ZB = (bf16_t*)(ws + WS_Z + 32 * MiB); const float* gn = p.out_norm + (size_t)l * 1024;
    float* fb = (float*)(lds + OFF_F); float* bvec = fb; float* livec = fb + 64; float* mt = fb + 128; float* wint = fb + 192; float* denV = fb + 256; float* denC = fb + 320; float* lsum = fb + 384; float* lsq = fb + 448; float* nvec = fb + 512;
    for (int u = blockIdx.x; u < 1024; u += gridDim.x) {
        const int bh = u >> 6, c = u & 63, b = bh >> 2, h = bh & 3; const size_t t0 = (size_t)b * SEQ + c * 64;
        if (tid == 0) { const unsigned want = 16u * (unsigned)(l + 1); while (__hip_atomic_load((unsigned*)(ws + WS_CTR) + 16 + bh, __ATOMIC_RELAXED, __HIP_MEMORY_SCOPE_AGENT) < want) __builtin_amdgcn_s_sleep(1);
            __builtin_amdgcn_fence(__ATOMIC_ACQUIRE, "agent"); asm volatile("s_waitcnt vmcnt(0)" ::: "memory"); }
        __syncthreads();
        const float mc = ((const float*)(ws + WS_MST))[u];
#pragma unroll
        for (int it = 0; it < 2; ++it) { const int id = tid + NTHR * it, s = id >> 4, ch = id & 15;
            *(u32x4*)(lds + OFF_Q + s * QRS + ch * 16) = *(const u32x4*)(Q2 + (t0 + s) * 512 + h * 128 + ch * 8); *(u32x4*)(lds + OFF_K + s * QRS + ch * 16) = *(const u32x4*)(K2 + (t0 + s) * 512 + h * 128 + ch * 8); }
#pragma unroll 2
        for (int it = 0; it < 4; ++it) { const int item = tid + NTHR * it, s = item & 63, eg = item >> 6; const u32x4 vw = *(const u32x4*)(VB + (t0 + s) * 1024 + h * 256 + eg * 8);
            unsigned char* d = lds + OFF_VT + (eg * 8) * TRS + s * 2; const unsigned vv[4] = {vw.x, vw.y, vw.z, vw.w};
#pragma unroll
            for (int i = 0; i < 4; ++i) { *(bf16_t*)(d + (2 * i) * TRS) = (bf16_t)(vv[i] & 0xffffu); *(bf16_t*)(d + (2 * i + 1) * TRS) = (bf16_t)(vv[i] >> 16); } }
        if (tid < 64) { bvec[tid] = ((const float*)(ws + WS_BV))[(size_t)u * 64 + tid]; livec[tid] = ((const float*)(ws + WS_LIV))[(size_t)u * 64 + tid]; lsum[tid] = 0.f; lsq[tid] = 0.f; }
        else if (tid < 192) nvec[tid - 64] = ((const float*)(ws + WS_NST))[(size_t)u * 128 + tid - 64];
        __syncthreads();
        if (w == 0) { float x = livec[lane] - bvec[lane];
#pragma unroll
            for (int o = 1; o < 64; o <<= 1) { const float v = shup(x, o, lane); if (lane >= o) x = fmaxf(x, v); }
            const float mtl = bvec[lane] + fmaxf(mc, x); mt[lane] = mtl; wint[lane] = __expf(bvec[lane] + mc - mtl); }
        __syncthreads();
        { const int lb = w >> 1;
#pragma unroll
          for (int si = 0; si < 2; ++si) { const int sb = (w & 1) * 2 + si; f32x4 a = zero4();
            if (sb <= lb) {
#pragma unroll
                for (int kc = 0; kc < 4; ++kc) { const bf16x8 qf = *(const bf16x8*)(lds + OFF_Q + (lb * 16 + lr) * QRS + kc * 64 + g * 16), kf = *(const bf16x8*)(lds + OFF_K + (sb * 16 + lr) * QRS + kc * 64 + g * 16); a = mfma16(qf, kf, a); }
            }
            const int s = sb * 16 + lr; const float bs = bvec[s] - livec[s];
#pragma unroll
            for (int r = 0; r < 4; ++r) { const int ll = lb * 16 + g * 4 + r; float v = 0.f; if (s <= ll) v = a[r] * __expf(bvec[ll] - bs - mt[ll]); *(bf16_t*)(lds + OFF_P + ll * TRS + s * 2) = f2bf(v); } } }
        __syncthreads();
        if (w == 0) { float a = 0.f; const unsigned char* r = lds + OFF_P + lane * TRS;
#pragma unroll
            for (int i = 0; i < 8; ++i) { const u32x4 x = *(const u32x4*)(r + i * 16); a += (bflo(x.x) + bfhi(x.x)) + (bflo(x.y) + bfhi(x.y)) + (bflo(x.z) + bfhi(x.z)) + (bflo(x.w) + bfhi(x.w)); }
            denV[lane] = a; }
        else if (w == 1) { float a = 0.f; const unsigned char* r = lds + OFF_Q + lane * QRS;
#pragma unroll
            for (int i = 0; i < 16; ++i) { const u32x4 x = *(const u32x4*)(r + i * 16); const float* nv = nvec + i * 8;
                a += bflo(x.x) * nv[0] + bfhi(x.x) * nv[1] + bflo(x.y) * nv[2] + bfhi(x.y) * nv[3] + bflo(x.z) * nv[4] + bfhi(x.z) * nv[5] + bflo(x.w) * nv[6] + bfhi(x.w) * nv[7]; }
            denC[lane] = a; }
        f32x4 accV[2][4], accC[2][4];
#pragma unroll
        for (int i = 0; i < 2; ++i)
#pragma unroll
            for (int j = 0; j < 4; ++j) { accV[i][j] = zero4(); accC[i][j] = zero4(); }
        const bf16_t* cst = (const bf16_t*)(ws + WS_CST) + (size_t)u * 32768;
#pragma unroll
        for (int kp = 0; kp < 2; ++kp) {
        bf16x8 ctf[2][2];
#pragma unroll
        for (int k2 = 0; k2 < 2; ++k2) { const int kc = kp * 2 + k2; ctf[k2][0] = *(const bf16x8*)(cst + (size_t)(w * 32 + lr) * 128 + kc * 32 + g * 8); ctf[k2][1] = *(const bf16x8*)(cst + (size_t)(w * 32 + 16 + lr) * 128 + kc * 32 + g * 8); }
#pragma unroll
        for (int k2 = 0; k2 < 2; ++k2) { const int kc = kp * 2 + k2;
            const bf16x8 c0 = ctf[k2][0], c1 = ctf[k2][1];
#pragma unroll
            for (int lb = 0; lb < 4; ++lb) { const bf16x8 qf = *(const bf16x8*)(lds + OFF_Q + (lb * 16 + lr) * QRS + kc * 64 + g * 16); accC[0][lb] = mfma16(c0, qf, accC[0][lb]); accC[1][lb] = mfma16(c1, qf, accC[1][lb]); }
        }
        }
#pragma unroll
        for (int kc = 0; kc < 2; ++kc) {
            const bf16x8 v0 = *(const bf16x8*)(lds + OFF_VT + (w * 32 + lr) * TRS + kc * 64 + g * 16), v1 = *(const bf16x8*)(lds + OFF_VT + (w * 32 + 16 + lr) * TRS + kc * 64 + g * 16);
#pragma unroll
            for (int lb = 0; lb < 4; ++lb) { const bf16x8 pf = *(const bf16x8*)(lds + OFF_P + (lb * 16 + lr) * TRS + kc * 64 + g * 16); accV[0][lb] = mfma16(v0, pf, accV[0][lb]); accV[1][lb] = mfma16(v1, pf, accV[1][lb]); }
        }
        __syncthreads();
#pragma unroll
        for (int lb = 0; lb < 4; ++lb) { const int ll = lb * 16 + lr; const float wi = wint[ll]; const float den = wi * denC[ll] + denV[ll]; const float dn = 1.0f / fmaxf(fabsf(den), __expf(-mt[ll])); float s1 = 0.f, s2 = 0.f;
#pragma unroll
            for (int eb = 0; eb < 2; ++eb) { const f32x4 hv = (accC[eb][lb] * wi + accV[eb][lb]) * dn; accV[eb][lb] = hv; s1 += (hv[0] + hv[1]) + (hv[2] + hv[3]); s2 += (hv[0] * hv[0] + hv[1] * hv[1]) + (hv[2] * hv[2] + hv[3] * hv[3]); }
            s1 += shx(s1, 16, lane); s1 += shx(s1, 32, lane); s2 += shx(s2, 16, lane); s2 += shx(s2, 32, lane);
            if (g == 0) { fb[640 + w * 64 + ll] = s1; fb[1152 + w * 64 + ll] = s2; } }
        __syncthreads();
#pragma unroll
        for (int lb = 0; lb < 4; ++lb) { const int ll = lb * 16 + lr; float t1 = 0.f, t2 = 0.f;
#pragma unroll
            for (int ww = 0; ww < 8; ++ww) { t1 += fb[640 + ww * 64 + ll]; t2 += fb[1152 + ww * 64 + ll]; }
            const float mu = t1 * (1.0f / 256.0f); const float var = fmaxf(t2 * (1.0f / 256.0f) - mu * mu, 0.f); const float rstd = rsqrtf(var + EPS);
#pragma unroll
            for (int eb = 0; eb < 2; ++eb) { const int e = w * 32 + eb * 16 + g * 4; const size_t off = (t0 + ll) * 1024 + h * 256 + e; const f32x4 gv = *(const f32x4*)(gn + h * 256 + e);
                const u32x2 ow = *(const u32x2*)(OB + off), zw = *(const u32x2*)(ZB + off); const f32x4 hv = accV[eb][lb]; u32x2 o;
                o.x = cvt_pk_bf16((hv[0] - mu) * rstd * gv[0] * bflo(ow.x) * bflo(zw.x), (hv[1] - mu) * rstd * gv[1] * bfhi(ow.x) * bfhi(zw.x));
                o.y = cvt_pk_bf16((hv[2] - mu) * rstd * gv[2] * bflo(ow.y) * bflo(zw.y), (hv[3] - mu) * rstd * gv[3] * bfhi(ow.y) * bfhi(zw.y)); *(u32x2*)(ZB + off) = o; } }
        __syncthreads();
    }
}

#ifndef PHM
#define PHM 4095
#endif
typedef const __attribute__((address_space(4))) Params* KParams;
#if defined(__HIP_DEVICE_COMPILE__)
__device__ __forceinline__ Params load_params() { KParams k = (KParams)__builtin_amdgcn_kernarg_segment_ptr(); asm volatile("" : "+s"(k)); return *k; }
#else
__device__ __forceinline__ Params load_params() { return Params{}; }
#endif
#define PP load_params()
#define GSYNC() do { asm volatile("s_waitcnt vmcnt(0) lgkmcnt(0)" ::: "memory"); __builtin_amdgcn_fence(__ATOMIC_RELEASE, "agent"); asm volatile("s_waitcnt vmcnt(0)" ::: "memory"); grid.sync(); \
    __builtin_amdgcn_fence(__ATOMIC_ACQUIRE, "agent"); asm volatile("s_waitcnt vmcnt(0) lgkmcnt(0)" ::: "memory"); } while (0)
__device__ __forceinline__ void gbar(unsigned* ctr, unsigned target, const int g_wv) {
    asm volatile("s_waitcnt vmcnt(0) lgkmcnt(0)" ::: "memory");
    __syncthreads();
    if (TIDX == 0) {
        __builtin_amdgcn_fence(__ATOMIC_RELEASE, "agent"); asm volatile("s_waitcnt vmcnt(0)" ::: "memory");
        __hip_atomic_fetch_add(ctr, 1u, __ATOMIC_RELAXED, __HIP_MEMORY_SCOPE_AGENT);
        while (__hip_atomic_load(ctr, __ATOMIC_RELAXED, __HIP_MEMORY_SCOPE_AGENT) < target) __builtin_amdgcn_s_sleep(1);
        __builtin_amdgcn_fence(__ATOMIC_ACQUIRE, "agent"); asm volatile("s_waitcnt vmcnt(0)" ::: "memory");
    }
    __syncthreads();
}
template <bool AL = true, bool SP = true, class Epi, class Sched> __device__ __forceinline__ void run_gemm(unsigned char* lds, const bf16_t* A, const bf16_t* Bt, int M, int N, int K, int lda, int ldb, const Sched& S, const Epi& E, const int g_wv) {
    pg8::Gemm g{A, Bt, M, N, K, lda, ldb};
    pg8::gemm_phase<Epi, Sched, AL, SP>((PG8_LAS unsigned char*)lds, g, S, E, g_wv);
    __syncthreads();
}

__global__ void __launch_bounds__(NTHR, 2) mega(Params p_arg) {
    extern __shared__ __attribute__((aligned(16))) unsigned char lds[];
    cg::grid_group grid = cg::this_grid();
    const int g_wv = __builtin_amdgcn_readfirstlane((int)(__builtin_amdgcn_workitem_id_x() >> 6));
    const int G = gridDim.x, cb = blockIdx.x; const int w_lo = p_arg.w_lo, w_hi = p_arg.w_hi;
#define WIN(k_) (w_lo <= (k_) && (k_) < w_hi)
    unsigned nbar = 0;
#define SEAM(k_) do { if (WIN(k_) && WIN((k_) + 1)) { ++nbar; gbar((unsigned*)(PP.ws + WS_CTR), nbar * (unsigned)G, g_wv); } } while (0)
    if (w_lo > 1000) GSYNC();
    if (WIN(0)) {
#if PHM & 1
    convert_weights(lds, PP, 0, g_wv); convert_weights(lds, PP, 1, g_wv);
#endif
#if PHM & 2
    build_cs(PP, g_wv);
    { const Params p = PP; rmsnorm_rows<true>(p.x, p.norm_gain, (bf16_t*)(p.ws + WS_H), nullptr, g_wv); }
#endif
    }
    SEAM(0);
#pragma unroll 1
    for (int l = 0; l < 2; ++l) {
        const int wb = 1 + 7 * l;
        if (WIN(wb)) {
#if PHM & 4
        { unsigned char* ws = PP.ws; unsigned char* wl = ws + WS_W0 + (size_t)l * WL_SIZE; const f32x2* cs = (const f32x2*)(ws + WS_CS); (void)cs; (void)wl; pg8::StaticOrder S; S.init(T, 15360, G, cb); EpiIn E{ws}; run_gemm(lds, (const bf16_t*)(ws + WS_H), (const bf16_t*)(wl + WL_WIN), T, 15360, DM, DM, DM, S, E, g_wv); }
        { unsigned char* ws = PP.ws; unsigned char* wl = ws + WS_W0 + (size_t)l * WL_SIZE; const f32x2* cs = (const f32x2*)(ws + WS_CS); (void)cs; (void)wl; pg8::StaticOrder S; S.init(1024, T, G, cb); EpiVT E{(bf16_t*)(ws + WS_VAT), T, nullptr, 0.f}; run_gemm(lds, (const bf16_t*)(wl + WL_WIN) + (size_t)15360 * DM, (const bf16_t*)(ws + WS_H), 1024, T, DM, DM, DM, S, E, g_wv); }
#endif
        }
        SEAM(wb);
        if (WIN(wb + 1)) {
#if PHM & 32
        mlstm_a(lds, PP, l, g_wv);
#endif
#if PHM & 16
        kmean_phase(PP, l, g_wv);
#endif
#if PHM & 8
        { unsigned char* ws = PP.ws; unsigned char* wl = ws + WS_W0 + (size_t)l * WL_SIZE; const f32x2* cs = (const f32x2*)(ws + WS_CS); (void)cs; (void)wl; pg8::StaticOrder S; S.init(T, 1536, G, cb); EpiRow<true> E{(bf16_t*)(ws + WS_QC), 1536, (const float*)(ws + WS_SSP), 1.0f / 512.0f, CC_SCALE, cs}; run_gemm(lds, (const bf16_t*)(ws + WS_CQ), (const bf16_t*)(wl + WL_WUQ), T, 1536, 512, 512, 512, S, E, g_wv); }
        { unsigned char* ws = PP.ws; unsigned char* wl = ws + WS_W0 + (size_t)l * WL_SIZE; const f32x2* cs = (const f32x2*)(ws + WS_CS); (void)cs; (void)wl; pg8::StaticOrder S; S.init(T, 1024, G, cb); EpiRow<false> E{(bf16_t*)(ws + WS_KNC), 1024, (const float*)(ws + WS_SSP), 1.0f / 256.0f, 1.0f, cs}; run_gemm(lds, (const bf16_t*)(ws + WS_CKV), (const bf16_t*)(wl + WL_WKN), T, 1024, 256, 256, 256, S, E, g_wv); }
        { unsigned char* ws = PP.ws; unsigned char* wl = ws + WS_W0 + (size_t)l * WL_SIZE; const f32x2* cs = (const f32x2*)(ws + WS_CS); (void)cs; (void)wl; pg8::StaticOrder S; S.init(1024, T, G, cb); EpiVT E{(bf16_t*)(ws + WS_VCT), T, (const float*)(ws + WS_SSP), 1.0f / 256.0f}; run_gemm(lds, (const bf16_t*)(wl + WL_WV), (const bf16_t*)(ws + WS_CKV), 1024, T, 256, 256, 256, S, E, g_wv); }
#endif
        }
        SEAM(wb + 1);
        if (WIN(wb + 2)) {
#if PHM & 128
        mlstm_b(PP, g_wv);
#endif
#if PHM & 64
        attn_phase<0>(lds, PP, l, g_wv);
#endif
        }
        if (WIN(wb + 3)) {
#if PHM & 256
        attn_phase<1>(lds, PP, l, g_wv);
#endif
#if PHM & 512
        mlstm_c(lds, PP, l, g_wv);
#endif
        }
        SEAM(wb + 3);
        if (WIN(wb + 4)) {
#if PHM & 1024
        { unsigned char* ws = PP.ws; unsigned char* wl = ws + WS_W0 + (size_t)l * WL_SIZE; MergeOrder S{G, cb}; EpiMerge E{(bf16_t*)(ws + WS_H), (const bf16_t*)(ws + WS_GT)}; run_gemm(lds, (const bf16_t*)(ws + WS_Z), (const bf16_t*)(wl + WL_WB), 3 * T, 2048, 1024, 1024, 1024, S, E, g_wv); }
#endif
        }
        SEAM(wb + 4);
        if (WIN(wb + 5)) {
#if PHM & 2048
        { unsigned char* ws = PP.ws; unsigned char* wl = ws + WS_W0 + (size_t)l * WL_SIZE; const f32x2* cs = (const f32x2*)(ws + WS_CS); (void)cs; (void)wl; pg8::StaticOrder S; S.init(T, DM, G, cb); const Params p = PP; EpiOut E{l == 0 ? p.x : p.out, p.out}; run_gemm(lds, (const bf16_t*)(ws + WS_H), (const bf16_t*)(wl + WL_WO), T, DM, DM, DM, DM, S, E, g_wv); }
#endif
        }
        SEAM(wb + 5);
        if (WIN(wb + 6)) {
            if (l == 0) { const Params p = PP; rmsnorm_rows<true>(p.out, p.norm_gain + DM, (bf16_t*)(p.ws + WS_H), nullptr, g_wv); }
            else { const Params p = PP; rmsnorm_rows<false>(p.out, p.final_norm, nullptr, p.out, g_wv); }
        }
        if (l == 0) SEAM(wb + 6);
    }
}


#if defined(MK_DEBUG_HASH)
__global__ void hash_buf(const unsigned* p, size_t nwords, unsigned long long* acc) {
    unsigned long long s = 0; const size_t stride = (size_t)gridDim.x * blockDim.x;
    for (size_t i = (size_t)blockIdx.x * blockDim.x + threadIdx.x; i < nwords; i += stride) s += (unsigned long long)p[i] * (unsigned long long)(((unsigned)i * 2654435761u) | 1u);
    atomicAdd(acc, s);
}
__global__ void dbg_final(float* out, size_t n, const unsigned long long* h, int R, int NK) {
    __shared__ float flag;
    if (threadIdx.x == 0) { float f = 1.0f; for (int k = NK - 1; k >= 0; --k) for (int r = 1; r < R; ++r) if (h[r * NK + k] != h[k]) { f = 100.0f; for (int q = 0; q < k; ++q) f *= 10.0f; } flag = f; }
    __syncthreads();
    for (size_t i = (size_t)blockIdx.x * blockDim.x + threadIdx.x; i < n; i += (size_t)gridDim.x * blockDim.x) out[i] = (i == 0) ? flag : 0.0f;
}
#endif
extern "C" void kernel_launch(void* const* d_in, const int* in_sizes, int n_in, void* d_out, int out_size, void* d_ws, size_t ws_size, hipStream_t stream) {
    static int grid = 0;
    if (grid == 0) {
        if (n_in != 16 || ws_size < WS_END) { fprintf(stderr, "kernel_launch: unexpected n_in %d or ws_size %zu < %zu\n", n_in, ws_size, (size_t)WS_END); grid = -1; return; }
        int dev = 0, cus = 0, per_cu = 0;
        hipGetDevice(&dev); hipDeviceGetAttribute(&cus, hipDeviceAttributeMultiprocessorCount, dev);
        if (hipFuncSetAttribute((const void*)mega, hipFuncAttributeMaxDynamicSharedMemorySize, LDS_BYTES) != hipSuccess) { fprintf(stderr, "kernel_launch: hipFuncSetAttribute failed\n"); grid = -1; return; }
        if (hipOccupancyMaxActiveBlocksPerMultiprocessor(&per_cu, (const void*)mega, NTHR, LDS_BYTES) != hipSuccess || per_cu < 1) { fprintf(stderr, "kernel_launch: occupancy query gave %d\n", per_cu); per_cu = 1; }
        (void)hipGetLastError();
        grid = cus * 1;
    }
    if (grid < 0) return;
    Params p{};
    p.x = (const float*)d_in[0]; p.norm_gain = (const float*)d_in[1]; p.w_in = (const float*)d_in[2]; p.t5 = (const float*)d_in[3]; p.conv_w = (const float*)d_in[4]; p.conv_b = (const float*)d_in[5];
    p.i_bias = (const float*)d_in[6]; p.f_bias = (const float*)d_in[7]; p.out_norm = (const float*)d_in[8]; p.q_norm = (const float*)d_in[9]; p.kv_norm = (const float*)d_in[10];
    p.w_uq = (const float*)d_in[11]; p.w_ukv = (const float*)d_in[12]; p.w_branch = (const float*)d_in[13]; p.w_out = (const float*)d_in[14]; p.final_norm = (const float*)d_in[15];
    p.out = (float*)d_out; p.ws = (unsigned char*)d_ws;
    (void)hipMemsetAsync((unsigned char*)d_ws + WS_CTR, 0, 256, stream);
    void* args[] = {&p};
#if defined(MK_DEBUG_HASH)
    {
        constexpr int R = 4, NK = 9; unsigned char* W = (unsigned char*)d_ws; unsigned long long* H = (unsigned long long*)(W + WS_END);
        hipMemsetAsync(H, 0, R * NK * 8, stream);
        struct HB { int win; size_t off; size_t bytes; };
        const HB hb[NK] = { {3, WS_Z, 32 * MiB}, {3, WS_CST, 64 * MiB}, {3, WS_NST, 524288}, {3, WS_MST, 4096},
                            {4, WS_Z + 64 * MiB, 32 * MiB}, {4, WS_Z + 32 * MiB, 32 * MiB}, {5, WS_H, 64 * MiB}, {6, WS_H, 64 * MiB}, {2, WS_CST, 64 * MiB} };
        for (int r = 0; r < R; ++r)
            for (int w = 0; w < 7; ++w) { p.w_lo = w; p.w_hi = w + 1;
                hipError_t e = hipLaunchCooperativeKernel((const void*)mega, dim3(grid), dim3(NTHR), args, LDS_BYTES, stream);
                if (e != hipSuccess) fprintf(stderr, "kernel_launch: cooperative launch failed: %s\n", hipGetErrorString(e));
                for (int k = 0; k < NK; ++k) if (hb[k].win == w) {
                    if (k == 7) hash_buf<<<256, 256, 0, stream>>>((const unsigned*)d_out, (size_t)T * DM, H + r * NK + k);
                    else hash_buf<<<256, 256, 0, stream>>>((const unsigned*)(W + hb[k].off), hb[k].bytes / 4, H + r * NK + k); } }
        dbg_final<<<256, 256, 0, stream>>>((float*)d_out, (size_t)T * DM, H, R, NK);
    }
    if (false) {
#elif defined(MK_MULTI)
    for (int w = 0; w < 15; ++w) { p.w_lo = w; p.w_hi = w + 1;
#else
    { p.w_lo = 0; p.w_hi = 15;
#endif
        hipError_t e = hipLaunchCooperativeKernel((const void*)mega, dim3(grid), dim3(NTHR), args, LDS_BYTES, stream);
        if (e != hipSuccess) fprintf(stderr, "kernel_launch: cooperative launch failed: %s (grid %d)\n", hipGetErrorString(e), grid);
    }
}
```

```cpp
#include <hip/hip_runtime.h>
#include <hip/hip_cooperative_groups.h>
#include <cstdio>
#include <cstdint>
namespace cg = cooperative_groups;
__device__ __forceinline__ int tidx_opaque(int g_wv) { int l; asm volatile("v_mbcnt_lo_u32_b32 %0, -1, 0\n\tv_mbcnt_hi_u32_b32 %0, -1, %0" : "=v"(l)); return g_wv * 64 + l; }
#define TIDX tidx_opaque(g_wv)
__device__ __forceinline__ float shx(float v, int o, int lane) { return __int_as_float(__builtin_amdgcn_ds_bpermute(((lane ^ o) & 63) << 2, __float_as_int(v))); }
__device__ __forceinline__ int shxi(int v, int o, int lane) { return __builtin_amdgcn_ds_bpermute(((lane ^ o) & 63) << 2, v); }
__device__ __forceinline__ float shup(float v, int o, int lane) { return __int_as_float(__builtin_amdgcn_ds_bpermute(((lane - o) & 63) << 2, __float_as_int(v))); }

namespace pg8 {
#define PG8_LAS __attribute__((address_space(3)))
typedef unsigned short bf16_t;
typedef short bf16x8 __attribute__((ext_vector_type(8)));
typedef float f32x4 __attribute__((ext_vector_type(4)));
typedef unsigned u32x4 __attribute__((ext_vector_type(4)));
constexpr int BM = 256, BK = 64, HALF = 128, HTB = HALF * BK * 2  , STAGE_BYTES = 8 * HTB, NXCD = 8, WGM = 8;

__host__ __device__ __forceinline__ int lds_byte(int r, int c) { const int st = (r >> 4) * 2 + (c >> 5), rr = r & 15, cc = c & 31, ob = rr * 64 + cc * 2; return st * 1024 + (ob ^ (((ob >> 9) & 1) << 5)); }
__host__ __device__ __forceinline__ void stage_rc(int b, int& R, int& C) { const int st = b / 1024, sb = b % 1024, swz = sb ^ (((sb >> 9) & 1) << 5); R = (st >> 1) * 16 + swz / 64; C = (st & 1) * 32 + (swz % 64) / 2; }
__host__ __device__ __forceinline__ int perm32(int rho) { const int n = rho >> 4, i = rho & 15; return 8 * (i >> 2) + 4 * n + (i & 3); }

struct Unit { int pm, pn, pb; };
struct Gemm { const bf16_t* A; const bf16_t* Bt; int M, N, K, lda, ldb; };

struct StaticOrder {
    int nM, nN, nwg, G, c;
    __host__ __device__ void init(int M, int N, int G_, int c_) { nM = M / BM; nN = N / BM; nwg = nM * nN; G = G_; c = c_; }
    __host__ __device__ bool next(int i, Unit& u) const {
        const long L = (long)i * G + c; if (L >= nwg) return false;
        int wgid = (int)L; { const int q = nwg / NXCD, r = nwg % NXCD, xcd = wgid % NXCD, off = wgid / NXCD; wgid = (xcd < r ? xcd * (q + 1) : r * (q + 1) + (xcd - r) * q) + off; }
        const int nig = WGM * nN, gid = wgid / nig, fm = gid * WGM, gsz = (nM - fm) < WGM ? (nM - fm) : WGM;
        u.pm = fm + ((wgid % nig) % gsz); u.pn = (wgid % nig) / gsz; u.pb = u.pn; return true;
    }
    __device__ __forceinline__ void a_ready(const Unit&) const {}
    __device__ __forceinline__ void done(const Unit&) const {}
};

__device__ __forceinline__ unsigned cvt_pk_bf16(float lo, float hi) { unsigned r; asm volatile("s_nop 1\n\tv_cvt_pk_bf16_f32 %0, %1, %2\n\ts_nop 1" : "=v"(r) : "v"(lo), "v"(hi)); return r; }
template <class Epi, class Sched, bool ALIGN_EPI = false, bool SP2 = false>
__device__ __forceinline__ void gemm_phase(PG8_LAS unsigned char* lds, const Gemm g, const Sched& S, const Epi& E, const int g_wv) {
    int tid = TIDX; asm volatile("" : "+v"(tid)); const int wid = __builtin_amdgcn_readfirstlane(tid >> 6), lane = tid & 63, wr = wid >> 2, wc = wid & 3, fr = lane & 15, fq = lane >> 4;
    const int K = g.K, nt = K / BK;
    unsigned voffA[2], voffB[2];
#pragma unroll
    for (int i = 0; i < 2; ++i) { int R, C; stage_rc(tid * 16 + i * 8192, R, C); const int Rb = Epi::PERM ? ((R & ~31) + perm32(R & 31)) : R;
        voffA[i] = (unsigned)(R * K + C) * 2u; voffB[i] = (unsigned)(Rb * K + C) * 2u; }
    const size_t kstep = (size_t)(BK * 2);
    const size_t hstepA = (size_t)HALF * K * 2; const size_t hstepB = hstepA;
    const size_t tstepA = 2 * hstepA; const size_t tstepB = tstepA;
    const unsigned ldsw = (unsigned)wid * 1024u;
    const int aoff = lds_byte(wr * 64 + fr, fq * 8), boff = lds_byte(wc * 32 + fr, fq * 8);
#define PG8_SA(b, h) (((b) * 2 + (h)) * HTB)
#define PG8_SB(b, h) ((4 + (b) * 2 + (h)) * HTB)
#define PG8_STAGE(bufoff, gbase, voff) do { _Pragma("unroll") for (int _i = 0; _i < 2; ++_i) \
        __builtin_amdgcn_global_load_lds((const unsigned*)((const char*)(gbase) + (voff)[_i]), (PG8_LAS unsigned*)(lds + (bufoff) + ldsw + _i * 8192), 16, 0, 0); } while (0)
#define PG8_LDA(dst, b, h) do { _Pragma("unroll") for (int m = 0; m < 4; ++m) _Pragma("unroll") for (int k = 0; k < 2; ++k) dst[m][k] = *(const PG8_LAS bf16x8*)(lds + PG8_SA(b, h) + aoff + m * 2048 + k * 1024); } while (0)
#define PG8_LDB(dst, b, h) do { _Pragma("unroll") for (int n = 0; n < 2; ++n) _Pragma("unroll") for (int k = 0; k < 2; ++k) dst[n][k] = *(const PG8_LAS bf16x8*)(lds + PG8_SB(b, h) + boff + n * 2048 + k * 1024); } while (0)
#define PG8_MMA(ai, bj, At, Bt) do { __builtin_amdgcn_s_setprio(1); _Pragma("unroll") for (int m = 0; m < 4; ++m) _Pragma("unroll") for (int n = 0; n < 2; ++n) _Pragma("unroll") for (int k = 0; k < 2; ++k) \
        acc[ai][bj][m][n] = __builtin_amdgcn_mfma_f32_16x16x32_bf16(Bt[n][k], At[m][k], acc[ai][bj][m][n], 0, 0, 0); __builtin_amdgcn_s_setprio(0); } while (0)
#define PG8_WAIT_V(n) asm volatile("s_waitcnt vmcnt(" #n ")" ::: "memory")
#define PG8_WAIT_L(n) asm volatile("s_waitcnt lgkmcnt(" #n ")" ::: "memory")
#define PG8_BAR __builtin_amdgcn_s_barrier()
#define PG8_SCHED __builtin_amdgcn_sched_barrier(0)
    Unit cur, nxt; int ui = 0;
    if (!S.next(0, cur)) return;
    f32x4 acc[2][2][4][2];
#pragma unroll
    for (int a = 0; a < 2; ++a)
#pragma unroll
        for (int b = 0; b < 2; ++b)
#pragma unroll
            for (int m = 0; m < 4; ++m)
#pragma unroll
                for (int n = 0; n < 2; ++n) acc[a][b][m][n] = (f32x4){0.f, 0.f, 0.f, 0.f};
    bf16x8 At[4][2], B0[2][2], B1[2][2];
    const char* cA = (const char*)g.A + (size_t)cur.pm * tstepA; const char* cB = (const char*)g.Bt + (size_t)cur.pb * tstepB;
    S.a_ready(cur);
    if constexpr (SP2) {
        PG8_STAGE(PG8_SB(0, 0), cB, voffB); PG8_STAGE(PG8_SB(0, 1), cB + hstepB, voffB); PG8_STAGE(PG8_SA(0, 0), cA, voffA); PG8_STAGE(PG8_SA(0, 1), cA + hstepA, voffA);
        if (wr == 1) PG8_BAR;
        PG8_WAIT_V(2); PG8_BAR;
        PG8_STAGE(PG8_SB(1, 0), cB + kstep, voffB); PG8_STAGE(PG8_SA(1, 0), cA + kstep, voffA); PG8_STAGE(PG8_SB(1, 1), cB + hstepB + kstep, voffB);
        PG8_WAIT_V(6); PG8_BAR;
    } else {
        PG8_STAGE(PG8_SB(0, 0), cB, voffB); PG8_STAGE(PG8_SA(0, 0), cA, voffA); PG8_STAGE(PG8_SB(0, 1), cB + hstepB, voffB); PG8_STAGE(PG8_SA(0, 1), cA + hstepA, voffA);
        if (wr == 1) PG8_BAR;
        PG8_WAIT_V(4); PG8_BAR;
        PG8_STAGE(PG8_SB(1, 0), cB + kstep, voffB); PG8_STAGE(PG8_SA(1, 0), cA + kstep, voffA); PG8_STAGE(PG8_SB(1, 1), cB + hstepB + kstep, voffB);
        PG8_WAIT_V(6); PG8_BAR;
    }
    for (;;) {
        const bool has_next = S.next(ui + 1, nxt);
        const char* nA = has_next ? (const char*)g.A + (size_t)nxt.pm * tstepA : cA; const char* nB = has_next ? (const char*)g.Bt + (size_t)nxt.pb * tstepB : cB;
        for (int t = 0; t < nt; t += 2) {
            const bool last = (t == nt - 2);
            const char* a1 = cA + (size_t)(t + 1) * kstep;
            const char* a2 = last ? nA : cA + (size_t)(t + 2) * kstep; const char* b2 = last ? nB : cB + (size_t)(t + 2) * kstep;
            const char* a3 = a2 + kstep; const char* b3 = b2 + kstep;
            if (last && has_next) S.a_ready(nxt);
            if constexpr (SP2) {
            PG8_LDB(B0, 0, 0); PG8_LDB(B1, 0, 1); PG8_SCHED; PG8_LDA(At, 0, 0); PG8_STAGE(PG8_SA(1, 1), a1 + hstepA, voffA);
            PG8_WAIT_V(8); PG8_WAIT_L(0); PG8_BAR; PG8_MMA(0, 0, At, B0); PG8_MMA(0, 1, At, B1); PG8_BAR; PG8_SCHED;
            PG8_LDA(At, 0, 1); PG8_STAGE(PG8_SB(0, 0), b2, voffB); PG8_STAGE(PG8_SB(0, 1), b2 + hstepB, voffB); PG8_STAGE(PG8_SA(0, 0), a2, voffA);
            PG8_WAIT_V(8); PG8_WAIT_L(0); PG8_BAR; PG8_MMA(1, 0, At, B0); PG8_MMA(1, 1, At, B1); PG8_BAR; PG8_SCHED;
            PG8_LDB(B0, 1, 0); PG8_LDB(B1, 1, 1); PG8_SCHED; PG8_LDA(At, 1, 0); PG8_STAGE(PG8_SA(0, 1), a2 + hstepA, voffA);
            PG8_WAIT_V(8); PG8_WAIT_L(0); PG8_BAR; PG8_MMA(0, 0, At, B0); PG8_MMA(0, 1, At, B1); PG8_BAR; PG8_SCHED;
            PG8_LDA(At, 1, 1); PG8_STAGE(PG8_SB(1, 0), b3, voffB); PG8_STAGE(PG8_SB(1, 1), b3 + hstepB, voffB); PG8_STAGE(PG8_SA(1, 0), a3, voffA);
            PG8_WAIT_V(8); PG8_WAIT_L(0); PG8_BAR; PG8_MMA(1, 0, At, B0); PG8_MMA(1, 1, At, B1); PG8_BAR; PG8_SCHED;
            } else {
            PG8_LDB(B0, 0, 0); PG8_SCHED; PG8_LDA(At, 0, 0); PG8_STAGE(PG8_SA(1, 1), a1 + hstepA, voffA);
            PG8_WAIT_L(8); PG8_BAR; PG8_WAIT_L(0); PG8_MMA(0, 0, At, B0); PG8_BAR; PG8_SCHED;
            PG8_LDB(B1, 0, 1); PG8_STAGE(PG8_SB(0, 0), b2, voffB);
            PG8_BAR; PG8_WAIT_L(0); PG8_MMA(0, 1, At, B1); PG8_BAR;
            PG8_LDA(At, 0, 1); PG8_STAGE(PG8_SA(0, 0), a2, voffA);
            PG8_BAR; PG8_WAIT_L(0); PG8_MMA(1, 0, At, B0); PG8_BAR; PG8_SCHED;
            PG8_STAGE(PG8_SB(0, 1), b2 + hstepB, voffB);
            PG8_WAIT_V(6); PG8_BAR; PG8_MMA(1, 1, At, B1); PG8_BAR;
            PG8_LDB(B0, 1, 0); PG8_SCHED; PG8_LDA(At, 1, 0); PG8_STAGE(PG8_SA(0, 1), a2 + hstepA, voffA);
            PG8_WAIT_L(8); PG8_BAR; PG8_WAIT_L(0); PG8_MMA(0, 0, At, B0); PG8_BAR; PG8_SCHED;
            PG8_LDB(B1, 1, 1); PG8_STAGE(PG8_SB(1, 0), b3, voffB);
            PG8_BAR; PG8_WAIT_L(0); PG8_MMA(0, 1, At, B1); PG8_BAR;
            PG8_LDA(At, 1, 1); PG8_STAGE(PG8_SA(1, 0), a3, voffA);
            PG8_BAR; PG8_WAIT_L(0); PG8_MMA(1, 0, At, B0); PG8_BAR; PG8_SCHED;
            PG8_STAGE(PG8_SB(1, 1), b3 + hstepB, voffB);
            PG8_WAIT_V(6); PG8_BAR; PG8_MMA(1, 1, At, B1); PG8_BAR;
            }
        }
        if constexpr (ALIGN_EPI) { if (wr == 0) PG8_BAR; }
        if constexpr (!Epi::AFTER_DRAIN) { E(acc, cur, wr, wc, fr, fq); S.done(cur); }
        if (!has_next) break;
#pragma unroll
        for (int a = 0; a < 2; ++a)
#pragma unroll
            for (int b = 0; b < 2; ++b)
#pragma unroll
                for (int m = 0; m < 4; ++m)
#pragma unroll
                    for (int n = 0; n < 2; ++n) acc[a][b][m][n] = (f32x4){0.f, 0.f, 0.f, 0.f};
        cur = nxt; cA = nA; cB = nB; ++ui;
        if constexpr (ALIGN_EPI) { if (wr == 1) PG8_BAR; }
    }
    PG8_WAIT_V(0);
    if constexpr (!ALIGN_EPI) { if (wr == 0) PG8_BAR; }
    PG8_BAR;
    if constexpr (Epi::AFTER_DRAIN) { E.fused(acc, cur, wr, wc, fr, fq, lds, wid, lane); S.done(cur); }
#undef PG8_SA
#undef PG8_SB
#undef PG8_STAGE
#undef PG8_LDA
#undef PG8_LDB
#undef PG8_MMA
#undef PG8_WAIT_V
#undef PG8_WAIT_L
#undef PG8_BAR
#undef PG8_SCHED
}
}

using pg8::bf16_t; using pg8::bf16x8; using pg8::f32x4; using pg8::u32x4; using pg8::Unit; using pg8::cvt_pk_bf16;
typedef unsigned u32x2 __attribute__((ext_vector_type(2)));
typedef float f32x2 __attribute__((ext_vector_type(2)));
constexpr int T = 16384, SEQ = 4096, DM = 2048, DIN = 16200;
constexpr float EPS = 1e-6f, NEGV = -1e30f, LOG2E = 1.4426950408889634f;
constexpr float CA_SCALE = 0.12751743082459868f;
constexpr float CC_SCALE = 0.10411754627697264f;
constexpr int NTHR = 512;
constexpr int LDS_BYTES = 131072;

constexpr size_t MiB = 1ull << 20;
constexpr size_t WS_CS = 0;
constexpr size_t WS_SSQ = WS_CS + MiB;
constexpr size_t WS_SSKV = WS_SSQ + 65536;
constexpr size_t WS_GATES = WS_SSKV + 65536;
constexpr size_t WS_KM = WS_GATES + 524288;
constexpr size_t WS_BV = WS_KM + 131072;
constexpr size_t WS_LIV = WS_BV + 262144;
constexpr size_t WS_BLAST = WS_LIV + 262144;
constexpr size_t WS_GMAX = WS_BLAST + 4096;
constexpr size_t WS_MST = WS_GMAX + 4096;
constexpr size_t WS_NST = WS_MST + 4096;
constexpr size_t WS_W0 = WS_NST + 524288;
constexpr size_t WL_WIN = 0;
constexpr size_t WL_WB = WL_WIN + 64 * MiB;
constexpr size_t WL_WO = WL_WB + 12 * MiB;
constexpr size_t WL_WUQ = WL_WO + 8 * MiB;
constexpr size_t WL_WKN = WL_WUQ + 1536 * 1024;
constexpr size_t WL_WV = WL_WKN + 512 * 1024;
constexpr size_t WL_SIZE = WL_WV + 512 * 1024;
constexpr size_t WS_H = WS_W0 + 2 * WL_SIZE;
constexpr size_t WS_QA = WS_H + 64 * MiB;
constexpr size_t WS_KA = WS_QA + 32 * MiB;
constexpr size_t WS_VAT = WS_KA + 32 * MiB;
constexpr size_t WS_Z = WS_VAT + 32 * MiB;
constexpr size_t WS_QB = WS_Z + 96 * MiB;
constexpr size_t WS_KB = WS_QB + 16 * MiB;
constexpr size_t WS_VB = WS_KB + 16 * MiB;
constexpr size_t WS_OB = WS_VB + 32 * MiB;
constexpr size_t WS_Q2 = WS_OB + 32 * MiB;
constexpr size_t WS_K2 = WS_Q2 + 16 * MiB;
constexpr size_t WS_CST = WS_K2 + 16 * MiB;
constexpr size_t WS_CQ = WS_CST + 64 * MiB;
constexpr size_t WS_CKV = WS_CQ + 16 * MiB;
constexpr size_t WS_KR = WS_CKV + 8 * MiB;
constexpr size_t WS_QC = WS_KR + 2 * MiB;
constexpr size_t WS_KNC = WS_QC + 48 * MiB;
constexpr size_t WS_VCT = WS_KNC + 32 * MiB;
constexpr size_t WS_GT = WS_VCT + 32 * MiB;
constexpr size_t WS_SSP = WS_GT + 192 * MiB;
constexpr size_t WS_QAL = WS_SSP + MiB;
constexpr size_t WS_CTR = WS_QAL + 32 * MiB;
constexpr size_t WS_END = WS_CTR + 256;

struct Params {
    const float* x; const float* norm_gain; const float* w_in; const float* t5; const float* conv_w; const float* conv_b; const float* i_bias; const float* f_bias;
    const float* out_norm; const float* q_norm; const float* kv_norm; const float* w_uq; const float* w_ukv; const float* w_branch; const float* w_out; const float* final_norm;
    float* out; unsigned char* ws; int w_lo, w_hi;
};

__device__ __forceinline__ float bf2f(unsigned v16) { return __uint_as_float(v16 << 16); }
__device__ __forceinline__ float bflo(unsigned w) { return __uint_as_float(w << 16); }
__device__ __forceinline__ float bfhi(unsigned w) { return __uint_as_float(w & 0xffff0000u); }
__device__ __forceinline__ bf16_t f2bf(float f) { return (bf16_t)(cvt_pk_bf16(f, 0.f) & 0xffffu); }
__device__ __forceinline__ float fsigmoid(float v) { return __builtin_amdgcn_rcpf(1.0f + __expf(-v)); }
__device__ __forceinline__ float fsilu(float v) { return v * __builtin_amdgcn_rcpf(1.0f + __expf(-v)); }
__device__ __forceinline__ float fexp2(float v) { return __builtin_amdgcn_exp2f(v); }
__device__ __forceinline__ f32x4 zero4() { f32x4 z = (f32x4){0.f, 0.f, 0.f, 0.f}; asm volatile("" : "+v"(z)); return z; }
__device__ __forceinline__ f32x4 mfma16(bf16x8 a, bf16x8 b, f32x4 c) { return __builtin_amdgcn_mfma_f32_16x16x32_bf16(a, b, c, 0, 0, 0); }

struct EpiIn {
    static constexpr bool PERM = true, AFTER_DRAIN = false;
    unsigned char* ws;
    __device__ __forceinline__ void operator()(const f32x4 (&acc)[2][2][4][2], const Unit& u, int wr, int wc, int fr, int fq) const {
        const int pn = u.pn; const int row0 = u.pm * 256 + wr * 64 + fr;
        if (pn == 59) {
            const int cb = wc * 32 + 8 * fq;
            if (cb >= 72) return;
            float* gates = (float*)(ws + WS_GATES); bf16_t* kr = (bf16_t*)(ws + WS_KR); const f32x2* cs = (const f32x2*)(ws + WS_CS);
#pragma unroll
            for (int ai = 0; ai < 2; ++ai)
#pragma unroll
                for (int m = 0; m < 4; ++m) {
                    const int row = row0 + ai * 128 + m * 16; const f32x4 v0 = acc[ai][0][m][0], v1 = acc[ai][0][m][1];
                    if (cb == 0) { *(f32x4*)(gates + (size_t)row * 8) = v0; *(f32x4*)(gates + (size_t)row * 8 + 4) = v1; }
                    else {
                        const int j0 = (cb - 8) >> 1, pos = row & (SEQ - 1);
                        const f32x2 c0 = cs[pos * 32 + j0], c1 = cs[pos * 32 + j0 + 1], c2 = cs[pos * 32 + j0 + 2], c3 = cs[pos * 32 + j0 + 3];
                        u32x4 w;
                        w.x = cvt_pk_bf16(v0[0] * c0.x - v0[1] * c0.y, v0[0] * c0.y + v0[1] * c0.x);
                        w.y = cvt_pk_bf16(v0[2] * c1.x - v0[3] * c1.y, v0[2] * c1.y + v0[3] * c1.x);
                        w.z = cvt_pk_bf16(v1[0] * c2.x - v1[1] * c2.y, v1[0] * c2.y + v1[1] * c2.x);
                        w.w = cvt_pk_bf16(v1[2] * c3.x - v1[3] * c3.y, v1[2] * c3.y + v1[3] * c3.x);
                        *(u32x4*)(kr + (size_t)row * 64 + (cb - 8)) = w;
                    }
                }
            return;
        }
        size_t off; int ld, c0, act = 0, ssk = 0; float sc = 1.f;
        if (pn < 4) { off = WS_QA; ld = 1024; c0 = pn * 256; sc = CA_SCALE; }
        else if (pn < 8) { off = WS_KA; ld = 1024; c0 = (pn - 4) * 256; }
        else if (pn < 12) { off = WS_Z; ld = 1024; c0 = (pn - 8) * 256; act = 1; }
        else if (pn < 14) { off = WS_QB; ld = 512; c0 = (pn - 12) * 256; }
        else if (pn < 16) { off = WS_KB; ld = 512; c0 = (pn - 14) * 256; }
        else if (pn < 20) { off = WS_VB; ld = 1024; c0 = (pn - 16) * 256; }
        else if (pn < 24) { off = WS_OB; ld = 1024; c0 = (pn - 20) * 256; act = 2; }
        else if (pn < 28) { off = WS_Z + 32 * MiB; ld = 1024; c0 = (pn - 24) * 256; act = 1; }
        else if (pn < 30) { off = WS_CQ; ld = 512; c0 = (pn - 28) * 256; ssk = 1; }
        else if (pn < 31) { off = WS_CKV; ld = 256; c0 = 0; ssk = 2; }
        else if (pn < 35) { off = WS_Z + 64 * MiB; ld = 1024; c0 = (pn - 31) * 256; act = 1; }
        else { off = WS_GT; ld = 6144; c0 = (pn - 35) * 256; act = 2; }
        bf16_t* dst = (bf16_t*)(ws + off); float* ssp = (float*)(ws + WS_SSP) + (ssk == 2 ? 8 : (pn - 28) * 4) + wc;
        const int col0 = c0 + wc * 32 + 8 * fq;
#pragma unroll
        for (int ai = 0; ai < 2; ++ai)
#pragma unroll
            for (int m = 0; m < 4; ++m) {
                const int row = row0 + ai * 128 + m * 16; bf16_t* rowp = dst + (size_t)row * ld + col0; float ss = 0.f;
#pragma unroll
                for (int bj = 0; bj < 2; ++bj) {
                    f32x4 v0 = acc[ai][bj][m][0], v1 = acc[ai][bj][m][1];
                    if (act == 1) {
#pragma unroll
                        for (int i = 0; i < 4; ++i) { v0[i] = fsilu(v0[i]); v1[i] = fsilu(v1[i]); }
                    } else if (act == 2) {
#pragma unroll
                        for (int i = 0; i < 4; ++i) { v0[i] = fsigmoid(v0[i]); v1[i] = fsigmoid(v1[i]); }
                    } else { v0 = v0 * sc; v1 = v1 * sc; }
                    if (ssk) ss += (v0[0] * v0[0] + v0[1] * v0[1]) + (v0[2] * v0[2] + v0[3] * v0[3]) + (v1[0] * v1[0] + v1[1] * v1[1]) + (v1[2] * v1[2] + v1[3] * v1[3]);
                    u32x4 w; w.x = cvt_pk_bf16(v0[0], v0[1]); w.y = cvt_pk_bf16(v0[2], v0[3]); w.z = cvt_pk_bf16(v1[0], v1[1]); w.w = cvt_pk_bf16(v1[2], v1[3]);
                    *(u32x4*)(rowp + bj * 128) = w;
                    if (pn < 4) {
                        u32x4 wl; wl.x = cvt_pk_bf16(v0[0] - bflo(w.x), v0[1] - bfhi(w.x)); wl.y = cvt_pk_bf16(v0[2] - bflo(w.y), v0[3] - bfhi(w.y));
                        wl.z = cvt_pk_bf16(v1[0] - bflo(w.z), v1[1] - bfhi(w.z)); wl.w = cvt_pk_bf16(v1[2] - bflo(w.w), v1[3] - bfhi(w.w));
                        *(u32x4*)((bf16_t*)(ws + WS_QAL) + (size_t)row * 1024 + col0 + bj * 128) = wl; }
                }
                if (ssk) { const int ln = fq * 16 + fr; ss += shx(ss, 16, ln); ss += shx(ss, 32, ln); if (fq == 0) ssp[(size_t)row * 16] = ss; }
            }
    }
};

struct EpiVT {
    static constexpr bool PERM = true, AFTER_DRAIN = false;
    bf16_t* dst; int ld; const float* ss; float inv_n;
    __device__ __forceinline__ void operator()(const f32x4 (&acc)[2][2][4][2], const Unit& u, int wr, int wc, int fr, int fq) const {
        const int row0 = u.pm * 256 + wr * 64 + fr, col0 = u.pn * 256 + wc * 32 + 8 * fq;
        f32x4 s0[2], s1[2];
#pragma unroll
        for (int bj = 0; bj < 2; ++bj) {
            if (ss) { f32x4 a, b;
#pragma unroll
                for (int i = 0; i < 4; ++i) { const f32x4 pa = *(const f32x4*)(ss + (size_t)(col0 + bj * 128 + i) * 16 + 8), pb = *(const f32x4*)(ss + (size_t)(col0 + bj * 128 + 4 + i) * 16 + 8);
                    a[i] = rsqrtf(((pa[0] + pa[1]) + (pa[2] + pa[3])) * inv_n + EPS); b[i] = rsqrtf(((pb[0] + pb[1]) + (pb[2] + pb[3])) * inv_n + EPS); }
                s0[bj] = a; s1[bj] = b; }
            else { s0[bj] = (f32x4){1.f, 1.f, 1.f, 1.f}; s1[bj] = s0[bj]; }
        }
#pragma unroll
        for (int ai = 0; ai < 2; ++ai)
#pragma unroll
            for (int m = 0; m < 4; ++m) {
                bf16_t* rowp = dst + (size_t)(row0 + ai * 128 + m * 16) * ld + col0;
#pragma unroll
                for (int bj = 0; bj < 2; ++bj) {
                    const f32x4 v0 = acc[ai][bj][m][0] * s0[bj], v1 = acc[ai][bj][m][1] * s1[bj];
                    u32x4 w; w.x = cvt_pk_bf16(v0[0], v0[1]); w.y = cvt_pk_bf16(v0[2], v0[3]); w.z = cvt_pk_bf16(v1[0], v1[1]); w.w = cvt_pk_bf16(v1[2], v1[3]);
                    *(u32x4*)(rowp + bj * 128) = w;
                }
            }
    }
};

template <bool ROPE> struct EpiRow {
    static constexpr bool PERM = true, AFTER_DRAIN = false;
    bf16_t* dst; int ld; const float* ss; float inv_n, sc; const f32x2* cs;
    __device__ __forceinline__ void operator()(const f32x4 (&acc)[2][2][4][2], const Unit& u, int wr, int wc, int fr, int fq) const {
        const int row0 = u.pm * 256 + wr * 64 + fr, col0 = u.pn * 256 + wc * 32 + 8 * fq;
#pragma unroll
        for (int ai = 0; ai < 2; ++ai)
#pragma unroll
            for (int m = 0; m < 4; ++m) {
                const int row = row0 + ai * 128 + m * 16; float sq;
                if (ROPE) { const f32x4 pa = *(const f32x4*)(ss + (size_t)row * 16), pb = *(const f32x4*)(ss + (size_t)row * 16 + 4); sq = ((pa[0] + pa[1]) + (pa[2] + pa[3])) + ((pb[0] + pb[1]) + (pb[2] + pb[3])); }
                else { const f32x4 pa = *(const f32x4*)(ss + (size_t)row * 16 + 8); sq = (pa[0] + pa[1]) + (pa[2] + pa[3]); }
                const float rs = rsqrtf(sq * inv_n + EPS) * sc; bf16_t* rowp = dst + (size_t)row * ld + col0;
#pragma unroll
                for (int bj = 0; bj < 2; ++bj) {
                    f32x4 v0 = acc[ai][bj][m][0] * rs, v1 = acc[ai][bj][m][1] * rs; u32x4 w;
                    const int hc = (col0 + bj * 128) % 192;
                    if (ROPE && hc >= 128) {
                        const int j0 = (hc - 128) >> 1, pos = row & (SEQ - 1);
                        const f32x2 c0 = cs[pos * 32 + j0], c1 = cs[pos * 32 + j0 + 1], c2 = cs[pos * 32 + j0 + 2], c3 = cs[pos * 32 + j0 + 3];
                        w.x = cvt_pk_bf16(v0[0] * c0.x - v0[1] * c0.y, v0[0] * c0.y + v0[1] * c0.x);
                        w.y = cvt_pk_bf16(v0[2] * c1.x - v0[3] * c1.y, v0[2] * c1.y + v0[3] * c1.x);
                        w.z = cvt_pk_bf16(v1[0] * c2.x - v1[1] * c2.y, v1[0] * c2.y + v1[1] * c2.x);
                        w.w = cvt_pk_bf16(v1[2] * c3.x - v1[3] * c3.y, v1[2] * c3.y + v1[3] * c3.x);
                    } else { w.x = cvt_pk_bf16(v0[0], v0[1]); w.y = cvt_pk_bf16(v0[2], v0[3]); w.z = cvt_pk_bf16(v1[0], v1[1]); w.w = cvt_pk_bf16(v1[2], v1[3]); }
                    *(u32x4*)(rowp + bj * 128) = w;
                }
            }
    }
};

struct EpiMerge {
    static constexpr bool PERM = true, AFTER_DRAIN = false;
    bf16_t* merged; const bf16_t* gt;
    __device__ __forceinline__ void operator()(const f32x4 (&acc)[2][2][4][2], const Unit& u, int wr, int wc, int fr, int fq) const {
        const int n = u.pm >> 6, pmr = u.pm & 63; const int row0 = pmr * 256 + wr * 64 + fr, col0 = u.pn * 256 + wc * 32 + 8 * fq;
#pragma unroll
        for (int ai = 0; ai < 2; ++ai)
#pragma unroll
            for (int m = 0; m < 4; ++m) {
                const int row = row0 + ai * 128 + m * 16;
#pragma unroll
                for (int bj = 0; bj < 2; ++bj) {
                    const u32x4 gw = *(const u32x4*)(gt + (size_t)row * 6144 + n * 2048 + col0 + bj * 128);
                    bf16_t* mp = merged + (size_t)row * 2048 + col0 + bj * 128;
                    u32x4 pw = (u32x4){0u, 0u, 0u, 0u}; if (n > 0) pw = __builtin_nontemporal_load((const u32x4*)mp);
                    const f32x4 v0 = acc[ai][bj][m][0], v1 = acc[ai][bj][m][1]; u32x4 w;
                    w.x = cvt_pk_bf16(bflo(pw.x) + bflo(gw.x) * v0[0], bfhi(pw.x) + bfhi(gw.x) * v0[1]);
                    w.y = cvt_pk_bf16(bflo(pw.y) + bflo(gw.y) * v0[2], bfhi(pw.y) + bfhi(gw.y) * v0[3]);
                    w.z = cvt_pk_bf16(bflo(pw.z) + bflo(gw.z) * v1[0], bfhi(pw.z) + bfhi(gw.z) * v1[1]);
                    w.w = cvt_pk_bf16(bflo(pw.w) + bflo(gw.w) * v1[2], bfhi(pw.w) + bfhi(gw.w) * v1[3]);
                    *(u32x4*)mp = w;
                }
            }
        asm volatile("s_waitcnt vmcnt(0)" ::: "memory");
    }
};
struct MergeOrder {
    int G, c;
    __device__ bool next(int i, Unit& u) const {
        const int t3 = i / 3, n = i - 3 * t3; const long L = (long)t3 * G + c; if (L >= 512) return false;
        const int tm = (int)(L >> 3), tn = (int)(L & 7); u.pm = n * 64 + tm; u.pn = tn; u.pb = n * 8 + tn; return true;
    }
    __device__ __forceinline__ void a_ready(const Unit&) const {}
    __device__ __forceinline__ void done(const Unit&) const {}
};

struct EpiOut {
    static constexpr bool PERM = false, AFTER_DRAIN = false;
    const float* xin; float* xout;
    __device__ __forceinline__ void operator()(const f32x4 (&acc)[2][2][4][2], const Unit& u, int wr, int wc, int fr, int fq) const {
        const int row0 = u.pm * 256 + wr * 64 + fr, col0 = u.pn * 256 + wc * 32 + 4 * fq;
#pragma unroll
        for (int ai = 0; ai < 2; ++ai)
#pragma unroll
            for (int m = 0; m < 4; ++m) {
                const size_t ro = (size_t)(row0 + ai * 128 + m * 16) * DM + col0;
#pragma unroll
                for (int bj = 0; bj < 2; ++bj)
#pragma unroll
                    for (int n = 0; n < 2; ++n) { const f32x4 b = *(const f32x4*)(xin + ro + bj * 128 + n * 16); *(f32x4*)(xout + ro + bj * 128 + n * 16) = b + acc[ai][bj][m][n]; }
            }
    }
};

template <class F> __device__ __forceinline__ void tconv(unsigned char* lds, const float* src, int ldsrc, int K, bf16_t* dst, int N, const float* gain, F f, const int g_wv) {
    float* tile = (float*)lds; int tid = TIDX; asm volatile("" : "+v"(tid)); const int tilesK = K >> 6, ntile = tilesK * (N >> 8);
    const int nn4 = (tid & 63) * 4, kk0 = tid >> 6; f32x4 pre[8];
#define TCONV_LOAD(tt_) do { const int tn_ = (tt_) / tilesK, tk_ = (tt_) - tn_ * tilesK; const int c0 = f(tn_ * 256 + nn4), c1 = f(tn_ * 256 + nn4 + 1), c2 = f(tn_ * 256 + nn4 + 2), c3 = f(tn_ * 256 + nn4 + 3); \
        const bool vec = (c0 >= 0) && ((c0 & 3) == 0) && (c3 == c0 + 3); const float* sp = src + (size_t)(tk_ * 64 + kk0) * ldsrc; \
        _Pragma("unroll") for (int e = 0; e < 8; ++e) { const float* rp = sp + (size_t)(8 * e) * ldsrc; f32x4 v; \
            if (vec) v = *(const f32x4*)(rp + c0); \
            else { v[0] = c0 >= 0 ? rp[c0] : 0.f; v[1] = c1 >= 0 ? rp[c1] : 0.f; v[2] = c2 >= 0 ? rp[c2] : 0.f; v[3] = c3 >= 0 ? rp[c3] : 0.f; } \
            pre[e] = v; } } while (0)
    int t = blockIdx.x;
    if (t < ntile) TCONV_LOAD(t);
    for (; t < ntile; t += gridDim.x) {
        const int tn = t / tilesK, tk = t - tn * tilesK;
#pragma unroll
        for (int e = 0; e < 8; ++e) { f32x4 v = pre[e]; if (gain) v = v * gain[tk * 64 + kk0 + 8 * e]; *(f32x4*)(tile + (kk0 + 8 * e) * 260 + nn4) = v; }
        __syncthreads();
        { const int t2 = t + (int)gridDim.x; if (t2 < ntile) TCONV_LOAD(t2); }
        { const int nn = tid >> 1, kc = (tid & 1) * 32; bf16_t* dp = dst + (size_t)(tn * 256 + nn) * K + tk * 64 + kc;
#pragma unroll
          for (int q4 = 0; q4 < 4; ++q4) { float v[8];
#pragma unroll
              for (int i = 0; i < 8; ++i) v[i] = tile[(kc + q4 * 8 + i) * 260 + nn];
              u32x4 w; w.x = cvt_pk_bf16(v[0], v[1]); w.y = cvt_pk_bf16(v[2], v[3]); w.z = cvt_pk_bf16(v[4], v[5]); w.w = cvt_pk_bf16(v[6], v[7]);
              *(u32x4*)(dp + q4 * 8) = w; } }
        __syncthreads();
    }
#undef TCONV_LOAD
}
__device__ __forceinline__ int win_src_col(int n) {
    if (n < 1024) return n;
    if (n < 2048) return 1024 + (n - 1024);
    if (n < 3072) return 3072 + (n - 2048);
    if (n < 3584) return 4096 + (n - 3072);
    if (n < 4096) return 4608 + (n - 3584);
    if (n < 5120) return 5120 + (n - 4096);
    if (n < 6144) return 6152 + (n - 5120);
    if (n < 7168) return 7176 + (n - 6144);
    if (n < 7680) return 8200 + (n - 7168);
    if (n < 7936) return 8712 + (n - 7680);
    if (n < 8960) return 9032 + (n - 7936);
    if (n < 15104) return 10056 + (n - 8960);
    if (n < 15360) { const int r = n - 15104; if (r < 4) return 6144 + r; if (r < 8) return 6148 + (r - 4); if (r < 72) { const int j = (r - 8) >> 1, odd = (r - 8) & 1; return 8968 + j + 32 * odd; } return -1; }
    return 2048 + (n - 15360);
}
__device__ __forceinline__ void convert_weights(unsigned char* lds, const Params& p, int l, const int g_wv) {
    unsigned char* wl = p.ws + WS_W0 + (size_t)l * WL_SIZE;
    tconv(lds, p.w_in + (size_t)l * DM * DIN, DIN, DM, (bf16_t*)(wl + WL_WIN), 16384, nullptr, [](int n) { return win_src_col(n); }, g_wv);
#pragma unroll 1
    for (int n = 0; n < 3; ++n)
        tconv(lds, p.w_branch + ((size_t)l * 3 + n) * 1024 * DM, DM, 1024, (bf16_t*)(wl + WL_WB) + (size_t)n * 2048 * 1024, 2048, nullptr, [](int c) { return c; }, g_wv);
    tconv(lds, p.w_out + (size_t)l * DM * DM, DM, DM, (bf16_t*)(wl + WL_WO), DM, nullptr, [](int c) { return c; }, g_wv);
    tconv(lds, p.w_uq + (size_t)l * 512 * 1536, 1536, 512, (bf16_t*)(wl + WL_WUQ), 1536, p.q_norm + l * 512,
          [](int n) { const int h = n / 192, hc = n - h * 192; if (hc < 128) return n; const int r = hc - 128; return h * 192 + 128 + (r >> 1) + 32 * (r & 1); }, g_wv);
    tconv(lds, p.w_ukv + (size_t)l * 256 * 2048, 2048, 256, (bf16_t*)(wl + WL_WKN), 1024, p.kv_norm + l * 256, [](int n) { return (n >> 7) * 256 + (n & 127); }, g_wv);
    tconv(lds, p.w_ukv + (size_t)l * 256 * 2048, 2048, 256, (bf16_t*)(wl + WL_WV), 1024, p.kv_norm + l * 256, [](int n) { return (n >> 7) * 256 + 128 + (n & 127); }, g_wv);
}
__device__ __forceinline__ void sincos_acc(float ang, float& s, float& c) {
    const double x = (double)ang; const double q = rint(x * 0.63661977236758134308);
    double r = fma(-q, 1.57079632679489655800e+00, x); r = fma(-q, 6.12323399573676603587e-17, r);
    const int qi = ((int)q) & 3; const double r2 = r * r;
    const double sp = r + r * r2 * (-1.66666666666666324348e-01 + r2 * (8.33333333332248946124e-03 + r2 * (-1.98412698298579493134e-04 + r2 * (2.75573137070700676789e-06 + r2 * (-2.50507602534068634195e-08 + r2 * 1.58969099521155010221e-10)))));
    const double cp = 1.0 - 0.5 * r2 + r2 * r2 * (4.16666666666666019037e-02 + r2 * (-1.38888888888741095749e-03 + r2 * (2.48015872894767294178e-05 + r2 * (-2.75573143513906633035e-07 + r2 * (2.08757232129817482790e-09 + r2 * -1.13596475577881948265e-11)))));
    double ss, cc; if (qi == 0) { ss = sp; cc = cp; } else if (qi == 1) { ss = cp; cc = -sp; } else if (qi == 2) { ss = -sp; cc = -cp; } else { ss = -cp; cc = sp; }
    s = (float)ss; c = (float)cc;
}
__device__ __forceinline__ void build_cs(const Params& p, const int g_wv) {
    f32x2* cs = (f32x2*)(p.ws + WS_CS);
    int i0 = blockIdx.x * NTHR + TIDX; asm volatile("" : "+v"(i0));
    for (int i = i0; i < SEQ * 32; i += gridDim.x * NTHR) {
        const int pos = i >> 5, j = i & 31; double inv = 1.0; for (int k = 0; k < j; ++k) inv *= 0.7498942093324558;
        const float ang = (float)pos * (float)inv; float s, c; sincos_acc(ang, s, c); cs[i] = (f32x2){c, s};
    }
}
__device__ __forceinline__ void zero_ss(const Params& p, const int g_wv) {
    float* a = (float*)(p.ws + WS_SSQ);
    int i0 = blockIdx.x * NTHR + TIDX; asm volatile("" : "+v"(i0));
    for (int i = i0; i < 2 * T; i += gridDim.x * NTHR) a[i] = 0.f;
}
template <bool OUTBF> __device__ __forceinline__ void rmsnorm_rows(const float* x, const float* gain, bf16_t* hb, float* of, const int g_wv) {
    int tid = TIDX; asm volatile("" : "+v"(tid)); const int lane = tid & 63, gw = blockIdx.x * (NTHR / 64) + (tid >> 6), nw = gridDim.x * (NTHR / 64);
    for (int row = gw; row < T; row += nw) {
        const float* xr = x + (size_t)row * DM; f32x4 v[8]; float ss = 0.f;
#pragma unroll
        for (int i = 0; i < 8; ++i) { v[i] = *(const f32x4*)(xr + i * 256 + lane * 4); ss += (v[i][0] * v[i][0] + v[i][1] * v[i][1]) + (v[i][2] * v[i][2] + v[i][3] * v[i][3]); }
#pragma unroll
        for (int o = 1; o < 64; o <<= 1) ss += shx(ss, o, lane);
        const float rs = rsqrtf(ss * (1.0f / DM) + EPS);
#pragma unroll
        for (int i = 0; i < 8; ++i) {
            const f32x4 gn = *(const f32x4*)(gain + i * 256 + lane * 4); const f32x4 y = v[i] * rs * gn;
            if (OUTBF) { u32x2 w; w.x = cvt_pk_bf16(y[0], y[1]); w.y = cvt_pk_bf16(y[2], y[3]); *(u32x2*)(hb + (size_t)row * DM + i * 256 + lane * 4) = w; }
            else *(f32x4*)(of + (size_t)row * DM + i * 256 + lane * 4) = y;
        }
    }
}

__device__ __forceinline__ void kmean_phase(const Params& p, int l, const int g_wv) {
    const bf16_t* ka = (const bf16_t*)(p.ws + WS_KA); bf16_t* km = (bf16_t*)(p.ws + WS_KM); bf16_t* kml = (bf16_t*)(p.ws + WS_SSQ); int tid = TIDX; asm volatile("" : "+v"(tid));
    for (int u = (gridDim.x == 256) ? (int)blockIdx.x - 192 : (int)blockIdx.x; u < 64; u += gridDim.x) { if (u < 0) continue;
        const int b = u >> 4, j = u & 15; const unsigned* src = (const unsigned*)(ka + ((size_t)b * SEQ + j * 256) * 1024) + tid; float a0 = 0.f, a1 = 0.f;
#pragma unroll 8
        for (int r = 0; r < 256; ++r) { const unsigned w = src[(size_t)r * 512]; a0 += bflo(w); a1 += bfhi(w); }
        const int col = tid * 2, h = col >> 7, d = col & 127;
        const float m0 = a0 * (1.0f / 256.0f), m1 = a1 * (1.0f / 256.0f); const unsigned hi = cvt_pk_bf16(m0, m1);
        *(unsigned*)(km + ((size_t)((b * 8 + h) * 16 + j)) * 128 + d) = hi;
        *(unsigned*)(kml + ((size_t)((b * 8 + h) * 16 + j)) * 128 + d) = cvt_pk_bf16(m0 - bflo(hi), m1 - bfhi(hi));
    }
}

template <int MODE> __device__ __forceinline__ void attn_phase(unsigned char* lds, const Params& p, int l, const int g_wv) {
    constexpr int DQK = MODE ? 192 : 128, NC = DQK / 32, NCH = DQK / 8, KRS = DQK * 2 + 32, KBUF = 64 * KRS, VRS = 144, VBUF = 128 * VRS;
    constexpr int OFF_V = 2 * KBUF, OFF_LUT = OFF_V + 2 * VBUF, OFF_KM = OFF_LUT + 512, NKL = (64 * NCH) / NTHR;
    int tid = TIDX; asm volatile("" : "+v"(tid)); const int lane = tid & 63, w = tid >> 6, lr = lane & 15, g = lane >> 4; const int G = gridDim.x, c = blockIdx.x;
    unsigned char* ws = p.ws;
    const bf16_t* Qp = (const bf16_t*)(ws + (MODE ? WS_QC : WS_QA)); constexpr int LDQ = MODE ? 1536 : 1024;
    const bf16_t* Kp = (const bf16_t*)(ws + (MODE ? WS_KNC : WS_KA)); const bf16_t* KRp = (const bf16_t*)(ws + WS_KR);
    const bf16_t* VTp = (const bf16_t*)(ws + (MODE ? WS_VCT : WS_VAT)); bf16_t* Zp = (bf16_t*)(ws + WS_Z + (MODE ? 64 * MiB : 0));
    float* lut = (float*)(lds + OFF_LUT);
    for (int rd = 0; rd * G < 512; ++rd) {
        int qblk, bh;
        if (G == 256) {
            const int xq = c & 7, iq = c >> 3, qq = iq >> 1;
            bh = 2 * xq + (iq & 1) + 16 * rd; qblk = rd ? qq : 15 - qq;
        } else { const int idx = rd * G + ((rd & 1) ? (G - 1 - c) : c); if (idx >= 512) continue; qblk = 15 - (idx >> 5); bh = idx & 31; }
        const int b = bh >> 3, h = bh & 7;
        const int q0 = qblk * 256 + w * 32; const size_t tq = (size_t)b * SEQ + q0; const int nt = (qblk + 1) * 4;
        bf16x8 qf[2][NC];
#pragma unroll
        for (int qb = 0; qb < 2; ++qb)
#pragma unroll
            for (int c2 = 0; c2 < NC; ++c2) qf[qb][c2] = *(const bf16x8*)(Qp + (tq + qb * 16 + lr) * LDQ + h * DQK + c2 * 32 + g * 8);
        u32x4 kreg[NKL];
#define ATT_LOADK(t_) do { const int t__ = (t_); \
        _Pragma("unroll") for (int i = 0; i < NKL; ++i) { const int id = tid + NTHR * i; const int key = id / NCH, ch = id - key * NCH; const size_t tk = (size_t)b * SEQ + t__ * 64 + key; \
            const bf16_t* s_ = (!MODE || ch < 16) ? (Kp + tk * 1024 + h * 128 + ch * 8) : (KRp + tk * 64 + (ch - 16) * 8); kreg[i] = *(const u32x4*)s_; } } while (0)
#define ATT_LOADV(t_) do { const int t__ = (t_); \
        _Pragma("unroll") for (int i = 0; i < 2; ++i) { const int id = tid + NTHR * i; const int row = id >> 3, ch = id & 7; \
            kreg[i] = *(const u32x4*)(VTp + (size_t)(h * 128 + row) * T + (size_t)b * SEQ + t__ * 64 + ch * 8); } } while (0)
#define ATT_STOREK(buf_) do { unsigned char* kb_ = lds + (buf_) * KBUF; \
        _Pragma("unroll") for (int i = 0; i < NKL; ++i) { const int id = tid + NTHR * i; const int key = id / NCH, ch = id - key * NCH; *(u32x4*)(kb_ + key * KRS + ch * 16) = kreg[i]; } } while (0)
#define ATT_STOREV(buf_) do { unsigned char* vb_ = lds + OFF_V + (buf_) * VBUF; \
        _Pragma("unroll") for (int i = 0; i < 2; ++i) { const int id = tid + NTHR * i; const int row = id >> 3, ch = id & 7; *(u32x4*)(vb_ + row * VRS + ch * 16) = kreg[i]; } } while (0)
        ATT_LOADK(0); ATT_STOREK(0); ATT_LOADV(0);
        unsigned sel[2] = {0u, 0u};
        if (MODE == 0) {
            if (tid < 128) { const int d = tid; int bk = d; if (d >= 16) { bk = 16 + (int)(logf((float)d * (1.0f / 16.0f)) / 2.0794415416798357f * 16.0f); bk = bk > 31 ? 31 : bk; } lut[d] = p.t5[bk * 8 + h] * LOG2E; }
            { const int half = tid >> 8, row = (tid >> 4) & 15, ch = tid & 15; *(u32x4*)(lds + OFF_KM + half * 4608 + row * 288 + ch * 16) = *(const u32x4*)((const bf16_t*)(ws + (half ? WS_SSQ : WS_KM)) + ((size_t)((b * 8 + h) * 16 + row)) * 128 + ch * 8); }
        }
        ATT_STOREV(0);
        __syncthreads();
        if (MODE == 0) {
            f32x4 ga[2] = {zero4(), zero4()};
#pragma unroll
            for (int c2 = 0; c2 < NC; ++c2) { const bf16x8 kf = *(const bf16x8*)(lds + OFF_KM + lr * 288 + c2 * 64 + g * 16), kfl = *(const bf16x8*)(lds + OFF_KM + 4608 + lr * 288 + c2 * 64 + g * 16);
#pragma unroll
                for (int qb = 0; qb < 2; ++qb) { const bf16x8 ql = *(const bf16x8*)((const bf16_t*)(ws + WS_QAL) + (tq + qb * 16 + lr) * 1024 + h * 128 + c2 * 32 + g * 8);
                    ga[qb] = mfma16(kfl, qf[qb][c2], ga[qb]); ga[qb] = mfma16(kf, ql, ga[qb]); ga[qb] = mfma16(kf, qf[qb][c2], ga[qb]); } }
#pragma unroll
            for (int qb = 0; qb < 2; ++qb) {
                float gv[4];
#pragma unroll
                for (int r = 0; r < 4; ++r) gv[r] = (g * 4 + r < qblk) ? ga[qb][r] : -INFINITY;
                unsigned s = 0u;
#pragma unroll
                for (int it = 0; it < 3; ++it) {
                    float bv = -INFINITY; int bi = 99;
#pragma unroll
                    for (int r = 0; r < 4; ++r) if (gv[r] > bv) { bv = gv[r]; bi = g * 4 + r; }
#pragma unroll
                    for (int o = 16; o <= 32; o <<= 1) { const float ov = shx(bv, o, lane); const int oi = shxi(bi, o, lane); if (ov > bv || (ov == bv && oi < bi)) { bv = ov; bi = oi; } }
                    if (bv > -INFINITY) s |= 1u << bi;
#pragma unroll
                    for (int r = 0; r < 4; ++r) if (g * 4 + r == bi) gv[r] = -INFINITY;
                }
                sel[qb] = s;
            }
        }
        f32x4 oacc[8][2];
#pragma unroll
        for (int i = 0; i < 8; ++i) { oacc[i][0] = zero4(); oacc[i][1] = zero4(); }
        float mrow[2] = {NEGV, NEGV}, lrow[2] = {0.f, 0.f};
        for (int t = 0; t < nt; ++t) {
            const int buf = t & 1; const bool more = (t + 1 < nt);
            if (more) ATT_LOADK(t + 1);
            const int k0 = t * 64;
            const unsigned char* kb_ = lds + buf * KBUF; const unsigned char* vb_ = lds + OFF_V + buf * VBUF;
#pragma unroll 1
            for (int hf = 0; hf < 2; ++hf) {
              const int kh = k0 + hf * 32;
              if (kh <= q0 + 31) {
                f32x4 sacc[2][2];
#pragma unroll
                for (int kb = 0; kb < 2; ++kb) { sacc[kb][0] = zero4(); sacc[kb][1] = zero4(); }
#pragma unroll
                for (int c2 = 0; c2 < NC; ++c2)
#pragma unroll
                    for (int kb = 0; kb < 2; ++kb) { const bf16x8 kf = *(const bf16x8*)(kb_ + (hf * 32 + kb * 16 + lr) * KRS + c2 * 64 + g * 16);
                        sacc[kb][0] = mfma16(kf, qf[0][c2], sacc[kb][0]); sacc[kb][1] = mfma16(kf, qf[1][c2], sacc[kb][1]); }
                if (MODE == 0) {
                    const int jblk = t >> 2; const bool far = (kh + 31 + 127 <= q0);
                    if (far) { const float bfar = lut[127];
#pragma unroll
                        for (int qb = 0; qb < 2; ++qb) { const bool al = (jblk < qblk) ? (((sel[qb] >> jblk) & 1u) != 0u) : true;
#pragma unroll
                            for (int kb = 0; kb < 2; ++kb)
#pragma unroll
                                for (int r = 0; r < 4; ++r) sacc[kb][qb][r] = al ? sacc[kb][qb][r] + bfar : NEGV; }
                    } else {
#pragma unroll
                        for (int qb = 0; qb < 2; ++qb) { const int qpos = q0 + qb * 16 + lr; const bool alp = (sel[qb] >> jblk) & 1u;
#pragma unroll
                            for (int kb = 0; kb < 2; ++kb)
#pragma unroll
                                for (int r = 0; r < 4; ++r) { const int d = qpos - (kh + kb * 16 + g * 4 + r); const int di = d < 0 ? 0 : (d > 127 ? 127 : d);
                                    const bool al = (jblk < qblk) ? alp : (d >= 0); sacc[kb][qb][r] = al ? sacc[kb][qb][r] + lut[di] : NEGV; } }
                    }
                } else {
                    if (kh + 31 > q0) {
#pragma unroll
                        for (int qb = 0; qb < 2; ++qb) { const int qpos = q0 + qb * 16 + lr;
#pragma unroll
                            for (int kb = 0; kb < 2; ++kb)
#pragma unroll
                                for (int r = 0; r < 4; ++r) if (kh + kb * 16 + g * 4 + r > qpos) sacc[kb][qb][r] = NEGV; }
                    }
                }
                bf16x8 pf[2];
#pragma unroll
                for (int qb = 0; qb < 2; ++qb) {
                    float mx = NEGV;
#pragma unroll
                    for (int kb = 0; kb < 2; ++kb)
#pragma unroll
                        for (int r = 0; r < 4; ++r) mx = fmaxf(mx, sacc[kb][qb][r]);
                    float mnew = mrow[qb];
                    if (__builtin_amdgcn_ballot_w64(mx > mrow[qb] + 8.0f) != 0ull) {
                        mx = fmaxf(mx, shx(mx, 16, lane)); mx = fmaxf(mx, shx(mx, 32, lane));
                        mnew = fmaxf(mrow[qb], mx); const float alpha = fexp2(mrow[qb] - mnew); mrow[qb] = mnew; lrow[qb] *= alpha;
#pragma unroll
                        for (int i = 0; i < 8; ++i) oacc[i][qb] = oacc[i][qb] * alpha;
                    }
                    float ps = 0.f;
#pragma unroll
                    for (int kb = 0; kb < 2; ++kb)
#pragma unroll
                        for (int r = 0; r < 4; ++r) { const float e = fexp2(sacc[kb][qb][r] - mnew); sacc[kb][qb][r] = e; ps += e; }
                    lrow[qb] += ps;
                    union { u32x4 u; bf16x8 v; } cvt;
                    cvt.u.x = cvt_pk_bf16(sacc[0][qb][0], sacc[0][qb][1]); cvt.u.y = cvt_pk_bf16(sacc[0][qb][2], sacc[0][qb][3]);
                    cvt.u.z = cvt_pk_bf16(sacc[1][qb][0], sacc[1][qb][1]); cvt.u.w = cvt_pk_bf16(sacc[1][qb][2], sacc[1][qb][3]); pf[qb] = cvt.v;
                }
#pragma unroll
                for (int dvb = 0; dvb < 8; ++dvb) { union { u32x2 u[2]; bf16x8 v; } vf; const unsigned char* vp = vb_ + (dvb * 16 + lr) * VRS + (hf * 32 + g * 4) * 2;
                    vf.u[0] = *(const u32x2*)vp; vf.u[1] = *(const u32x2*)(vp + 32);
                    oacc[dvb][0] = mfma16(vf.v, pf[0], oacc[dvb][0]); oacc[dvb][1] = mfma16(vf.v, pf[1], oacc[dvb][1]); }
              }
              if (more) { if (hf == 0) { ATT_STOREK(buf ^ 1); ATT_LOADV(t + 1); } else { ATT_STOREV(buf ^ 1); } }
            }
            __syncthreads();
        }
#pragma unroll
        for (int qb = 0; qb < 2; ++qb) {
            float l = lrow[qb]; l += shx(l, 16, lane); l += shx(l, 32, lane); const float inv = 1.0f / l;
            bf16_t* zr = Zp + (tq + qb * 16 + lr) * 1024 + h * 128 + g * 4;
#pragma unroll
            for (int dvb = 0; dvb < 8; ++dvb) { const u32x2 zw = *(const u32x2*)(zr + dvb * 16); const f32x4 o = oacc[dvb][qb] * inv; u32x2 ow;
                ow.x = cvt_pk_bf16(o[0] * bflo(zw.x), o[1] * bfhi(zw.x)); ow.y = cvt_pk_bf16(o[2] * bflo(zw.y), o[3] * bfhi(zw.y)); *(u32x2*)(zr + dvb * 16) = ow; }
        }
#undef ATT_LOADK
#undef ATT_LOADV
#undef ATT_STOREK
#undef ATT_STOREV
    }
}

__device__ __forceinline__ void mlstm_a(unsigned char* lds, const Params& p, int l, const int g_wv) {
    constexpr int K2RS = 272, TRS = 160; constexpr int OFF_K2 = 0, OFF_WKT = 64 * K2RS, OFF_VT = OFF_WKT + 128 * TRS, OFF_WG = OFF_VT + 256 * TRS;
    unsigned char* ws = p.ws; int tid = TIDX; asm volatile("" : "+v"(tid)); const int lane = tid & 63, w = tid >> 6, lr = lane & 15, g = lane >> 4;
    const bf16_t* QB = (const bf16_t*)(ws + WS_QB); const bf16_t* KB = (const bf16_t*)(ws + WS_KB); const bf16_t* VB = (const bf16_t*)(ws + WS_VB);
    bf16_t* Q2 = (bf16_t*)(ws + WS_Q2); bf16_t* K2 = (bf16_t*)(ws + WS_K2); const float* gates = (const float*)(ws + WS_GATES);
    const float* cw = p.conv_w + (size_t)l * 4 * 1024; const float* cb = p.conv_b + (size_t)l * 1024;
    float* wg = (float*)(lds + OFF_WG);
    for (int ku = 0; ; ++ku) { int u; { const int cb_ = blockIdx.x; if (gridDim.x == 256) { if (ku >= (cb_ < 128 ? 3 : 5)) break; u = cb_ < 128 ? cb_ + 128 * ku : 384 + (cb_ - 128) + 128 * ku; } else { u = cb_ + ku * (int)gridDim.x; if (u >= 1024) break; } }
        const int bh = u >> 6, c = u & 63, b = bh >> 2, h = bh & 3; const size_t t0 = (size_t)b * SEQ + c * 64;
#pragma unroll 1
        for (int it = 0; it < 4; ++it) {
            const int item = tid + NTHR * it, which = item >> 10, s = (item >> 4) & 63, grp = item & 15; const int ch0 = h * 128 + grp * 8, cc0 = which * 512 + ch0;
            const bf16_t* src = which ? KB : QB; float a[8];
            { const f32x4 b0 = *(const f32x4*)(cb + cc0), b1 = *(const f32x4*)(cb + cc0 + 4); a[0] = b0[0]; a[1] = b0[1]; a[2] = b0[2]; a[3] = b0[3]; a[4] = b1[0]; a[5] = b1[1]; a[6] = b1[2]; a[7] = b1[3]; }
#pragma unroll
            for (int j = 0; j < 4; ++j) { const int tp = c * 64 + s - 3 + j;
                if (tp >= 0) { const u32x4 xw = *(const u32x4*)(src + ((size_t)b * SEQ + tp) * 512 + ch0); const f32x4 w0 = *(const f32x4*)(cw + j * 1024 + cc0), w1 = *(const f32x4*)(cw + j * 1024 + cc0 + 4);
                    a[0] += bflo(xw.x) * w0[0]; a[1] += bfhi(xw.x) * w0[1]; a[2] += bflo(xw.y) * w0[2]; a[3] += bfhi(xw.y) * w0[3];
                    a[4] += bflo(xw.z) * w1[0]; a[5] += bfhi(xw.z) * w1[1]; a[6] += bflo(xw.w) * w1[2]; a[7] += bfhi(xw.w) * w1[3]; } }
            const float ksc = which ? 0.08838834764831845f : 1.0f;
#pragma unroll
            for (int i = 0; i < 8; ++i) a[i] = fsilu(a[i]) * ksc;
            u32x4 ow; ow.x = cvt_pk_bf16(a[0], a[1]); ow.y = cvt_pk_bf16(a[2], a[3]); ow.z = cvt_pk_bf16(a[4], a[5]); ow.w = cvt_pk_bf16(a[6], a[7]);
            *(u32x4*)((which ? K2 : Q2) + (t0 + s) * 512 + ch0) = ow;
            if (which) *(u32x4*)(lds + OFF_K2 + s * K2RS + grp * 16) = ow;
        }
        if (w == 0) {
            const float fpre = gates[(t0 + lane) * 8 + 4 + h] + p.f_bias[l * 4 + h]; const float li = gates[(t0 + lane) * 8 + h] + p.i_bias[l * 4 + h];
            const float lf = fminf(fpre, 0.f) - log1pf(__expf(-fabsf(fpre)));
            float bc = lf;
#pragma unroll
            for (int o = 1; o < 64; o <<= 1) { const float v = shup(bc, o, lane); if (lane >= o) bc += v; }
            const float blast = __int_as_float(__builtin_amdgcn_readlane(__float_as_int(bc), 63)); const float gg = blast - bc + li; float gm = gg;
#pragma unroll
            for (int o = 1; o < 64; o <<= 1) gm = fmaxf(gm, shx(gm, o, lane));
            wg[lane] = __expf(gg - gm);
            ((float*)(ws + WS_BV))[(size_t)u * 64 + lane] = bc; ((float*)(ws + WS_LIV))[(size_t)u * 64 + lane] = li;
            if (lane == 0) { ((float*)(ws + WS_BLAST))[u] = blast; ((float*)(ws + WS_GMAX))[u] = gm; }
        }
#pragma unroll
        for (int it = 0; it < 4; ++it) { const int item = tid + NTHR * it, s = item & 63, eg = item >> 6; const u32x4 vw = *(const u32x4*)(VB + (t0 + s) * 1024 + h * 256 + eg * 8);
            bf16_t* d = (bf16_t*)(lds + OFF_VT + (eg * 8) * TRS + s * 2); const unsigned vv[4] = {vw.x, vw.y, vw.z, vw.w};
#pragma unroll
            for (int i = 0; i < 4; ++i) { *(bf16_t*)((unsigned char*)d + (2 * i) * TRS) = (bf16_t)(vv[i] & 0xffffu); *(bf16_t*)((unsigned char*)d + (2 * i + 1) * TRS) = (bf16_t)(vv[i] >> 16); } }
        __syncthreads();
#pragma unroll 1
        for (int it = 0; it < 2; ++it) { const int item = tid + NTHR * it, s = item & 63, dg = item >> 6; const u32x4 kw = *(const u32x4*)(lds + OFF_K2 + s * K2RS + dg * 16); const float ww = wg[s];
            const unsigned kv[4] = {kw.x, kw.y, kw.z, kw.w}; unsigned char* d = lds + OFF_WKT + (dg * 8) * TRS + s * 2;
#pragma unroll
            for (int i = 0; i < 4; ++i) { *(bf16_t*)(d + (2 * i) * TRS) = f2bf(bflo(kv[i]) * ww); *(bf16_t*)(d + (2 * i + 1) * TRS) = f2bf(bfhi(kv[i]) * ww); } }
        __syncthreads();
#if defined(MK_DEBUG_HASH)
        { unsigned char* dbg = ws + WS_END + MiB + (size_t)u * 40960; for (int i = tid; i < 2560; i += NTHR) *(u32x4*)(dbg + i * 16) = *(const u32x4*)(lds + OFF_VT + i * 16); }
#endif
        if (tid < 128) { float a = 0.f; const unsigned char* r = lds + OFF_WKT + tid * TRS;
#pragma unroll
            for (int i = 0; i < 8; ++i) { const u32x4 x = *(const u32x4*)(r + i * 16); a += (bflo(x.x) + bfhi(x.x)) + (bflo(x.y) + bfhi(x.y)) + (bflo(x.z) + bfhi(x.z)) + (bflo(x.w) + bfhi(x.w)); }
            ((float*)(ws + WS_NST))[(size_t)u * 128 + tid] = a; }
        f32x4 acc[8][2];
#pragma unroll
        for (int i = 0; i < 8; ++i) { acc[i][0] = zero4(); acc[i][1] = zero4(); }
#pragma unroll
        for (int kc = 0; kc < 2; ++kc) {
            const bf16x8 v0 = *(const bf16x8*)(lds + OFF_VT + (w * 32 + lr) * TRS + kc * 64 + g * 16), v1 = *(const bf16x8*)(lds + OFF_VT + (w * 32 + 16 + lr) * TRS + kc * 64 + g * 16);
#pragma unroll
            for (int db = 0; db < 8; ++db) { const bf16x8 kf = *(const bf16x8*)(lds + OFF_WKT + (db * 16 + lr) * TRS + kc * 64 + g * 16); acc[db][0] = mfma16(kf, v0, acc[db][0]); acc[db][1] = mfma16(kf, v1, acc[db][1]); }
        }
        bf16_t* cst = (bf16_t*)(ws + WS_CST) + (size_t)u * 32768; float one = 1.0f; asm volatile("" : "+v"(one));
#pragma unroll
        for (int eb = 0; eb < 2; ++eb)
#pragma unroll
            for (int db = 0; db < 8; ++db) { const f32x4 av = acc[db][eb] * one; u32x2 o; o.x = cvt_pk_bf16(av[0], av[1]); o.y = cvt_pk_bf16(av[2], av[3]); *(u32x2*)(cst + (size_t)(w * 32 + eb * 16 + lr) * 128 + db * 16 + g * 4) = o; }
        __syncthreads();
    }
}
__device__ __forceinline__ void mlstm_b(const Params& p, const int g_wv) {
    unsigned char* ws = p.ws; int tid = TIDX; asm volatile("" : "+v"(tid)); const float* blast = (const float*)(ws + WS_BLAST); const float* gmax = (const float*)(ws + WS_GMAX);
    for (int u = blockIdx.x; u < 256; u += gridDim.x) {
        const int bh = u >> 4, eb = u & 15; bf16_t* base = (bf16_t*)(ws + WS_CST) + (size_t)bh * 64 * 32768 + eb * 2048 + tid * 4;
        float* nb = (float*)(ws + WS_NST) + (size_t)bh * 64 * 128 + tid; const bool don = (eb == 0 && tid < 128);
        float m = 0.f, c0 = 0.f, c1 = 0.f, c2 = 0.f, c3 = 0.f, nn = 0.f;
#pragma unroll 16
        for (int c = 0; c < 64; ++c) {
            const float bl = blast[bh * 64 + c], gm = gmax[bh * 64 + c]; const float mn = fmaxf(bl + m, gm); const float dec = __expf(bl + m - mn), inw = __expf(gm - mn);
            u32x2* sp = (u32x2*)(base + (size_t)c * 32768); const u32x2 uw = *sp; u32x2 o; o.x = cvt_pk_bf16(c0, c1); o.y = cvt_pk_bf16(c2, c3); *sp = o;
            c0 = dec * c0 + inw * bflo(uw.x); c1 = dec * c1 + inw * bfhi(uw.x); c2 = dec * c2 + inw * bflo(uw.y); c3 = dec * c3 + inw * bfhi(uw.y);
            if (don) { const float nu = nb[c * 128]; nb[c * 128] = nn; nn = dec * nn + inw * nu; }
            if (eb == 0 && tid == 0) ((float*)(ws + WS_MST))[bh * 64 + c] = m;
            m = mn;
        }
        asm volatile("s_waitcnt vmcnt(0)" ::: "memory"); __syncthreads();
        if (tid == 0) { __builtin_amdgcn_fence(__ATOMIC_RELEASE, "agent"); asm volatile("s_waitcnt vmcnt(0)" ::: "memory");
            __hip_atomic_fetch_add((unsigned*)(ws + WS_CTR) + 16 + bh, 1u, __ATOMIC_RELAXED, __HIP_MEMORY_SCOPE_AGENT); }
    }
}
__device__ __forceinline__ void mlstm_c(unsigned char* lds, const Params& p, int l, const int g_wv) {
    constexpr int QRS = 288, TRS = 160; constexpr int OFF_Q = 0, OFF_K = 64 * QRS, OFF_VT = 2 * 64 * QRS, OFF_P = OFF_VT + 256 * TRS, OFF_F = OFF_P + 64 * TRS;
    unsigned char* ws = p.ws; int tid = TIDX; asm volatile("" : "+v"(tid)); const int lane = tid & 63, w = tid >> 6, lr = lane & 15, g = lane >> 4;
    const bf16_t* Q2 = (const bf16_t*)(ws + WS_Q2); const bf16_t* K2 = (const bf16_t*)(ws + WS_K2); const bf16_t* VB = (const bf16_t*)(ws + WS_VB);
    const bf16_t* OB = (const bf16_t*)(ws + WS_OB); bf16_t* ZB = (bf16_t*)(ws + WS_Z + 32 * MiB); const float* gn = p.out_norm + (size_t)l * 1024;
    float* fb = (float*)(lds + OFF_F); float* bvec = fb; float* livec = fb + 64; float* mt = fb + 128; float* wint = fb + 192; float* denV = fb + 256; float* denC = fb + 320; float* lsum = fb + 384; float* lsq = fb + 448; float* nvec = fb + 512;
    for (int u = blockIdx.x; u < 1024; u += gridDim.x) {
        const int bh = u >> 6, c = u & 63, b = bh >> 2, h = bh & 3; const size_t t0 = (size_t)b * SEQ + c * 64;
        if (tid == 0) { const unsigned want = 16u * (unsigned)(l + 1); while (__hip_atomic_load((unsigned*)(ws + WS_CTR) + 16 + bh, __ATOMIC_RELAXED, __HIP_MEMORY_SCOPE_AGENT) < want) __builtin_amdgcn_s_sleep(1);
            __builtin_amdgcn_fence(__ATOMIC_ACQUIRE, "agent"); asm volatile("s_waitcnt vmcnt(0)" ::: "memory"); }
        __syncthreads();
        const float mc = ((const float*)(ws + WS_MST))[u];
#pragma unroll
        for (int it = 0; it < 2; ++it) { const int id = tid + NTHR * it, s = id >> 4, ch = id & 15;
            *(u32x4*)(lds + OFF_Q + s * QRS + ch * 16) = *(const u32x4*)(Q2 + (t0 + s) * 512 + h * 128 + ch * 8); *(u32x4*)(lds + OFF_K + s * QRS + ch * 16) = *(const u32x4*)(K2 + (t0 + s) * 512 + h * 128 + ch * 8); }
#pragma unroll 2
        for (int it = 0; it < 4; ++it) { const int item = tid + NTHR * it, s = item & 63, eg = item >> 6; const u32x4 vw = *(const u32x4*)(VB + (t0 + s) * 1024 + h * 256 + eg * 8);
            unsigned char* d = lds + OFF_VT + (eg * 8) * TRS + s * 2; const unsigned vv[4] = {vw.x, vw.y, vw.z, vw.w};
#pragma unroll
            for (int i = 0; i < 4; ++i) { *(bf16_t*)(d + (2 * i) * TRS) = (bf16_t)(vv[i] & 0xffffu); *(bf16_t*)(d + (2 * i + 1) * TRS) = (bf16_t)(vv[i] >> 16); } }
        if (tid < 64) { bvec[tid] = ((const float*)(ws + WS_BV))[(size_t)u * 64 + tid]; livec[tid] = ((const float*)(ws + WS_LIV))[(size_t)u * 64 + tid]; lsum[tid] = 0.f; lsq[tid] = 0.f; }
        else if (tid < 192) nvec[tid - 64] = ((const float*)(ws + WS_NST))[(size_t)u * 128 + tid - 64];
        __syncthreads();
        if (w == 0) { float x = livec[lane] - bvec[lane];
#pragma unroll
            for (int o = 1; o < 64; o <<= 1) { const float v = shup(x, o, lane); if (lane >= o) x = fmaxf(x, v); }
            const float mtl = bvec[lane] + fmaxf(mc, x); mt[lane] = mtl; wint[lane] = __expf(bvec[lane] + mc - mtl); }
        __syncthreads();
        { const int lb = w >> 1;
#pragma unroll
          for (int si = 0; si < 2; ++si) { const int sb = (w & 1) * 2 + si; f32x4 a = zero4();
            if (sb <= lb) {
#pragma unroll
                for (int kc = 0; kc < 4; ++kc) { const bf16x8 qf = *(const bf16x8*)(lds + OFF_Q + (lb * 16 + lr) * QRS + kc * 64 + g * 16), kf = *(const bf16x8*)(lds + OFF_K + (sb * 16 + lr) * QRS + kc * 64 + g * 16); a = mfma16(qf, kf, a); }
            }
            const int s = sb * 16 + lr; const float bs = bvec[s] - livec[s];
#pragma unroll
            for (int r = 0; r < 4; ++r) { const int ll = lb * 16 + g * 4 + r; float v = 0.f; if (s <= ll) v = a[r] * __expf(bvec[ll] - bs - mt[ll]); *(bf16_t*)(lds + OFF_P + ll * TRS + s * 2) = f2bf(v); } } }
        __syncthreads();
        if (w == 0) { float a = 0.f; const unsigned char* r = lds + OFF_P + lane * TRS;
#pragma unroll
            for (int i = 0; i < 8; ++i) { const u32x4 x = *(const u32x4*)(r + i * 16); a += (bflo(x.x) + bfhi(x.x)) + (bflo(x.y) + bfhi(x.y)) + (bflo(x.z) + bfhi(x.z)) + (bflo(x.w) + bfhi(x.w)); }
            denV[lane] = a; }
        else if (w == 1) { float a = 0.f; const unsigned char* r = lds + OFF_Q + lane * QRS;
#pragma unroll
            for (int i = 0; i < 16; ++i) { const u32x4 x = *(const u32x4*)(r + i * 16); const float* nv = nvec + i * 8;
                a += bflo(x.x) * nv[0] + bfhi(x.x) * nv[1] + bflo(x.y) * nv[2] + bfhi(x.y) * nv[3] + bflo(x.z) * nv[4] + bfhi(x.z) * nv[5] + bflo(x.w) * nv[6] + bfhi(x.w) * nv[7]; }
            denC[lane] = a; }
        f32x4 accV[2][4], accC[2][4];
#pragma unroll
        for (int i = 0; i < 2; ++i)
#pragma unroll
            for (int j = 0; j < 4; ++j) { accV[i][j] = zero4(); accC[i][j] = zero4(); }
        const bf16_t* cst = (const bf16_t*)(ws + WS_CST) + (size_t)u * 32768;
#pragma unroll
        for (int kp = 0; kp < 2; ++kp) {
        bf16x8 ctf[2][2];
#pragma unroll
        for (int k2 = 0; k2 < 2; ++k2) { const int kc = kp * 2 + k2; ctf[k2][0] = *(const bf16x8*)(cst + (size_t)(w * 32 + lr) * 128 + kc * 32 + g * 8); ctf[k2][1] = *(const bf16x8*)(cst + (size_t)(w * 32 + 16 + lr) * 128 + kc * 32 + g * 8); }
#pragma unroll
        for (int k2 = 0; k2 < 2; ++k2) { const int kc = kp * 2 + k2;
            const bf16x8 c0 = ctf[k2][0], c1 = ctf[k2][1];
#pragma unroll
            for (int lb = 0; lb < 4; ++lb) { const bf16x8 qf = *(const bf16x8*)(lds + OFF_Q + (lb * 16 + lr) * QRS + kc * 64 + g * 16); accC[0][lb] = mfma16(c0, qf, accC[0][lb]); accC[1][lb] = mfma16(c1, qf, accC[1][lb]); }
        }
        }
#pragma unroll
        for (int kc = 0; kc < 2; ++kc) {
            const bf16x8 v0 = *(const bf16x8*)(lds + OFF_VT + (w * 32 + lr) * TRS + kc * 64 + g * 16), v1 = *(const bf16x8*)(lds + OFF_VT + (w * 32 + 16 + lr) * TRS + kc * 64 + g * 16);
#pragma unroll
            for (int lb = 0; lb < 4; ++lb) { const bf16x8 pf = *(const bf16x8*)(lds + OFF_P + (lb * 16 + lr) * TRS + kc * 64 + g * 16); accV[0][lb] = mfma16(v0, pf, accV[0][lb]); accV[1][lb] = mfma16(v1, pf, accV[1][lb]); }
        }
        __syncthreads();
#pragma unroll
        for (int lb = 0; lb < 4; ++lb) { const int ll = lb * 16 + lr; const float wi = wint[ll]; const float den = wi * denC[ll] + denV[ll]; const float dn = 1.0f / fmaxf(fabsf(den), __expf(-mt[ll])); float s1 = 0.f, s2 = 0.f;
#pragma unroll
            for (int eb = 0; eb < 2; ++eb) { const f32x4 hv = (accC[eb][lb] * wi + accV[eb][lb]) * dn; accV[eb][lb] = hv; s1 += (hv[0] + hv[1]) + (hv[2] + hv[3]); s2 += (hv[0] * hv[0] + hv[1] * hv[1]) + (hv[2] * hv[2] + hv[3] * hv[3]); }
            s1 += shx(s1, 16, lane); s1 += shx(s1, 32, lane); s2 += shx(s2, 16, lane); s2 += shx(s2, 32, lane);
            if (g == 0) { fb[640 + w * 64 + ll] = s1; fb[1152 + w * 64 + ll] = s2; } }
        __syncthreads();
#pragma unroll
        for (int lb = 0; lb < 4; ++lb) { const int ll = lb * 16 + lr; float t1 = 0.f, t2 = 0.f;
#pragma unroll
            for (int ww = 0; ww < 8; ++ww) { t1 += fb[640 + ww * 64 + ll]; t2 += fb[1152 + ww * 64 + ll]; }
            const float mu = t1 * (1.0f / 256.0f); const float var = fmaxf(t2 * (1.0f / 256.0f) - mu * mu, 0.f); const float rstd = rsqrtf(var + EPS);
#pragma unroll
            for (int eb = 0; eb < 2; ++eb) { const int e = w * 32 + eb * 16 + g * 4; const size_t off = (t0 + ll) * 1024 + h * 256 + e; const f32x4 gv = *(const f32x4*)(gn + h * 256 + e);
                const u32x2 ow = *(const u32x2*)(OB + off), zw = *(const u32x2*)(ZB + off); const f32x4 hv = accV[eb][lb]; u32x2 o;
                o.x = cvt_pk_bf16((hv[0] - mu) * rstd * gv[0] * bflo(ow.x) * bflo(zw.x), (hv[1] - mu) * rstd * gv[1] * bfhi(ow.x) * bfhi(zw.x));
                o.y = cvt_pk_bf16((hv[2] - mu) * rstd * gv[2] * bflo(ow.y) * bflo(zw.y), (hv[3] - mu) * rstd * gv[3] * bfhi(ow.y) * bfhi(zw.y)); *(u32x2*)(ZB + off) = o; } }
        __syncthreads();
    }
}

#ifndef PHM
#define PHM 4095
#endif
typedef const __attribute__((address_space(4))) Params* KParams;
#if defined(__HIP_DEVICE_COMPILE__)
__device__ __forceinline__ Params load_params() { KParams k = (KParams)__builtin_amdgcn_kernarg_segment_ptr(); asm volatile("" : "+s"(k)); return *k; }
#else
__device__ __forceinline__ Params load_params() { return Params{}; }
#endif
#define PP load_params()
#define GSYNC() do { asm volatile("s_waitcnt vmcnt(0) lgkmcnt(0)" ::: "memory"); __builtin_amdgcn_fence(__ATOMIC_RELEASE, "agent"); asm volatile("s_waitcnt vmcnt(0)" ::: "memory"); grid.sync(); \
    __builtin_amdgcn_fence(__ATOMIC_ACQUIRE, "agent"); asm volatile("s_waitcnt vmcnt(0) lgkmcnt(0)" ::: "memory"); } while (0)
__device__ __forceinline__ void gbar(unsigned* ctr, unsigned target, const int g_wv) {
    asm volatile("s_waitcnt vmcnt(0) lgkmcnt(0)" ::: "memory");
    __syncthreads();
    if (TIDX == 0) {
        __builtin_amdgcn_fence(__ATOMIC_RELEASE, "agent"); asm volatile("s_waitcnt vmcnt(0)" ::: "memory");
        __hip_atomic_fetch_add(ctr, 1u, __ATOMIC_RELAXED, __HIP_MEMORY_SCOPE_AGENT);
        while (__hip_atomic_load(ctr, __ATOMIC_RELAXED, __HIP_MEMORY_SCOPE_AGENT) < target) __builtin_amdgcn_s_sleep(1);
        __builtin_amdgcn_fence(__ATOMIC_ACQUIRE, "agent"); asm volatile("s_waitcnt vmcnt(0)" ::: "memory");
    }
    __syncthreads();
}
template <bool AL = true, bool SP = true, class Epi, class Sched> __device__ __forceinline__ void run_gemm(unsigned char* lds, const bf16_t* A, const bf16_t* Bt, int M, int N, int K, int lda, int ldb, const Sched& S, const Epi& E, const int g_wv) {
    pg8::Gemm g{A, Bt, M, N, K, lda, ldb};
    pg8::gemm_phase<Epi, Sched, AL, SP>((PG8_LAS unsigned char*)lds, g, S, E, g_wv);
    __syncthreads();
}

__global__ void __launch_bounds__(NTHR, 2) mega(Params p_arg) {
    extern __shared__ __attribute__((aligned(16))) unsigned char lds[];
    cg::grid_group grid = cg::this_grid();
    const int g_wv = __builtin_amdgcn_readfirstlane((int)(__builtin_amdgcn_workitem_id_x() >> 6));
    const int G = gridDim.x, cb = blockIdx.x; const int w_lo = p_arg.w_lo, w_hi = p_arg.w_hi;
#define WIN(k_) (w_lo <= (k_) && (k_) < w_hi)
    unsigned nbar = 0;
#define SEAM(k_) do { if (WIN(k_) && WIN((k_) + 1)) { ++nbar; gbar((unsigned*)(PP.ws + WS_CTR), nbar * (unsigned)G, g_wv); } } while (0)
    if (w_lo > 1000) GSYNC();
    if (WIN(0)) {
#if PHM & 1
    convert_weights(lds, PP, 0, g_wv); convert_weights(lds, PP, 1, g_wv);
#endif
#if PHM & 2
    build_cs(PP, g_wv);
    { const Params p = PP; rmsnorm_rows<true>(p.x, p.norm_gain, (bf16_t*)(p.ws + WS_H), nullptr, g_wv); }
#endif
    }
    SEAM(0);
#pragma unroll 1
    for (int l = 0; l < 2; ++l) {
        const int wb = 1 + 7 * l;
        if (WIN(wb)) {
#if PHM & 4
        { unsigned char* ws = PP.ws; unsigned char* wl = ws + WS_W0 + (size_t)l * WL_SIZE; const f32x2* cs = (const f32x2*)(ws + WS_CS); (void)cs; (void)wl; pg8::StaticOrder S; S.init(T, 15360, G, cb); EpiIn E{ws}; run_gemm(lds, (const bf16_t*)(ws + WS_H), (const bf16_t*)(wl + WL_WIN), T, 15360, DM, DM, DM, S, E, g_wv); }
        { unsigned char* ws = PP.ws; unsigned char* wl = ws + WS_W0 + (size_t)l * WL_SIZE; const f32x2* cs = (const f32x2*)(ws + WS_CS); (void)cs; (void)wl; pg8::StaticOrder S; S.init(1024, T, G, cb); EpiVT E{(bf16_t*)(ws + WS_VAT), T, nullptr, 0.f}; run_gemm(lds, (const bf16_t*)(wl + WL_WIN) + (size_t)15360 * DM, (const bf16_t*)(ws + WS_H), 1024, T, DM, DM, DM, S, E, g_wv); }
#endif
        }
        SEAM(wb);
        if (WIN(wb + 1)) {
#if PHM & 32
        mlstm_a(lds, PP, l, g_wv);
#endif
#if PHM & 16
        kmean_phase(PP, l, g_wv);
#endif
#if PHM & 8
        { unsigned char* ws = PP.ws; unsigned char* wl = ws + WS_W0 + (size_t)l * WL_SIZE; const f32x2* cs = (const f32x2*)(ws + WS_CS); (void)cs; (void)wl; pg8::StaticOrder S; S.init(T, 1536, G, cb); EpiRow<true> E{(bf16_t*)(ws + WS_QC), 1536, (const float*)(ws + WS_SSP), 1.0f / 512.0f, CC_SCALE, cs}; run_gemm(lds, (const bf16_t*)(ws + WS_CQ), (const bf16_t*)(wl + WL_WUQ), T, 1536, 512, 512, 512, S, E, g_wv); }
        { unsigned char* ws = PP.ws; unsigned char* wl = ws + WS_W0 + (size_t)l * WL_SIZE; const f32x2* cs = (const f32x2*)(ws + WS_CS); (void)cs; (void)wl; pg8::StaticOrder S; S.init(T, 1024, G, cb); EpiRow<false> E{(bf16_t*)(ws + WS_KNC), 1024, (const float*)(ws + WS_SSP), 1.0f / 256.0f, 1.0f, cs}; run_gemm(lds, (const bf16_t*)(ws + WS_CKV), (const bf16_t*)(wl + WL_WKN), T, 1024, 256, 256, 256, S, E, g_wv); }
        { unsigned char* ws = PP.ws; unsigned char* wl = ws + WS_W0 + (size_t)l * WL_SIZE; const f32x2* cs = (const f32x2*)(ws + WS_CS); (void)cs; (void)wl; pg8::StaticOrder S; S.init(1024, T, G, cb); EpiVT E{(bf16_t*)(ws + WS_VCT), T, (const float*)(ws + WS_SSP), 1.0f / 256.0f}; run_gemm(lds, (const bf16_t*)(wl + WL_WV), (const bf16_t*)(ws + WS_CKV), 1024, T, 256, 256, 256, S, E, g_wv); }
#endif
        }
        SEAM(wb + 1);
        if (WIN(wb + 2)) {
#if PHM & 128
        mlstm_b(PP, g_wv);
#endif
#if PHM & 64
        attn_phase<0>(lds, PP, l, g_wv);
#endif
        }
        if (WIN(wb + 3)) {
#if PHM & 256
        attn_phase<1>(lds, PP, l, g_wv);
#endif
#if PHM & 512
        mlstm_c(lds, PP, l, g_wv);
#endif
        }
        SEAM(wb + 3);
        if (WIN(wb + 4)) {
#if PHM & 1024
        { unsigned char* ws = PP.ws; unsigned char* wl = ws + WS_W0 + (size_t)l * WL_SIZE; MergeOrder S{G, cb}; EpiMerge E{(bf16_t*)(ws + WS_H), (const bf16_t*)(ws + WS_GT)}; run_gemm(lds, (const bf16_t*)(ws + WS_Z), (const bf16_t*)(wl + WL_WB), 3 * T, 2048, 1024, 1024, 1024, S, E, g_wv); }
#endif
        }
        SEAM(wb + 4);
        if (WIN(wb + 5)) {
#if PHM & 2048
        { unsigned char* ws = PP.ws; unsigned char* wl = ws + WS_W0 + (size_t)l * WL_SIZE; const f32x2* cs = (const f32x2*)(ws + WS_CS); (void)cs; (void)wl; pg8::StaticOrder S; S.init(T, DM, G, cb); const Params p = PP; EpiOut E{l == 0 ? p.x : p.out, p.out}; run_gemm(lds, (const bf16_t*)(ws + WS_H), (const bf16_t*)(wl + WL_WO), T, DM, DM, DM, DM, S, E, g_wv); }
#endif
        }
        SEAM(wb + 5);
        if (WIN(wb + 6)) {
            if (l == 0) { const Params p = PP; rmsnorm_rows<true>(p.out, p.norm_gain + DM, (bf16_t*)(p.ws + WS_H), nullptr, g_wv); }
            else { const Params p = PP; rmsnorm_rows<false>(p.out, p.final_norm, nullptr, p.out, g_wv); }
        }
        if (l == 0) SEAM(wb + 6);
    }
}


#if defined(MK_DEBUG_HASH)
__global__ void hash_buf(const unsigned* p, size_t nwords, unsigned long long* acc) {
    unsigned long long s = 0; const size_t stride = (size_t)gridDim.x * blockDim.x;
    for (size_t i = (size_t)blockIdx.x * blockDim.x + threadIdx.x; i < nwords; i += stride) s += (unsigned long long)p[i] * (unsigned long long)(((unsigned)i * 2654435761u) | 1u);
    atomicAdd(acc, s);
}
__global__ void dbg_final(float* out, size_t n, const unsigned long long* h, int R, int NK) {
    __shared__ float flag;
    if (threadIdx.x == 0) { float f = 1.0f; for (int k = NK - 1; k >= 0; --k) for (int r = 1; r < R; ++r) if (h[r * NK + k] != h[k]) { f = 100.0f; for (int q = 0; q < k; ++q) f *= 10.0f; } flag = f; }
    __syncthreads();
    for (size_t i = (size_t)blockIdx.x * blockDim.x + threadIdx.x; i < n; i += (size_t)gridDim.x * blockDim.x) out[i] = (i == 0) ? flag : 0.0f;
}
#endif
extern "C" void kernel_launch(void* const* d_in, const int* in_sizes, int n_in, void* d_out, int out_size, void* d_ws, size_t ws_size, hipStream_t stream) {
    static int grid = 0;
    if (grid == 0) {
        if (n_in != 16 || ws_size < WS_END) { fprintf(stderr, "kernel_launch: unexpected n_in %d or ws_size %zu < %zu\n", n_in, ws_size, (size_t)WS_END); grid = -1; return; }
        int dev = 0, cus = 0, per_cu = 0;
        hipGetDevice(&dev); hipDeviceGetAttribute(&cus, hipDeviceAttributeMultiprocessorCount, dev);
        if (hipFuncSetAttribute((const void*)mega, hipFuncAttributeMaxDynamicSharedMemorySize, LDS_BYTES) != hipSuccess) { fprintf(stderr, "kernel_launch: hipFuncSetAttribute failed\n"); grid = -1; return; }
        if (hipOccupancyMaxActiveBlocksPerMultiprocessor(&per_cu, (const void*)mega, NTHR, LDS_BYTES) != hipSuccess || per_cu < 1) { fprintf(stderr, "kernel_launch: occupancy query gave %d\n", per_cu); per_cu = 1; }
        (void)hipGetLastError();
        grid = cus * 1;
    }
    if (grid < 0) return;
    Params p{};
    p.x = (const float*)d_in[0]; p.norm_gain = (const float*)d_in[1]; p.w_in = (const float*)d_in[2]; p.t5 = (const float*)d_in[3]; p.conv_w = (const float*)d_in[4]; p.conv_b = (const float*)d_in[5];
    p.i_bias = (const float*)d_in[6]; p.f_bias = (const float*)d_in[7]; p.out_norm = (const float*)d_in[8]; p.q_norm = (const float*)d_in[9]; p.kv_norm = (const float*)d_in[10];
    p.w_uq = (const float*)d_in[11]; p.w_ukv = (const float*)d_in[12]; p.w_branch = (const float*)d_in[13]; p.w_out = (const float*)d_in[14]; p.final_norm = (const float*)d_in[15];
    p.out = (float*)d_out; p.ws = (unsigned char*)d_ws;
    (void)hipMemsetAsync((unsigned char*)d_ws + WS_CTR, 0, 256, stream);
    void* args[] = {&p};
#if defined(MK_DEBUG_HASH)
    {
        constexpr int R = 4, NK = 9; unsigned char* W = (unsigned char*)d_ws; unsigned long long* H = (unsigned long long*)(W + WS_END);
        hipMemsetAsync(H, 0, R * NK * 8, stream);
        struct HB { int win; size_t off; size_t bytes; };
        const HB hb[NK] = { {3, WS_Z, 32 * MiB}, {3, WS_CST, 64 * MiB}, {3, WS_NST, 524288}, {3, WS_MST, 4096},
                            {4, WS_Z + 64 * MiB, 32 * MiB}, {4, WS_Z + 32 * MiB, 32 * MiB}, {5, WS_H, 64 * MiB}, {6, WS_H, 64 * MiB}, {2, WS_CST, 64 * MiB} };
        for (int r = 0; r < R; ++r)
            for (int w = 0; w < 7; ++w) { p.w_lo = w; p.w_hi = w + 1;
                hipError_t e = hipLaunchCooperativeKernel((const void*)mega, dim3(grid), dim3(NTHR), args, LDS_BYTES, stream);
                if (e != hipSuccess) fprintf(stderr, "kernel_launch: cooperative launch failed: %s\n", hipGetErrorString(e));
                for (int k = 0; k < NK; ++k) if (hb[k].win == w) {
                    if (k == 7) hash_buf<<<256, 256, 0, stream>>>((const unsigned*)d_out, (size_t)T * DM, H + r * NK + k);
                    else hash_buf<<<256, 256, 0, stream>>>((const unsigned*)(W + hb[k].off), hb[k].bytes / 4, H + r * NK + k); } }
        dbg_final<<<256, 256, 0, stream>>>((float*)d_out, (size_t)T * DM, H, R, NK);
    }
    if (false) {
#elif defined(MK_MULTI)
    for (int w = 0; w < 15; ++w) { p.w_lo = w; p.w_hi = w + 1;
#else
    { p.w_lo = 0; p.w_hi = 15;
#endif
        hipError_t e = hipLaunchCooperativeKernel((const void*)mega, dim3(grid), dim3(NTHR), args, LDS_BYTES, stream);
        if (e != hipSuccess) fprintf(stderr, "kernel_launch: cooperative launch failed: %s (grid %d)\n", hipGetErrorString(e), grid);
    }
}
```

```cpp
#include <hip/hip_runtime.h>
#include <hip/hip_cooperative_groups.h>
#include <cstdio>
#include <cstdint>
namespace cg = cooperative_groups;
__device__ __forceinline__ int tidx_opaque(int g_wv) { int l; asm volatile("v_mbcnt_lo_u32_b32 %0, -1, 0\n\tv_mbcnt_hi_u32_b32 %0, -1, %0" : "=v"(l)); return g_wv * 64 + l; }
#define TIDX tidx_opaque(g_wv)
__device__ __forceinline__ float shx(float v, int o, int lane) { return __int_as_float(__builtin_amdgcn_ds_bpermute(((lane ^ o) & 63) << 2, __float_as_int(v))); }
__device__ __forceinline__ int shxi(int v, int o, int lane) { return __builtin_amdgcn_ds_bpermute(((lane ^ o) & 63) << 2, v); }
__device__ __forceinline__ float shup(float v, int o, int lane) { return __int_as_float(__builtin_amdgcn_ds_bpermute(((lane - o) & 63) << 2, __float_as_int(v))); }

namespace pg8 {
#define PG8_LAS __attribute__((address_space(3)))
typedef unsigned short bf16_t;
typedef short bf16x8 __attribute__((ext_vector_type(8)));
typedef float f32x4 __attribute__((ext_vector_type(4)));
typedef unsigned u32x4 __attribute__((ext_vector_type(4)));
constexpr int BM = 256, BK = 64, HALF = 128, HTB = HALF * BK * 2  , STAGE_BYTES = 8 * HTB, NXCD = 8, WGM = 8;

__host__ __device__ __forceinline__ int lds_byte(int r, int c) { const int st = (r >> 4) * 2 + (c >> 5), rr = r & 15, cc = c & 31, ob = rr * 64 + cc * 2; return st * 1024 + (ob ^ (((ob >> 9) & 1) << 5)); }
__host__ __device__ __forceinline__ void stage_rc(int b, int& R, int& C) { const int st = b / 1024, sb = b % 1024, swz = sb ^ (((sb >> 9) & 1) << 5); R = (st >> 1) * 16 + swz / 64; C = (st & 1) * 32 + (swz % 64) / 2; }
__host__ __device__ __forceinline__ int perm32(int rho) { const int n = rho >> 4, i = rho & 15; return 8 * (i >> 2) + 4 * n + (i & 3); }

struct Unit { int pm, pn, pb; };
struct Gemm { const bf16_t* A; const bf16_t* Bt; int M, N, K, lda, ldb; };

struct StaticOrder {
    int nM, nN, nwg, G, c;
    __host__ __device__ void init(int M, int N, int G_, int c_) { nM = M / BM; nN = N / BM; nwg = nM * nN; G = G_; c = c_; }
    __host__ __device__ bool next(int i, Unit& u) const {
        const long L = (long)i * G + c; if (L >= nwg) return false;
        int wgid = (int)L; { const int q = nwg / NXCD, r = nwg % NXCD, xcd = wgid % NXCD, off = wgid / NXCD; wgid = (xcd < r ? xcd * (q + 1) : r * (q + 1) + (xcd - r) * q) + off; }
        const int nig = WGM * nN, gid = wgid / nig, fm = gid * WGM, gsz = (nM - fm) < WGM ? (nM - fm) : WGM;
        u.pm = fm + ((wgid % nig) % gsz); u.pn = (wgid % nig) / gsz; u.pb = u.pn; return true;
    }
    __device__ __forceinline__ void a_ready(const Unit&) const {}
    __device__ __forceinline__ void done(const Unit&) const {}
};

__device__ __forceinline__ unsigned cvt_pk_bf16(float lo, float hi) { unsigned r; asm volatile("s_nop 1\n\tv_cvt_pk_bf16_f32 %0, %1, %2\n\ts_nop 1" : "=v"(r) : "v"(lo), "v"(hi)); return r; }
template <class Epi, class Sched, bool ALIGN_EPI = false, bool SP2 = false>
__device__ __forceinline__ void gemm_phase(PG8_LAS unsigned char* lds, const Gemm g, const Sched& S, const Epi& E, const int g_wv) {
    int tid = TIDX; asm volatile("" : "+v"(tid)); const int wid = __builtin_amdgcn_readfirstlane(tid >> 6), lane = tid & 63, wr = wid >> 2, wc = wid & 3, fr = lane & 15, fq = lane >> 4;
    const int K = g.K, nt = K / BK;
    unsigned voffA[2], voffB[2];
#pragma unroll
    for (int i = 0; i < 2; ++i) { int R, C; stage_rc(tid * 16 + i * 8192, R, C); const int Rb = Epi::PERM ? ((R & ~31) + perm32(R & 31)) : R;
        voffA[i] = (unsigned)(R * K + C) * 2u; voffB[i] = (unsigned)(Rb * K + C) * 2u; }
    const size_t kstep = (size_t)(BK * 2);
    const size_t hstepA = (size_t)HALF * K * 2; const size_t hstepB = hstepA;
    const size_t tstepA = 2 * hstepA; const size_t tstepB = tstepA;
    const unsigned ldsw = (unsigned)wid * 1024u;
    const int aoff = lds_byte(wr * 64 + fr, fq * 8), boff = lds_byte(wc * 32 + fr, fq * 8);
#define PG8_SA(b, h) (((b) * 2 + (h)) * HTB)
#define PG8_SB(b, h) ((4 + (b) * 2 + (h)) * HTB)
#define PG8_STAGE(bufoff, gbase, voff) do { _Pragma("unroll") for (int _i = 0; _i < 2; ++_i) \
        __builtin_amdgcn_global_load_lds((const unsigned*)((const char*)(gbase) + (voff)[_i]), (PG8_LAS unsigned*)(lds + (bufoff) + ldsw + _i * 8192), 16, 0, 0); } while (0)
#define PG8_LDA(dst, b, h) do { _Pragma("unroll") for (int m = 0; m < 4; ++m) _Pragma("unroll") for (int k = 0; k < 2; ++k) dst[m][k] = *(const PG8_LAS bf16x8*)(lds + PG8_SA(b, h) + aoff + m * 2048 + k * 1024); } while (0)
#define PG8_LDB(dst, b, h) do { _Pragma("unroll") for (int n = 0; n < 2; ++n) _Pragma("unroll") for (int k = 0; k < 2; ++k) dst[n][k] = *(const PG8_LAS bf16x8*)(lds + PG8_SB(b, h) + boff + n * 2048 + k * 1024); } while (0)
#define PG8_MMA(ai, bj, At, Bt) do { __builtin_amdgcn_s_setprio(1); _Pragma("unroll") for (int m = 0; m < 4; ++m) _Pragma("unroll") for (int n = 0; n < 2; ++n) _Pragma("unroll") for (int k = 0; k < 2; ++k) \
        acc[ai][bj][m][n] = __builtin_amdgcn_mfma_f32_16x16x32_bf16(Bt[n][k], At[m][k], acc[ai][bj][m][n], 0, 0, 0); __builtin_amdgcn_s_setprio(0); } while (0)
#define PG8_WAIT_V(n) asm volatile("s_waitcnt vmcnt(" #n ")" ::: "memory")
#define PG8_WAIT_L(n) asm volatile("s_waitcnt lgkmcnt(" #n ")" ::: "memory")
#define PG8_BAR __builtin_amdgcn_s_barrier()
#define PG8_SCHED __builtin_amdgcn_sched_barrier(0)
    Unit cur, nxt; int ui = 0;
    if (!S.next(0, cur)) return;
    f32x4 acc[2][2][4][2];
#pragma unroll
    for (int a = 0; a < 2; ++a)
#pragma unroll
        for (int b = 0; b < 2; ++b)
#pragma unroll
            for (int m = 0; m < 4; ++m)
#pragma unroll
                for (int n = 0; n < 2; ++n) acc[a][b][m][n] = (f32x4){0.f, 0.f, 0.f, 0.f};
    bf16x8 At[4][2], B0[2][2], B1[2][2];
    const char* cA = (const char*)g.A + (size_t)cur.pm * tstepA; const char* cB = (const char*)g.Bt + (size_t)cur.pb * tstepB;
    S.a_ready(cur);
    if constexpr (SP2) {
        PG8_STAGE(PG8_SB(0, 0), cB, voffB); PG8_STAGE(PG8_SB(0, 1), cB + hstepB, voffB); PG8_STAGE(PG8_SA(0, 0), cA, voffA); PG8_STAGE(PG8_SA(0, 1), cA + hstepA, voffA);
        if (wr == 1) PG8_BAR;
        PG8_WAIT_V(2); PG8_BAR;
        PG8_STAGE(PG8_SB(1, 0), cB + kstep, voffB); PG8_STAGE(PG8_SA(1, 0), cA + kstep, voffA); PG8_STAGE(PG8_SB(1, 1), cB + hstepB + kstep, voffB);
        PG8_WAIT_V(6); PG8_BAR;
    } else {
        PG8_STAGE(PG8_SB(0, 0), cB, voffB); PG8_STAGE(PG8_SA(0, 0), cA, voffA); PG8_STAGE(PG8_SB(0, 1), cB + hstepB, voffB); PG8_STAGE(PG8_SA(0, 1), cA + hstepA, voffA);
        if (wr == 1) PG8_BAR;
        PG8_WAIT_V(4); PG8_BAR;
        PG8_STAGE(PG8_SB(1, 0), cB + kstep, voffB); PG8_STAGE(PG8_SA(1, 0), cA + kstep, voffA); PG8_STAGE(PG8_SB(1, 1), cB + hstepB + kstep, voffB);
        PG8_WAIT_V(6); PG8_BAR;
    }
    for (;;) {
        const bool has_next = S.next(ui + 1, nxt);
        const char* nA = has_next ? (const char*)g.A + (size_t)nxt.pm * tstepA : cA; const char* nB = has_next ? (const char*)g.Bt + (size_t)nxt.pb * tstepB : cB;
        for (int t = 0; t < nt; t += 2) {
            const bool last = (t == nt - 2);
            const char* a1 = cA + (size_t)(t + 1) * kstep;
            const char* a2 = last ? nA : cA + (size_t)(t + 2) * kstep; const char* b2 = last ? nB : cB + (size_t)(t + 2) * kstep;
            const char* a3 = a2 + kstep; const char* b3 = b2 + kstep;
            if (last && has_next) S.a_ready(nxt);
            if constexpr (SP2) {
            PG8_LDB(B0, 0, 0); PG8_LDB(B1, 0, 1); PG8_SCHED; PG8_LDA(At, 0, 0); PG8_STAGE(PG8_SA(1, 1), a1 + hstepA, voffA);
            PG8_WAIT_V(8); PG8_WAIT_L(0); PG8_BAR; PG8_MMA(0, 0, At, B0); PG8_MMA(0, 1, At, B1); PG8_BAR; PG8_SCHED;
            PG8_LDA(At, 0, 1); PG8_STAGE(PG8_SB(0, 0), b2, voffB); PG8_STAGE(PG8_SB(0, 1), b2 + hstepB, voffB); PG8_STAGE(PG8_SA(0, 0), a2, voffA);
            PG8_WAIT_V(8); PG8_WAIT_L(0); PG8_BAR; PG8_MMA(1, 0, At, B0); PG8_MMA(1, 1, At, B1); PG8_BAR; PG8_SCHED;
            PG8_LDB(B0, 1, 0); PG8_LDB(B1, 1, 1); PG8_SCHED; PG8_LDA(At, 1, 0); PG8_STAGE(PG8_SA(0, 1), a2 + hstepA, voffA);
            PG8_WAIT_V(8); PG8_WAIT_L(0); PG8_BAR; PG8_MMA(0, 0, At, B0); PG8_MMA(0, 1, At, B1); PG8_BAR; PG8_SCHED;
            PG8_LDA(At, 1, 1); PG8_STAGE(PG8_SB(1, 0), b3, voffB); PG8_STAGE(PG8_SB(1, 1), b3 + hstepB, voffB); PG8_STAGE(PG8_SA(1, 0), a3, voffA);
            PG8_WAIT_V(8); PG8_WAIT_L(0); PG8_BAR; PG8_MMA(1, 0, At, B0); PG8_MMA(1, 1, At, B1); PG8_BAR; PG8_SCHED;
            } else {
            PG8_LDB(B0, 0, 0); PG8_SCHED; PG8_LDA(At, 0, 0); PG8_STAGE(PG8_SA(1, 1), a1 + hstepA, voffA);
            PG8_WAIT_L(8); PG8_BAR; PG8_WAIT_L(0); PG8_MMA(0, 0, At, B0); PG8_BAR; PG8_SCHED;
            PG8_LDB(B1, 0, 1); PG8_STAGE(PG8_SB(0, 0), b2, voffB);
            PG8_BAR; PG8_WAIT_L(0); PG8_MMA(0, 1, At, B1); PG8_BAR;
            PG8_LDA(At, 0, 1); PG8_STAGE(PG8_SA(0, 0), a2, voffA);
            PG8_BAR; PG8_WAIT_L(0); PG8_MMA(1, 0, At, B0); PG8_BAR; PG8_SCHED;
            PG8_STAGE(PG8_SB(0, 1), b2 + hstepB, voffB);
            PG8_WAIT_V(6); PG8_BAR; PG8_MMA(1, 1, At, B1); PG8_BAR;
            PG8_LDB(B0, 1, 0); PG8_SCHED; PG8_LDA(At, 1, 0); PG8_STAGE(PG8_SA(0, 1), a2 + hstepA, voffA);
            PG8_WAIT_L(8); PG8_BAR; PG8_WAIT_L(0); PG8_MMA(0, 0, At, B0); PG8_BAR; PG8_SCHED;
            PG8_LDB(B1, 1, 1); PG8_STAGE(PG8_SB(1, 0), b3, voffB);
            PG8_BAR; PG8_WAIT_L(0); PG8_MMA(0, 1, At, B1); PG8_BAR;
            PG8_LDA(At, 1, 1); PG8_STAGE(PG8_SA(1, 0), a3, voffA);
            PG8_BAR; PG8_WAIT_L(0); PG8_MMA(1, 0, At, B0); PG8_BAR; PG8_SCHED;
            PG8_STAGE(PG8_SB(1, 1), b3 + hstepB, voffB);
            PG8_WAIT_V(6); PG8_BAR; PG8_MMA(1, 1, At, B1); PG8_BAR;
            }
        }
        if constexpr (ALIGN_EPI) { if (wr == 0) PG8_BAR; }
        if constexpr (!Epi::AFTER_DRAIN) { E(acc, cur, wr, wc, fr, fq); S.done(cur); }
        if (!has_next) break;
#pragma unroll
        for (int a = 0; a < 2; ++a)
#pragma unroll
            for (int b = 0; b < 2; ++b)
#pragma unroll
                for (int m = 0; m < 4; ++m)
#pragma unroll
                    for (int n = 0; n < 2; ++n) acc[a][b][m][n] = (f32x4){0.f, 0.f, 0.f, 0.f};
        cur = nxt; cA = nA; cB = nB; ++ui;
        if constexpr (ALIGN_EPI) { if (wr == 1) PG8_BAR; }
    }
    PG8_WAIT_V(0);
    if constexpr (!ALIGN_EPI) { if (wr == 0) PG8_BAR; }
    PG8_BAR;
    if constexpr (Epi::AFTER_DRAIN) { E.fused(acc, cur, wr, wc, fr, fq, lds, wid, lane); S.done(cur); }
#undef PG8_SA
#undef PG8_SB
#undef PG8_STAGE
#undef PG8_LDA
#undef PG8_LDB
#undef PG8_MMA
#undef PG8_WAIT_V
#undef PG8_WAIT_L
#undef PG8_BAR
#undef PG8_SCHED
}
}

using pg8::bf16_t; using pg8::bf16x8; using pg8::f32x4; using pg8::u32x4; using pg8::Unit; using pg8::cvt_pk_bf16;
typedef unsigned u32x2 __attribute__((ext_vector_type(2)));
typedef float f32x2 __attribute__((ext_vector_type(2)));
constexpr int T = 16384, SEQ = 4096, DM = 2048, DIN = 16200;
constexpr float EPS = 1e-6f, NEGV = -1e30f, LOG2E = 1.4426950408889634f;
constexpr float CA_SCALE = 0.12751743082459868f;
constexpr float CC_SCALE = 0.10411754627697264f;
constexpr int NTHR = 512;
constexpr int LDS_BYTES = 131072;

constexpr size_t MiB = 1ull << 20;
constexpr size_t WS_CS = 0;
constexpr size_t WS_SSQ = WS_CS + MiB;
constexpr size_t WS_SSKV = WS_SSQ + 65536;
constexpr size_t WS_GATES = WS_SSKV + 65536;
constexpr size_t WS_KM = WS_GATES + 524288;
constexpr size_t WS_BV = WS_KM + 131072;
constexpr size_t WS_LIV = WS_BV + 262144;
constexpr size_t WS_BLAST = WS_LIV + 262144;
constexpr size_t WS_GMAX = WS_BLAST + 4096;
constexpr size_t WS_MST = WS_GMAX + 4096;
constexpr size_t WS_NST = WS_MST + 4096;
constexpr size_t WS_W0 = WS_NST + 524288;
constexpr size_t WL_WIN = 0;
constexpr size_t WL_WB = WL_WIN + 64 * MiB;
constexpr size_t WL_WO = WL_WB + 12 * MiB;
constexpr size_t WL_WUQ = WL_WO + 8 * MiB;
constexpr size_t WL_WKN = WL_WUQ + 1536 * 1024;
constexpr size_t WL_WV = WL_WKN + 512 * 1024;
constexpr size_t WL_SIZE = WL_WV + 512 * 1024;
constexpr size_t WS_H = WS_W0 + 2 * WL_SIZE;
constexpr size_t WS_QA = WS_H + 64 * MiB;
constexpr size_t WS_KA = WS_QA + 32 * MiB;
constexpr size_t WS_VAT = WS_KA + 32 * MiB;
constexpr size_t WS_Z = WS_VAT + 32 * MiB;
constexpr size_t WS_QB = WS_Z + 96 * MiB;
constexpr size_t WS_KB = WS_QB + 16 * MiB;
constexpr size_t WS_VB = WS_KB + 16 * MiB;
constexpr size_t WS_OB = WS_VB + 32 * MiB;
constexpr size_t WS_Q2 = WS_OB + 32 * MiB;
constexpr size_t WS_K2 = WS_Q2 + 16 * MiB;
constexpr size_t WS_CST = WS_K2 + 16 * MiB;
constexpr size_t WS_CQ = WS_CST + 64 * MiB;
constexpr size_t WS_CKV = WS_CQ + 16 * MiB;
constexpr size_t WS_KR = WS_CKV + 8 * MiB;
constexpr size_t WS_QC = WS_KR + 2 * MiB;
constexpr size_t WS_KNC = WS_QC + 48 * MiB;
constexpr size_t WS_VCT = WS_KNC + 32 * MiB;
constexpr size_t WS_GT = WS_VCT + 32 * MiB;
constexpr size_t WS_SSP = WS_GT + 192 * MiB;
constexpr size_t WS_QAL = WS_SSP + MiB;
constexpr size_t WS_CTR = WS_QAL + 32 * MiB;
constexpr size_t WS_END = WS_CTR + 256;

struct Params {
    const float* x; const float* norm_gain; const float* w_in; const float* t5; const float* conv_w; const float* conv_b; const float* i_bias; const float* f_bias;
    const float* out_norm; const float* q_norm; const float* kv_norm; const float* w_uq; const float* w_ukv; const float* w_branch; const float* w_out; const float* final_norm;
    float* out; unsigned char* ws; int w_lo, w_hi;
};

__device__ __forceinline__ float bf2f(unsigned v16) { return __uint_as_float(v16 << 16); }
__device__ __forceinline__ float bflo(unsigned w) { return __uint_as_float(w << 16); }
__device__ __forceinline__ float bfhi(unsigned w) { return __uint_as_float(w & 0xffff0000u); }
__device__ __forceinline__ bf16_t f2bf(float f) { return (bf16_t)(cvt_pk_bf16(f, 0.f) & 0xffffu); }
__device__ __forceinline__ float fsigmoid(float v) { return __builtin_amdgcn_rcpf(1.0f + __expf(-v)); }
__device__ __forceinline__ float fsilu(float v) { return v * __builtin_amdgcn_rcpf(1.0f + __expf(-v)); }
__device__ __forceinline__ float fexp2(float v) { return __builtin_amdgcn_exp2f(v); }
__device__ __forceinline__ f32x4 zero4() { f32x4 z = (f32x4){0.f, 0.f, 0.f, 0.f}; asm volatile("" : "+v"(z)); return z; }
__device__ __forceinline__ f32x4 mfma16(bf16x8 a, bf16x8 b, f32x4 c) { return __builtin_amdgcn_mfma_f32_16x16x32_bf16(a, b, c, 0, 0, 0); }

struct EpiIn {
    static constexpr bool PERM = true, AFTER_DRAIN = false;
    unsigned char* ws;
    __device__ __forceinline__ void operator()(const f32x4 (&acc)[2][2][4][2], const Unit& u, int wr, int wc, int fr, int fq) const {
        const int pn = u.pn; const int row0 = u.pm * 256 + wr * 64 + fr;
        if (pn == 59) {
            const int cb = wc * 32 + 8 * fq;
            if (cb >= 72) return;
            float* gates = (float*)(ws + WS_GATES); bf16_t* kr = (bf16_t*)(ws + WS_KR); const f32x2* cs = (const f32x2*)(ws + WS_CS);
#pragma unroll
            for (int ai = 0; ai < 2; ++ai)
#pragma unroll
                for (int m = 0; m < 4; ++m) {
                    const int row = row0 + ai * 128 + m * 16; const f32x4 v0 = acc[ai][0][m][0], v1 = acc[ai][0][m][1];
                    if (cb == 0) { *(f32x4*)(gates + (size_t)row * 8) = v0; *(f32x4*)(gates + (size_t)row * 8 + 4) = v1; }
                    else {
                        const int j0 = (cb - 8) >> 1, pos = row & (SEQ - 1);
                        const f32x2 c0 = cs[pos * 32 + j0], c1 = cs[pos * 32 + j0 + 1], c2 = cs[pos * 32 + j0 + 2], c3 = cs[pos * 32 + j0 + 3];
                        u32x4 w;
                        w.x = cvt_pk_bf16(v0[0] * c0.x - v0[1] * c0.y, v0[0] * c0.y + v0[1] * c0.x);
                        w.y = cvt_pk_bf16(v0[2] * c1.x - v0[3] * c1.y, v0[2] * c1.y + v0[3] * c1.x);
                        w.z = cvt_pk_bf16(v1[0] * c2.x - v1[1] * c2.y, v1[0] * c2.y + v1[1] * c2.x);
                        w.w = cvt_pk_bf16(v1[2] * c3.x - v1[3] * c3.y, v1[2] * c3.y + v1[3] * c3.x);
                        *(u32x4*)(kr + (size_t)row * 64 + (cb - 8)) = w;
                    }
                }
            return;
        }
        size_t off; int ld, c0, act = 0, ssk = 0; float sc = 1.f;
        if (pn < 4) { off = WS_QA; ld = 1024; c0 = pn * 256; sc = CA_SCALE; }
        else if (pn < 8) { off = WS_KA; ld = 1024; c0 = (pn - 4) * 256; }
        else if (pn < 12) { off = WS_Z; ld = 1024; c0 = (pn - 8) * 256; act = 1; }
        else if (pn < 14) { off = WS_QB; ld = 512; c0 = (pn - 12) * 256; }
        else if (pn < 16) { off = WS_KB; ld = 512; c0 = (pn - 14) * 256; }
        else if (pn < 20) { off = WS_VB; ld = 1024; c0 = (pn - 16) * 256; }
        else if (pn < 24) { off = WS_OB; ld = 1024; c0 = (pn - 20) * 256; act = 2; }
        else if (pn < 28) { off = WS_Z + 32 * MiB; ld = 1024; c0 = (pn - 24) * 256; act = 1; }
        else if (pn < 30) { off = WS_CQ; ld = 512; c0 = (pn - 28) * 256; ssk = 1; }
        else if (pn < 31) { off = WS_CKV; ld = 256; c0 = 0; ssk = 2; }
        else if (pn < 35) { off = WS_Z + 64 * MiB; ld = 1024; c0 = (pn - 31) * 256; act = 1; }
        else { off = WS_GT; ld = 6144; c0 = (pn - 35) * 256; act = 2; }
        bf16_t* dst = (bf16_t*)(ws + off); float* ssp = (float*)(ws + WS_SSP) + (ssk == 2 ? 8 : (pn - 28) * 4) + wc;
        const int col0 = c0 + wc * 32 + 8 * fq;
#pragma unroll
        for (int ai = 0; ai < 2; ++ai)
#pragma unroll
            for (int m = 0; m < 4; ++m) {
                const int row = row0 + ai * 128 + m * 16; bf16_t* rowp = dst + (size_t)row * ld + col0; float ss = 0.f;
#pragma unroll
                for (int bj = 0; bj < 2; ++bj) {
                    f32x4 v0 = acc[ai][bj][m][0], v1 = acc[ai][bj][m][1];
                    if (act == 1) {
#pragma unroll
                        for (int i = 0; i < 4; ++i) { v0[i] = fsilu(v0[i]); v1[i] = fsilu(v1[i]); }
                    } else if (act == 2) {
#pragma unroll
                        for (int i = 0; i < 4; ++i) { v0[i] = fsigmoid(v0[i]); v1[i] = fsigmoid(v1[i]); }
                    } else { v0 = v0 * sc; v1 = v1 * sc; }
                    if (ssk) ss += (v0[0] * v0[0] + v0[1] * v0[1]) + (v0[2] * v0[2] + v0[3] * v0[3]) + (v1[0] * v1[0] + v1[1] * v1[1]) + (v1[2] * v1[2] + v1[3] * v1[3]);
                    u32x4 w; w.x = cvt_pk_bf16(v0[0], v0[1]); w.y = cvt_pk_bf16(v0[2], v0[3]); w.z = cvt_pk_bf16(v1[0], v1[1]); w.w = cvt_pk_bf16(v1[2], v1[3]);
                    *(u32x4*)(rowp + bj * 128) = w;
                    if (pn < 4) {
                        u32x4 wl; wl.x = cvt_pk_bf16(v0[0] - bflo(w.x), v0[1] - bfhi(w.x)); wl.y = cvt_pk_bf16(v0[2] - bflo(w.y), v0[3] - bfhi(w.y));
                        wl.z = cvt_pk_bf16(v1[0] - bflo(w.z), v1[1] - bfhi(w.z)); wl.w = cvt_pk_bf16(v1[2] - bflo(w.w), v1[3] - bfhi(w.w));
                        *(u32x4*)((bf16_t*)(ws + WS_QAL) + (size_t)row * 1024 + col0 + bj * 128) = wl; }
                }
                if (ssk) { const int ln = fq * 16 + fr; ss += shx(ss, 16, ln); ss += shx(ss, 32, ln); if (fq == 0) ssp[(size_t)row * 16] = ss; }
            }
    }
};

struct EpiVT {
    static constexpr bool PERM = true, AFTER_DRAIN = false;
    bf16_t* dst; int ld; const float* ss; float inv_n;
    __device__ __forceinline__ void operator()(const f32x4 (&acc)[2][2][4][2], const Unit& u, int wr, int wc, int fr, int fq) const {
        const int row0 = u.pm * 256 + wr * 64 + fr, col0 = u.pn * 256 + wc * 32 + 8 * fq;
        f32x4 s0[2], s1[2];
#pragma unroll
        for (int bj = 0; bj < 2; ++bj) {
            if (ss) { f32x4 a, b;
#pragma unroll
                for (int i = 0; i < 4; ++i) { const f32x4 pa = *(const f32x4*)(ss + (size_t)(col0 + bj * 128 + i) * 16 + 8), pb = *(const f32x4*)(ss + (size_t)(col0 + bj * 128 + 4 + i) * 16 + 8);
                    a[i] = rsqrtf(((pa[0] + pa[1]) + (pa[2] + pa[3])) * inv_n + EPS); b[i] = rsqrtf(((pb[0] + pb[1]) + (pb[2] + pb[3])) * inv_n + EPS); }
                s0[bj] = a; s1[bj] = b; }
            else { s0[bj] = (f32x4){1.f, 1.f, 1.f, 1.f}; s1[bj] = s0[bj]; }
        }
#pragma unroll
        for (int ai = 0; ai < 2; ++ai)
#pragma unroll
            for (int m = 0; m < 4; ++m) {
                bf16_t* rowp = dst + (size_t)(row0 + ai * 128 + m * 16) * ld + col0;
#pragma unroll
                for (int bj = 0; bj < 2; ++bj) {
                    const f32x4 v0 = acc[ai][bj][m][0] * s0[bj], v1 = acc[ai][bj][m][1] * s1[bj];
                    u32x4 w; w.x = cvt_pk_bf16(v0[0], v0[1]); w.y = cvt_pk_bf16(v0[2], v0[3]); w.z = cvt_pk_bf16(v1[0], v1[1]); w.w = cvt_pk_bf16(v1[2], v1[3]);
                    *(u32x4*)(rowp + bj * 128) = w;
                }
            }
    }
};

template <bool ROPE> struct EpiRow {
    static constexpr bool PERM = true, AFTER_DRAIN = false;
    bf16_t* dst; int ld; const float* ss; float inv_n, sc; const f32x2* cs;
    __device__ __forceinline__ void operator()(const f32x4 (&acc)[2][2][4][2], const Unit& u, int wr, int wc, int fr, int fq) const {
        const int row0 = u.pm * 256 + wr * 64 + fr, col0 = u.pn * 256 + wc * 32 + 8 * fq;
#pragma unroll
        for (int ai = 0; ai < 2; ++ai)
#pragma unroll
            for (int m = 0; m < 4; ++m) {
                const int row = row0 + ai * 128 + m * 16; float sq;
                if (ROPE) { const f32x4 pa = *(const f32x4*)(ss + (size_t)row * 16), pb = *(const f32x4*)(ss + (size_t)row * 16 + 4); sq = ((pa[0] + pa[1]) + (pa[2] + pa[3])) + ((pb[0] + pb[1]) + (pb[2] + pb[3])); }
                else { const f32x4 pa = *(const f32x4*)(ss + (size_t)row * 16 + 8); sq = (pa[0] + pa[1]) + (pa[2] + pa[3]); }
                const float rs = rsqrtf(sq * inv_n + EPS) * sc; bf16_t* rowp = dst + (size_t)row * ld + col0;
#pragma unroll
                for (int bj = 0; bj < 2; ++bj) {
                    f32x4 v0 = acc[ai][bj][m][0] * rs, v1 = acc[ai][bj][m][1] * rs; u32x4 w;
                    const int hc = (col0 + bj * 128) % 192;
                    if (ROPE && hc >= 128) {
                        const int j0 = (hc - 128) >> 1, pos = row & (SEQ - 1);
                        const f32x2 c0 = cs[pos * 32 + j0], c1 = cs[pos * 32 + j0 + 1], c2 = cs[pos * 32 + j0 + 2], c3 = cs[pos * 32 + j0 + 3];
                        w.x = cvt_pk_bf16(v0[0] * c0.x - v0[1] * c0.y, v0[0] * c0.y + v0[1] * c0.x);
                        w.y = cvt_pk_bf16(v0[2] * c1.x - v0[3] * c1.y, v0[2] * c1.y + v0[3] * c1.x);
                        w.z = cvt_pk_bf16(v1[0] * c2.x - v1[1] * c2.y, v1[0] * c2.y + v1[1] * c2.x);
                        w.w = cvt_pk_bf16(v1[2] * c3.x - v1[3] * c3.y, v1[2] * c3.y + v1[3] * c3.x);
                    } else { w.x = cvt_pk_bf16(v0[0], v0[1]); w.y = cvt_pk_bf16(v0[2], v0[3]); w.z = cvt_pk_bf16(v1[0], v1[1]); w.w = cvt_pk_bf16(v1[2], v1[3]); }
                    *(u32x4*)(rowp + bj * 128) = w;
                }
            }
    }
};

struct EpiMerge {
    static constexpr bool PERM = true, AFTER_DRAIN = false;
    bf16_t* merged; const bf16_t* gt;
    __device__ __forceinline__ void operator()(const f32x4 (&acc)[2][2][4][2], const Unit& u, int wr, int wc, int fr, int fq) const {
        const int n = u.pm >> 6, pmr = u.pm & 63; const int row0 = pmr * 256 + wr * 64 + fr, col0 = u.pn * 256 + wc * 32 + 8 * fq;
#pragma unroll
        for (int ai = 0; ai < 2; ++ai)
#pragma unroll
            for (int m = 0; m < 4; ++m) {
                const int row = row0 + ai * 128 + m * 16;
#pragma unroll
                for (int bj = 0; bj < 2; ++bj) {
                    const u32x4 gw = *(const u32x4*)(gt + (size_t)row * 6144 + n * 2048 + col0 + bj * 128);
                    bf16_t* mp = merged + (size_t)row * 2048 + col0 + bj * 128;
                    u32x4 pw = (u32x4){0u, 0u, 0u, 0u}; if (n > 0) pw = __builtin_nontemporal_load((const u32x4*)mp);
                    const f32x4 v0 = acc[ai][bj][m][0], v1 = acc[ai][bj][m][1]; u32x4 w;
                    w.x = cvt_pk_bf16(bflo(pw.x) + bflo(gw.x) * v0[0], bfhi(pw.x) + bfhi(gw.x) * v0[1]);
                    w.y = cvt_pk_bf16(bflo(pw.y) + bflo(gw.y) * v0[2], bfhi(pw.y) + bfhi(gw.y) * v0[3]);
                    w.z = cvt_pk_bf16(bflo(pw.z) + bflo(gw.z) * v1[0], bfhi(pw.z) + bfhi(gw.z) * v1[1]);
                    w.w = cvt_pk_bf16(bflo(pw.w) + bflo(gw.w) * v1[2], bfhi(pw.w) + bfhi(gw.w) * v1[3]);
                    *(u32x4*)mp = w;
                }
            }
        asm volatile("s_waitcnt vmcnt(0)" ::: "memory");
    }
};
struct MergeOrder {
    int G, c;
    __device__ bool next(int i, Unit& u) const {
        const int t3 = i / 3, n = i - 3 * t3; const long L = (long)t3 * G + c; if (L >= 512) return false;
        const int tm = (int)(L >> 3), tn = (int)(L & 7); u.pm = n * 64 + tm; u.pn = tn; u.pb = n * 8 + tn; return true;
    }
    __device__ __forceinline__ void a_ready(const Unit&) const {}
    __device__ __forceinline__ void done(const Unit&) const {}
};

struct EpiOut {
    static constexpr bool PERM = false, AFTER_DRAIN = false;
    const float* xin; float* xout;
    __device__ __forceinline__ void operator()(const f32x4 (&acc)[2][2][4][2], const Unit& u, int wr, int wc, int fr, int fq) const {
        const int row0 = u.pm * 256 + wr * 64 + fr, col0 = u.pn * 256 + wc * 32 + 4 * fq;
#pragma unroll
        for (int ai = 0; ai < 2; ++ai)
#pragma unroll
            for (int m = 0; m < 4; ++m) {
                const size_t ro = (size_t)(row0 + ai * 128 + m * 16) * DM + col0;
#pragma unroll
                for (int bj = 0; bj < 2; ++bj)
#pragma unroll
                    for (int n = 0; n < 2; ++n) { const f32x4 b = *(const f32x4*)(xin + ro + bj * 128 + n * 16); *(f32x4*)(xout + ro + bj * 128 + n * 16) = b + acc[ai][bj][m][n]; }
            }
    }
};

template <class F> __device__ __forceinline__ void tconv(unsigned char* lds, const float* src, int ldsrc, int K, bf16_t* dst, int N, const float* gain, F f, const int g_wv) {
    float* tile = (float*)lds; int tid = TIDX; asm volatile("" : "+v"(tid)); const int tilesK = K >> 6, ntile = tilesK * (N >> 8);
    const int nn4 = (tid & 63) * 4, kk0 = tid >> 6; f32x4 pre[8];
#define TCONV_LOAD(tt_) do { const int tn_ = (tt_) / tilesK, tk_ = (tt_) - tn_ * tilesK; const int c0 = f(tn_ * 256 + nn4), c1 = f(tn_ * 256 + nn4 + 1), c2 = f(tn_ * 256 + nn4 + 2), c3 = f(tn_ * 256 + nn4 + 3); \
        const bool vec = (c0 >= 0) && ((c0 & 3) == 0) && (c3 == c0 + 3); const float* sp = src + (size_t)(tk_ * 64 + kk0) * ldsrc; \
        _Pragma("unroll") for (int e = 0; e < 8; ++e) { const float* rp = sp + (size_t)(8 * e) * ldsrc; f32x4 v; \
            if (vec) v = *(const f32x4*)(rp + c0); \
            else { v[0] = c0 >= 0 ? rp[c0] : 0.f; v[1] = c1 >= 0 ? rp[c1] : 0.f; v[2] = c2 >= 0 ? rp[c2] : 0.f; v[3] = c3 >= 0 ? rp[c3] : 0.f; } \
            pre[e] = v; } } while (0)
    int t = blockIdx.x;
    if (t < ntile) TCONV_LOAD(t);
    for (; t < ntile; t += gridDim.x) {
        const int tn = t / tilesK, tk = t - tn * tilesK;
#pragma unroll
        for (int e = 0; e < 8; ++e) { f32x4 v = pre[e]; if (gain) v = v * gain[tk * 64 + kk0 + 8 * e]; *(f32x4*)(tile + (kk0 + 8 * e) * 260 + nn4) = v; }
        __syncthreads();
        { const int t2 = t + (int)gridDim.x; if (t2 < ntile) TCONV_LOAD(t2); }
        { const int nn = tid >> 1, kc = (tid & 1) * 32; bf16_t* dp = dst + (size_t)(tn * 256 + nn) * K + tk * 64 + kc;
#pragma unroll
          for (int q4 = 0; q4 < 4; ++q4) { float v[8];
#pragma unroll
              for (int i = 0; i < 8; ++i) v[i] = tile[(kc + q4 * 8 + i) * 260 + nn];
              u32x4 w; w.x = cvt_pk_bf16(v[0], v[1]); w.y = cvt_pk_bf16(v[2], v[3]); w.z = cvt_pk_bf16(v[4], v[5]); w.w = cvt_pk_bf16(v[6], v[7]);
              *(u32x4*)(dp + q4 * 8) = w; } }
        __syncthreads();
    }
#undef TCONV_LOAD
}
__device__ __forceinline__ int win_src_col(int n) {
    if (n < 1024) return n;
    if (n < 2048) return 1024 + (n - 1024);
    if (n < 3072) return 3072 + (n - 2048);
    if (n < 3584) return 4096 + (n - 3072);
    if (n < 4096) return 4608 + (n - 3584);
    if (n < 5120) return 5120 + (n - 4096);
    if (n < 6144) return 6152 + (n - 5120);
    if (n < 7168) return 7176 + (n - 6144);
    if (n < 7680) return 8200 + (n - 7168);
    if (n < 7936) return 8712 + (n - 7680);
    if (n < 8960) return 9032 + (n - 7936);
    if (n < 15104) return 10056 + (n - 8960);
    if (n < 15360) { const int r = n - 15104; if (r < 4) return 6144 + r; if (r < 8) return 6148 + (r - 4); if (r < 72) { const int j = (r - 8) >> 1, odd = (r - 8) & 1; return 8968 + j + 32 * odd; } return -1; }
    return 2048 + (n - 15360);
}
__device__ __forceinline__ void convert_weights(unsigned char* lds, const Params& p, int l, const int g_wv) {
    unsigned char* wl = p.ws + WS_W0 + (size_t)l * WL_SIZE;
    tconv(lds, p.w_in + (size_t)l * DM * DIN, DIN, DM, (bf16_t*)(wl + WL_WIN), 16384, nullptr, [](int n) { return win_src_col(n); }, g_wv);
#pragma unroll 1
    for (int n = 0; n < 3; ++n)
        tconv(lds, p.w_branch + ((size_t)l * 3 + n) * 1024 * DM, DM, 1024, (bf16_t*)(wl + WL_WB) + (size_t)n * 2048 * 1024, 2048, nullptr, [](int c) { return c; }, g_wv);
    tconv(lds, p.w_out + (size_t)l * DM * DM, DM, DM, (bf16_t*)(wl + WL_WO), DM, nullptr, [](int c) { return c; }, g_wv);
    tconv(lds, p.w_uq + (size_t)l * 512 * 1536, 1536, 512, (bf16_t*)(wl + WL_WUQ), 1536, p.q_norm + l * 512,
          [](int n) { const int h = n / 192, hc = n - h * 192; if (hc < 128) return n; const int r = hc - 128; return h * 192 + 128 + (r >> 1) + 32 * (r & 1); }, g_wv);
    tconv(lds, p.w_ukv + (size_t)l * 256 * 2048, 2048, 256, (bf16_t*)(wl + WL_WKN), 1024, p.kv_norm + l * 256, [](int n) { return (n >> 7) * 256 + (n & 127); }, g_wv);
    tconv(lds, p.w_ukv + (size_t)l * 256 * 2048, 2048, 256, (bf16_t*)(wl + WL_WV), 1024, p.kv_norm + l * 256, [](int n) { return (n >> 7) * 256 + 128 + (n & 127); }, g_wv);
}
__device__ __forceinline__ void sincos_acc(float ang, float& s, float& c) {
    const double x = (double)ang; const double q = rint(x * 0.63661977236758134308);
    double r = fma(-q, 1.57079632679489655800e+00, x); r = fma(-q, 6.12323399573676603587e-17, r);
    const int qi = ((int)q) & 3; const double r2 = r * r;
    const double sp = r + r * r2 * (-1.66666666666666324348e-01 + r2 * (8.33333333332248946124e-03 + r2 * (-1.98412698298579493134e-04 + r2 * (2.75573137070700676789e-06 + r2 * (-2.50507602534068634195e-08 + r2 * 1.58969099521155010221e-10)))));
    const double cp = 1.0 - 0.5 * r2 + r2 * r2 * (4.16666666666666019037e-02 + r2 * (-1.38888888888741095749e-03 + r2 * (2.48015872894767294178e-05 + r2 * (-2.75573143513906633035e-07 + r2 * (2.08757232129817482790e-09 + r2 * -1.13596475577881948265e-11)))));
    double ss, cc; if (qi == 0) { ss = sp; cc = cp; } else if (qi == 1) { ss = cp; cc = -sp; } else if (qi == 2) { ss = -sp; cc = -cp; } else { ss = -cp; cc = sp; }
    s = (float)ss; c = (float)cc;
}
__device__ __forceinline__ void build_cs(const Params& p, const int g_wv) {
    f32x2* cs = (f32x2*)(p.ws + WS_CS);
    int i0 = blockIdx.x * NTHR + TIDX; asm volatile("" : "+v"(i0));
    for (int i = i0; i < SEQ * 32; i += gridDim.x * NTHR) {
        const int pos = i >> 5, j = i & 31; double inv = 1.0; for (int k = 0; k < j; ++k) inv *= 0.7498942093324558;
        const float ang = (float)pos * (float)inv; float s, c; sincos_acc(ang, s, c); cs[i] = (f32x2){c, s};
    }
}
__device__ __forceinline__ void zero_ss(const Params& p, const int g_wv) {
    float* a = (float*)(p.ws + WS_SSQ);
    int i0 = blockIdx.x * NTHR + TIDX; asm volatile("" : "+v"(i0));
    for (int i = i0; i < 2 * T; i += gridDim.x * NTHR) a[i] = 0.f;
}
template <bool OUTBF> __device__ __forceinline__ void rmsnorm_rows(const float* x, const float* gain, bf16_t* hb, float* of, const int g_wv) {
    int tid = TIDX; asm volatile("" : "+v"(tid)); const int lane = tid & 63, gw = blockIdx.x * (NTHR / 64) + (tid >> 6), nw = gridDim.x * (NTHR / 64);
    for (int row = gw; row < T; row += nw) {
        const float* xr = x + (size_t)row * DM; f32x4 v[8]; float ss = 0.f;
#pragma unroll
        for (int i = 0; i < 8; ++i) { v[i] = *(const f32x4*)(xr + i * 256 + lane * 4); ss += (v[i][0] * v[i][0] + v[i][1] * v[i][1]) + (v[i][2] * v[i][2] + v[i][3] * v[i][3]); }
#pragma unroll
        for (int o = 1; o < 64; o <<= 1) ss += shx(ss, o, lane);
        const float rs = rsqrtf(ss * (1.0f / DM) + EPS);
#pragma unroll
        for (int i = 0; i < 8; ++i) {
            const f32x4 gn = *(const f32x4*)(gain + i * 256 + lane * 4); const f32x4 y = v[i] * rs * gn;
            if (OUTBF) { u32x2 w; w.x = cvt_pk_bf16(y[0], y[1]); w.y = cvt_pk_bf16(y[2], y[3]); *(u32x2*)(hb + (size_t)row * DM + i * 256 + lane * 4) = w; }
            else *(f32x4*)(of + (size_t)row * DM + i * 256 + lane * 4) = y;
        }
    }
}

__device__ __forceinline__ void kmean_phase(const Params& p, int l, const int g_wv) {
    const bf16_t* ka = (const bf16_t*)(p.ws + WS_KA); bf16_t* km = (bf16_t*)(p.ws + WS_KM); bf16_t* kml = (bf16_t*)(p.ws + WS_SSQ); int tid = TIDX; asm volatile("" : "+v"(tid));
    for (int u = (gridDim.x == 256) ? (int)blockIdx.x - 192 : (int)blockIdx.x; u < 64; u += gridDim.x) { if (u < 0) continue;
        const int b = u >> 4, j = u & 15; const unsigned* src = (const unsigned*)(ka + ((size_t)b * SEQ + j * 256) * 1024) + tid; float a0 = 0.f, a1 = 0.f;
#pragma unroll 8
        for (int r = 0; r < 256; ++r) { const unsigned w = src[(size_t)r * 512]; a0 += bflo(w); a1 += bfhi(w); }
        const int col = tid * 2, h = col >> 7, d = col & 127;
        const float m0 = a0 * (1.0f / 256.0f), m1 = a1 * (1.0f / 256.0f); const unsigned hi = cvt_pk_bf16(m0, m1);
        *(unsigned*)(km + ((size_t)((b * 8 + h) * 16 + j)) * 128 + d) = hi;
        *(unsigned*)(kml + ((size_t)((b * 8 + h) * 16 + j)) * 128 + d) = cvt_pk_bf16(m0 - bflo(hi), m1 - bfhi(hi));
    }
}

template <int MODE> __device__ __forceinline__ void attn_phase(unsigned char* lds, const Params& p, int l, const int g_wv) {
    constexpr int DQK = MODE ? 192 : 128, NC = DQK / 32, NCH = DQK / 8, KRS = DQK * 2 + 32, KBUF = 64 * KRS, VRS = 144, VBUF = 128 * VRS;
    constexpr int OFF_V = 2 * KBUF, OFF_LUT = OFF_V + 2 * VBUF, OFF_KM = OFF_LUT + 512, NKL = (64 * NCH) / NTHR;
    int tid = TIDX; asm volatile("" : "+v"(tid)); const int lane = tid & 63, w = tid >> 6, lr = lane & 15, g = lane >> 4; const int G = gridDim.x, c = blockIdx.x;
    unsigned char* ws = p.ws;
    const bf16_t* Qp = (const bf16_t*)(ws + (MODE ? WS_QC : WS_QA)); constexpr int LDQ = MODE ? 1536 : 1024;
    const bf16_t* Kp = (const bf16_t*)(ws + (MODE ? WS_KNC : WS_KA)); const bf16_t* KRp = (const bf16_t*)(ws + WS_KR);
    const bf16_t* VTp = (const bf16_t*)(ws + (MODE ? WS_VCT : WS_VAT)); bf16_t* Zp = (bf16_t*)(ws + WS_Z + (MODE ? 64 * MiB : 0));
    float* lut = (float*)(lds + OFF_LUT);
    for (int rd = 0; rd * G < 512; ++rd) {
        int qblk, bh;
        if (G == 256) {
            const int xq = c & 7, iq = c >> 3, qq = iq >> 1;
            bh = 2 * xq + (iq & 1) + 16 * rd; qblk = rd ? qq : 15 - qq;
        } else { const int idx = rd * G + ((rd & 1) ? (G - 1 - c) : c); if (idx >= 512) continue; qblk = 15 - (idx >> 5); bh = idx & 31; }
        const int b = bh >> 3, h = bh & 7;
        const int q0 = qblk * 256 + w * 32; const size_t tq = (size_t)b * SEQ + q0; const int nt = (qblk + 1) * 4;
        bf16x8 qf[2][NC];
#pragma unroll
        for (int qb = 0; qb < 2; ++qb)
#pragma unroll
            for (int c2 = 0; c2 < NC; ++c2) qf[qb][c2] = *(const bf16x8*)(Qp + (tq + qb * 16 + lr) * LDQ + h * DQK + c2 * 32 + g * 8);
        u32x4 kreg[NKL], vreg[2];
#define ATT_LOADK(t_) do { const int t__ = (t_); \
        _Pragma("unroll") for (int i = 0; i < NKL; ++i) { const int id = tid + NTHR * i; const int key = id / NCH, ch = id - key * NCH; const size_t tk = (size_t)b * SEQ + t__ * 64 + key; \
            const bf16_t* s_ = (!MODE || ch < 16) ? (Kp + tk * 1024 + h * 128 + ch * 8) : (KRp + tk * 64 + (ch - 16) * 8); kreg[i] = *(const u32x4*)s_; } } while (0)
#define ATT_LOADV(t_) do { const int t__ = (t_); \
        _Pragma("unroll") for (int i = 0; i < 2; ++i) { const int id = tid + NTHR * i; const int row = id >> 3, ch = id & 7; \
            vreg[i] = *(const u32x4*)(VTp + (size_t)(h * 128 + row) * T + (size_t)b * SEQ + t__ * 64 + ch * 8); } } while (0)
#define ATT_STOREK(buf_) do { unsigned char* kb_ = lds + (buf_) * KBUF; \
        _Pragma("unroll") for (int i = 0; i < NKL; ++i) { const int id = tid + NTHR * i; const int key = id / NCH, ch = id - key * NCH; *(u32x4*)(kb_ + key * KRS + ch * 16) = kreg[i]; } } while (0)
#define ATT_STOREV(buf_) do { unsigned char* vb_ = lds + OFF_V + (buf_) * VBUF; \
        _Pragma("unroll") for (int i = 0; i < 2; ++i) { const int id = tid + NTHR * i; const int row = id >> 3, ch = id & 7; *(u32x4*)(vb_ + row * VRS + ch * 16) = vreg[i]; } } while (0)
        ATT_LOADK(0); ATT_LOADV(0); ATT_STOREK(0); ATT_STOREV(0); ATT_LOADK(1); ATT_LOADV(1);
        unsigned sel[2] = {0u, 0u};
        if (MODE == 0) {
            if (tid < 128) { const int d = tid; int bk = d; if (d >= 16) { bk = 16 + (int)(logf((float)d * (1.0f / 16.0f)) / 2.0794415416798357f * 16.0f); bk = bk > 31 ? 31 : bk; } lut[d] = p.t5[bk * 8 + h] * LOG2E; }
            { const int half = tid >> 8, row = (tid >> 4) & 15, ch = tid & 15; *(u32x4*)(lds + OFF_KM + half * 4608 + row * 288 + ch * 16) = *(const u32x4*)((const bf16_t*)(ws + (half ? WS_SSQ : WS_KM)) + ((size_t)((b * 8 + h) * 16 + row)) * 128 + ch * 8); }
        }
        __syncthreads();
        if (MODE == 0) {
            f32x4 ga[2] = {zero4(), zero4()};
#pragma unroll
            for (int c2 = 0; c2 < NC; ++c2) { const bf16x8 kf = *(const bf16x8*)(lds + OFF_KM + lr * 288 + c2 * 64 + g * 16), kfl = *(const bf16x8*)(lds + OFF_KM + 4608 + lr * 288 + c2 * 64 + g * 16);
#pragma unroll
                for (int qb = 0; qb < 2; ++qb) { const bf16x8 ql = *(const bf16x8*)((const bf16_t*)(ws + WS_QAL) + (tq + qb * 16 + lr) * 1024 + h * 128 + c2 * 32 + g * 8);
                    ga[qb] = mfma16(kfl, qf[qb][c2], ga[qb]); ga[qb] = mfma16(kf, ql, ga[qb]); ga[qb] = mfma16(kf, qf[qb][c2], ga[qb]); } }
#pragma unroll
            for (int qb = 0; qb < 2; ++qb) {
                float gv[4];
#pragma unroll
                for (int r = 0; r < 4; ++r) gv[r] = (g * 4 + r < qblk) ? ga[qb][r] : -INFINITY;
                unsigned s = 0u;
#pragma unroll
                for (int it = 0; it < 3; ++it) {
                    float bv = -INFINITY; int bi = 99;
#pragma unroll
                    for (int r = 0; r < 4; ++r) if (gv[r] > bv) { bv = gv[r]; bi = g * 4 + r; }
#pragma unroll
                    for (int o = 16; o <= 32; o <<= 1) { const float ov = shx(bv, o, lane); const int oi = shxi(bi, o, lane); if (ov > bv || (ov == bv && oi < bi)) { bv = ov; bi = oi; } }
                    if (bv > -INFINITY) s |= 1u << bi;
#pragma unroll
                    for (int r = 0; r < 4; ++r) if (g * 4 + r == bi) gv[r] = -INFINITY;
                }
                sel[qb] = s;
            }
        }
        f32x4 oacc[8][2];
#pragma unroll
        for (int i = 0; i < 8; ++i) { oacc[i][0] = zero4(); oacc[i][1] = zero4(); }
        float mrow[2] = {NEGV, NEGV}, lrow[2] = {0.f, 0.f};
        for (int t = 0; t < nt; ++t) {
            const int buf = t & 1; const bool more = (t + 1 < nt);
            if (more) { ATT_STOREK(buf ^ 1); ATT_STOREV(buf ^ 1); }
            if (t + 2 < nt) { ATT_LOADK(t + 2); ATT_LOADV(t + 2); }
            const int k0 = t * 64;
            const unsigned char* kb_ = lds + buf * KBUF; const unsigned char* vb_ = lds + OFF_V + buf * VBUF;
#pragma unroll 1
            for (int hf = 0; hf < 2; ++hf) {
              const int kh = k0 + hf * 32;
              if (kh <= q0 + 31) {
                f32x4 sacc[2][2];
#pragma unroll
                for (int kb = 0; kb < 2; ++kb) { sacc[kb][0] = zero4(); sacc[kb][1] = zero4(); }
#pragma unroll
                for (int c2 = 0; c2 < NC; ++c2)
#pragma unroll
                    for (int kb = 0; kb < 2; ++kb) { const bf16x8 kf = *(const bf16x8*)(kb_ + (hf * 32 + kb * 16 + lr) * KRS + c2 * 64 + g * 16);
                        sacc[kb][0] = mfma16(kf, qf[0][c2], sacc[kb][0]); sacc[kb][1] = mfma16(kf, qf[1][c2], sacc[kb][1]); }
                if (MODE == 0) {
                    const int jblk = t >> 2; const bool far = (kh + 31 + 127 <= q0);
                    if (far) { const float bfar = lut[127];
#pragma unroll
                        for (int qb = 0; qb < 2; ++qb) { const bool al = (jblk < qblk) ? (((sel[qb] >> jblk) & 1u) != 0u) : true;
#pragma unroll
                            for (int kb = 0; kb < 2; ++kb)
#pragma unroll
                                for (int r = 0; r < 4; ++r) sacc[kb][qb][r] = al ? sacc[kb][qb][r] + bfar : NEGV; }
                    } else {
#pragma unroll
                        for (int qb = 0; qb < 2; ++qb) { const int qpos = q0 + qb * 16 + lr; const bool alp = (sel[qb] >> jblk) & 1u;
#pragma unroll
                            for (int kb = 0; kb < 2; ++kb)
#pragma unroll
                                for (int r = 0; r < 4; ++r) { const int d = qpos - (kh + kb * 16 + g * 4 + r); const int di = d < 0 ? 0 : (d > 127 ? 127 : d);
                                    const bool al = (jblk < qblk) ? alp : (d >= 0); sacc[kb][qb][r] = al ? sacc[kb][qb][r] + lut[di] : NEGV; } }
                    }
                } else {
                    if (kh + 31 > q0) {
#pragma unroll
                        for (int qb = 0; qb < 2; ++qb) { const int qpos = q0 + qb * 16 + lr;
#pragma unroll
                            for (int kb = 0; kb < 2; ++kb)
#pragma unroll
                                for (int r = 0; r < 4; ++r) if (kh + kb * 16 + g * 4 + r > qpos) sacc[kb][qb][r] = NEGV; }
                    }
                }
                bf16x8 pf[2];
#pragma unroll
                for (int qb = 0; qb < 2; ++qb) {
                    float mx = NEGV;
#pragma unroll
                    for (int kb = 0; kb < 2; ++kb)
#pragma unroll
                        for (int r = 0; r < 4; ++r) mx = fmaxf(mx, sacc[kb][qb][r]);
                    float mnew = mrow[qb];
                    if (__builtin_amdgcn_ballot_w64(mx > mrow[qb] + 8.0f) != 0ull) {
                        mx = fmaxf(mx, shx(mx, 16, lane)); mx = fmaxf(mx, shx(mx, 32, lane));
                        mnew = fmaxf(mrow[qb], mx); const float alpha = fexp2(mrow[qb] - mnew); mrow[qb] = mnew; lrow[qb] *= alpha;
#pragma unroll
                        for (int i = 0; i < 8; ++i) oacc[i][qb] = oacc[i][qb] * alpha;
                    }
                    float ps = 0.f;
#pragma unroll
                    for (int kb = 0; kb < 2; ++kb)
#pragma unroll
                        for (int r = 0; r < 4; ++r) { const float e = fexp2(sacc[kb][qb][r] - mnew); sacc[kb][qb][r] = e; ps += e; }
                    lrow[qb] += ps;
                    union { u32x4 u; bf16x8 v; } cvt;
                    cvt.u.x = cvt_pk_bf16(sacc[0][qb][0], sacc[0][qb][1]); cvt.u.y = cvt_pk_bf16(sacc[0][qb][2], sacc[0][qb][3]);
                    cvt.u.z = cvt_pk_bf16(sacc[1][qb][0], sacc[1][qb][1]); cvt.u.w = cvt_pk_bf16(sacc[1][qb][2], sacc[1][qb][3]); pf[qb] = cvt.v;
                }
#pragma unroll
                for (int dvb = 0; dvb < 8; ++dvb) { union { u32x2 u[2]; bf16x8 v; } vf; const unsigned char* vp = vb_ + (dvb * 16 + lr) * VRS + (hf * 32 + g * 4) * 2;
                    vf.u[0] = *(const u32x2*)vp; vf.u[1] = *(const u32x2*)(vp + 32);
                    oacc[dvb][0] = mfma16(vf.v, pf[0], oacc[dvb][0]); oacc[dvb][1] = mfma16(vf.v, pf[1], oacc[dvb][1]); }
              }
            }
            __syncthreads();
        }
#pragma unroll
        for (int qb = 0; qb < 2; ++qb) {
            float l = lrow[qb]; l += shx(l, 16, lane); l += shx(l, 32, lane); const float inv = 1.0f / l;
            bf16_t* zr = Zp + (tq + qb * 16 + lr) * 1024 + h * 128 + g * 4;
#pragma unroll
            for (int dvb = 0; dvb < 8; ++dvb) { const u32x2 zw = *(const u32x2*)(zr + dvb * 16); const f32x4 o = oacc[dvb][qb] * inv; u32x2 ow;
                ow.x = cvt_pk_bf16(o[0] * bflo(zw.x), o[1] * bfhi(zw.x)); ow.y = cvt_pk_bf16(o[2] * bflo(zw.y), o[3] * bfhi(zw.y)); *(u32x2*)(zr + dvb * 16) = ow; }
        }
#undef ATT_LOADK
#undef ATT_LOADV
#undef ATT_STOREK
#undef ATT_STOREV
    }
}

__device__ __forceinline__ void mlstm_a(unsigned char* lds, const Params& p, int l, const int g_wv) {
    constexpr int K2RS = 272, TRS = 160; constexpr int OFF_K2 = 0, OFF_WKT = 64 * K2RS, OFF_VT = OFF_WKT + 128 * TRS, OFF_WG = OFF_VT + 256 * TRS;
    unsigned char* ws = p.ws; int tid = TIDX; asm volatile("" : "+v"(tid)); const int lane = tid & 63, w = tid >> 6, lr = lane & 15, g = lane >> 4;
    const bf16_t* QB = (const bf16_t*)(ws + WS_QB); const bf16_t* KB = (const bf16_t*)(ws + WS_KB); const bf16_t* VB = (const bf16_t*)(ws + WS_VB);
    bf16_t* Q2 = (bf16_t*)(ws + WS_Q2); bf16_t* K2 = (bf16_t*)(ws + WS_K2); const float* gates = (const float*)(ws + WS_GATES);
    const float* cw = p.conv_w + (size_t)l * 4 * 1024; const float* cb = p.conv_b + (size_t)l * 1024;
    float* wg = (float*)(lds + OFF_WG);
    for (int ku = 0; ; ++ku) { int u; { const int cb_ = blockIdx.x; if (gridDim.x == 256) { if (ku >= (cb_ < 128 ? 3 : 5)) break; u = cb_ < 128 ? cb_ + 128 * ku : 384 + (cb_ - 128) + 128 * ku; } else { u = cb_ + ku * (int)gridDim.x; if (u >= 1024) break; } }
        const int bh = u >> 6, c = u & 63, b = bh >> 2, h = bh & 3; const size_t t0 = (size_t)b * SEQ + c * 64;
#pragma unroll 1
        for (int it = 0; it < 4; ++it) {
            const int item = tid + NTHR * it, which = item >> 10, s = (item >> 4) & 63, grp = item & 15; const int ch0 = h * 128 + grp * 8, cc0 = which * 512 + ch0;
            const bf16_t* src = which ? KB : QB; float a[8];
            { const f32x4 b0 = *(const f32x4*)(cb + cc0), b1 = *(const f32x4*)(cb + cc0 + 4); a[0] = b0[0]; a[1] = b0[1]; a[2] = b0[2]; a[3] = b0[3]; a[4] = b1[0]; a[5] = b1[1]; a[6] = b1[2]; a[7] = b1[3]; }
#pragma unroll
            for (int j = 0; j < 4; ++j) { const int tp = c * 64 + s - 3 + j;
                if (tp >= 0) { const u32x4 xw = *(const u32x4*)(src + ((size_t)b * SEQ + tp) * 512 + ch0); const f32x4 w0 = *(const f32x4*)(cw + j * 1024 + cc0), w1 = *(const f32x4*)(cw + j * 1024 + cc0 + 4);
                    a[0] += bflo(xw.x) * w0[0]; a[1] += bfhi(xw.x) * w0[1]; a[2] += bflo(xw.y) * w0[2]; a[3] += bfhi(xw.y) * w0[3];
                    a[4] += bflo(xw.z) * w1[0]; a[5] += bfhi(xw.z) * w1[1]; a[6] += bflo(xw.w) * w1[2]; a[7] += bfhi(xw.w) * w1[3]; } }
            const float ksc = which ? 0.08838834764831845f : 1.0f;
#pragma unroll
            for (int i = 0; i < 8; ++i) a[i] = fsilu(a[i]) * ksc;
            u32x4 ow; ow.x = cvt_pk_bf16(a[0], a[1]); ow.y = cvt_pk_bf16(a[2], a[3]); ow.z = cvt_pk_bf16(a[4], a[5]); ow.w = cvt_pk_bf16(a[6], a[7]);
            *(u32x4*)((which ? K2 : Q2) + (t0 + s) * 512 + ch0) = ow;
            if (which) *(u32x4*)(lds + OFF_K2 + s * K2RS + grp * 16) = ow;
        }
        if (w == 0) {
            const float fpre = gates[(t0 + lane) * 8 + 4 + h] + p.f_bias[l * 4 + h]; const float li = gates[(t0 + lane) * 8 + h] + p.i_bias[l * 4 + h];
            const float lf = fminf(fpre, 0.f) - log1pf(__expf(-fabsf(fpre)));
            float bc = lf;
#pragma unroll
            for (int o = 1; o < 64; o <<= 1) { const float v = shup(bc, o, lane); if (lane >= o) bc += v; }
            const float blast = __int_as_float(__builtin_amdgcn_readlane(__float_as_int(bc), 63)); const float gg = blast - bc + li; float gm = gg;
#pragma unroll
            for (int o = 1; o < 64; o <<= 1) gm = fmaxf(gm, shx(gm, o, lane));
            wg[lane] = __expf(gg - gm);
            ((float*)(ws + WS_BV))[(size_t)u * 64 + lane] = bc; ((float*)(ws + WS_LIV))[(size_t)u * 64 + lane] = li;
            if (lane == 0) { ((float*)(ws + WS_BLAST))[u] = blast; ((float*)(ws + WS_GMAX))[u] = gm; }
        }
#pragma unroll
        for (int it = 0; it < 4; ++it) { const int item = tid + NTHR * it, s = item & 63, eg = item >> 6; const u32x4 vw = *(const u32x4*)(VB + (t0 + s) * 1024 + h * 256 + eg * 8);
            bf16_t* d = (bf16_t*)(lds + OFF_VT + (eg * 8) * TRS + s * 2); const unsigned vv[4] = {vw.x, vw.y, vw.z, vw.w};
#pragma unroll
            for (int i = 0; i < 4; ++i) { *(bf16_t*)((unsigned char*)d + (2 * i) * TRS) = (bf16_t)(vv[i] & 0xffffu); *(bf16_t*)((unsigned char*)d + (2 * i + 1) * TRS) = (bf16_t)(vv[i] >> 16); } }
        __syncthreads();
#pragma unroll 1
        for (int it = 0; it < 2; ++it) { const int item = tid + NTHR * it, s = item & 63, dg = item >> 6; const u32x4 kw = *(const u32x4*)(lds + OFF_K2 + s * K2RS + dg * 16); const float ww = wg[s];
            const unsigned kv[4] = {kw.x, kw.y, kw.z, kw.w}; unsigned char* d = lds + OFF_WKT + (dg * 8) * TRS + s * 2;
#pragma unroll
            for (int i = 0; i < 4; ++i) { *(bf16_t*)(d + (2 * i) * TRS) = f2bf(bflo(kv[i]) * ww); *(bf16_t*)(d + (2 * i + 1) * TRS) = f2bf(bfhi(kv[i]) * ww); } }
        __syncthreads();
#if defined(MK_DEBUG_HASH)
        { unsigned char* dbg = ws + WS_END + MiB + (size_t)u * 40960; for (int i = tid; i < 2560; i += NTHR) *(u32x4*)(dbg + i * 16) = *(const u32x4*)(lds + OFF_VT + i * 16); }
#endif
        if (tid < 128) { float a = 0.f; const unsigned char* r = lds + OFF_WKT + tid * TRS;
#pragma unroll
            for (int i = 0; i < 8; ++i) { const u32x4 x = *(const u32x4*)(r + i * 16); a += (bflo(x.x) + bfhi(x.x)) + (bflo(x.y) + bfhi(x.y)) + (bflo(x.z) + bfhi(x.z)) + (bflo(x.w) + bfhi(x.w)); }
            ((float*)(ws + WS_NST))[(size_t)u * 128 + tid] = a; }
        f32x4 acc[8][2];
#pragma unroll
        for (int i = 0; i < 8; ++i) { acc[i][0] = zero4(); acc[i][1] = zero4(); }
#pragma unroll
        for (int kc = 0; kc < 2; ++kc) {
            const bf16x8 v0 = *(const bf16x8*)(lds + OFF_VT + (w * 32 + lr) * TRS + kc * 64 + g * 16), v1 = *(const bf16x8*)(lds + OFF_VT + (w * 32 + 16 + lr) * TRS + kc * 64 + g * 16);
#pragma unroll
            for (int db = 0; db < 8; ++db) { const bf16x8 kf = *(const bf16x8*)(lds + OFF_WKT + (db * 16 + lr) * TRS + kc * 64 + g * 16); acc[db][0] = mfma16(kf, v0, acc[db][0]); acc[db][1] = mfma16(kf, v1, acc[db][1]); }
        }
        bf16_t* cst = (bf16_t*)(ws + WS_CST) + (size_t)u * 32768; float one = 1.0f; asm volatile("" : "+v"(one));
#pragma unroll
        for (int eb = 0; eb < 2; ++eb)
#pragma unroll
            for (int db = 0; db < 8; ++db) { const f32x4 av = acc[db][eb] * one; u32x2 o; o.x = cvt_pk_bf16(av[0], av[1]); o.y = cvt_pk_bf16(av[2], av[3]); *(u32x2*)(cst + (size_t)(w * 32 + eb * 16 + lr) * 128 + db * 16 + g * 4) = o; }
        __syncthreads();
    }
}
__device__ __forceinline__ void mlstm_b(const Params& p, const int g_wv) {
    unsigned char* ws = p.ws; int tid = TIDX; asm volatile("" : "+v"(tid)); const float* blast = (const float*)(ws + WS_BLAST); const float* gmax = (const float*)(ws + WS_GMAX);
    for (int u = blockIdx.x; u < 256; u += gridDim.x) {
        const int bh = u >> 4, eb = u & 15; bf16_t* base = (bf16_t*)(ws + WS_CST) + (size_t)bh * 64 * 32768 + eb * 2048 + tid * 4;
        float* nb = (float*)(ws + WS_NST) + (size_t)bh * 64 * 128 + tid; const bool don = (eb == 0 && tid < 128);
        float m = 0.f, c0 = 0.f, c1 = 0.f, c2 = 0.f, c3 = 0.f, nn = 0.f;
#pragma unroll 16
        for (int c = 0; c < 64; ++c) {
            const float bl = blast[bh * 64 + c], gm = gmax[bh * 64 + c]; const float mn = fmaxf(bl + m, gm); const float dec = __expf(bl + m - mn), inw = __expf(gm - mn);
            u32x2* sp = (u32x2*)(base + (size_t)c * 32768); const u32x2 uw = *sp; u32x2 o; o.x = cvt_pk_bf16(c0, c1); o.y = cvt_pk_bf16(c2, c3); *sp = o;
            c0 = dec * c0 + inw * bflo(uw.x); c1 = dec * c1 + inw * bfhi(uw.x); c2 = dec * c2 + inw * bflo(uw.y); c3 = dec * c3 + inw * bfhi(uw.y);
            if (don) { const float nu = nb[c * 128]; nb[c * 128] = nn; nn = dec * nn + inw * nu; }
            if (eb == 0 && tid == 0) ((float*)(ws + WS_MST))[bh * 64 + c] = m;
            m = mn;
        }
        asm volatile("s_waitcnt vmcnt(0)" ::: "memory"); __syncthreads();
        if (tid == 0) { __builtin_amdgcn_fence(__ATOMIC_RELEASE, "agent"); asm volatile("s_waitcnt vmcnt(0)" ::: "memory");
            __hip_atomic_fetch_add((unsigned*)(ws + WS_CTR) + 16 + bh, 1u, __ATOMIC_RELAXED, __HIP_MEMORY_SCOPE_AGENT); }
    }
}
__device__ __forceinline__ void mlstm_c(unsigned char* lds, const Params& p, int l, const int g_wv) {
    constexpr int QRS = 288, TRS = 160; constexpr int OFF_Q = 0, OFF_K = 64 * QRS, OFF_VT = 2 * 64 * QRS, OFF_P = OFF_VT + 256 * TRS, OFF_F = OFF_P + 64 * TRS;
    unsigned char* ws = p.ws; int tid = TIDX; asm volatile("" : "+v"(tid)); const int lane = tid & 63, w = tid >> 6, lr = lane & 15, g = lane >> 4;
    const bf16_t* Q2 = (const bf16_t*)(ws + WS_Q2); const bf16_t* K2 = (const bf16_t*)(ws + WS_K2); const bf16_t* VB = (const bf16_t*)(ws + WS_VB);
    const bf16_t* OB = (const bf16_t*)(ws + WS_OB); bf16_t* ZB = (bf16_t*)(ws + WS_Z + 32 * MiB); const float* gn = p.out_norm + (size_t)l * 1024;
    float* fb = (float*)(lds + OFF_F); float* bvec = fb; float* livec = fb + 64; float* mt = fb + 128; float* wint = fb + 192; float* denV = fb + 256; float* denC = fb + 320; float* lsum = fb + 384; float* lsq = fb + 448; float* nvec = fb + 512;
    for (int u = blockIdx.x; u < 1024; u += gridDim.x) {
        const int bh = u >> 6, c = u & 63, b = bh >> 2, h = bh & 3; const size_t t0 = (size_t)b * SEQ + c * 64;
        if (tid == 0) { const unsigned want = 16u * (unsigned)(l + 1); while (__hip_atomic_load((unsigned*)(ws + WS_CTR) + 16 + bh, __ATOMIC_RELAXED, __HIP_MEMORY_SCOPE_AGENT) < want) __builtin_amdgcn_s_sleep(1);
            __builtin_amdgcn_fence(__ATOMIC_ACQUIRE, "agent"); asm volatile("s_waitcnt vmcnt(0)" ::: "memory"); }
        __syncthreads();
        const float mc = ((const float*)(ws + WS_MST))[u];
#pragma unroll
        for (int it = 0; it < 2; ++it) { const int id = tid + NTHR * it, s = id >> 4, ch = id & 15;
            *(u32x4*)(lds + OFF_Q + s * QRS + ch * 16) = *(const u32x4*)(Q2 + (t0 + s) * 512 + h * 128 + ch * 8); *(u32x4*)(lds + OFF_K + s * QRS + ch * 16) = *(const u32x4*)(K2 + (t0 + s) * 512 + h * 128 + ch * 8); }
#pragma unroll 2
        for (int it = 0; it < 4; ++it) { const int item = tid + NTHR * it, s = item & 63, eg = item >> 6; const u32x4 vw = *(const u32x4*)(VB + (t0 + s) * 1024 + h * 256 + eg * 8);
            unsigned char* d = lds + OFF_VT + (eg * 8) * TRS + s * 2; const unsigned vv[4] = {vw.x, vw.y, vw.z, vw.w};
#pragma unroll
            for (int i = 0; i < 4; ++i) { *(bf16_t*)(d + (2 * i) * TRS) = (bf16_t)(vv[i] & 0xffffu); *(bf16_t*)(d + (2 * i + 1) * TRS) = (bf16_t)(vv[i] >> 16); } }
        if (tid < 64) { bvec[tid] = ((const float*)(ws + WS_BV))[(size_t)u * 64 + tid]; livec[tid] = ((const float*)(ws + WS_LIV))[(size_t)u * 64 + tid]; lsum[tid] = 0.f; lsq[tid] = 0.f; }
        else if (tid < 192) nvec[tid - 64] = ((const float*)(ws + WS_NST))[(size_t)u * 128 + tid - 64];
        __syncthreads();
        if (w == 0) { float x = livec[lane] - bvec[lane];
#pragma unroll
            for (int o = 1; o < 64; o <<= 1) { const float v = shup(x, o, lane); if (lane >= o) x = fmaxf(x, v); }
            const float mtl = bvec[lane] + fmaxf(mc, x); mt[lane] = mtl; wint[lane] = __expf(bvec[lane] + mc - mtl); }
        __syncthreads();
        { const int lb = w >> 1;
#pragma unroll
          for (int si = 0; si < 2; ++si) { const int sb = (w & 1) * 2 + si; f32x4 a = zero4();
            if (sb <= lb) {
#pragma unroll
                for (int kc = 0; kc < 4; ++kc) { const bf16x8 qf = *(const bf16x8*)(lds + OFF_Q + (lb * 16 + lr) * QRS + kc * 64 + g * 16), kf = *(const bf16x8*)(lds + OFF_K + (sb * 16 + lr) * QRS + kc * 64 + g * 16); a = mfma16(qf, kf, a); }
            }
            const int s = sb * 16 + lr; const float bs = bvec[s] - livec[s];
#pragma unroll
            for (int r = 0; r < 4; ++r) { const int ll = lb * 16 + g * 4 + r; float v = 0.f; if (s <= ll) v = a[r] * __expf(bvec[ll] - bs - mt[ll]); *(bf16_t*)(lds + OFF_P + ll * TRS + s * 2) = f2bf(v); } } }
        __syncthreads();
        if (w == 0) { float a = 0.f; const unsigned char* r = lds + OFF_P + lane * TRS;
#pragma unroll
            for (int i = 0; i < 8; ++i) { const u32x4 x = *(const u32x4*)(r + i * 16); a += (bflo(x.x) + bfhi(x.x)) + (bflo(x.y) + bfhi(x.y)) + (bflo(x.z) + bfhi(x.z)) + (bflo(x.w) + bfhi(x.w)); }
            denV[lane] = a; }
        else if (w == 1) { float a = 0.f; const unsigned char* r = lds + OFF_Q + lane * QRS;
#pragma unroll
            for (int i = 0; i < 16; ++i) { const u32x4 x = *(const u32x4*)(r + i * 16); const float* nv = nvec + i * 8;
                a += bflo(x.x) * nv[0] + bfhi(x.x) * nv[1] + bflo(x.y) * nv[2] + bfhi(x.y) * nv[3] + bflo(x.z) * nv[4] + bfhi(x.z) * nv[5] + bflo(x.w) * nv[6] + bfhi(x.w) * nv[7]; }
            denC[lane] = a; }
        f32x4 accV[2][4], accC[2][4];
#pragma unroll
        for (int i = 0; i < 2; ++i)
#pragma unroll
            for (int j = 0; j < 4; ++j) { accV[i][j] = zero4(); accC[i][j] = zero4(); }
        const bf16_t* cst = (const bf16_t*)(ws + WS_CST) + (size_t)u * 32768;
#pragma unroll
        for (int kp = 0; kp < 2; ++kp) {
        bf16x8 ctf[2][2];
#pragma unroll
        for (int k2 = 0; k2 < 2; ++k2) { const int kc = kp * 2 + k2; ctf[k2][0] = *(const bf16x8*)(cst + (size_t)(w * 32 + lr) * 128 + kc * 32 + g * 8); ctf[k2][1] = *(const bf16x8*)(cst + (size_t)(w * 32 + 16 + lr) * 128 + kc * 32 + g * 8); }
#pragma unroll
        for (int k2 = 0; k2 < 2; ++k2) { const int kc = kp * 2 + k2;
            const bf16x8 c0 = ctf[k2][0], c1 = ctf[k2][1];
#pragma unroll
            for (int lb = 0; lb < 4; ++lb) { const bf16x8 qf = *(const bf16x8*)(lds + OFF_Q + (lb * 16 + lr) * QRS + kc * 64 + g * 16); accC[0][lb] = mfma16(c0, qf, accC[0][lb]); accC[1][lb] = mfma16(c1, qf, accC[1][lb]); }
        }
        }
#pragma unroll
        for (int kc = 0; kc < 2; ++kc) {
            const bf16x8 v0 = *(const bf16x8*)(lds + OFF_VT + (w * 32 + lr) * TRS + kc * 64 + g * 16), v1 = *(const bf16x8*)(lds + OFF_VT + (w * 32 + 16 + lr) * TRS + kc * 64 + g * 16);
#pragma unroll
            for (int lb = 0; lb < 4; ++lb) { const bf16x8 pf = *(const bf16x8*)(lds + OFF_P + (lb * 16 + lr) * TRS + kc * 64 + g * 16); accV[0][lb] = mfma16(v0, pf, accV[0][lb]); accV[1][lb] = mfma16(v1, pf, accV[1][lb]); }
        }
        __syncthreads();
#pragma unroll
        for (int lb = 0; lb < 4; ++lb) { const int ll = lb * 16 + lr; const float wi = wint[ll]; const float den = wi * denC[ll] + denV[ll]; const float dn = 1.0f / fmaxf(fabsf(den), __expf(-mt[ll])); float s1 = 0.f, s2 = 0.f;
#pragma unroll
            for (int eb = 0; eb < 2; ++eb) { const f32x4 hv = (accC[eb][lb] * wi + accV[eb][lb]) * dn; accV[eb][lb] = hv; s1 += (hv[0] + hv[1]) + (hv[2] + hv[3]); s2 += (hv[0] * hv[0] + hv[1] * hv[1]) + (hv[2] * hv[2] + hv[3] * hv[3]); }
            s1 += shx(s1, 16, lane); s1 += shx(s1, 32, lane); s2 += shx(s2, 16, lane); s2 += shx(s2, 32, lane);
            if (g == 0) { fb[640 + w * 64 + ll] = s1; fb[1152 + w * 64 + ll] = s2; } }
        __syncthreads();
#pragma unroll
        for (int lb = 0; lb < 4; ++lb) { const int ll = lb * 16 + lr; float t1 = 0.f, t2 = 0.f;
#pragma unroll
            for (int ww = 0; ww < 8; ++ww) { t1 += fb[640 + ww * 64 + ll]; t2 += fb[1152 + ww * 64 + ll]; }
            const float mu = t1 * (1.0f / 256.0f); const float var = fmaxf(t2 * (1.0f / 256.0f) - mu * mu, 0.f); const float rstd = rsqrtf(var + EPS);
#pragma unroll
            for (int eb = 0; eb < 2; ++eb) { const int e = w * 32 + eb * 16 + g * 4; const size_t off = (t0 + ll) * 1024 + h * 256 + e; const f32x4 gv = *(const f32x4*)(gn + h * 256 + e);
                const u32x2 ow = *(const u32x2*)(OB + off), zw = *(const u32x2*)(ZB + off); const f32x4 hv = accV[eb][lb]; u32x2 o;
                o.x = cvt_pk_bf16((hv[0] - mu) * rstd * gv[0] * bflo(ow.x) * bflo(zw.x), (hv[1] - mu) * rstd * gv[1] * bfhi(ow.x) * bfhi(zw.x));
                o.y = cvt_pk_bf16((hv[2] - mu) * rstd * gv[2] * bflo(ow.y) * bflo(zw.y), (hv[3] - mu) * rstd * gv[3] * bfhi(ow.y) * bfhi(zw.y)); *(u32x2*)(ZB + off) = o; } }
        __syncthreads();
    }
}

#ifndef PHM
#define PHM 4095
#endif
typedef const __attribute__((address_space(4))) Params* KParams;
#if defined(__HIP_DEVICE_COMPILE__)
__device__ __forceinline__ Params load_params() { KParams k = (KParams)__builtin_amdgcn_kernarg_segment_ptr(); asm volatile("" : "+s"(k)); return *k; }
#else
__device__ __forceinline__ Params load_params() { return Params{}; }
#endif
#define PP load_params()
#define GSYNC() do { asm volatile("s_waitcnt vmcnt(0) lgkmcnt(0)" ::: "memory"); __builtin_amdgcn_fence(__ATOMIC_RELEASE, "agent"); asm volatile("s_waitcnt vmcnt(0)" ::: "memory"); grid.sync(); \
    __builtin_amdgcn_fence(__ATOMIC_ACQUIRE, "agent"); asm volatile("s_waitcnt vmcnt(0) lgkmcnt(0)" ::: "memory"); } while (0)
__device__ __forceinline__ void gbar(unsigned* ctr, unsigned target, const int g_wv) {
    asm volatile("s_waitcnt vmcnt(0) lgkmcnt(0)" ::: "memory");
    __syncthreads();
    if (TIDX == 0) {
        __builtin_amdgcn_fence(__ATOMIC_RELEASE, "agent"); asm volatile("s_waitcnt vmcnt(0)" ::: "memory");
        __hip_atomic_fetch_add(ctr, 1u, __ATOMIC_RELAXED, __HIP_MEMORY_SCOPE_AGENT);
        while (__hip_atomic_load(ctr, __ATOMIC_RELAXED, __HIP_MEMORY_SCOPE_AGENT) < target) __builtin_amdgcn_s_sleep(1);
        __builtin_amdgcn_fence(__ATOMIC_ACQUIRE, "agent"); asm volatile("s_waitcnt vmcnt(0)" ::: "memory");
    }
    __syncthreads();
}
template <bool AL = true, bool SP = true, class Epi, class Sched> __device__ __forceinline__ void run_gemm(unsigned char* lds, const bf16_t* A, const bf16_t* Bt, int M, int N, int K, int lda, int ldb, const Sched& S, const Epi& E, const int g_wv) {
    pg8::Gemm g{A, Bt, M, N, K, lda, ldb};
    pg8::gemm_phase<Epi, Sched, AL, SP>((PG8_LAS unsigned char*)lds, g, S, E, g_wv);
    __syncthreads();
}

__global__ void __launch_bounds__(NTHR, 2) mega(Params p_arg) {
    extern __shared__ __attribute__((aligned(16))) unsigned char lds[];
    cg::grid_group grid = cg::this_grid();
    const int g_wv = __builtin_amdgcn_readfirstlane((int)(__builtin_amdgcn_workitem_id_x() >> 6));
    const int G = gridDim.x, cb = blockIdx.x; const int w_lo = p_arg.w_lo, w_hi = p_arg.w_hi;
#define WIN(k_) (w_lo <= (k_) && (k_) < w_hi)
    unsigned nbar = 0;
#define SEAM(k_) do { if (WIN(k_) && WIN((k_) + 1)) { ++nbar; gbar((unsigned*)(PP.ws + WS_CTR), nbar * (unsigned)G, g_wv); } } while (0)
    if (w_lo > 1000) GSYNC();
    if (WIN(0)) {
#if PHM & 1
    convert_weights(lds, PP, 0, g_wv); convert_weights(lds, PP, 1, g_wv);
#endif
#if PHM & 2
    build_cs(PP, g_wv);
    { const Params p = PP; rmsnorm_rows<true>(p.x, p.norm_gain, (bf16_t*)(p.ws + WS_H), nullptr, g_wv); }
#endif
    }
    SEAM(0);
#pragma unroll 1
    for (int l = 0; l < 2; ++l) {
        const int wb = 1 + 7 * l;
        if (WIN(wb)) {
#if PHM & 4
        { unsigned char* ws = PP.ws; unsigned char* wl = ws + WS_W0 + (size_t)l * WL_SIZE; const f32x2* cs = (const f32x2*)(ws + WS_CS); (void)cs; (void)wl; pg8::StaticOrder S; S.init(T, 15360, G, cb); EpiIn E{ws}; run_gemm(lds, (const bf16_t*)(ws + WS_H), (const bf16_t*)(wl + WL_WIN), T, 15360, DM, DM, DM, S, E, g_wv); }
        { unsigned char* ws = PP.ws; unsigned char* wl = ws + WS_W0 + (size_t)l * WL_SIZE; const f32x2* cs = (const f32x2*)(ws + WS_CS); (void)cs; (void)wl; pg8::StaticOrder S; S.init(1024, T, G, cb); EpiVT E{(bf16_t*)(ws + WS_VAT), T, nullptr, 0.f}; run_gemm(lds, (const bf16_t*)(wl + WL_WIN) + (size_t)15360 * DM, (const bf16_t*)(ws + WS_H), 1024, T, DM, DM, DM, S, E, g_wv); }
#endif
        }
        SEAM(wb);
        if (WIN(wb + 1)) {
#if PHM & 32
        mlstm_a(lds, PP, l, g_wv);
#endif
#if PHM & 16
        kmean_phase(PP, l, g_wv);
#endif
#if PHM & 8
        { unsigned char* ws = PP.ws; unsigned char* wl = ws + WS_W0 + (size_t)l * WL_SIZE; const f32x2* cs = (const f32x2*)(ws + WS_CS); (void)cs; (void)wl; pg8::StaticOrder S; S.init(T, 1536, G, cb); EpiRow<true> E{(bf16_t*)(ws + WS_QC), 1536, (const float*)(ws + WS_SSP), 1.0f / 512.0f, CC_SCALE, cs}; run_gemm(lds, (const bf16_t*)(ws + WS_CQ), (const bf16_t*)(wl + WL_WUQ), T, 1536, 512, 512, 512, S, E, g_wv); }
        { unsigned char* ws = PP.ws; unsigned char* wl = ws + WS_W0 + (size_t)l * WL_SIZE; const f32x2* cs = (const f32x2*)(ws + WS_CS); (void)cs; (void)wl; pg8::StaticOrder S; S.init(T, 1024, G, cb); EpiRow<false> E{(bf16_t*)(ws + WS_KNC), 1024, (const float*)(ws + WS_SSP), 1.0f / 256.0f, 1.0f, cs}; run_gemm(lds, (const bf16_t*)(ws + WS_CKV), (const bf16_t*)(wl + WL_WKN), T, 1024, 256, 256, 256, S, E, g_wv); }
        { unsigned char* ws = PP.ws; unsigned char* wl = ws + WS_W0 + (size_t)l * WL_SIZE; const f32x2* cs = (const f32x2*)(ws + WS_CS); (void)cs; (void)wl; pg8::StaticOrder S; S.init(1024, T, G, cb); EpiVT E{(bf16_t*)(ws + WS_VCT), T, (const float*)(ws + WS_SSP), 1.0f / 256.0f}; run_gemm(lds, (const bf16_t*)(wl + WL_WV), (const bf16_t*)(ws + WS_CKV), 1024, T, 256, 256, 256, S, E, g_wv); }
#endif
        }
        SEAM(wb + 1);
        if (WIN(wb + 2)) {
#if PHM & 128
        mlstm_b(PP, g_wv);
#endif
#if PHM & 64
        attn_phase<0>(lds, PP, l, g_wv);
#endif
        }
        if (WIN(wb + 3)) {
#if PHM & 256
        attn_phase<1>(lds, PP, l, g_wv);
#endif
#if PHM & 512
        mlstm_c(lds, PP, l, g_wv);
#endif
        }
        SEAM(wb + 3);
        if (WIN(wb + 4)) {
#if PHM & 1024
        { unsigned char* ws = PP.ws; unsigned char* wl = ws + WS_W0 + (size_t)l * WL_SIZE; MergeOrder S{G, cb}; EpiMerge E{(bf16_t*)(ws + WS_H), (const bf16_t*)(ws + WS_GT)}; run_gemm(lds, (const bf16_t*)(ws + WS_Z), (const bf16_t*)(wl + WL_WB), 3 * T, 2048, 1024, 1024, 1024, S, E, g_wv); }
#endif
        }
        SEAM(wb + 4);
        if (WIN(wb + 5)) {
#if PHM & 2048
        { unsigned char* ws = PP.ws; unsigned char* wl = ws + WS_W0 + (size_t)l * WL_SIZE; const f32x2* cs = (const f32x2*)(ws + WS_CS); (void)cs; (void)wl; pg8::StaticOrder S; S.init(T, DM, G, cb); const Params p = PP; EpiOut E{l == 0 ? p.x : p.out, p.out}; run_gemm(lds, (const bf16_t*)(ws + WS_H), (const bf16_t*)(wl + WL_WO), T, DM, DM, DM, DM, S, E, g_wv); }
#endif
        }
        SEAM(wb + 5);
        if (WIN(wb + 6)) {
            if (l == 0) { const Params p = PP; rmsnorm_rows<true>(p.out, p.norm_gain + DM, (bf16_t*)(p.ws + WS_H), nullptr, g_wv); }
            else { const Params p = PP; rmsnorm_rows<false>(p.out, p.final_norm, nullptr, p.out, g_wv); }
        }
        if (l == 0) SEAM(wb + 6);
    }
}


#if defined(MK_DEBUG_HASH)
__global__ void hash_buf(const unsigned* p, size_t nwords, unsigned long long* acc) {
    unsigned long long s = 0; const size_t stride = (size_t)gridDim.x * blockDim.x;
    for (size_t i = (size_t)blockIdx.x * blockDim.x + threadIdx.x; i < nwords; i += stride) s += (unsigned long long)p[i] * (unsigned long long)(((unsigned)i * 2654435761u) | 1u);
    atomicAdd(acc, s);
}
__global__ void dbg_final(float* out, size_t n, const unsigned long long* h, int R, int NK) {
    __shared__ float flag;
    if (threadIdx.x == 0) { float f = 1.0f; for (int k = NK - 1; k >= 0; --k) for (int r = 1; r < R; ++r) if (h[r * NK + k] != h[k]) { f = 100.0f; for (int q = 0; q < k; ++q) f *= 10.0f; } flag = f; }
    __syncthreads();
    for (size_t i = (size_t)blockIdx.x * blockDim.x + threadIdx.x; i < n; i += (size_t)gridDim.x * blockDim.x) out[i] = (i == 0) ? flag : 0.0f;
}
#endif
extern "C" void kernel_launch(void* const* d_in, const int* in_sizes, int n_in, void* d_out, int out_size, void* d_ws, size_t ws_size, hipStream_t stream) {
    static int grid = 0;
    if (grid == 0) {
        if (n_in != 16 || ws_size < WS_END) { fprintf(stderr, "kernel_launch: unexpected n_in %d or ws_size %zu < %zu\n", n_in, ws_size, (size_t)WS_END); grid = -1; return; }
        int dev = 0, cus = 0, per_cu = 0;
        hipGetDevice(&dev); hipDeviceGetAttribute(&cus, hipDeviceAttributeMultiprocessorCount, dev);
        if (hipFuncSetAttribute((const void*)mega, hipFuncAttributeMaxDynamicSharedMemorySize, LDS_BYTES) != hipSuccess) { fprintf(stderr, "kernel_launch: hipFuncSetAttribute failed\n"); grid = -1; return; }
        if (hipOccupancyMaxActiveBlocksPerMultiprocessor(&per_cu, (const void*)mega, NTHR, LDS_BYTES) != hipSuccess || per_cu < 1) { fprintf(stderr, "kernel_launch: occupancy query gave %d\n", per_cu); per_cu = 1; }
        (void)hipGetLastError();
        grid = cus * 1;
    }
    if (grid < 0) return;
    Params p{};
    p.x = (const float*)d_in[0]; p.norm_gain = (const float*)d_in[1]; p.w_in = (const float*)d_in[2]; p.t5 = (const float*)d_in[3]; p.conv_w = (const float*)d_in[4]; p.conv_b = (const float*)d_in[5];
    p.i_bias = (const float*)d_in[6]; p.f_bias = (const float*)d_in[7]; p.out_norm = (const float*)d_in[8]; p.q_norm = (const float*)d_in[9]; p.kv_norm = (const float*)d_in[10];
    p.w_uq = (const float*)d_in[11]; p.w_ukv = (const float*)d_in[12]; p.w_branch = (const float*)d_in[13]; p.w_out = (const float*)d_in[14]; p.final_norm = (const float*)d_in[15];
    p.out = (float*)d_out; p.ws = (unsigned char*)d_ws;
    (void)hipMemsetAsync((unsigned char*)d_ws + WS_CTR, 0, 256, stream);
    void* args[] = {&p};
#if defined(MK_DEBUG_HASH)
    {
        constexpr int R = 4, NK = 9; unsigned char* W = (unsigned char*)d_ws; unsigned long long* H = (unsigned long long*)(W + WS_END);
        hipMemsetAsync(H, 0, R * NK * 8, stream);
        struct HB { int win; size_t off; size_t bytes; };
        const HB hb[NK] = { {3, WS_Z, 32 * MiB}, {3, WS_CST, 64 * MiB}, {3, WS_NST, 524288}, {3, WS_MST, 4096},
                            {4, WS_Z + 64 * MiB, 32 * MiB}, {4, WS_Z + 32 * MiB, 32 * MiB}, {5, WS_H, 64 * MiB}, {6, WS_H, 64 * MiB}, {2, WS_CST, 64 * MiB} };
        for (int r = 0; r < R; ++r)
            for (int w = 0; w < 7; ++w) { p.w_lo = w; p.w_hi = w + 1;
                hipError_t e = hipLaunchCooperativeKernel((const void*)mega, dim3(grid), dim3(NTHR), args, LDS_BYTES, stream);
                if (e != hipSuccess) fprintf(stderr, "kernel_launch: cooperative launch failed: %s\n", hipGetErrorString(e));
                for (int k = 0; k < NK; ++k) if (hb[k].win == w) {
                    if (k == 7) hash_buf<<<256, 256, 0, stream>>>((const unsigned*)d_out, (size_t)T * DM, H + r * NK + k);
                    else hash_buf<<<256, 256, 0, stream>>>((const unsigned*)(W + hb[k].off), hb[k].bytes / 4, H + r * NK + k); } }
        dbg_final<<<256, 256, 0, stream>>>((float*)d_out, (size_t)T * DM, H, R, NK);
    }
    if (false) {
#elif defined(MK_MULTI)
    for (int w = 0; w < 15; ++w) { p.w_lo = w; p.w_hi = w + 1;
#else
    { p.w_lo = 0; p.w_hi = 15;
#endif
        hipError_t e = hipLaunchCooperativeKernel((const void*)mega, dim3(grid), dim3(NTHR), args, LDS_BYTES, stream);
        if (e != hipSuccess) fprintf(stderr, "kernel_launch: cooperative launch failed: %s (grid %d)\n", hipGetErrorString(e), grid);
    }
}
```

```cpp
#include <hip/hip_runtime.h>
#include <hip/hip_cooperative_groups.h>
#include <cstdio>
#include <cstdint>
namespace cg = cooperative_groups;
__device__ __forceinline__ int tidx_opaque(int g_wv) { int l; asm volatile("v_mbcnt_lo_u32_b32 %0, -1, 0\n\tv_mbcnt_hi_u32_b32 %0, -1, %0" : "=v"(l)); return g_wv * 64 + l; }
#define TIDX tidx_opaque(g_wv)
__device__ __forceinline__ float shx(float v, int o, int lane) { return __int_as_float(__builtin_amdgcn_ds_bpermute(((lane ^ o) & 63) << 2, __float_as_int(v))); }
__device__ __forceinline__ int shxi(int v, int o, int lane) { return __builtin_amdgcn_ds_bpermute(((lane ^ o) & 63) << 2, v); }
__device__ __forceinline__ float shup(float v, int o, int lane) { return __int_as_float(__builtin_amdgcn_ds_bpermute(((lane - o) & 63) << 2, __float_as_int(v))); }

namespace pg8 {
#define PG8_LAS __attribute__((address_space(3)))
typedef unsigned short bf16_t;
typedef short bf16x8 __attribute__((ext_vector_type(8)));
typedef float f32x4 __attribute__((ext_vector_type(4)));
typedef unsigned u32x4 __attribute__((ext_vector_type(4)));
constexpr int BM = 256, BK = 64, HALF = 128, HTB = HALF * BK * 2  , STAGE_BYTES = 8 * HTB, NXCD = 8, WGM = 8;

__host__ __device__ __forceinline__ int lds_byte(int r, int c) { const int st = (r >> 4) * 2 + (c >> 5), rr = r & 15, cc = c & 31, ob = rr * 64 + cc * 2; return st * 1024 + (ob ^ (((ob >> 9) & 1) << 5)); }
__host__ __device__ __forceinline__ void stage_rc(int b, int& R, int& C) { const int st = b / 1024, sb = b % 1024, swz = sb ^ (((sb >> 9) & 1) << 5); R = (st >> 1) * 16 + swz / 64; C = (st & 1) * 32 + (swz % 64) / 2; }
__host__ __device__ __forceinline__ int perm32(int rho) { const int n = rho >> 4, i = rho & 15; return 8 * (i >> 2) + 4 * n + (i & 3); }

struct Unit { int pm, pn, pb; };
struct Gemm { const bf16_t* A; const bf16_t* Bt; int M, N, K, lda, ldb; };

struct StaticOrder {
    int nM, nN, nwg, G, c;
    __host__ __device__ void init(int M, int N, int G_, int c_) { nM = M / BM; nN = N / BM; nwg = nM * nN; G = G_; c = c_; }
    __host__ __device__ bool next(int i, Unit& u) const {
        const long L = (long)i * G + c; if (L >= nwg) return false;
        int wgid = (int)L; { const int q = nwg / NXCD, r = nwg % NXCD, xcd = wgid % NXCD, off = wgid / NXCD; wgid = (xcd < r ? xcd * (q + 1) : r * (q + 1) + (xcd - r) * q) + off; }
        const int nig = WGM * nN, gid = wgid / nig, fm = gid * WGM, gsz = (nM - fm) < WGM ? (nM - fm) : WGM;
        u.pm = fm + ((wgid % nig) % gsz); u.pn = (wgid % nig) / gsz; u.pb = u.pn; return true;
    }
    __device__ __forceinline__ void a_ready(const Unit&) const {}
    __device__ __forceinline__ void done(const Unit&) const {}
};

__device__ __forceinline__ unsigned cvt_pk_bf16(float lo, float hi) { unsigned r; asm volatile("s_nop 1\n\tv_cvt_pk_bf16_f32 %0, %1, %2\n\ts_nop 1" : "=v"(r) : "v"(lo), "v"(hi)); return r; }
template <class Epi, class Sched, bool ALIGN_EPI = false, bool SP2 = false>
__device__ __forceinline__ void gemm_phase(PG8_LAS unsigned char* lds, const Gemm g, const Sched& S, const Epi& E, const int g_wv) {
    int tid = TIDX; asm volatile("" : "+v"(tid)); const int wid = __builtin_amdgcn_readfirstlane(tid >> 6), lane = tid & 63, wr = wid >> 2, wc = wid & 3, fr = lane & 15, fq = lane >> 4;
    const int K = g.K, nt = K / BK;
    unsigned voffA[2], voffB[2];
#pragma unroll
    for (int i = 0; i < 2; ++i) { int R, C; stage_rc(tid * 16 + i * 8192, R, C); const int Rb = Epi::PERM ? ((R & ~31) + perm32(R & 31)) : R;
        voffA[i] = (unsigned)(R * K + C) * 2u; voffB[i] = (unsigned)(Rb * K + C) * 2u; }
    const size_t kstep = (size_t)(BK * 2);
    const size_t hstepA = (size_t)HALF * K * 2; const size_t hstepB = hstepA;
    const size_t tstepA = 2 * hstepA; const size_t tstepB = tstepA;
    const unsigned ldsw = (unsigned)wid * 1024u;
    const int aoff = lds_byte(wr * 64 + fr, fq * 8), boff = lds_byte(wc * 32 + fr, fq * 8);
#define PG8_SA(b, h) (((b) * 2 + (h)) * HTB)
#define PG8_SB(b, h) ((4 + (b) * 2 + (h)) * HTB)
#define PG8_STAGE(bufoff, gbase, voff) do { _Pragma("unroll") for (int _i = 0; _i < 2; ++_i) \
        __builtin_amdgcn_global_load_lds((const unsigned*)((const char*)(gbase) + (voff)[_i]), (PG8_LAS unsigned*)(lds + (bufoff) + ldsw + _i * 8192), 16, 0, 0); } while (0)
#define PG8_LDA(dst, b, h) do { _Pragma("unroll") for (int m = 0; m < 4; ++m) _Pragma("unroll") for (int k = 0; k < 2; ++k) dst[m][k] = *(const PG8_LAS bf16x8*)(lds + PG8_SA(b, h) + aoff + m * 2048 + k * 1024); } while (0)
#define PG8_LDB(dst, b, h) do { _Pragma("unroll") for (int n = 0; n < 2; ++n) _Pragma("unroll") for (int k = 0; k < 2; ++k) dst[n][k] = *(const PG8_LAS bf16x8*)(lds + PG8_SB(b, h) + boff + n * 2048 + k * 1024); } while (0)
#define PG8_MMA(ai, bj, At, Bt) do { __builtin_amdgcn_s_setprio(1); _Pragma("unroll") for (int m = 0; m < 4; ++m) _Pragma("unroll") for (int n = 0; n < 2; ++n) _Pragma("unroll") for (int k = 0; k < 2; ++k) \
        acc[ai][bj][m][n] = __builtin_amdgcn_mfma_f32_16x16x32_bf16(Bt[n][k], At[m][k], acc[ai][bj][m][n], 0, 0, 0); __builtin_amdgcn_s_setprio(0); } while (0)
#define PG8_WAIT_V(n) asm volatile("s_waitcnt vmcnt(" #n ")" ::: "memory")
#define PG8_WAIT_L(n) asm volatile("s_waitcnt lgkmcnt(" #n ")" ::: "memory")
#define PG8_BAR __builtin_amdgcn_s_barrier()
#define PG8_SCHED __builtin_amdgcn_sched_barrier(0)
    Unit cur, nxt; int ui = 0;
    if (!S.next(0, cur)) return;
    f32x4 acc[2][2][4][2];
#pragma unroll
    for (int a = 0; a < 2; ++a)
#pragma unroll
        for (int b = 0; b < 2; ++b)
#pragma unroll
            for (int m = 0; m < 4; ++m)
#pragma unroll
                for (int n = 0; n < 2; ++n) acc[a][b][m][n] = (f32x4){0.f, 0.f, 0.f, 0.f};
    bf16x8 At[4][2], B0[2][2], B1[2][2];
    const char* cA = (const char*)g.A + (size_t)cur.pm * tstepA; const char* cB = (const char*)g.Bt + (size_t)cur.pb * tstepB;
    S.a_ready(cur);
    if constexpr (SP2) {
        PG8_STAGE(PG8_SB(0, 0), cB, voffB); PG8_STAGE(PG8_SB(0, 1), cB + hstepB, voffB); PG8_STAGE(PG8_SA(0, 0), cA, voffA); PG8_STAGE(PG8_SA(0, 1), cA + hstepA, voffA);
        if (wr == 1) PG8_BAR;
        PG8_WAIT_V(2); PG8_BAR;
        PG8_STAGE(PG8_SB(1, 0), cB + kstep, voffB); PG8_STAGE(PG8_SA(1, 0), cA + kstep, voffA); PG8_STAGE(PG8_SB(1, 1), cB + hstepB + kstep, voffB);
        PG8_WAIT_V(6); PG8_BAR;
    } else {
        PG8_STAGE(PG8_SB(0, 0), cB, voffB); PG8_STAGE(PG8_SA(0, 0), cA, voffA); PG8_STAGE(PG8_SB(0, 1), cB + hstepB, voffB); PG8_STAGE(PG8_SA(0, 1), cA + hstepA, voffA);
        if (wr == 1) PG8_BAR;
        PG8_WAIT_V(4); PG8_BAR;
        PG8_STAGE(PG8_SB(1, 0), cB + kstep, voffB); PG8_STAGE(PG8_SA(1, 0), cA + kstep, voffA); PG8_STAGE(PG8_SB(1, 1), cB + hstepB + kstep, voffB);
        PG8_WAIT_V(6); PG8_BAR;
    }
    for (;;) {
        const bool has_next = S.next(ui + 1, nxt);
        const char* nA = has_next ? (const char*)g.A + (size_t)nxt.pm * tstepA : cA; const char* nB = has_next ? (const char*)g.Bt + (size_t)nxt.pb * tstepB : cB;
        for (int t = 0; t < nt; t += 2) {
            const bool last = (t == nt - 2);
            const char* a1 = cA + (size_t)(t + 1) * kstep;
            const char* a2 = last ? nA : cA + (size_t)(t + 2) * kstep; const char* b2 = last ? nB : cB + (size_t)(t + 2) * kstep;
            const char* a3 = a2 + kstep; const char* b3 = b2 + kstep;
            if (last && has_next) S.a_ready(nxt);
            if constexpr (SP2) {
            PG8_LDB(B0, 0, 0); PG8_LDB(B1, 0, 1); PG8_SCHED; PG8_LDA(At, 0, 0); PG8_STAGE(PG8_SA(1, 1), a1 + hstepA, voffA);
            PG8_WAIT_V(8); PG8_WAIT_L(0); PG8_BAR; PG8_MMA(0, 0, At, B0); PG8_MMA(0, 1, At, B1); PG8_BAR; PG8_SCHED;
            PG8_LDA(At, 0, 1); PG8_STAGE(PG8_SB(0, 0), b2, voffB); PG8_STAGE(PG8_SB(0, 1), b2 + hstepB, voffB); PG8_STAGE(PG8_SA(0, 0), a2, voffA);
            PG8_WAIT_V(8); PG8_WAIT_L(0); PG8_BAR; PG8_MMA(1, 0, At, B0); PG8_MMA(1, 1, At, B1); PG8_BAR; PG8_SCHED;
            PG8_LDB(B0, 1, 0); PG8_LDB(B1, 1, 1); PG8_SCHED; PG8_LDA(At, 1, 0); PG8_STAGE(PG8_SA(0, 1), a2 + hstepA, voffA);
            PG8_WAIT_V(8); PG8_WAIT_L(0); PG8_BAR; PG8_MMA(0, 0, At, B0); PG8_MMA(0, 1, At, B1); PG8_BAR; PG8_SCHED;
            PG8_LDA(At, 1, 1); PG8_STAGE(PG8_SB(1, 0), b3, voffB); PG8_STAGE(PG8_SB(1, 1), b3 + hstepB, voffB); PG8_STAGE(PG8_SA(1, 0), a3, voffA);
            PG8_WAIT_V(8); PG8_WAIT_L(0); PG8_BAR; PG8_MMA(1, 0, At, B0); PG8_MMA(1, 1, At, B1); PG8_BAR; PG8_SCHED;
            } else {
            PG8_LDB(B0, 0, 0); PG8_SCHED; PG8_LDA(At, 0, 0); PG8_STAGE(PG8_SA(1, 1), a1 + hstepA, voffA);
            PG8_WAIT_L(8); PG8_BAR; PG8_WAIT_L(0); PG8_MMA(0, 0, At, B0); PG8_BAR; PG8_SCHED;
            PG8_LDB(B1, 0, 1); PG8_STAGE(PG8_SB(0, 0), b2, voffB);
            PG8_BAR; PG8_WAIT_L(0); PG8_MMA(0, 1, At, B1); PG8_BAR;
            PG8_LDA(At, 0, 1); PG8_STAGE(PG8_SA(0, 0), a2, voffA);
            PG8_BAR; PG8_WAIT_L(0); PG8_MMA(1, 0, At, B0); PG8_BAR; PG8_SCHED;
            PG8_STAGE(PG8_SB(0, 1), b2 + hstepB, voffB);
            PG8_WAIT_V(6); PG8_BAR; PG8_MMA(1, 1, At, B1); PG8_BAR;
            PG8_LDB(B0, 1, 0); PG8_SCHED; PG8_LDA(At, 1, 0); PG8_STAGE(PG8_SA(0, 1), a2 + hstepA, voffA);
            PG8_WAIT_L(8); PG8_BAR; PG8_WAIT_L(0); PG8_MMA(0, 0, At, B0); PG8_BAR; PG8_SCHED;
            PG8_LDB(B1, 1, 1); PG8_STAGE(PG8_SB(1, 0), b3, voffB);
            PG8_BAR; PG8_WAIT_L(0); PG8_MMA(0, 1, At, B1); PG8_BAR;
            PG8_LDA(At, 1, 1); PG8_STAGE(PG8_SA(1, 0), a3, voffA);
            PG8_BAR; PG8_WAIT_L(0); PG8_MMA(1, 0, At, B0); PG8_BAR; PG8_SCHED;
            PG8_STAGE(PG8_SB(1, 1), b3 + hstepB, voffB);
            PG8_WAIT_V(6); PG8_BAR; PG8_MMA(1, 1, At, B1); PG8_BAR;
            }
        }
        if constexpr (ALIGN_EPI) { if (wr == 0) PG8_BAR; }
        if constexpr (!Epi::AFTER_DRAIN) { E(acc, cur, wr, wc, fr, fq); S.done(cur); }
        if (!has_next) break;
#pragma unroll
        for (int a = 0; a < 2; ++a)
#pragma unroll
            for (int b = 0; b < 2; ++b)
#pragma unroll
                for (int m = 0; m < 4; ++m)
#pragma unroll
                    for (int n = 0; n < 2; ++n) acc[a][b][m][n] = (f32x4){0.f, 0.f, 0.f, 0.f};
        cur = nxt; cA = nA; cB = nB; ++ui;
        if constexpr (ALIGN_EPI) { if (wr == 1) PG8_BAR; }
    }
    PG8_WAIT_V(0);
    if constexpr (!ALIGN_EPI) { if (wr == 0) PG8_BAR; }
    PG8_BAR;
    if constexpr (Epi::AFTER_DRAIN) { E.fused(acc, cur, wr, wc, fr, fq, lds, wid, lane); S.done(cur); }
#undef PG8_SA
#undef PG8_SB
#undef PG8_STAGE
#undef PG8_LDA
#undef PG8_LDB
#undef PG8_MMA
#undef PG8_WAIT_V
#undef PG8_WAIT_L
#undef PG8_BAR
#undef PG8_SCHED
}
}

using pg8::bf16_t; using pg8::bf16x8; using pg8::f32x4; using pg8::u32x4; using pg8::Unit; using pg8::cvt_pk_bf16;
typedef unsigned u32x2 __attribute__((ext_vector_type(2)));
typedef float f32x2 __attribute__((ext_vector_type(2)));
constexpr int T = 16384, SEQ = 4096, DM = 2048, DIN = 16200;
constexpr float EPS = 1e-6f, NEGV = -1e30f, LOG2E = 1.4426950408889634f;
constexpr float CA_SCALE = 0.12751743082459868f;
constexpr float CC_SCALE = 0.10411754627697264f;
constexpr int NTHR = 512;
constexpr int LDS_BYTES = 131072;

constexpr size_t MiB = 1ull << 20;
constexpr size_t WS_CS = 0;
constexpr size_t WS_SSQ = WS_CS + MiB;
constexpr size_t WS_SSKV = WS_SSQ + 65536;
constexpr size_t WS_GATES = WS_SSKV + 65536;
constexpr size_t WS_KM = WS_GATES + 524288;
constexpr size_t WS_BV = WS_KM + 131072;
constexpr size_t WS_LIV = WS_BV + 262144;
constexpr size_t WS_BLAST = WS_LIV + 262144;
constexpr size_t WS_GMAX = WS_BLAST + 4096;
constexpr size_t WS_MST = WS_GMAX + 4096;
constexpr size_t WS_NST = WS_MST + 4096;
constexpr size_t WS_W0 = WS_NST + 524288;
constexpr size_t WL_WIN = 0;
constexpr size_t WL_WB = WL_WIN + 64 * MiB;
constexpr size_t WL_WO = WL_WB + 12 * MiB;
constexpr size_t WL_WUQ = WL_WO + 8 * MiB;
constexpr size_t WL_WKN = WL_WUQ + 1536 * 1024;
constexpr size_t WL_WV = WL_WKN + 512 * 1024;
constexpr size_t WL_SIZE = WL_WV + 512 * 1024;
constexpr size_t WS_H = WS_W0 + 2 * WL_SIZE;
constexpr size_t WS_QA = WS_H + 64 * MiB;
constexpr size_t WS_KA = WS_QA + 32 * MiB;
constexpr size_t WS_VAT = WS_KA + 32 * MiB;
constexpr size_t WS_Z = WS_VAT + 32 * MiB;
constexpr size_t WS_QB = WS_Z + 96 * MiB;
constexpr size_t WS_KB = WS_QB + 16 * MiB;
constexpr size_t WS_VB = WS_KB + 16 * MiB;
constexpr size_t WS_OB = WS_VB + 32 * MiB;
constexpr size_t WS_Q2 = WS_OB + 32 * MiB;
constexpr size_t WS_K2 = WS_Q2 + 16 * MiB;
constexpr size_t WS_CST = WS_K2 + 16 * MiB;
constexpr size_t WS_CQ = WS_CST + 64 * MiB;
constexpr size_t WS_CKV = WS_CQ + 16 * MiB;
constexpr size_t WS_KR = WS_CKV + 8 * MiB;
constexpr size_t WS_QC = WS_KR + 2 * MiB;
constexpr size_t WS_KNC = WS_QC + 48 * MiB;
constexpr size_t WS_VCT = WS_KNC + 32 * MiB;
constexpr size_t WS_GT = WS_VCT + 32 * MiB;
constexpr size_t WS_SSP = WS_GT + 192 * MiB;
constexpr size_t WS_QAL = WS_SSP + MiB;
constexpr size_t WS_CTR = WS_QAL + 32 * MiB;
constexpr size_t WS_END = WS_CTR + 256;

struct Params {
    const float* x; const float* norm_gain; const float* w_in; const float* t5; const float* conv_w; const float* conv_b; const float* i_bias; const float* f_bias;
    const float* out_norm; const float* q_norm; const float* kv_norm; const float* w_uq; const float* w_ukv; const float* w_branch; const float* w_out; const float* final_norm;
    float* out; unsigned char* ws; int w_lo, w_hi;
};

__device__ __forceinline__ float bf2f(unsigned v16) { return __uint_as_float(v16 << 16); }
__device__ __forceinline__ float bflo(unsigned w) { return __uint_as_float(w << 16); }
__device__ __forceinline__ float bfhi(unsigned w) { return __uint_as_float(w & 0xffff0000u); }
__device__ __forceinline__ bf16_t f2bf(float f) { return (bf16_t)(cvt_pk_bf16(f, 0.f) & 0xffffu); }
__device__ __forceinline__ float fsigmoid(float v) { return __builtin_amdgcn_rcpf(1.0f + __expf(-v)); }
__device__ __forceinline__ float fsilu(float v) { return v * __builtin_amdgcn_rcpf(1.0f + __expf(-v)); }
__device__ __forceinline__ float fexp2(float v) { return __builtin_amdgcn_exp2f(v); }
__device__ __forceinline__ f32x4 zero4() { f32x4 z = (f32x4){0.f, 0.f, 0.f, 0.f}; asm volatile("" : "+v"(z)); return z; }
__device__ __forceinline__ f32x4 mfma16(bf16x8 a, bf16x8 b, f32x4 c) { return __builtin_amdgcn_mfma_f32_16x16x32_bf16(a, b, c, 0, 0, 0); }

struct EpiIn {
    static constexpr bool PERM = true, AFTER_DRAIN = false;
    unsigned char* ws;
    __device__ __forceinline__ void operator()(const f32x4 (&acc)[2][2][4][2], const Unit& u, int wr, int wc, int fr, int fq) const {
        const int pn = u.pn; const int row0 = u.pm * 256 + wr * 64 + fr;
        if (pn == 59) {
            const int cb = wc * 32 + 8 * fq;
            if (cb >= 72) return;
            float* gates = (float*)(ws + WS_GATES); bf16_t* kr = (bf16_t*)(ws + WS_KR); const f32x2* cs = (const f32x2*)(ws + WS_CS);
#pragma unroll
            for (int ai = 0; ai < 2; ++ai)
#pragma unroll
                for (int m = 0; m < 4; ++m) {
                    const int row = row0 + ai * 128 + m * 16; const f32x4 v0 = acc[ai][0][m][0], v1 = acc[ai][0][m][1];
                    if (cb == 0) { *(f32x4*)(gates + (size_t)row * 8) = v0; *(f32x4*)(gates + (size_t)row * 8 + 4) = v1; }
                    else {
                        const int j0 = (cb - 8) >> 1, pos = row & (SEQ - 1);
                        const f32x2 c0 = cs[pos * 32 + j0], c1 = cs[pos * 32 + j0 + 1], c2 = cs[pos * 32 + j0 + 2], c3 = cs[pos * 32 + j0 + 3];
                        u32x4 w;
                        w.x = cvt_pk_bf16(v0[0] * c0.x - v0[1] * c0.y, v0[0] * c0.y + v0[1] * c0.x);
                        w.y = cvt_pk_bf16(v0[2] * c1.x - v0[3] * c1.y, v0[2] * c1.y + v0[3] * c1.x);
                        w.z = cvt_pk_bf16(v1[0] * c2.x - v1[1] * c2.y, v1[0] * c2.y + v1[1] * c2.x);
                        w.w = cvt_pk_bf16(v1[2] * c3.x - v1[3] * c3.y, v1[2] * c3.y + v1[3] * c3.x);
                        *(u32x4*)(kr + (size_t)row * 64 + (cb - 8)) = w;
                    }
                }
            return;
        }
        size_t off; int ld, c0, act = 0, ssk = 0; float sc = 1.f;
        if (pn < 4) { off = WS_QA; ld = 1024; c0 = pn * 256; sc = CA_SCALE; }
        else if (pn < 8) { off = WS_KA; ld = 1024; c0 = (pn - 4) * 256; }
        else if (pn < 12) { off = WS_Z; ld = 1024; c0 = (pn - 8) * 256; act = 1; }
        else if (pn < 14) { off = WS_QB; ld = 512; c0 = (pn - 12) * 256; }
        else if (pn < 16) { off = WS_KB; ld = 512; c0 = (pn - 14) * 256; }
        else if (pn < 20) { off = WS_VB; ld = 1024; c0 = (pn - 16) * 256; }
        else if (pn < 24) { off = WS_OB; ld = 1024; c0 = (pn - 20) * 256; act = 2; }
        else if (pn < 28) { off = WS_Z + 32 * MiB; ld = 1024; c0 = (pn - 24) * 256; act = 1; }
        else if (pn < 30) { off = WS_CQ; ld = 512; c0 = (pn - 28) * 256; ssk = 1; }
        else if (pn < 31) { off = WS_CKV; ld = 256; c0 = 0; ssk = 2; }
        else if (pn < 35) { off = WS_Z + 64 * MiB; ld = 1024; c0 = (pn - 31) * 256; act = 1; }
        else { off = WS_GT; ld = 6144; c0 = (pn - 35) * 256; act = 2; }
        bf16_t* dst = (bf16_t*)(ws + off); float* ssp = (float*)(ws + WS_SSP) + (ssk == 2 ? 8 : (pn - 28) * 4) + wc;
        const int col0 = c0 + wc * 32 + 8 * fq;
#pragma unroll
        for (int ai = 0; ai < 2; ++ai)
#pragma unroll
            for (int m = 0; m < 4; ++m) {
                const int row = row0 + ai * 128 + m * 16; bf16_t* rowp = dst + (size_t)row * ld + col0; float ss = 0.f;
#pragma unroll
                for (int bj = 0; bj < 2; ++bj) {
                    f32x4 v0 = acc[ai][bj][m][0], v1 = acc[ai][bj][m][1];
                    if (act == 1) {
#pragma unroll
                        for (int i = 0; i < 4; ++i) { v0[i] = fsilu(v0[i]); v1[i] = fsilu(v1[i]); }
                    } else if (act == 2) {
#pragma unroll
                        for (int i = 0; i < 4; ++i) { v0[i] = fsigmoid(v0[i]); v1[i] = fsigmoid(v1[i]); }
                    } else { v0 = v0 * sc; v1 = v1 * sc; }
                    if (ssk) ss += (v0[0] * v0[0] + v0[1] * v0[1]) + (v0[2] * v0[2] + v0[3] * v0[3]) + (v1[0] * v1[0] + v1[1] * v1[1]) + (v1[2] * v1[2] + v1[3] * v1[3]);
                    u32x4 w; w.x = cvt_pk_bf16(v0[0], v0[1]); w.y = cvt_pk_bf16(v0[2], v0[3]); w.z = cvt_pk_bf16(v1[0], v1[1]); w.w = cvt_pk_bf16(v1[2], v1[3]);
                    *(u32x4*)(rowp + bj * 128) = w;
                    if (pn < 4) {
                        u32x4 wl; wl.x = cvt_pk_bf16(v0[0] - bflo(w.x), v0[1] - bfhi(w.x)); wl.y = cvt_pk_bf16(v0[2] - bflo(w.y), v0[3] - bfhi(w.y));
                        wl.z = cvt_pk_bf16(v1[0] - bflo(w.z), v1[1] - bfhi(w.z)); wl.w = cvt_pk_bf16(v1[2] - bflo(w.w), v1[3] - bfhi(w.w));
                        *(u32x4*)((bf16_t*)(ws + WS_QAL) + (size_t)row * 1024 + col0 + bj * 128) = wl; }
                }
                if (ssk) { const int ln = fq * 16 + fr; ss += shx(ss, 16, ln); ss += shx(ss, 32, ln); if (fq == 0) ssp[(size_t)row * 16] = ss; }
            }
    }
};

struct EpiVT {
    static constexpr bool PERM = true, AFTER_DRAIN = false;
    bf16_t* dst; int ld; const float* ss; float inv_n;
    __device__ __forceinline__ void operator()(const f32x4 (&acc)[2][2][4][2], const Unit& u, int wr, int wc, int fr, int fq) const {
        const int row0 = u.pm * 256 + wr * 64 + fr, col0 = u.pn * 256 + wc * 32 + 8 * fq;
        f32x4 s0[2], s1[2];
#pragma unroll
        for (int bj = 0; bj < 2; ++bj) {
            if (ss) { f32x4 a, b;
#pragma unroll
                for (int i = 0; i < 4; ++i) { const f32x4 pa = *(const f32x4*)(ss + (size_t)(col0 + bj * 128 + i) * 16 + 8), pb = *(const f32x4*)(ss + (size_t)(col0 + bj * 128 + 4 + i) * 16 + 8);
                    a[i] = rsqrtf(((pa[0] + pa[1]) + (pa[2] + pa[3])) * inv_n + EPS); b[i] = rsqrtf(((pb[0] + pb[1]) + (pb[2] + pb[3])) * inv_n + EPS); }
                s0[bj] = a; s1[bj] = b; }
            else { s0[bj] = (f32x4){1.f, 1.f, 1.f, 1.f}; s1[bj] = s0[bj]; }
        }
#pragma unroll
        for (int ai = 0; ai < 2; ++ai)
#pragma unroll
            for (int m = 0; m < 4; ++m) {
                bf16_t* rowp = dst + (size_t)(row0 + ai * 128 + m * 16) * ld + col0;
#pragma unroll
                for (int bj = 0; bj < 2; ++bj) {
                    const f32x4 v0 = acc[ai][bj][m][0] * s0[bj], v1 = acc[ai][bj][m][1] * s1[bj];
                    u32x4 w; w.x = cvt_pk_bf16(v0[0], v0[1]); w.y = cvt_pk_bf16(v0[2], v0[3]); w.z = cvt_pk_bf16(v1[0], v1[1]); w.w = cvt_pk_bf16(v1[2], v1[3]);
                    *(u32x4*)(rowp + bj * 128) = w;
                }
            }
    }
};

template <bool ROPE> struct EpiRow {
    static constexpr bool PERM = true, AFTER_DRAIN = false;
    bf16_t* dst; int ld; const float* ss; float inv_n, sc; const f32x2* cs;
    __device__ __forceinline__ void operator()(const f32x4 (&acc)[2][2][4][2], const Unit& u, int wr, int wc, int fr, int fq) const {
        const int row0 = u.pm * 256 + wr * 64 + fr, col0 = u.pn * 256 + wc * 32 + 8 * fq;
#pragma unroll
        for (int ai = 0; ai < 2; ++ai)
#pragma unroll
            for (int m = 0; m < 4; ++m) {
                const int row = row0 + ai * 128 + m * 16; float sq;
                if (ROPE) { const f32x4 pa = *(const f32x4*)(ss + (size_t)row * 16), pb = *(const f32x4*)(ss + (size_t)row * 16 + 4); sq = ((pa[0] + pa[1]) + (pa[2] + pa[3])) + ((pb[0] + pb[1]) + (pb[2] + pb[3])); }
                else { const f32x4 pa = *(const f32x4*)(ss + (size_t)row * 16 + 8); sq = (pa[0] + pa[1]) + (pa[2] + pa[3]); }
                const float rs = rsqrtf(sq * inv_n + EPS) * sc; bf16_t* rowp = dst + (size_t)row * ld + col0;
#pragma unroll
                for (int bj = 0; bj < 2; ++bj) {
                    f32x4 v0 = acc[ai][bj][m][0] * rs, v1 = acc[ai][bj][m][1] * rs; u32x4 w;
                    const int hc = (col0 + bj * 128) % 192;
                    if (ROPE && hc >= 128) {
                        const int j0 = (hc - 128) >> 1, pos = row & (SEQ - 1);
                        const f32x2 c0 = cs[pos * 32 + j0], c1 = cs[pos * 32 + j0 + 1], c2 = cs[pos * 32 + j0 + 2], c3 = cs[pos * 32 + j0 + 3];
                        w.x = cvt_pk_bf16(v0[0] * c0.x - v0[1] * c0.y, v0[0] * c0.y + v0[1] * c0.x);
                        w.y = cvt_pk_bf16(v0[2] * c1.x - v0[3] * c1.y, v0[2] * c1.y + v0[3] * c1.x);
                        w.z = cvt_pk_bf16(v1[0] * c2.x - v1[1] * c2.y, v1[0] * c2.y + v1[1] * c2.x);
                        w.w = cvt_pk_bf16(v1[2] * c3.x - v1[3] * c3.y, v1[2] * c3.y + v1[3] * c3.x);
                    } else { w.x = cvt_pk_bf16(v0[0], v0[1]); w.y = cvt_pk_bf16(v0[2], v0[3]); w.z = cvt_pk_bf16(v1[0], v1[1]); w.w = cvt_pk_bf16(v1[2], v1[3]); }
                    *(u32x4*)(rowp + bj * 128) = w;
                }
            }
    }
};

struct EpiMerge {
    static constexpr bool PERM = true, AFTER_DRAIN = false;
    bf16_t* merged; const bf16_t* gt;
    __device__ __forceinline__ void operator()(const f32x4 (&acc)[2][2][4][2], const Unit& u, int wr, int wc, int fr, int fq) const {
        const int n = u.pm >> 6, pmr = u.pm & 63; const int row0 = pmr * 256 + wr * 64 + fr, col0 = u.pn * 256 + wc * 32 + 8 * fq;
#pragma unroll
        for (int ai = 0; ai < 2; ++ai)
#pragma unroll
            for (int m = 0; m < 4; ++m) {
                const int row = row0 + ai * 128 + m * 16;
#pragma unroll
                for (int bj = 0; bj < 2; ++bj) {
                    const u32x4 gw = *(const u32x4*)(gt + (size_t)row * 6144 + n * 2048 + col0 + bj * 128);
                    bf16_t* mp = merged + (size_t)row * 2048 + col0 + bj * 128;
                    u32x4 pw = (u32x4){0u, 0u, 0u, 0u}; if (n > 0) pw = __builtin_nontemporal_load((const u32x4*)mp);
                    const f32x4 v0 = acc[ai][bj][m][0], v1 = acc[ai][bj][m][1]; u32x4 w;
                    w.x = cvt_pk_bf16(bflo(pw.x) + bflo(gw.x) * v0[0], bfhi(pw.x) + bfhi(gw.x) * v0[1]);
                    w.y = cvt_pk_bf16(bflo(pw.y) + bflo(gw.y) * v0[2], bfhi(pw.y) + bfhi(gw.y) * v0[3]);
                    w.z = cvt_pk_bf16(bflo(pw.z) + bflo(gw.z) * v1[0], bfhi(pw.z) + bfhi(gw.z) * v1[1]);
                    w.w = cvt_pk_bf16(bflo(pw.w) + bflo(gw.w) * v1[2], bfhi(pw.w) + bfhi(gw.w) * v1[3]);
                    *(u32x4*)mp = w;
                }
            }
    }
};
struct MergeOrder {
    int G, c;
    __device__ bool next(int i, Unit& u) const {
        const int t3 = i / 3, n = i - 3 * t3; const long L = (long)t3 * G + c; if (L >= 512) return false;
        const int tm = (int)(L >> 3), tn = (int)(L & 7); u.pm = n * 64 + tm; u.pn = tn; u.pb = n * 8 + tn; return true;
    }
    __device__ __forceinline__ void a_ready(const Unit&) const {}
    __device__ __forceinline__ void done(const Unit&) const {}
};

struct EpiOut {
    static constexpr bool PERM = false, AFTER_DRAIN = false;
    const float* xin; float* xout;
    __device__ __forceinline__ void operator()(const f32x4 (&acc)[2][2][4][2], const Unit& u, int wr, int wc, int fr, int fq) const {
        const int row0 = u.pm * 256 + wr * 64 + fr, col0 = u.pn * 256 + wc * 32 + 4 * fq;
#pragma unroll
        for (int ai = 0; ai < 2; ++ai)
#pragma unroll
            for (int m = 0; m < 4; ++m) {
                const size_t ro = (size_t)(row0 + ai * 128 + m * 16) * DM + col0;
#pragma unroll
                for (int bj = 0; bj < 2; ++bj)
#pragma unroll
                    for (int n = 0; n < 2; ++n) { const f32x4 b = *(const f32x4*)(xin + ro + bj * 128 + n * 16); *(f32x4*)(xout + ro + bj * 128 + n * 16) = b + acc[ai][bj][m][n]; }
            }
    }
};

template <class F> __device__ __forceinline__ void tconv(unsigned char* lds, const float* src, int ldsrc, int K, bf16_t* dst, int N, const float* gain, F f, const int g_wv) {
    float* tile = (float*)lds; int tid = TIDX; asm volatile("" : "+v"(tid)); const int tilesK = K >> 6, ntile = tilesK * (N >> 8);
    const int nn4 = (tid & 63) * 4, kk0 = tid >> 6; f32x4 pre[8];
#define TCONV_LOAD(tt_) do { const int tn_ = (tt_) / tilesK, tk_ = (tt_) - tn_ * tilesK; const int c0 = f(tn_ * 256 + nn4), c1 = f(tn_ * 256 + nn4 + 1), c2 = f(tn_ * 256 + nn4 + 2), c3 = f(tn_ * 256 + nn4 + 3); \
        const bool vec = (c0 >= 0) && ((c0 & 3) == 0) && (c3 == c0 + 3); const float* sp = src + (size_t)(tk_ * 64 + kk0) * ldsrc; \
        _Pragma("unroll") for (int e = 0; e < 8; ++e) { const float* rp = sp + (size_t)(8 * e) * ldsrc; f32x4 v; \
            if (vec) v = *(const f32x4*)(rp + c0); \
            else { v[0] = c0 >= 0 ? rp[c0] : 0.f; v[1] = c1 >= 0 ? rp[c1] : 0.f; v[2] = c2 >= 0 ? rp[c2] : 0.f; v[3] = c3 >= 0 ? rp[c3] : 0.f; } \
            pre[e] = v; } } while (0)
    int t = blockIdx.x;
    if (t < ntile) TCONV_LOAD(t);
    for (; t < ntile; t += gridDim.x) {
        const int tn = t / tilesK, tk = t - tn * tilesK;
#pragma unroll
        for (int e = 0; e < 8; ++e) { f32x4 v = pre[e]; if (gain) v = v * gain[tk * 64 + kk0 + 8 * e]; *(f32x4*)(tile + (kk0 + 8 * e) * 260 + nn4) = v; }
        __syncthreads();
        { const int t2 = t + (int)gridDim.x; if (t2 < ntile) TCONV_LOAD(t2); }
        { const int nn = tid >> 1, kc = (tid & 1) * 32; bf16_t* dp = dst + (size_t)(tn * 256 + nn) * K + tk * 64 + kc;
#pragma unroll
          for (int q4 = 0; q4 < 4; ++q4) { float v[8];
#pragma unroll
              for (int i = 0; i < 8; ++i) v[i] = tile[(kc + q4 * 8 + i) * 260 + nn];
              u32x4 w; w.x = cvt_pk_bf16(v[0], v[1]); w.y = cvt_pk_bf16(v[2], v[3]); w.z = cvt_pk_bf16(v[4], v[5]); w.w = cvt_pk_bf16(v[6], v[7]);
              *(u32x4*)(dp + q4 * 8) = w; } }
        __syncthreads();
    }
#undef TCONV_LOAD
}
__device__ __forceinline__ int win_src_col(int n) {
    if (n < 1024) return n;
    if (n < 2048) return 1024 + (n - 1024);
    if (n < 3072) return 3072 + (n - 2048);
    if (n < 3584) return 4096 + (n - 3072);
    if (n < 4096) return 4608 + (n - 3584);
    if (n < 5120) return 5120 + (n - 4096);
    if (n < 6144) return 6152 + (n - 5120);
    if (n < 7168) return 7176 + (n - 6144);
    if (n < 7680) return 8200 + (n - 7168);
    if (n < 7936) return 8712 + (n - 7680);
    if (n < 8960) return 9032 + (n - 7936);
    if (n < 15104) return 10056 + (n - 8960);
    if (n < 15360) { const int r = n - 15104; if (r < 4) return 6144 + r; if (r < 8) return 6148 + (r - 4); if (r < 72) { const int j = (r - 8) >> 1, odd = (r - 8) & 1; return 8968 + j + 32 * odd; } return -1; }
    return 2048 + (n - 15360);
}
__device__ __forceinline__ void convert_weights(unsigned char* lds, const Params& p, int l, const int g_wv) {
    unsigned char* wl = p.ws + WS_W0 + (size_t)l * WL_SIZE;
    tconv(lds, p.w_in + (size_t)l * DM * DIN, DIN, DM, (bf16_t*)(wl + WL_WIN), 16384, nullptr, [](int n) { return win_src_col(n); }, g_wv);
#pragma unroll 1
    for (int n = 0; n < 3; ++n)
        tconv(lds, p.w_branch + ((size_t)l * 3 + n) * 1024 * DM, DM, 1024, (bf16_t*)(wl + WL_WB) + (size_t)n * 2048 * 1024, 2048, nullptr, [](int c) { return c; }, g_wv);
    tconv(lds, p.w_out + (size_t)l * DM * DM, DM, DM, (bf16_t*)(wl + WL_WO), DM, nullptr, [](int c) { return c; }, g_wv);
    tconv(lds, p.w_uq + (size_t)l * 512 * 1536, 1536, 512, (bf16_t*)(wl + WL_WUQ), 1536, p.q_norm + l * 512,
          [](int n) { const int h = n / 192, hc = n - h * 192; if (hc < 128) return n; const int r = hc - 128; return h * 192 + 128 + (r >> 1) + 32 * (r & 1); }, g_wv);
    tconv(lds, p.w_ukv + (size_t)l * 256 * 2048, 2048, 256, (bf16_t*)(wl + WL_WKN), 1024, p.kv_norm + l * 256, [](int n) { return (n >> 7) * 256 + (n & 127); }, g_wv);
    tconv(lds, p.w_ukv + (size_t)l * 256 * 2048, 2048, 256, (bf16_t*)(wl + WL_WV), 1024, p.kv_norm + l * 256, [](int n) { return (n >> 7) * 256 + 128 + (n & 127); }, g_wv);
}
__device__ __forceinline__ void sincos_acc(float ang, float& s, float& c) {
    const double x = (double)ang; const double q = rint(x * 0.63661977236758134308);
    double r = fma(-q, 1.57079632679489655800e+00, x); r = fma(-q, 6.12323399573676603587e-17, r);
    const int qi = ((int)q) & 3; const double r2 = r * r;
    const double sp = r + r * r2 * (-1.66666666666666324348e-01 + r2 * (8.33333333332248946124e-03 + r2 * (-1.98412698298579493134e-04 + r2 * (2.75573137070700676789e-06 + r2 * (-2.50507602534068634195e-08 + r2 * 1.58969099521155010221e-10)))));
    const double cp = 1.0 - 0.5 * r2 + r2 * r2 * (4.16666666666666019037e-02 + r2 * (-1.38888888888741095749e-03 + r2 * (2.48015872894767294178e-05 + r2 * (-2.75573143513906633035e-07 + r2 * (2.08757232129817482790e-09 + r2 * -1.13596475577881948265e-11)))));
    double ss, cc; if (qi == 0) { ss = sp; cc = cp; } else if (qi == 1) { ss = cp; cc = -sp; } else if (qi == 2) { ss = -sp; cc = -cp; } else { ss = -cp; cc = sp; }
    s = (float)ss; c = (float)cc;
}
__device__ __forceinline__ void build_cs(const Params& p, const int g_wv) {
    f32x2* cs = (f32x2*)(p.ws + WS_CS);
    int i0 = blockIdx.x * NTHR + TIDX; asm volatile("" : "+v"(i0));
    for (int i = i0; i < SEQ * 32; i += gridDim.x * NTHR) {
        const int pos = i >> 5, j = i & 31; double inv = 1.0; for (int k = 0; k < j; ++k) inv *= 0.7498942093324558;
        const float ang = (float)pos * (float)inv; float s, c; sincos_acc(ang, s, c); cs[i] = (f32x2){c, s};
    }
}
__device__ __forceinline__ void zero_ss(const Params& p, const int g_wv) {
    float* a = (float*)(p.ws + WS_SSQ);
    int i0 = blockIdx.x * NTHR + TIDX; asm volatile("" : "+v"(i0));
    for (int i = i0; i < 2 * T; i += gridDim.x * NTHR) a[i] = 0.f;
}
template <bool OUTBF> __device__ __forceinline__ void rmsnorm_rows(const float* x, const float* gain, bf16_t* hb, float* of, const int g_wv) {
    int tid = TIDX; asm volatile("" : "+v"(tid)); const int lane = tid & 63, gw = blockIdx.x * (NTHR / 64) + (tid >> 6), nw = gridDim.x * (NTHR / 64);
    for (int row = gw; row < T; row += nw) {
        const float* xr = x + (size_t)row * DM; f32x4 v[8]; float ss = 0.f;
#pragma unroll
        for (int i = 0; i < 8; ++i) { v[i] = *(const f32x4*)(xr + i * 256 + lane * 4); ss += (v[i][0] * v[i][0] + v[i][1] * v[i][1]) + (v[i][2] * v[i][2] + v[i][3] * v[i][3]); }
#pragma unroll
        for (int o = 1; o < 64; o <<= 1) ss += shx(ss, o, lane);
        const float rs = rsqrtf(ss * (1.0f / DM) + EPS);
#pragma unroll
        for (int i = 0; i < 8; ++i) {
            const f32x4 gn = *(const f32x4*)(gain + i * 256 + lane * 4); const f32x4 y = v[i] * rs * gn;
            if (OUTBF) { u32x2 w; w.x = cvt_pk_bf16(y[0], y[1]); w.y = cvt_pk_bf16(y[2], y[3]); *(u32x2*)(hb + (size_t)row * DM + i * 256 + lane * 4) = w; }
            else *(f32x4*)(of + (size_t)row * DM + i * 256 + lane * 4) = y;
        }
    }
}

__device__ __forceinline__ void kmean_phase(const Params& p, int l, const int g_wv) {
    const bf16_t* ka = (const bf16_t*)(p.ws + WS_KA); bf16_t* km = (bf16_t*)(p.ws + WS_KM); bf16_t* kml = (bf16_t*)(p.ws + WS_SSQ); int tid = TIDX; asm volatile("" : "+v"(tid));
    for (int u = (gridDim.x == 256) ? (int)blockIdx.x - 192 : (int)blockIdx.x; u < 64; u += gridDim.x) { if (u < 0) continue;
        const int b = u >> 4, j = u & 15; const unsigned* src = (const unsigned*)(ka + ((size_t)b * SEQ + j * 256) * 1024) + tid; float a0 = 0.f, a1 = 0.f;
#pragma unroll 8
        for (int r = 0; r < 256; ++r) { const unsigned w = src[(size_t)r * 512]; a0 += bflo(w); a1 += bfhi(w); }
        const int col = tid * 2, h = col >> 7, d = col & 127;
        const float m0 = a0 * (1.0f / 256.0f), m1 = a1 * (1.0f / 256.0f); const unsigned hi = cvt_pk_bf16(m0, m1);
        *(unsigned*)(km + ((size_t)((b * 8 + h) * 16 + j)) * 128 + d) = hi;
        *(unsigned*)(kml + ((size_t)((b * 8 + h) * 16 + j)) * 128 + d) = cvt_pk_bf16(m0 - bflo(hi), m1 - bfhi(hi));
    }
}

template <int MODE> __device__ __forceinline__ void attn_phase(unsigned char* lds, const Params& p, int l, const int g_wv) {
    constexpr int DQK = MODE ? 192 : 128, NC = DQK / 32, NCH = DQK / 8, KRS = DQK * 2 + 32, KBUF = 64 * KRS, VRS = 144, VBUF = 128 * VRS;
    constexpr int OFF_V = 2 * KBUF, OFF_LUT = OFF_V + 2 * VBUF, OFF_KM = OFF_LUT + 512, NKL = (64 * NCH) / NTHR;
    int tid = TIDX; asm volatile("" : "+v"(tid)); const int lane = tid & 63, w = tid >> 6, lr = lane & 15, g = lane >> 4; const int G = gridDim.x, c = blockIdx.x;
    unsigned char* ws = p.ws;
    const bf16_t* Qp = (const bf16_t*)(ws + (MODE ? WS_QC : WS_QA)); constexpr int LDQ = MODE ? 1536 : 1024;
    const bf16_t* Kp = (const bf16_t*)(ws + (MODE ? WS_KNC : WS_KA)); const bf16_t* KRp = (const bf16_t*)(ws + WS_KR);
    const bf16_t* VTp = (const bf16_t*)(ws + (MODE ? WS_VCT : WS_VAT)); bf16_t* Zp = (bf16_t*)(ws + WS_Z + (MODE ? 64 * MiB : 0));
    float* lut = (float*)(lds + OFF_LUT);
    for (int rd = 0; rd * G < 512; ++rd) {
        int qblk, bh;
        if (G == 256) {
            const int xq = c & 7, iq = c >> 3, qq = iq >> 1;
            bh = 2 * xq + (iq & 1) + 16 * rd; qblk = rd ? qq : 15 - qq;
        } else { const int idx = rd * G + ((rd & 1) ? (G - 1 - c) : c); if (idx >= 512) continue; qblk = 15 - (idx >> 5); bh = idx & 31; }
        const int b = bh >> 3, h = bh & 7;
        const int q0 = qblk * 256 + w * 32; const size_t tq = (size_t)b * SEQ + q0; const int nt = (qblk + 1) * 4;
        bf16x8 qf[2][NC];
#pragma unroll
        for (int qb = 0; qb < 2; ++qb)
#pragma unroll
            for (int c2 = 0; c2 < NC; ++c2) qf[qb][c2] = *(const bf16x8*)(Qp + (tq + qb * 16 + lr) * LDQ + h * DQK + c2 * 32 + g * 8);
        u32x4 kreg[NKL], vreg[2];
#define ATT_LOADK(t_) do { const int t__ = (t_); \
        _Pragma("unroll") for (int i = 0; i < NKL; ++i) { const int id = tid + NTHR * i; const int key = id / NCH, ch = id - key * NCH; const size_t tk = (size_t)b * SEQ + t__ * 64 + key; \
            const bf16_t* s_ = (!MODE || ch < 16) ? (Kp + tk * 1024 + h * 128 + ch * 8) : (KRp + tk * 64 + (ch - 16) * 8); kreg[i] = *(const u32x4*)s_; } } while (0)
#define ATT_LOADV(t_) do { const int t__ = (t_); \
        _Pragma("unroll") for (int i = 0; i < 2; ++i) { const int id = tid + NTHR * i; const int row = id >> 3, ch = id & 7; \
            vreg[i] = *(const u32x4*)(VTp + (size_t)(h * 128 + row) * T + (size_t)b * SEQ + t__ * 64 + ch * 8); } } while (0)
#define ATT_STOREK(buf_) do { unsigned char* kb_ = lds + (buf_) * KBUF; \
        _Pragma("unroll") for (int i = 0; i < NKL; ++i) { const int id = tid + NTHR * i; const int key = id / NCH, ch = id - key * NCH; *(u32x4*)(kb_ + key * KRS + ch * 16) = kreg[i]; } } while (0)
#define ATT_STOREV(buf_) do { unsigned char* vb_ = lds + OFF_V + (buf_) * VBUF; \
        _Pragma("unroll") for (int i = 0; i < 2; ++i) { const int id = tid + NTHR * i; const int row = id >> 3, ch = id & 7; *(u32x4*)(vb_ + row * VRS + ch * 16) = vreg[i]; } } while (0)
        ATT_LOADK(0); ATT_LOADV(0); ATT_STOREK(0); ATT_STOREV(0); ATT_LOADK(1); ATT_LOADV(1);
        unsigned sel[2] = {0u, 0u};
        if (MODE == 0) {
            if (tid < 128) { const int d = tid; int bk = d; if (d >= 16) { bk = 16 + (int)(logf((float)d * (1.0f / 16.0f)) / 2.0794415416798357f * 16.0f); bk = bk > 31 ? 31 : bk; } lut[d] = p.t5[bk * 8 + h] * LOG2E; }
            { const int half = tid >> 8, row = (tid >> 4) & 15, ch = tid & 15; *(u32x4*)(lds + OFF_KM + half * 4608 + row * 288 + ch * 16) = *(const u32x4*)((const bf16_t*)(ws + (half ? WS_SSQ : WS_KM)) + ((size_t)((b * 8 + h) * 16 + row)) * 128 + ch * 8); }
        }
        __syncthreads();
        if (MODE == 0) {
            f32x4 ga[2] = {zero4(), zero4()};
#pragma unroll
            for (int c2 = 0; c2 < NC; ++c2) { const bf16x8 kf = *(const bf16x8*)(lds + OFF_KM + lr * 288 + c2 * 64 + g * 16), kfl = *(const bf16x8*)(lds + OFF_KM + 4608 + lr * 288 + c2 * 64 + g * 16);
#pragma unroll
                for (int qb = 0; qb < 2; ++qb) { const bf16x8 ql = *(const bf16x8*)((const bf16_t*)(ws + WS_QAL) + (tq + qb * 16 + lr) * 1024 + h * 128 + c2 * 32 + g * 8);
                    ga[qb] = mfma16(kfl, qf[qb][c2], ga[qb]); ga[qb] = mfma16(kf, ql, ga[qb]); ga[qb] = mfma16(kf, qf[qb][c2], ga[qb]); } }
#pragma unroll
            for (int qb = 0; qb < 2; ++qb) {
                float gv[4];
#pragma unroll
                for (int r = 0; r < 4; ++r) gv[r] = (g * 4 + r < qblk) ? ga[qb][r] : -INFINITY;
                unsigned s = 0u;
#pragma unroll
                for (int it = 0; it < 3; ++it) {
                    float bv = -INFINITY; int bi = 99;
#pragma unroll
                    for (int r = 0; r < 4; ++r) if (gv[r] > bv) { bv = gv[r]; bi = g * 4 + r; }
#pragma unroll
                    for (int o = 16; o <= 32; o <<= 1) { const float ov = shx(bv, o, lane); const int oi = shxi(bi, o, lane); if (ov > bv || (ov == bv && oi < bi)) { bv = ov; bi = oi; } }
                    if (bv > -INFINITY) s |= 1u << bi;
#pragma unroll
                    for (int r = 0; r < 4; ++r) if (g * 4 + r == bi) gv[r] = -INFINITY;
                }
                sel[qb] = s;
            }
        }
        f32x4 oacc[8][2];
#pragma unroll
        for (int i = 0; i < 8; ++i) { oacc[i][0] = zero4(); oacc[i][1] = zero4(); }
        float mrow[2] = {NEGV, NEGV}, lrow[2] = {0.f, 0.f};
        for (int t = 0; t < nt; ++t) {
            const int buf = t & 1; const bool more = (t + 1 < nt);
            if (more) { ATT_STOREK(buf ^ 1); ATT_STOREV(buf ^ 1); }
            if (t + 2 < nt) { ATT_LOADK(t + 2); ATT_LOADV(t + 2); }
            const int k0 = t * 64;
            const unsigned char* kb_ = lds + buf * KBUF; const unsigned char* vb_ = lds + OFF_V + buf * VBUF;
#pragma unroll 1
            for (int hf = 0; hf < 2; ++hf) {
              const int kh = k0 + hf * 32;
              if (kh <= q0 + 31) {
                f32x4 sacc[2][2];
#pragma unroll
                for (int kb = 0; kb < 2; ++kb) { sacc[kb][0] = zero4(); sacc[kb][1] = zero4(); }
#pragma unroll
                for (int c2 = 0; c2 < NC; ++c2)
#pragma unroll
                    for (int kb = 0; kb < 2; ++kb) { const bf16x8 kf = *(const bf16x8*)(kb_ + (hf * 32 + kb * 16 + lr) * KRS + c2 * 64 + g * 16);
                        sacc[kb][0] = mfma16(kf, qf[0][c2], sacc[kb][0]); sacc[kb][1] = mfma16(kf, qf[1][c2], sacc[kb][1]); }
                if (MODE == 0) {
                    const int jblk = t >> 2; const bool far = (kh + 31 + 127 <= q0);
                    if (far) { const float bfar = lut[127];
#pragma unroll
                        for (int qb = 0; qb < 2; ++qb) { const bool al = (jblk < qblk) ? (((sel[qb] >> jblk) & 1u) != 0u) : true;
#pragma unroll
                            for (int kb = 0; kb < 2; ++kb)
#pragma unroll
                                for (int r = 0; r < 4; ++r) sacc[kb][qb][r] = al ? sacc[kb][qb][r] + bfar : NEGV; }
                    } else {
#pragma unroll
                        for (int qb = 0; qb < 2; ++qb) { const int qpos = q0 + qb * 16 + lr; const bool alp = (sel[qb] >> jblk) & 1u;
#pragma unroll
                            for (int kb = 0; kb < 2; ++kb)
#pragma unroll
                                for (int r = 0; r < 4; ++r) { const int d = qpos - (kh + kb * 16 + g * 4 + r); const int di = d < 0 ? 0 : (d > 127 ? 127 : d);
                                    const bool al = (jblk < qblk) ? alp : (d >= 0); sacc[kb][qb][r] = al ? sacc[kb][qb][r] + lut[di] : NEGV; } }
                    }
                } else {
                    if (kh + 31 > q0) {
#pragma unroll
                        for (int qb = 0; qb < 2; ++qb) { const int qpos = q0 + qb * 16 + lr;
#pragma unroll
                            for (int kb = 0; kb < 2; ++kb)
#pragma unroll
                                for (int r = 0; r < 4; ++r) if (kh + kb * 16 + g * 4 + r > qpos) sacc[kb][qb][r] = NEGV; }
                    }
                }
                bf16x8 pf[2];
#pragma unroll
                for (int qb = 0; qb < 2; ++qb) {
                    float mx = NEGV;
#pragma unroll
                    for (int kb = 0; kb < 2; ++kb)
#pragma unroll
                        for (int r = 0; r < 4; ++r) mx = fmaxf(mx, sacc[kb][qb][r]);
                    float mnew = mrow[qb];
                    if (__builtin_amdgcn_ballot_w64(mx > mrow[qb] + 8.0f) != 0ull) {
                        mx = fmaxf(mx, shx(mx, 16, lane)); mx = fmaxf(mx, shx(mx, 32, lane));
                        mnew = fmaxf(mrow[qb], mx); const float alpha = fexp2(mrow[qb] - mnew); mrow[qb] = mnew; lrow[qb] *= alpha;
#pragma unroll
                        for (int i = 0; i < 8; ++i) oacc[i][qb] = oacc[i][qb] * alpha;
                    }
                    float ps = 0.f;
#pragma unroll
                    for (int kb = 0; kb < 2; ++kb)
#pragma unroll
                        for (int r = 0; r < 4; ++r) { const float e = fexp2(sacc[kb][qb][r] - mnew); sacc[kb][qb][r] = e; ps += e; }
                    lrow[qb] += ps;
                    union { u32x4 u; bf16x8 v; } cvt;
                    cvt.u.x = cvt_pk_bf16(sacc[0][qb][0], sacc[0][qb][1]); cvt.u.y = cvt_pk_bf16(sacc[0][qb][2], sacc[0][qb][3]);
                    cvt.u.z = cvt_pk_bf16(sacc[1][qb][0], sacc[1][qb][1]); cvt.u.w = cvt_pk_bf16(sacc[1][qb][2], sacc[1][qb][3]); pf[qb] = cvt.v;
                }
#pragma unroll
                for (int dvb = 0; dvb < 8; ++dvb) { union { u32x2 u[2]; bf16x8 v; } vf; const unsigned char* vp = vb_ + (dvb * 16 + lr) * VRS + (hf * 32 + g * 4) * 2;
                    vf.u[0] = *(const u32x2*)vp; vf.u[1] = *(const u32x2*)(vp + 32);
                    oacc[dvb][0] = mfma16(vf.v, pf[0], oacc[dvb][0]); oacc[dvb][1] = mfma16(vf.v, pf[1], oacc[dvb][1]); }
              }
            }
            __syncthreads();
        }
#pragma unroll
        for (int qb = 0; qb < 2; ++qb) {
            float l = lrow[qb]; l += shx(l, 16, lane); l += shx(l, 32, lane); const float inv = 1.0f / l;
            bf16_t* zr = Zp + (tq + qb * 16 + lr) * 1024 + h * 128 + g * 4;
#pragma unroll
            for (int dvb = 0; dvb < 8; ++dvb) { const u32x2 zw = *(const u32x2*)(zr + dvb * 16); const f32x4 o = oacc[dvb][qb] * inv; u32x2 ow;
                ow.x = cvt_pk_bf16(o[0] * bflo(zw.x), o[1] * bfhi(zw.x)); ow.y = cvt_pk_bf16(o[2] * bflo(zw.y), o[3] * bfhi(zw.y)); *(u32x2*)(zr + dvb * 16) = ow; }
        }
#undef ATT_LOADK
#undef ATT_LOADV
#undef ATT_STOREK
#undef ATT_STOREV
    }
}

__device__ __forceinline__ void mlstm_a(unsigned char* lds, const Params& p, int l, const int g_wv) {
    constexpr int K2RS = 272, TRS = 160; constexpr int OFF_K2 = 0, OFF_WKT = 64 * K2RS, OFF_VT = OFF_WKT + 128 * TRS, OFF_WG = OFF_VT + 256 * TRS;
    unsigned char* ws = p.ws; int tid = TIDX; asm volatile("" : "+v"(tid)); const int lane = tid & 63, w = tid >> 6, lr = lane & 15, g = lane >> 4;
    const bf16_t* QB = (const bf16_t*)(ws + WS_QB); const bf16_t* KB = (const bf16_t*)(ws + WS_KB); const bf16_t* VB = (const bf16_t*)(ws + WS_VB);
    bf16_t* Q2 = (bf16_t*)(ws + WS_Q2); bf16_t* K2 = (bf16_t*)(ws + WS_K2); const float* gates = (const float*)(ws + WS_GATES);
    const float* cw = p.conv_w + (size_t)l * 4 * 1024; const float* cb = p.conv_b + (size_t)l * 1024;
    float* wg = (float*)(lds + OFF_WG);
    for (int ku = 0; ; ++ku) { int u; { const int cb_ = blockIdx.x; if (gridDim.x == 256) { if (ku >= (cb_ < 128 ? 3 : 5)) break; u = cb_ < 128 ? cb_ + 128 * ku : 384 + (cb_ - 128) + 128 * ku; } else { u = cb_ + ku * (int)gridDim.x; if (u >= 1024) break; } }
        const int bh = u >> 6, c = u & 63, b = bh >> 2, h = bh & 3; const size_t t0 = (size_t)b * SEQ + c * 64;
#pragma unroll 1
        for (int it = 0; it < 4; ++it) {
            const int item = tid + NTHR * it, which = item >> 10, s = (item >> 4) & 63, grp = item & 15; const int ch0 = h * 128 + grp * 8, cc0 = which * 512 + ch0;
            const bf16_t* src = which ? KB : QB; float a[8];
            { const f32x4 b0 = *(const f32x4*)(cb + cc0), b1 = *(const f32x4*)(cb + cc0 + 4); a[0] = b0[0]; a[1] = b0[1]; a[2] = b0[2]; a[3] = b0[3]; a[4] = b1[0]; a[5] = b1[1]; a[6] = b1[2]; a[7] = b1[3]; }
#pragma unroll
            for (int j = 0; j < 4; ++j) { const int tp = c * 64 + s - 3 + j;
                if (tp >= 0) { const u32x4 xw = *(const u32x4*)(src + ((size_t)b * SEQ + tp) * 512 + ch0); const f32x4 w0 = *(const f32x4*)(cw + j * 1024 + cc0), w1 = *(const f32x4*)(cw + j * 1024 + cc0 + 4);
                    a[0] += bflo(xw.x) * w0[0]; a[1] += bfhi(xw.x) * w0[1]; a[2] += bflo(xw.y) * w0[2]; a[3] += bfhi(xw.y) * w0[3];
                    a[4] += bflo(xw.z) * w1[0]; a[5] += bfhi(xw.z) * w1[1]; a[6] += bflo(xw.w) * w1[2]; a[7] += bfhi(xw.w) * w1[3]; } }
            const float ksc = which ? 0.08838834764831845f : 1.0f;
#pragma unroll
            for (int i = 0; i < 8; ++i) a[i] = fsilu(a[i]) * ksc;
            u32x4 ow; ow.x = cvt_pk_bf16(a[0], a[1]); ow.y = cvt_pk_bf16(a[2], a[3]); ow.z = cvt_pk_bf16(a[4], a[5]); ow.w = cvt_pk_bf16(a[6], a[7]);
            *(u32x4*)((which ? K2 : Q2) + (t0 + s) * 512 + ch0) = ow;
            if (which) *(u32x4*)(lds + OFF_K2 + s * K2RS + grp * 16) = ow;
        }
        if (w == 0) {
            const float fpre = gates[(t0 + lane) * 8 + 4 + h] + p.f_bias[l * 4 + h]; const float li = gates[(t0 + lane) * 8 + h] + p.i_bias[l * 4 + h];
            const float lf = fminf(fpre, 0.f) - log1pf(__expf(-fabsf(fpre)));
            float bc = lf;
#pragma unroll
            for (int o = 1; o < 64; o <<= 1) { const float v = shup(bc, o, lane); if (lane >= o) bc += v; }
            const float blast = __int_as_float(__builtin_amdgcn_readlane(__float_as_int(bc), 63)); const float gg = blast - bc + li; float gm = gg;
#pragma unroll
            for (int o = 1; o < 64; o <<= 1) gm = fmaxf(gm, shx(gm, o, lane));
            wg[lane] = __expf(gg - gm);
            ((float*)(ws + WS_BV))[(size_t)u * 64 + lane] = bc; ((float*)(ws + WS_LIV))[(size_t)u * 64 + lane] = li;
            if (lane == 0) { ((float*)(ws + WS_BLAST))[u] = blast; ((float*)(ws + WS_GMAX))[u] = gm; }
        }
#pragma unroll
        for (int it = 0; it < 4; ++it) { const int item = tid + NTHR * it, s = item & 63, eg = item >> 6; const u32x4 vw = *(const u32x4*)(VB + (t0 + s) * 1024 + h * 256 + eg * 8);
            bf16_t* d = (bf16_t*)(lds + OFF_VT + (eg * 8) * TRS + s * 2); const unsigned vv[4] = {vw.x, vw.y, vw.z, vw.w};
#pragma unroll
            for (int i = 0; i < 4; ++i) { *(bf16_t*)((unsigned char*)d + (2 * i) * TRS) = (bf16_t)(vv[i] & 0xffffu); *(bf16_t*)((unsigned char*)d + (2 * i + 1) * TRS) = (bf16_t)(vv[i] >> 16); } }
        __syncthreads();
#pragma unroll 1
        for (int it = 0; it < 2; ++it) { const int item = tid + NTHR * it, s = item & 63, dg = item >> 6; const u32x4 kw = *(const u32x4*)(lds + OFF_K2 + s * K2RS + dg * 16); const float ww = wg[s];
            const unsigned kv[4] = {kw.x, kw.y, kw.z, kw.w}; unsigned char* d = lds + OFF_WKT + (dg * 8) * TRS + s * 2;
#pragma unroll
            for (int i = 0; i < 4; ++i) { *(bf16_t*)(d + (2 * i) * TRS) = f2bf(bflo(kv[i]) * ww); *(bf16_t*)(d + (2 * i + 1) * TRS) = f2bf(bfhi(kv[i]) * ww); } }
        __syncthreads();
#if defined(MK_DEBUG_HASH)
        { unsigned char* dbg = ws + WS_END + MiB + (size_t)u * 40960; for (int i = tid; i < 2560; i += NTHR) *(u32x4*)(dbg + i * 16) = *(const u32x4*)(lds + OFF_VT + i * 16); }
#endif
        if (tid < 128) { float a = 0.f; const unsigned char* r = lds + OFF_WKT + tid * TRS;
#pragma unroll
            for (int i = 0; i < 8; ++i) { const u32x4 x = *(const u32x4*)(r + i * 16); a += (bflo(x.x) + bfhi(x.x)) + (bflo(x.y) + bfhi(x.y)) + (bflo(x.z) + bfhi(x.z)) + (bflo(x.w) + bfhi(x.w)); }
            ((float*)(ws + WS_NST))[(size_t)u * 128 + tid] = a; }
        f32x4 acc[8][2];
#pragma unroll
        for (int i = 0; i < 8; ++i) { acc[i][0] = zero4(); acc[i][1] = zero4(); }
#pragma unroll
        for (int kc = 0; kc < 2; ++kc) {
            const bf16x8 v0 = *(const bf16x8*)(lds + OFF_VT + (w * 32 + lr) * TRS + kc * 64 + g * 16), v1 = *(const bf16x8*)(lds + OFF_VT + (w * 32 + 16 + lr) * TRS + kc * 64 + g * 16);
#pragma unroll
            for (int db = 0; db < 8; ++db) { const bf16x8 kf = *(const bf16x8*)(lds + OFF_WKT + (db * 16 + lr) * TRS + kc * 64 + g * 16); acc[db][0] = mfma16(kf, v0, acc[db][0]); acc[db][1] = mfma16(kf, v1, acc[db][1]); }
        }
        bf16_t* cst = (bf16_t*)(ws + WS_CST) + (size_t)u * 32768; float one = 1.0f; asm volatile("" : "+v"(one));
#pragma unroll
        for (int eb = 0; eb < 2; ++eb)
#pragma unroll
            for (int db = 0; db < 8; ++db) { const f32x4 av = acc[db][eb] * one; u32x2 o; o.x = cvt_pk_bf16(av[0], av[1]); o.y = cvt_pk_bf16(av[2], av[3]); *(u32x2*)(cst + (size_t)(w * 32 + eb * 16 + lr) * 128 + db * 16 + g * 4) = o; }
        __syncthreads();
    }
}
__device__ __forceinline__ void mlstm_b(const Params& p, const int g_wv) {
    unsigned char* ws = p.ws; int tid = TIDX; asm volatile("" : "+v"(tid)); const float* blast = (const float*)(ws + WS_BLAST); const float* gmax = (const float*)(ws + WS_GMAX);
    for (int u = blockIdx.x; u < 256; u += gridDim.x) {
        const int bh = u >> 4, eb = u & 15; bf16_t* base = (bf16_t*)(ws + WS_CST) + (size_t)bh * 64 * 32768 + eb * 2048 + tid * 4;
        float* nb = (float*)(ws + WS_NST) + (size_t)bh * 64 * 128 + tid; const bool don = (eb == 0 && tid < 128);
        float m = 0.f, c0 = 0.f, c1 = 0.f, c2 = 0.f, c3 = 0.f, nn = 0.f;
#pragma unroll 16
        for (int c = 0; c < 64; ++c) {
            const float bl = blast[bh * 64 + c], gm = gmax[bh * 64 + c]; const float mn = fmaxf(bl + m, gm); const float dec = __expf(bl + m - mn), inw = __expf(gm - mn);
            u32x2* sp = (u32x2*)(base + (size_t)c * 32768); const u32x2 uw = *sp; u32x2 o; o.x = cvt_pk_bf16(c0, c1); o.y = cvt_pk_bf16(c2, c3); *sp = o;
            c0 = dec * c0 + inw * bflo(uw.x); c1 = dec * c1 + inw * bfhi(uw.x); c2 = dec * c2 + inw * bflo(uw.y); c3 = dec * c3 + inw * bfhi(uw.y);
            if (don) { const float nu = nb[c * 128]; nb[c * 128] = nn; nn = dec * nn + inw * nu; }
            if (eb == 0 && tid == 0) ((float*)(ws + WS_MST))[bh * 64 + c] = m;
            m = mn;
        }
        asm volatile("s_waitcnt vmcnt(0)" ::: "memory"); __syncthreads();
        if (tid == 0) { __builtin_amdgcn_fence(__ATOMIC_RELEASE, "agent"); asm volatile("s_waitcnt vmcnt(0)" ::: "memory");
            __hip_atomic_fetch_add((unsigned*)(ws + WS_CTR) + 16 + bh, 1u, __ATOMIC_RELAXED, __HIP_MEMORY_SCOPE_AGENT); }
    }
}
__device__ __forceinline__ void mlstm_c(unsigned char* lds, const Params& p, int l, const int g_wv) {
    constexpr int QRS = 288, TRS = 160; constexpr int OFF_Q = 0, OFF_K = 64 * QRS, OFF_VT = 2 * 64 * QRS, OFF_P = OFF_VT + 256 * TRS, OFF_F = OFF_P + 64 * TRS;
    unsigned char* ws = p.ws; int tid = TIDX; asm volatile("" : "+v"(tid)); const int lane = tid & 63, w = tid >> 6, lr = lane & 15, g = lane >> 4;
    const bf16_t* Q2 = (const bf16_t*)(ws + WS_Q2); const bf16_t* K2 = (const bf16_t*)(ws + WS_K2); const bf16_t* VB = (const bf16_t*)(ws + WS_VB);
    const bf16_t* OB = (const bf16_t*)(ws + WS_OB); bf16_t* ZB = (bf16_t*)(ws + WS_Z + 32 * MiB); const float* gn = p.out_norm + (size_t)l * 1024;
    float* fb = (float*)(lds + OFF_F); float* bvec = fb; float* livec = fb + 64; float* mt = fb + 128; float* wint = fb + 192; float* denV = fb + 256; float* denC = fb + 320; float* lsum = fb + 384; float* lsq = fb + 448; float* nvec = fb + 512;
    for (int u = blockIdx.x; u < 1024; u += gridDim.x) {
        const int bh = u >> 6, c = u & 63, b = bh >> 2, h = bh & 3; const size_t t0 = (size_t)b * SEQ + c * 64;
        if (tid == 0) { const unsigned want = 16u * (unsigned)(l + 1); while (__hip_atomic_load((unsigned*)(ws + WS_CTR) + 16 + bh, __ATOMIC_RELAXED, __HIP_MEMORY_SCOPE_AGENT) < want) __builtin_amdgcn_s_sleep(1);
            __builtin_amdgcn_fence(__ATOMIC_ACQUIRE, "agent"); asm volatile("s_waitcnt vmcnt(0)" ::: "memory"); }
        __syncthreads();
        const float mc = ((const float*)(ws + WS_MST))[u];
#pragma unroll
        for (int it = 0; it < 2; ++it) { const int id = tid + NTHR * it, s = id >> 4, ch = id & 15;
            *(u32x4*)(lds + OFF_Q + s * QRS + ch * 16) = *(const u32x4*)(Q2 + (t0 + s) * 512 + h * 128 + ch * 8); *(u32x4*)(lds + OFF_K + s * QRS + ch * 16) = *(const u32x4*)(K2 + (t0 + s) * 512 + h * 128 + ch * 8); }
#pragma unroll 2
        for (int it = 0; it < 4; ++it) { const int item = tid + NTHR * it, s = item & 63, eg = item >> 6; const u32x4 vw = *(const u32x4*)(VB + (t0 + s) * 1024 + h * 256 + eg * 8);
            unsigned char* d = lds + OFF_VT + (eg * 8) * TRS + s * 2; const unsigned vv[4] = {vw.x, vw.y, vw.z, vw.w};
#pragma unroll
            for (int i = 0; i < 4; ++i) { *(bf16_t*)(d + (2 * i) * TRS) = (bf16_t)(vv[i] & 0xffffu); *(bf16_t*)(d + (2 * i + 1) * TRS) = (bf16_t)(vv[i] >> 16); } }
        if (tid < 64) { bvec[tid] = ((const float*)(ws + WS_BV))[(size_t)u * 64 + tid]; livec[tid] = ((const float*)(ws + WS_LIV))[(size_t)u * 64 + tid]; lsum[tid] = 0.f; lsq[tid] = 0.f; }
        else if (tid < 192) nvec[tid - 64] = ((const float*)(ws + WS_NST))[(size_t)u * 128 + tid - 64];
        __syncthreads();
        if (w == 0) { float x = livec[lane] - bvec[lane];
#pragma unroll
            for (int o = 1; o < 64; o <<= 1) { const float v = shup(x, o, lane); if (lane >= o) x = fmaxf(x, v); }
            const float mtl = bvec[lane] + fmaxf(mc, x); mt[lane] = mtl; wint[lane] = __expf(bvec[lane] + mc - mtl); }
        __syncthreads();
        { const int lb = w >> 1;
#pragma unroll
          for (int si = 0; si < 2; ++si) { const int sb = (w & 1) * 2 + si; f32x4 a = zero4();
            if (sb <= lb) {
#pragma unroll
                for (int kc = 0; kc < 4; ++kc) { const bf16x8 qf = *(const bf16x8*)(lds + OFF_Q + (lb * 16 + lr) * QRS + kc * 64 + g * 16), kf = *(const bf16x8*)(lds + OFF_K + (sb * 16 + lr) * QRS + kc * 64 + g * 16); a = mfma16(qf, kf, a); }
            }
            const int s = sb * 16 + lr; const float bs = bvec[s] - livec[s];
#pragma unroll
            for (int r = 0; r < 4; ++r) { const int ll = lb * 16 + g * 4 + r; float v = 0.f; if (s <= ll) v = a[r] * __expf(bvec[ll] - bs - mt[ll]); *(bf16_t*)(lds + OFF_P + ll * TRS + s * 2) = f2bf(v); } } }
        __syncthreads();
        if (w == 0) { float a = 0.f; const unsigned char* r = lds + OFF_P + lane * TRS;
#pragma unroll
            for (int i = 0; i < 8; ++i) { const u32x4 x = *(const u32x4*)(r + i * 16); a += (bflo(x.x) + bfhi(x.x)) + (bflo(x.y) + bfhi(x.y)) + (bflo(x.z) + bfhi(x.z)) + (bflo(x.w) + bfhi(x.w)); }
            denV[lane] = a; }
        else if (w == 1) { float a = 0.f; const unsigned char* r = lds + OFF_Q + lane * QRS;
#pragma unroll
            for (int i = 0; i < 16; ++i) { const u32x4 x = *(const u32x4*)(r + i * 16); const float* nv = nvec + i * 8;
                a += bflo(x.x) * nv[0] + bfhi(x.x) * nv[1] + bflo(x.y) * nv[2] + bfhi(x.y) * nv[3] + bflo(x.z) * nv[4] + bfhi(x.z) * nv[5] + bflo(x.w) * nv[6] + bfhi(x.w) * nv[7]; }
            denC[lane] = a; }
        f32x4 accV[2][4], accC[2][4];
#pragma unroll
        for (int i = 0; i < 2; ++i)
#pragma unroll
            for (int j = 0; j < 4; ++j) { accV[i][j] = zero4(); accC[i][j] = zero4(); }
        const bf16_t* cst = (const bf16_t*)(ws + WS_CST) + (size_t)u * 32768;
#pragma unroll
        for (int kp = 0; kp < 2; ++kp) {
        bf16x8 ctf[2][2];
#pragma unroll
        for (int k2 = 0; k2 < 2; ++k2) { const int kc = kp * 2 + k2; ctf[k2][0] = *(const bf16x8*)(cst + (size_t)(w * 32 + lr) * 128 + kc * 32 + g * 8); ctf[k2][1] = *(const bf16x8*)(cst + (size_t)(w * 32 + 16 + lr) * 128 + kc * 32 + g * 8); }
#pragma unroll
        for (int k2 = 0; k2 < 2; ++k2) { const int kc = kp * 2 + k2;
            const bf16x8 c0 = ctf[k2][0], c1 = ctf[k2][1];
#pragma unroll
            for (int lb = 0; lb < 4; ++lb) { const bf16x8 qf = *(const bf16x8*)(lds + OFF_Q + (lb * 16 + lr) * QRS + kc * 64 + g * 16); accC[0][lb] = mfma16(c0, qf, accC[0][lb]); accC[1][lb] = mfma16(c1, qf, accC[1][lb]); }
        }
        }
#pragma unroll
        for (int kc = 0; kc < 2; ++kc) {
            const bf16x8 v0 = *(const bf16x8*)(lds + OFF_VT + (w * 32 + lr) * TRS + kc * 64 + g * 16), v1 = *(const bf16x8*)(lds + OFF_VT + (w * 32 + 16 + lr) * TRS + kc * 64 + g * 16);
#pragma unroll
            for (int lb = 0; lb < 4; ++lb) { const bf16x8 pf = *(const bf16x8*)(lds + OFF_P + (lb * 16 + lr) * TRS + kc * 64 + g * 16); accV[0][lb] = mfma16(v0, pf, accV[0][lb]); accV[1][lb] = mfma16(v1, pf, accV[1][lb]); }
        }
        __syncthreads();
#pragma unroll
        for (int lb = 0; lb < 4; ++lb) { const int ll = lb * 16 + lr; const float wi = wint[ll]; const float den = wi * denC[ll] + denV[ll]; const float dn = 1.0f / fmaxf(fabsf(den), __expf(-mt[ll])); float s1 = 0.f, s2 = 0.f;
#pragma unroll
            for (int eb = 0; eb < 2; ++eb) { const f32x4 hv = (accC[eb][lb] * wi + accV[eb][lb]) * dn; accV[eb][lb] = hv; s1 += (hv[0] + hv[1]) + (hv[2] + hv[3]); s2 += (hv[0] * hv[0] + hv[1] * hv[1]) + (hv[2] * hv[2] + hv[3] * hv[3]); }
            s1 += shx(s1, 16, lane); s1 += shx(s1, 32, lane); s2 += shx(s2, 16, lane); s2 += shx(s2, 32, lane);
            if (g == 0) { fb[640 + w * 64 + ll] = s1; fb[1152 + w * 64 + ll] = s2; } }
        __syncthreads();
#pragma unroll
        for (int lb = 0; lb < 4; ++lb) { const int ll = lb * 16 + lr; float t1 = 0.f, t2 = 0.f;
#pragma unroll
            for (int ww = 0; ww < 8; ++ww) { t1 += fb[640 + ww * 64 + ll]; t2 += fb[1152 + ww * 64 + ll]; }
            const float mu = t1 * (1.0f / 256.0f); const float var = fmaxf(t2 * (1.0f / 256.0f) - mu * mu, 0.f); const float rstd = rsqrtf(var + EPS);
#pragma unroll
            for (int eb = 0; eb < 2; ++eb) { const int e = w * 32 + eb * 16 + g * 4; const size_t off = (t0 + ll) * 1024 + h * 256 + e; const f32x4 gv = *(const f32x4*)(gn + h * 256 + e);
                const u32x2 ow = *(const u32x2*)(OB + off), zw = *(const u32x2*)(ZB + off); const f32x4 hv = accV[eb][lb]; u32x2 o;
                o.x = cvt_pk_bf16((hv[0] - mu) * rstd * gv[0] * bflo(ow.x) * bflo(zw.x), (hv[1] - mu) * rstd * gv[1] * bfhi(ow.x) * bfhi(zw.x));
                o.y = cvt_pk_bf16((hv[2] - mu) * rstd * gv[2] * bflo(ow.y) * bflo(zw.y), (hv[3] - mu) * rstd * gv[3] * bfhi(ow.y) * bfhi(zw.y)); *(u32x2*)(ZB + off) = o; } }
        __syncthreads();
    }
}

#ifndef PHM
#define PHM 4095
#endif
typedef const __attribute__((address_space(4))) Params* KParams;
#if defined(__HIP_DEVICE_COMPILE__)
__device__ __forceinline__ Params load_params() { KParams k = (KParams)__builtin_amdgcn_kernarg_segment_ptr(); asm volatile("" : "+s"(k)); return *k; }
#else
__device__ __forceinline__ Params load_params() { return Params{}; }
#endif
#define PP load_params()
#define GSYNC() do { asm volatile("s_waitcnt vmcnt(0) lgkmcnt(0)" ::: "memory"); __builtin_amdgcn_fence(__ATOMIC_RELEASE, "agent"); asm volatile("s_waitcnt vmcnt(0)" ::: "memory"); grid.sync(); \
    __builtin_amdgcn_fence(__ATOMIC_ACQUIRE, "agent"); asm volatile("s_waitcnt vmcnt(0) lgkmcnt(0)" ::: "memory"); } while (0)
__device__ __forceinline__ void gbar(unsigned* ctr, unsigned target, const int g_wv) {
    asm volatile("s_waitcnt vmcnt(0) lgkmcnt(0)" ::: "memory");
    __syncthreads();
    if (TIDX == 0) {
        __builtin_amdgcn_fence(__ATOMIC_RELEASE, "agent"); asm volatile("s_waitcnt vmcnt(0)" ::: "memory");
        __hip_atomic_fetch_add(ctr, 1u, __ATOMIC_RELAXED, __HIP_MEMORY_SCOPE_AGENT);
        while (__hip_atomic_load(ctr, __ATOMIC_RELAXED, __HIP_MEMORY_SCOPE_AGENT) < target) __builtin_amdgcn_s_sleep(1);
        __builtin_amdgcn_fence(__ATOMIC_ACQUIRE, "agent"); asm volatile("s_waitcnt vmcnt(0)" ::: "memory");
    }
    __syncthreads();
}
template <bool AL = true, bool SP = true, class Epi, class Sched> __device__ __forceinline__ void run_gemm(unsigned char* lds, const bf16_t* A, const bf16_t* Bt, int M, int N, int K, int lda, int ldb, const Sched& S, const Epi& E, const int g_wv) {
    pg8::Gemm g{A, Bt, M, N, K, lda, ldb};
    pg8::gemm_phase<Epi, Sched, AL, SP>((PG8_LAS unsigned char*)lds, g, S, E, g_wv);
    __syncthreads();
}

__global__ void __launch_bounds__(NTHR, 2) mega(Params p_arg) {
    extern __shared__ __attribute__((aligned(16))) unsigned char lds[];
    cg::grid_group grid = cg::this_grid();
    const int g_wv = __builtin_amdgcn_readfirstlane((int)(__builtin_amdgcn_workitem_id_x() >> 6));
    const int G = gridDim.x, cb = blockIdx.x; const int w_lo = p_arg.w_lo, w_hi = p_arg.w_hi;
#define WIN(k_) (w_lo <= (k_) && (k_) < w_hi)
    unsigned nbar = 0;
#define SEAM(k_) do { if (WIN(k_) && WIN((k_) + 1)) { ++nbar; gbar((unsigned*)(PP.ws + WS_CTR), nbar * (unsigned)G, g_wv); } } while (0)
    if (w_lo > 1000) GSYNC();
    if (WIN(0)) {
#if PHM & 1
    convert_weights(lds, PP, 0, g_wv); convert_weights(lds, PP, 1, g_wv);
#endif
#if PHM & 2
    build_cs(PP, g_wv);
    { const Params p = PP; rmsnorm_rows<true>(p.x, p.norm_gain, (bf16_t*)(p.ws + WS_H), nullptr, g_wv); }
#endif
    }
    SEAM(0);
#pragma unroll 1
    for (int l = 0; l < 2; ++l) {
        const int wb = 1 + 7 * l;
        if (WIN(wb)) {
#if PHM & 4
        { unsigned char* ws = PP.ws; unsigned char* wl = ws + WS_W0 + (size_t)l * WL_SIZE; const f32x2* cs = (const f32x2*)(ws + WS_CS); (void)cs; (void)wl; pg8::StaticOrder S; S.init(T, 15360, G, cb); EpiIn E{ws}; run_gemm(lds, (const bf16_t*)(ws + WS_H), (const bf16_t*)(wl + WL_WIN), T, 15360, DM, DM, DM, S, E, g_wv); }
        { unsigned char* ws = PP.ws; unsigned char* wl = ws + WS_W0 + (size_t)l * WL_SIZE; const f32x2* cs = (const f32x2*)(ws + WS_CS); (void)cs; (void)wl; pg8::StaticOrder S; S.init(1024, T, G, cb); EpiVT E{(bf16_t*)(ws + WS_VAT), T, nullptr, 0.f}; run_gemm(lds, (const bf16_t*)(wl + WL_WIN) + (size_t)15360 * DM, (const bf16_t*)(ws + WS_H), 1024, T, DM, DM, DM, S, E, g_wv); }
#endif
        }
        SEAM(wb);
        if (WIN(wb + 1)) {
#if PHM & 32
        mlstm_a(lds, PP, l, g_wv);
#endif
#if PHM & 16
        kmean_phase(PP, l, g_wv);
#endif
#if PHM & 8
        { unsigned char* ws = PP.ws; unsigned char* wl = ws + WS_W0 + (size_t)l * WL_SIZE; const f32x2* cs = (const f32x2*)(ws + WS_CS); (void)cs; (void)wl; pg8::StaticOrder S; S.init(T, 1536, G, cb); EpiRow<true> E{(bf16_t*)(ws + WS_QC), 1536, (const float*)(ws + WS_SSP), 1.0f / 512.0f, CC_SCALE, cs}; run_gemm(lds, (const bf16_t*)(ws + WS_CQ), (const bf16_t*)(wl + WL_WUQ), T, 1536, 512, 512, 512, S, E, g_wv); }
        { unsigned char* ws = PP.ws; unsigned char* wl = ws + WS_W0 + (size_t)l * WL_SIZE; const f32x2* cs = (const f32x2*)(ws + WS_CS); (void)cs; (void)wl; pg8::StaticOrder S; S.init(T, 1024, G, cb); EpiRow<false> E{(bf16_t*)(ws + WS_KNC), 1024, (const float*)(ws + WS_SSP), 1.0f / 256.0f, 1.0f, cs}; run_gemm(lds, (const bf16_t*)(ws + WS_CKV), (const bf16_t*)(wl + WL_WKN), T, 1024, 256, 256, 256, S, E, g_wv); }
        { unsigned char* ws = PP.ws; unsigned char* wl = ws + WS_W0 + (size_t)l * WL_SIZE; const f32x2* cs = (const f32x2*)(ws + WS_CS); (void)cs; (void)wl; pg8::StaticOrder S; S.init(1024, T, G, cb); EpiVT E{(bf16_t*)(ws + WS_VCT), T, (const float*)(ws + WS_SSP), 1.0f / 256.0f}; run_gemm(lds, (const bf16_t*)(wl + WL_WV), (const bf16_t*)(ws + WS_CKV), 1024, T, 256, 256, 256, S, E, g_wv); }
#endif
        }
        SEAM(wb + 1);
        if (WIN(wb + 2)) {
#if PHM & 128
        mlstm_b(PP, g_wv);
#endif
#if PHM & 64
        attn_phase<0>(lds, PP, l, g_wv);
#endif
        }
        if (WIN(wb + 3)) {
#if PHM & 256
        attn_phase<1>(lds, PP, l, g_wv);
#endif
#if PHM & 512
        mlstm_c(lds, PP, l, g_wv);
#endif
        }
        SEAM(wb + 3);
        if (WIN(wb + 4)) {
#if PHM & 1024
        { unsigned char* ws = PP.ws; unsigned char* wl = ws + WS_W0 + (size_t)l * WL_SIZE; MergeOrder S{G, cb}; EpiMerge E{(bf16_t*)(ws + WS_H), (const bf16_t*)(ws + WS_GT)}; run_gemm(lds, (const bf16_t*)(ws + WS_Z), (const bf16_t*)(wl + WL_WB), 3 * T, 2048, 1024, 1024, 1024, S, E, g_wv); }
#endif
        }
        SEAM(wb + 4);
        if (WIN(wb + 5)) {
#if PHM & 2048
        { unsigned char* ws = PP.ws; unsigned char* wl = ws + WS_W0 + (size_t)l * WL_SIZE; const f32x2* cs = (const f32x2*)(ws + WS_CS); (void)cs; (void)wl; pg8::StaticOrder S; S.init(T, DM, G, cb); const Params p = PP; EpiOut E{l == 0 ? p.x : p.out, p.out}; run_gemm(lds, (const bf16_t*)(ws + WS_H), (const bf16_t*)(wl + WL_WO), T, DM, DM, DM, DM, S, E, g_wv); }
#endif
        }
        SEAM(wb + 5);
        if (WIN(wb + 6)) {
            if (l == 0) { const Params p = PP; rmsnorm_rows<true>(p.out, p.norm_gain + DM, (bf16_t*)(p.ws + WS_H), nullptr, g_wv); }
            else { const Params p = PP; rmsnorm_rows<false>(p.out, p.final_norm, nullptr, p.out, g_wv); }
        }
        if (l == 0) SEAM(wb + 6);
    }
}


#if defined(MK_DEBUG_HASH)
__global__ void hash_buf(const unsigned* p, size_t nwords, unsigned long long* acc) {
    unsigned long long s = 0; const size_t stride = (size_t)gridDim.x * blockDim.x;
    for (size_t i = (size_t)blockIdx.x * blockDim.x + threadIdx.x; i < nwords; i += stride) s += (unsigned long long)p[i] * (unsigned long long)(((unsigned)i * 2654435761u) | 1u);
    atomicAdd(acc, s);
}
__global__ void dbg_final(float* out, size_t n, const unsigned long long* h, int R, int NK) {
    __shared__ float flag;
    if (threadIdx.x == 0) { float f = 1.0f; for (int k = NK - 1; k >= 0; --k) for (int r = 1; r < R; ++r) if (h[r * NK + k] != h[k]) { f = 100.0f; for (int q = 0; q < k; ++q) f *= 10.0f; } flag = f; }
    __syncthreads();
    for (size_t i = (size_t)blockIdx.x * blockDim.x + threadIdx.x; i < n; i += (size_t)gridDim.x * blockDim.x) out[i] = (i == 0) ? flag : 0.0f;
}
#endif
extern "C" void kernel_launch(void* const* d_in, const int* in_sizes, int n_in, void* d_out, int out_size, void* d_ws, size_t ws_size, hipStream_t stream) {
    static int grid = 0;
    if (grid == 0) {
        if (n_in != 16 || ws_size < WS_END) { fprintf(stderr, "kernel_launch: unexpected n_in %d or ws_size %zu < %zu\n", n_in, ws_size, (size_t)WS_END); grid = -1; return; }
        int dev = 0, cus = 0, per_cu = 0;
        hipGetDevice(&dev); hipDeviceGetAttribute(&cus, hipDeviceAttributeMultiprocessorCount, dev);
        if (hipFuncSetAttribute((const void*)mega, hipFuncAttributeMaxDynamicSharedMemorySize, LDS_BYTES) != hipSuccess) { fprintf(stderr, "kernel_launch: hipFuncSetAttribute failed\n"); grid = -1; return; }
        if (hipOccupancyMaxActiveBlocksPerMultiprocessor(&per_cu, (const void*)mega, NTHR, LDS_BYTES) != hipSuccess || per_cu < 1) { fprintf(stderr, "kernel_launch: occupancy query gave %d\n", per_cu); per_cu = 1; }
        (void)hipGetLastError();
        grid = cus * 1;
    }
    if (grid < 0) return;
    Params p{};
    p.x = (const float*)d_in[0]; p.norm_gain = (const float*)d_in[1]; p.w_in = (const float*)d_in[2]; p.t5 = (const float*)d_in[3]; p.conv_w = (const float*)d_in[4]; p.conv_b = (const float*)d_in[5];
    p.i_bias = (const float*)d_in[6]; p.f_bias = (const float*)d_in[7]; p.out_norm = (const float*)d_in[8]; p.q_norm = (const float*)d_in[9]; p.kv_norm = (const float*)d_in[10];
    p.w_uq = (const float*)d_in[11]; p.w_ukv = (const float*)d_in[12]; p.w_branch = (const float*)d_in[13]; p.w_out = (const float*)d_in[14]; p.final_norm = (const float*)d_in[15];
    p.out = (float*)d_out; p.ws = (unsigned char*)d_ws;
    (void)hipMemsetAsync((unsigned char*)d_ws + WS_CTR, 0, 256, stream);
    void* args[] = {&p};
#if defined(MK_DEBUG_HASH)
    {
        constexpr int R = 4, NK = 9; unsigned char* W = (unsigned char*)d_ws; unsigned long long* H = (unsigned long long*)(W + WS_END);
        hipMemsetAsync(H, 0, R * NK * 8, stream);
        struct HB { int win; size_t off; size_t bytes; };
        const HB hb[NK] = { {3, WS_Z, 32 * MiB}, {3, WS_CST, 64 * MiB}, {3, WS_NST, 524288}, {3, WS_MST, 4096},
                            {4, WS_Z + 64 * MiB, 32 * MiB}, {4, WS_Z + 32 * MiB, 32 * MiB}, {5, WS_H, 64 * MiB}, {6, WS_H, 64 * MiB}, {2, WS_CST, 64 * MiB} };
        for (int r = 0; r < R; ++r)
            for (int w = 0; w < 7; ++w) { p.w_lo = w; p.w_hi = w + 1;
                hipError_t e = hipLaunchCooperativeKernel((const void*)mega, dim3(grid), dim3(NTHR), args, LDS_BYTES, stream);
                if (e != hipSuccess) fprintf(stderr, "kernel_launch: cooperative launch failed: %s\n", hipGetErrorString(e));
                for (int k = 0; k < NK; ++k) if (hb[k].win == w) {
                    if (k == 7) hash_buf<<<256, 256, 0, stream>>>((const unsigned*)d_out, (size_t)T * DM, H + r * NK + k);
                    else hash_buf<<<256, 256, 0, stream>>>((const unsigned*)(W + hb[k].off), hb[k].bytes / 4, H + r * NK + k); } }
        dbg_final<<<256, 256, 0, stream>>>((float*)d_out, (size_t)T * DM, H, R, NK);
    }
    if (false) {
#elif defined(MK_MULTI)
    for (int w = 0; w < 15; ++w) { p.w_lo = w; p.w_hi = w + 1;
#else
    { p.w_lo = 0; p.w_hi = 15;
#endif
        hipError_t e = hipLaunchCooperativeKernel((const void*)mega, dim3(grid), dim3(NTHR), args, LDS_BYTES, stream);
        if (e != hipSuccess) fprintf(stderr, "kernel_launch: cooperative launch failed: %s (grid %d)\n", hipGetErrorString(e), grid);
    }
}
```

```cpp
#include <hip/hip_runtime.h>
#include <hip/hip_cooperative_groups.h>
#include <cstdio>
#include <cstdint>
namespace cg = cooperative_groups;
__device__ __forceinline__ int tidx_opaque(int g_wv) { int l; asm volatile("v_mbcnt_lo_u32_b32 %0, -1, 0\n\tv_mbcnt_hi_u32_b32 %0, -1, %0" : "=v"(l)); return g_wv * 64 + l; }
#define TIDX tidx_opaque(g_wv)
__device__ __forceinline__ float shx(float v, int o, int lane) { return __int_as_float(__builtin_amdgcn_ds_bpermute(((lane ^ o) & 63) << 2, __float_as_int(v))); }
__device__ __forceinline__ int shxi(int v, int o, int lane) { return __builtin_amdgcn_ds_bpermute(((lane ^ o) & 63) << 2, v); }
__device__ __forceinline__ float shup(float v, int o, int lane) { return __int_as_float(__builtin_amdgcn_ds_bpermute(((lane - o) & 63) << 2, __float_as_int(v))); }

namespace pg8 {
#define PG8_LAS __attribute__((address_space(3)))
typedef unsigned short bf16_t;
typedef short bf16x8 __attribute__((ext_vector_type(8)));
typedef float f32x4 __attribute__((ext_vector_type(4)));
typedef unsigned u32x4 __attribute__((ext_vector_type(4)));
constexpr int BM = 256, BK = 64, HALF = 128, HTB = HALF * BK * 2  , STAGE_BYTES = 8 * HTB, NXCD = 8, WGM = 8;

__host__ __device__ __forceinline__ int lds_byte(int r, int c) { const int st = (r >> 4) * 2 + (c >> 5), rr = r & 15, cc = c & 31, ob = rr * 64 + cc * 2; return st * 1024 + (ob ^ (((ob >> 9) & 1) << 5)); }
__host__ __device__ __forceinline__ void stage_rc(int b, int& R, int& C) { const int st = b / 1024, sb = b % 1024, swz = sb ^ (((sb >> 9) & 1) << 5); R = (st >> 1) * 16 + swz / 64; C = (st & 1) * 32 + (swz % 64) / 2; }
__host__ __device__ __forceinline__ int perm32(int rho) { const int n = rho >> 4, i = rho & 15; return 8 * (i >> 2) + 4 * n + (i & 3); }

struct Unit { int pm, pn, pb; };
struct Gemm { const bf16_t* A; const bf16_t* Bt; int M, N, K, lda, ldb; };

struct StaticOrder {
    int nM, nN, nwg, G, c;
    __host__ __device__ void init(int M, int N, int G_, int c_) { nM = M / BM; nN = N / BM; nwg = nM * nN; G = G_; c = c_; }
    __host__ __device__ bool next(int i, Unit& u) const {
        const long L = (long)i * G + c; if (L >= nwg) return false;
        int wgid = (int)L; { const int q = nwg / NXCD, r = nwg % NXCD, xcd = wgid % NXCD, off = wgid / NXCD; wgid = (xcd < r ? xcd * (q + 1) : r * (q + 1) + (xcd - r) * q) + off; }
        const int nig = WGM * nN, gid = wgid / nig, fm = gid * WGM, gsz = (nM - fm) < WGM ? (nM - fm) : WGM;
        u.pm = fm + ((wgid % nig) % gsz); u.pn = (wgid % nig) / gsz; u.pb = u.pn; return true;
    }
    __device__ __forceinline__ void a_ready(const Unit&) const {}
    __device__ __forceinline__ void done(const Unit&) const {}
};

__device__ __forceinline__ unsigned cvt_pk_bf16(float lo, float hi) { unsigned r; asm volatile("s_nop 1\n\tv_cvt_pk_bf16_f32 %0, %1, %2\n\ts_nop 1" : "=v"(r) : "v"(lo), "v"(hi)); return r; }
template <class Epi, class Sched, bool ALIGN_EPI = false, bool SP2 = false>
__device__ __forceinline__ void gemm_phase(PG8_LAS unsigned char* lds, const Gemm g, const Sched& S, const Epi& E, const int g_wv) {
    int tid = TIDX; asm volatile("" : "+v"(tid)); const int wid = __builtin_amdgcn_readfirstlane(tid >> 6), lane = tid & 63, wr = wid >> 2, wc = wid & 3, fr = lane & 15, fq = lane >> 4;
    const int K = g.K, nt = K / BK;
    unsigned voffA[2], voffB[2];
#pragma unroll
    for (int i = 0; i < 2; ++i) { int R, C; stage_rc(tid * 16 + i * 8192, R, C); const int Rb = Epi::PERM ? ((R & ~31) + perm32(R & 31)) : R;
        voffA[i] = (unsigned)(R * K + C) * 2u; voffB[i] = (unsigned)(Rb * K + C) * 2u; }
    const size_t kstep = (size_t)(BK * 2);
    const size_t hstepA = (size_t)HALF * K * 2; const size_t hstepB = hstepA;
    const size_t tstepA = 2 * hstepA; const size_t tstepB = tstepA;
    const unsigned ldsw = (unsigned)wid * 1024u;
    const int aoff = lds_byte(wr * 64 + fr, fq * 8), boff = lds_byte(wc * 32 + fr, fq * 8);
#define PG8_SA(b, h) (((b) * 2 + (h)) * HTB)
#define PG8_SB(b, h) ((4 + (b) * 2 + (h)) * HTB)
#define PG8_STAGE(bufoff, gbase, voff) do { _Pragma("unroll") for (int _i = 0; _i < 2; ++_i) \
        __builtin_amdgcn_global_load_lds((const unsigned*)((const char*)(gbase) + (voff)[_i]), (PG8_LAS unsigned*)(lds + (bufoff) + ldsw + _i * 8192), 16, 0, 0); } while (0)
#define PG8_LDA(dst, b, h) do { _Pragma("unroll") for (int m = 0; m < 4; ++m) _Pragma("unroll") for (int k = 0; k < 2; ++k) dst[m][k] = *(const PG8_LAS bf16x8*)(lds + PG8_SA(b, h) + aoff + m * 2048 + k * 1024); } while (0)
#define PG8_LDB(dst, b, h) do { _Pragma("unroll") for (int n = 0; n < 2; ++n) _Pragma("unroll") for (int k = 0; k < 2; ++k) dst[n][k] = *(const PG8_LAS bf16x8*)(lds + PG8_SB(b, h) + boff + n * 2048 + k * 1024); } while (0)
#define PG8_MMA(ai, bj, At, Bt) do { __builtin_amdgcn_s_setprio(1); _Pragma("unroll") for (int m = 0; m < 4; ++m) _Pragma("unroll") for (int n = 0; n < 2; ++n) _Pragma("unroll") for (int k = 0; k < 2; ++k) \
        acc[ai][bj][m][n] = __builtin_amdgcn_mfma_f32_16x16x32_bf16(Bt[n][k], At[m][k], acc[ai][bj][m][n], 0, 0, 0); __builtin_amdgcn_s_setprio(0); } while (0)
#define PG8_WAIT_V(n) asm volatile("s_waitcnt vmcnt(" #n ")" ::: "memory")
#define PG8_WAIT_L(n) asm volatile("s_waitcnt lgkmcnt(" #n ")" ::: "memory")
#define PG8_BAR __builtin_amdgcn_s_barrier()
#define PG8_SCHED __builtin_amdgcn_sched_barrier(0)
    Unit cur, nxt; int ui = 0;
    if (!S.next(0, cur)) return;
    f32x4 acc[2][2][4][2];
#pragma unroll
    for (int a = 0; a < 2; ++a)
#pragma unroll
        for (int b = 0; b < 2; ++b)
#pragma unroll
            for (int m = 0; m < 4; ++m)
#pragma unroll
                for (int n = 0; n < 2; ++n) acc[a][b][m][n] = (f32x4){0.f, 0.f, 0.f, 0.f};
    bf16x8 At[4][2], B0[2][2], B1[2][2];
    const char* cA = (const char*)g.A + (size_t)cur.pm * tstepA; const char* cB = (const char*)g.Bt + (size_t)cur.pb * tstepB;
    S.a_ready(cur);
    if constexpr (SP2) {
        PG8_STAGE(PG8_SB(0, 0), cB, voffB); PG8_STAGE(PG8_SB(0, 1), cB + hstepB, voffB); PG8_STAGE(PG8_SA(0, 0), cA, voffA); PG8_STAGE(PG8_SA(0, 1), cA + hstepA, voffA);
        if (wr == 1) PG8_BAR;
        PG8_WAIT_V(2); PG8_BAR;
        PG8_STAGE(PG8_SB(1, 0), cB + kstep, voffB); PG8_STAGE(PG8_SA(1, 0), cA + kstep, voffA); PG8_STAGE(PG8_SB(1, 1), cB + hstepB + kstep, voffB);
        PG8_WAIT_V(6); PG8_BAR;
    } else {
        PG8_STAGE(PG8_SB(0, 0), cB, voffB); PG8_STAGE(PG8_SA(0, 0), cA, voffA); PG8_STAGE(PG8_SB(0, 1), cB + hstepB, voffB); PG8_STAGE(PG8_SA(0, 1), cA + hstepA, voffA);
        if (wr == 1) PG8_BAR;
        PG8_WAIT_V(4); PG8_BAR;
        PG8_STAGE(PG8_SB(1, 0), cB + kstep, voffB); PG8_STAGE(PG8_SA(1, 0), cA + kstep, voffA); PG8_STAGE(PG8_SB(1, 1), cB + hstepB + kstep, voffB);
        PG8_WAIT_V(6); PG8_BAR;
    }
    for (;;) {
        const bool has_next = S.next(ui + 1, nxt);
        const char* nA = has_next ? (const char*)g.A + (size_t)nxt.pm * tstepA : cA; const char* nB = has_next ? (const char*)g.Bt + (size_t)nxt.pb * tstepB : cB;
        for (int t = 0; t < nt; t += 2) {
            const bool last = (t == nt - 2);
            const char* a1 = cA + (size_t)(t + 1) * kstep;
            const char* a2 = last ? nA : cA + (size_t)(t + 2) * kstep; const char* b2 = last ? nB : cB + (size_t)(t + 2) * kstep;
            const char* a3 = a2 + kstep; const char* b3 = b2 + kstep;
            if (last && has_next) S.a_ready(nxt);
            if constexpr (SP2) {
            PG8_LDB(B0, 0, 0); PG8_LDB(B1, 0, 1); PG8_SCHED; PG8_LDA(At, 0, 0); PG8_STAGE(PG8_SA(1, 1), a1 + hstepA, voffA);
            PG8_WAIT_V(8); PG8_WAIT_L(0); PG8_BAR; PG8_MMA(0, 0, At, B0); PG8_MMA(0, 1, At, B1); PG8_BAR; PG8_SCHED;
            PG8_LDA(At, 0, 1); PG8_STAGE(PG8_SB(0, 0), b2, voffB); PG8_STAGE(PG8_SB(0, 1), b2 + hstepB, voffB); PG8_STAGE(PG8_SA(0, 0), a2, voffA);
            PG8_WAIT_V(8); PG8_WAIT_L(0); PG8_BAR; PG8_MMA(1, 0, At, B0); PG8_MMA(1, 1, At, B1); PG8_BAR; PG8_SCHED;
            PG8_LDB(B0, 1, 0); PG8_LDB(B1, 1, 1); PG8_SCHED; PG8_LDA(At, 1, 0); PG8_STAGE(PG8_SA(0, 1), a2 + hstepA, voffA);
            PG8_WAIT_V(8); PG8_WAIT_L(0); PG8_BAR; PG8_MMA(0, 0, At, B0); PG8_MMA(0, 1, At, B1); PG8_BAR; PG8_SCHED;
            PG8_LDA(At, 1, 1); PG8_STAGE(PG8_SB(1, 0), b3, voffB); PG8_STAGE(PG8_SB(1, 1), b3 + hstepB, voffB); PG8_STAGE(PG8_SA(1, 0), a3, voffA);
            PG8_WAIT_V(8); PG8_WAIT_L(0); PG8_BAR; PG8_MMA(1, 0, At, B0); PG8_MMA(1, 1, At, B1); PG8_BAR; PG8_SCHED;
            } else {
            PG8_LDB(B0, 0, 0); PG8_SCHED; PG8_LDA(At, 0, 0); PG8_STAGE(PG8_SA(1, 1), a1 + hstepA, voffA);
            PG8_WAIT_L(8); PG8_BAR; PG8_WAIT_L(0); PG8_MMA(0, 0, At, B0); PG8_BAR; PG8_SCHED;
            PG8_LDB(B1, 0, 1); PG8_STAGE(PG8_SB(0, 0), b2, voffB);
            PG8_BAR; PG8_WAIT_L(0); PG8_MMA(0, 1, At, B1); PG8_BAR;
            PG8_LDA(At, 0, 1); PG8_STAGE(PG8_SA(0, 0), a2, voffA);
            PG8_BAR; PG8_WAIT_L(0); PG8_MMA(1, 0, At, B0); PG8_BAR; PG8_SCHED;
            PG8_STAGE(PG8_SB(0, 1), b2 + hstepB, voffB);
            PG8_WAIT_V(6); PG8_BAR; PG8_MMA(1, 1, At, B1); PG8_BAR;
            PG8_LDB(B0, 1, 0); PG8_SCHED; PG8_LDA(At, 1, 0); PG8_STAGE(PG8_SA(0, 1), a2 + hstepA, voffA);
            PG8_WAIT_L(8); PG8_BAR; PG8_WAIT_L(0); PG8_MMA(0, 0, At, B0); PG8_BAR; PG8_SCHED;
            PG8_LDB(B1, 1, 1); PG8_STAGE(PG8_SB(1, 0), b3, voffB);
            PG8_BAR; PG8_WAIT_L(0); PG8_MMA(0, 1, At, B1); PG8_BAR;
            PG8_LDA(At, 1, 1); PG8_STAGE(PG8_SA(1, 0), a3, voffA);
            PG8_BAR; PG8_WAIT_L(0); PG8_MMA(1, 0, At, B0); PG8_BAR; PG8_SCHED;
            PG8_STAGE(PG8_SB(1, 1), b3 + hstepB, voffB);
            PG8_WAIT_V(6); PG8_BAR; PG8_MMA(1, 1, At, B1); PG8_BAR;
            }
        }
        if constexpr (ALIGN_EPI) { if (wr == 0) PG8_BAR; }
        if constexpr (!Epi::AFTER_DRAIN) { E(acc, cur, wr, wc, fr, fq); S.done(cur); }
        if (!has_next) break;
#pragma unroll
        for (int a = 0; a < 2; ++a)
#pragma unroll
            for (int b = 0; b < 2; ++b)
#pragma unroll
                for (int m = 0; m < 4; ++m)
#pragma unroll
                    for (int n = 0; n < 2; ++n) acc[a][b][m][n] = (f32x4){0.f, 0.f, 0.f, 0.f};
        cur = nxt; cA = nA; cB = nB; ++ui;
        if constexpr (ALIGN_EPI) { if (wr == 1) PG8_BAR; }
    }
    PG8_WAIT_V(0);
    if constexpr (!ALIGN_EPI) { if (wr == 0) PG8_BAR; }
    PG8_BAR;
    if constexpr (Epi::AFTER_DRAIN) { E.fused(acc, cur, wr, wc, fr, fq, lds, wid, lane); S.done(cur); }
#undef PG8_SA
#undef PG8_SB
#undef PG8_STAGE
#undef PG8_LDA
#undef PG8_LDB
#undef PG8_MMA
#undef PG8_WAIT_V
#undef PG8_WAIT_L
#undef PG8_BAR
#undef PG8_SCHED
}
}

using pg8::bf16_t; using pg8::bf16x8; using pg8::f32x4; using pg8::u32x4; using pg8::Unit; using pg8::cvt_pk_bf16;
typedef unsigned u32x2 __attribute__((ext_vector_type(2)));
typedef float f32x2 __attribute__((ext_vector_type(2)));
constexpr int T = 16384, SEQ = 4096, DM = 2048, DIN = 16200;
constexpr float EPS = 1e-6f, NEGV = -1e30f, LOG2E = 1.4426950408889634f;
constexpr float CA_SCALE = 0.12751743082459868f;
constexpr float CC_SCALE = 0.10411754627697264f;
constexpr int NTHR = 512;
constexpr int LDS_BYTES = 131072;

constexpr size_t MiB = 1ull << 20;
constexpr size_t WS_CS = 0;
constexpr size_t WS_SSQ = WS_CS + MiB;
constexpr size_t WS_SSKV = WS_SSQ + 65536;
constexpr size_t WS_GATES = WS_SSKV + 65536;
constexpr size_t WS_KM = WS_GATES + 524288;
constexpr size_t WS_BV = WS_KM + 131072;
constexpr size_t WS_LIV = WS_BV + 262144;
constexpr size_t WS_BLAST = WS_LIV + 262144;
constexpr size_t WS_GMAX = WS_BLAST + 4096;
constexpr size_t WS_MST = WS_GMAX + 4096;
constexpr size_t WS_NST = WS_MST + 4096;
constexpr size_t WS_W0 = WS_NST + 524288;
constexpr size_t WL_WIN = 0;
constexpr size_t WL_WB = WL_WIN + 64 * MiB;
constexpr size_t WL_WO = WL_WB + 12 * MiB;
constexpr size_t WL_WUQ = WL_WO + 8 * MiB;
constexpr size_t WL_WKN = WL_WUQ + 1536 * 1024;
constexpr size_t WL_WV = WL_WKN + 512 * 1024;
constexpr size_t WL_SIZE = WL_WV + 512 * 1024;
constexpr size_t WS_H = WS_W0 + 2 * WL_SIZE;
constexpr size_t WS_QA = WS_H + 64 * MiB;
constexpr size_t WS_KA = WS_QA + 32 * MiB;
constexpr size_t WS_VAT = WS_KA + 32 * MiB;
constexpr size_t WS_Z = WS_VAT + 32 * MiB;
constexpr size_t WS_QB = WS_Z + 96 * MiB;
constexpr size_t WS_KB = WS_QB + 16 * MiB;
constexpr size_t WS_VB = WS_KB + 16 * MiB;
constexpr size_t WS_OB = WS_VB + 32 * MiB;
constexpr size_t WS_Q2 = WS_OB + 32 * MiB;
constexpr size_t WS_K2 = WS_Q2 + 16 * MiB;
constexpr size_t WS_CST = WS_K2 + 16 * MiB;
constexpr size_t WS_CQ = WS_CST + 64 * MiB;
constexpr size_t WS_CKV = WS_CQ + 16 * MiB;
constexpr size_t WS_KR = WS_CKV + 8 * MiB;
constexpr size_t WS_QC = WS_KR + 2 * MiB;
constexpr size_t WS_KNC = WS_QC + 48 * MiB;
constexpr size_t WS_VCT = WS_KNC + 32 * MiB;
constexpr size_t WS_GT = WS_VCT + 32 * MiB;
constexpr size_t WS_SSP = WS_GT + 192 * MiB;
constexpr size_t WS_QAL = WS_SSP + MiB;
constexpr size_t WS_CTR = WS_QAL + 32 * MiB;
constexpr size_t WS_END = WS_CTR + 256;

struct Params {
    const float* x; const float* norm_gain; const float* w_in; const float* t5; const float* conv_w; const float* conv_b; const float* i_bias; const float* f_bias;
    const float* out_norm; const float* q_norm; const float* kv_norm; const float* w_uq; const float* w_ukv; const float* w_branch; const float* w_out; const float* final_norm;
    float* out; unsigned char* ws; int w_lo, w_hi;
};

__device__ __forceinline__ float bf2f(unsigned v16) { return __uint_as_float(v16 << 16); }
__device__ __forceinline__ float bflo(unsigned w) { return __uint_as_float(w << 16); }
__device__ __forceinline__ float bfhi(unsigned w) { return __uint_as_float(w & 0xffff0000u); }
__device__ __forceinline__ bf16_t f2bf(float f) { return (bf16_t)(cvt_pk_bf16(f, 0.f) & 0xffffu); }
__device__ __forceinline__ float fsigmoid(float v) { return __builtin_amdgcn_rcpf(1.0f + __expf(-v)); }
__device__ __forceinline__ float fsilu(float v) { return v * __builtin_amdgcn_rcpf(1.0f + __expf(-v)); }
__device__ __forceinline__ float fexp2(float v) { return __builtin_amdgcn_exp2f(v); }
__device__ __forceinline__ f32x4 zero4() { f32x4 z = (f32x4){0.f, 0.f, 0.f, 0.f}; asm volatile("" : "+v"(z)); return z; }
__device__ __forceinline__ f32x4 mfma16(bf16x8 a, bf16x8 b, f32x4 c) { return __builtin_amdgcn_mfma_f32_16x16x32_bf16(a, b, c, 0, 0, 0); }

struct EpiIn {
    static constexpr bool PERM = true, AFTER_DRAIN = false;
    unsigned char* ws;
    __device__ __forceinline__ void operator()(const f32x4 (&acc)[2][2][4][2], const Unit& u, int wr, int wc, int fr, int fq) const {
        const int pn = u.pn; const int row0 = u.pm * 256 + wr * 64 + fr;
        if (pn == 59) {
            const int cb = wc * 32 + 8 * fq;
            if (cb >= 72) return;
            float* gates = (float*)(ws + WS_GATES); bf16_t* kr = (bf16_t*)(ws + WS_KR); const f32x2* cs = (const f32x2*)(ws + WS_CS);
#pragma unroll
            for (int ai = 0; ai < 2; ++ai)
#pragma unroll
                for (int m = 0; m < 4; ++m) {
                    const int row = row0 + ai * 128 + m * 16; const f32x4 v0 = acc[ai][0][m][0], v1 = acc[ai][0][m][1];
                    if (cb == 0) { *(f32x4*)(gates + (size_t)row * 8) = v0; *(f32x4*)(gates + (size_t)row * 8 + 4) = v1; }
                    else {
                        const int j0 = (cb - 8) >> 1, pos = row & (SEQ - 1);
                        const f32x2 c0 = cs[pos * 32 + j0], c1 = cs[pos * 32 + j0 + 1], c2 = cs[pos * 32 + j0 + 2], c3 = cs[pos * 32 + j0 + 3];
                        u32x4 w;
                        w.x = cvt_pk_bf16(v0[0] * c0.x - v0[1] * c0.y, v0[0] * c0.y + v0[1] * c0.x);
                        w.y = cvt_pk_bf16(v0[2] * c1.x - v0[3] * c1.y, v0[2] * c1.y + v0[3] * c1.x);
                        w.z = cvt_pk_bf16(v1[0] * c2.x - v1[1] * c2.y, v1[0] * c2.y + v1[1] * c2.x);
                        w.w = cvt_pk_bf16(v1[2] * c3.x - v1[3] * c3.y, v1[2] * c3.y + v1[3] * c3.x);
                        *(u32x4*)(kr + (size_t)row * 64 + (cb - 8)) = w;
                    }
                }
            return;
        }
        size_t off; int ld, c0, act = 0, ssk = 0; float sc = 1.f;
        if (pn < 4) { off = WS_QA; ld = 1024; c0 = pn * 256; sc = CA_SCALE; }
        else if (pn < 8) { off = WS_KA; ld = 1024; c0 = (pn - 4) * 256; }
        else if (pn < 12) { off = WS_Z; ld = 1024; c0 = (pn - 8) * 256; act = 1; }
        else if (pn < 14) { off = WS_QB; ld = 512; c0 = (pn - 12) * 256; }
        else if (pn < 16) { off = WS_KB; ld = 512; c0 = (pn - 14) * 256; }
        else if (pn < 20) { off = WS_VB; ld = 1024; c0 = (pn - 16) * 256; }
        else if (pn < 24) { off = WS_OB; ld = 1024; c0 = (pn - 20) * 256; act = 2; }
        else if (pn < 28) { off = WS_Z + 32 * MiB; ld = 1024; c0 = (pn - 24) * 256; act = 1; }
        else if (pn < 30) { off = WS_CQ; ld = 512; c0 = (pn - 28) * 256; ssk = 1; }
        else if (pn < 31) { off = WS_CKV; ld = 256; c0 = 0; ssk = 2; }
        else if (pn < 35) { off = WS_Z + 64 * MiB; ld = 1024; c0 = (pn - 31) * 256; act = 1; }
        else { off = WS_GT; ld = 6144; c0 = (pn - 35) * 256; act = 2; }
        bf16_t* dst = (bf16_t*)(ws + off); float* ssp = (float*)(ws + WS_SSP) + (ssk == 2 ? 8 : (pn - 28) * 4) + wc;
        const int col0 = c0 + wc * 32 + 8 * fq;
#pragma unroll
        for (int ai = 0; ai < 2; ++ai)
#pragma unroll
            for (int m = 0; m < 4; ++m) {
                const int row = row0 + ai * 128 + m * 16; bf16_t* rowp = dst + (size_t)row * ld + col0; float ss = 0.f;
#pragma unroll
                for (int bj = 0; bj < 2; ++bj) {
                    f32x4 v0 = acc[ai][bj][m][0], v1 = acc[ai][bj][m][1];
                    if (act == 1) {
#pragma unroll
                        for (int i = 0; i < 4; ++i) { v0[i] = fsilu(v0[i]); v1[i] = fsilu(v1[i]); }
                    } else if (act == 2) {
#pragma unroll
                        for (int i = 0; i < 4; ++i) { v0[i] = fsigmoid(v0[i]); v1[i] = fsigmoid(v1[i]); }
                    } else { v0 = v0 * sc; v1 = v1 * sc; }
                    if (ssk) ss += (v0[0] * v0[0] + v0[1] * v0[1]) + (v0[2] * v0[2] + v0[3] * v0[3]) + (v1[0] * v1[0] + v1[1] * v1[1]) + (v1[2] * v1[2] + v1[3] * v1[3]);
                    u32x4 w; w.x = cvt_pk_bf16(v0[0], v0[1]); w.y = cvt_pk_bf16(v0[2], v0[3]); w.z = cvt_pk_bf16(v1[0], v1[1]); w.w = cvt_pk_bf16(v1[2], v1[3]);
                    *(u32x4*)(rowp + bj * 128) = w;
                    if (pn < 4) {
                        u32x4 wl; wl.x = cvt_pk_bf16(v0[0] - bflo(w.x), v0[1] - bfhi(w.x)); wl.y = cvt_pk_bf16(v0[2] - bflo(w.y), v0[3] - bfhi(w.y));
                        wl.z = cvt_pk_bf16(v1[0] - bflo(w.z), v1[1] - bfhi(w.z)); wl.w = cvt_pk_bf16(v1[2] - bflo(w.w), v1[3] - bfhi(w.w));
                        *(u32x4*)((bf16_t*)(ws + WS_QAL) + (size_t)row * 1024 + col0 + bj * 128) = wl; }
                }
                if (ssk) { const int ln = fq * 16 + fr; ss += shx(ss, 16, ln); ss += shx(ss, 32, ln); if (fq == 0) ssp[(size_t)row * 16] = ss; }
            }
    }
};

struct EpiVT {
    static constexpr bool PERM = true, AFTER_DRAIN = false;
    bf16_t* dst; int ld; const float* ss; float inv_n;
    __device__ __forceinline__ void operator()(const f32x4 (&acc)[2][2][4][2], const Unit& u, int wr, int wc, int fr, int fq) const {
        const int row0 = u.pm * 256 + wr * 64 + fr, col0 = u.pn * 256 + wc * 32 + 8 * fq;
        f32x4 s0[2], s1[2];
#pragma unroll
        for (int bj = 0; bj < 2; ++bj) {
            if (ss) { f32x4 a, b;
#pragma unroll
                for (int i = 0; i < 4; ++i) { const f32x4 pa = *(const f32x4*)(ss + (size_t)(col0 + bj * 128 + i) * 16 + 8), pb = *(const f32x4*)(ss + (size_t)(col0 + bj * 128 + 4 + i) * 16 + 8);
                    a[i] = rsqrtf(((pa[0] + pa[1]) + (pa[2] + pa[3])) * inv_n + EPS); b[i] = rsqrtf(((pb[0] + pb[1]) + (pb[2] + pb[3])) * inv_n + EPS); }
                s0[bj] = a; s1[bj] = b; }
            else { s0[bj] = (f32x4){1.f, 1.f, 1.f, 1.f}; s1[bj] = s0[bj]; }
        }
#pragma unroll
        for (int ai = 0; ai < 2; ++ai)
#pragma unroll
            for (int m = 0; m < 4; ++m) {
                bf16_t* rowp = dst + (size_t)(row0 + ai * 128 + m * 16) * ld + col0;
#pragma unroll
                for (int bj = 0; bj < 2; ++bj) {
                    const f32x4 v0 = acc[ai][bj][m][0] * s0[bj], v1 = acc[ai][bj][m][1] * s1[bj];
                    u32x4 w; w.x = cvt_pk_bf16(v0[0], v0[1]); w.y = cvt_pk_bf16(v0[2], v0[3]); w.z = cvt_pk_bf16(v1[0], v1[1]); w.w = cvt_pk_bf16(v1[2], v1[3]);
                    *(u32x4*)(rowp + bj * 128) = w;
                }
            }
    }
};

template <bool ROPE> struct EpiRow {
    static constexpr bool PERM = true, AFTER_DRAIN = false;
    bf16_t* dst; int ld; const float* ss; float inv_n, sc; const f32x2* cs;
    __device__ __forceinline__ void operator()(const f32x4 (&acc)[2][2][4][2], const Unit& u, int wr, int wc, int fr, int fq) const {
        const int row0 = u.pm * 256 + wr * 64 + fr, col0 = u.pn * 256 + wc * 32 + 8 * fq;
#pragma unroll
        for (int ai = 0; ai < 2; ++ai)
#pragma unroll
            for (int m = 0; m < 4; ++m) {
                const int row = row0 + ai * 128 + m * 16; float sq;
                if (ROPE) { const f32x4 pa = *(const f32x4*)(ss + (size_t)row * 16), pb = *(const f32x4*)(ss + (size_t)row * 16 + 4); sq = ((pa[0] + pa[1]) + (pa[2] + pa[3])) + ((pb[0] + pb[1]) + (pb[2] + pb[3])); }
                else { const f32x4 pa = *(const f32x4*)(ss + (size_t)row * 16 + 8); sq = (pa[0] + pa[1]) + (pa[2] + pa[3]); }
                const float rs = rsqrtf(sq * inv_n + EPS) * sc; bf16_t* rowp = dst + (size_t)row * ld + col0;
#pragma unroll
                for (int bj = 0; bj < 2; ++bj) {
                    f32x4 v0 = acc[ai][bj][m][0] * rs, v1 = acc[ai][bj][m][1] * rs; u32x4 w;
                    const int hc = (col0 + bj * 128) % 192;
                    if (ROPE && hc >= 128) {
                        const int j0 = (hc - 128) >> 1, pos = row & (SEQ - 1);
                        const f32x2 c0 = cs[pos * 32 + j0], c1 = cs[pos * 32 + j0 + 1], c2 = cs[pos * 32 + j0 + 2], c3 = cs[pos * 32 + j0 + 3];
                        w.x = cvt_pk_bf16(v0[0] * c0.x - v0[1] * c0.y, v0[0] * c0.y + v0[1] * c0.x);
                        w.y = cvt_pk_bf16(v0[2] * c1.x - v0[3] * c1.y, v0[2] * c1.y + v0[3] * c1.x);
                        w.z = cvt_pk_bf16(v1[0] * c2.x - v1[1] * c2.y, v1[0] * c2.y + v1[1] * c2.x);
                        w.w = cvt_pk_bf16(v1[2] * c3.x - v1[3] * c3.y, v1[2] * c3.y + v1[3] * c3.x);
                    } else { w.x = cvt_pk_bf16(v0[0], v0[1]); w.y = cvt_pk_bf16(v0[2], v0[3]); w.z = cvt_pk_bf16(v1[0], v1[1]); w.w = cvt_pk_bf16(v1[2], v1[3]); }
                    *(u32x4*)(rowp + bj * 128) = w;
                }
            }
    }
};

struct EpiMerge {
    static constexpr bool PERM = true, AFTER_DRAIN = false;
    bf16_t* merged; const bf16_t* gt;
    __device__ __forceinline__ void operator()(const f32x4 (&acc)[2][2][4][2], const Unit& u, int wr, int wc, int fr, int fq) const {
        const int n = u.pm >> 6, pmr = u.pm & 63; const int row0 = pmr * 256 + wr * 64 + fr, col0 = u.pn * 256 + wc * 32 + 8 * fq;
#pragma unroll
        for (int ai = 0; ai < 2; ++ai)
#pragma unroll
            for (int m = 0; m < 4; ++m) {
                const int row = row0 + ai * 128 + m * 16;
#pragma unroll
                for (int bj = 0; bj < 2; ++bj) {
                    const u32x4 gw = *(const u32x4*)(gt + (size_t)row * 6144 + n * 2048 + col0 + bj * 128);
                    bf16_t* mp = merged + (size_t)row * 2048 + col0 + bj * 128;
                    u32x4 pw = (u32x4){0u, 0u, 0u, 0u}; if (n > 0) pw = __builtin_nontemporal_load((const u32x4*)mp);
                    const f32x4 v0 = acc[ai][bj][m][0], v1 = acc[ai][bj][m][1]; u32x4 w;
                    w.x = cvt_pk_bf16(bflo(pw.x) + bflo(gw.x) * v0[0], bfhi(pw.x) + bfhi(gw.x) * v0[1]);
                    w.y = cvt_pk_bf16(bflo(pw.y) + bflo(gw.y) * v0[2], bfhi(pw.y) + bfhi(gw.y) * v0[3]);
                    w.z = cvt_pk_bf16(bflo(pw.z) + bflo(gw.z) * v1[0], bfhi(pw.z) + bfhi(gw.z) * v1[1]);
                    w.w = cvt_pk_bf16(bflo(pw.w) + bflo(gw.w) * v1[2], bfhi(pw.w) + bfhi(gw.w) * v1[3]);
                    *(u32x4*)mp = w;
                }
            }
    }
};
struct MergeOrder {
    int G, c;
    __device__ bool next(int i, Unit& u) const {
        const int t3 = i / 3, n = i - 3 * t3; const long L = (long)t3 * G + c; if (L >= 512) return false;
        const int tm = (int)(L >> 3), tn = (int)(L & 7); u.pm = n * 64 + tm; u.pn = tn; u.pb = n * 8 + tn; return true;
    }
    __device__ __forceinline__ void a_ready(const Unit&) const {}
    __device__ __forceinline__ void done(const Unit&) const {}
};

struct EpiOut {
    static constexpr bool PERM = false, AFTER_DRAIN = false;
    const float* xin; float* xout;
    __device__ __forceinline__ void operator()(const f32x4 (&acc)[2][2][4][2], const Unit& u, int wr, int wc, int fr, int fq) const {
        const int row0 = u.pm * 256 + wr * 64 + fr, col0 = u.pn * 256 + wc * 32 + 4 * fq;
#pragma unroll
        for (int ai = 0; ai < 2; ++ai)
#pragma unroll
            for (int m = 0; m < 4; ++m) {
                const size_t ro = (size_t)(row0 + ai * 128 + m * 16) * DM + col0;
#pragma unroll
                for (int bj = 0; bj < 2; ++bj)
#pragma unroll
                    for (int n = 0; n < 2; ++n) { const f32x4 b = *(const f32x4*)(xin + ro + bj * 128 + n * 16); *(f32x4*)(xout + ro + bj * 128 + n * 16) = b + acc[ai][bj][m][n]; }
            }
    }
};

template <class F> __device__ __forceinline__ void tconv(unsigned char* lds, const float* src, int ldsrc, int K, bf16_t* dst, int N, const float* gain, F f, const int g_wv) {
    float* tile = (float*)lds; int tid = TIDX; asm volatile("" : "+v"(tid)); const int tilesK = K >> 6, ntile = tilesK * (N >> 8);
    const int nn4 = (tid & 63) * 4, kk0 = tid >> 6; f32x4 pre[8];
#define TCONV_LOAD(tt_) do { const int tn_ = (tt_) / tilesK, tk_ = (tt_) - tn_ * tilesK; const int c0 = f(tn_ * 256 + nn4), c1 = f(tn_ * 256 + nn4 + 1), c2 = f(tn_ * 256 + nn4 + 2), c3 = f(tn_ * 256 + nn4 + 3); \
        const bool vec = (c0 >= 0) && ((c0 & 3) == 0) && (c3 == c0 + 3); const float* sp = src + (size_t)(tk_ * 64 + kk0) * ldsrc; \
        _Pragma("unroll") for (int e = 0; e < 8; ++e) { const float* rp = sp + (size_t)(8 * e) * ldsrc; f32x4 v; \
            if (vec) v = *(const f32x4*)(rp + c0); \
            else { v[0] = c0 >= 0 ? rp[c0] : 0.f; v[1] = c1 >= 0 ? rp[c1] : 0.f; v[2] = c2 >= 0 ? rp[c2] : 0.f; v[3] = c3 >= 0 ? rp[c3] : 0.f; } \
            pre[e] = v; } } while (0)
    int t = blockIdx.x;
    if (t < ntile) TCONV_LOAD(t);
    for (; t < ntile; t += gridDim.x) {
        const int tn = t / tilesK, tk = t - tn * tilesK;
#pragma unroll
        for (int e = 0; e < 8; ++e) { f32x4 v = pre[e]; if (gain) v = v * gain[tk * 64 + kk0 + 8 * e]; *(f32x4*)(tile + (kk0 + 8 * e) * 260 + nn4) = v; }
        __syncthreads();
        { const int t2 = t + (int)gridDim.x; if (t2 < ntile) TCONV_LOAD(t2); }
        { const int nn = tid >> 1, kc = (tid & 1) * 32; bf16_t* dp = dst + (size_t)(tn * 256 + nn) * K + tk * 64 + kc;
#pragma unroll
          for (int q4 = 0; q4 < 4; ++q4) { float v[8];
#pragma unroll
              for (int i = 0; i < 8; ++i) v[i] = tile[(kc + q4 * 8 + i) * 260 + nn];
              u32x4 w; w.x = cvt_pk_bf16(v[0], v[1]); w.y = cvt_pk_bf16(v[2], v[3]); w.z = cvt_pk_bf16(v[4], v[5]); w.w = cvt_pk_bf16(v[6], v[7]);
              *(u32x4*)(dp + q4 * 8) = w; } }
        __syncthreads();
    }
#undef TCONV_LOAD
}
__device__ __forceinline__ int win_src_col(int n) {
    if (n < 1024) return n;
    if (n < 2048) return 1024 + (n - 1024);
    if (n < 3072) return 3072 + (n - 2048);
    if (n < 3584) return 4096 + (n - 3072);
    if (n < 4096) return 4608 + (n - 3584);
    if (n < 5120) return 5120 + (n - 4096);
    if (n < 6144) return 6152 + (n - 5120);
    if (n < 7168) return 7176 + (n - 6144);
    if (n < 7680) return 8200 + (n - 7168);
    if (n < 7936) return 8712 + (n - 7680);
    if (n < 8960) return 9032 + (n - 7936);
    if (n < 15104) return 10056 + (n - 8960);
    if (n < 15360) { const int r = n - 15104; if (r < 4) return 6144 + r; if (r < 8) return 6148 + (r - 4); if (r < 72) { const int j = (r - 8) >> 1, odd = (r - 8) & 1; return 8968 + j + 32 * odd; } return -1; }
    return 2048 + (n - 15360);
}
__device__ __forceinline__ void convert_weights(unsigned char* lds, const Params& p, int l, const int g_wv) {
    unsigned char* wl = p.ws + WS_W0 + (size_t)l * WL_SIZE;
    tconv(lds, p.w_in + (size_t)l * DM * DIN, DIN, DM, (bf16_t*)(wl + WL_WIN), 16384, nullptr, [](int n) { return win_src_col(n); }, g_wv);
#pragma unroll 1
    for (int n = 0; n < 3; ++n)
        tconv(lds, p.w_branch + ((size_t)l * 3 + n) * 1024 * DM, DM, 1024, (bf16_t*)(wl + WL_WB) + (size_t)n * 2048 * 1024, 2048, nullptr, [](int c) { return c; }, g_wv);
    tconv(lds, p.w_out + (size_t)l * DM * DM, DM, DM, (bf16_t*)(wl + WL_WO), DM, nullptr, [](int c) { return c; }, g_wv);
    tconv(lds, p.w_uq + (size_t)l * 512 * 1536, 1536, 512, (bf16_t*)(wl + WL_WUQ), 1536, p.q_norm + l * 512,
          [](int n) { const int h = n / 192, hc = n - h * 192; if (hc < 128) return n; const int r = hc - 128; return h * 192 + 128 + (r >> 1) + 32 * (r & 1); }, g_wv);
    tconv(lds, p.w_ukv + (size_t)l * 256 * 2048, 2048, 256, (bf16_t*)(wl + WL_WKN), 1024, p.kv_norm + l * 256, [](int n) { return (n >> 7) * 256 + (n & 127); }, g_wv);
    tconv(lds, p.w_ukv + (size_t)l * 256 * 2048, 2048, 256, (bf16_t*)(wl + WL_WV), 1024, p.kv_norm + l * 256, [](int n) { return (n >> 7) * 256 + 128 + (n & 127); }, g_wv);
}
__device__ __forceinline__ void sincos_acc(float ang, float& s, float& c) {
    const double x = (double)ang; const double q = rint(x * 0.63661977236758134308);
    double r = fma(-q, 1.57079632679489655800e+00, x); r = fma(-q, 6.12323399573676603587e-17, r);
    const int qi = ((int)q) & 3; const double r2 = r * r;
    const double sp = r + r * r2 * (-1.66666666666666324348e-01 + r2 * (8.33333333332248946124e-03 + r2 * (-1.98412698298579493134e-04 + r2 * (2.75573137070700676789e-06 + r2 * (-2.50507602534068634195e-08 + r2 * 1.58969099521155010221e-10)))));
    const double cp = 1.0 - 0.5 * r2 + r2 * r2 * (4.16666666666666019037e-02 + r2 * (-1.38888888888741095749e-03 + r2 * (2.48015872894767294178e-05 + r2 * (-2.75573143513906633035e-07 + r2 * (2.08757232129817482790e-09 + r2 * -1.13596475577881948265e-11)))));
    double ss, cc; if (qi == 0) { ss = sp; cc = cp; } else if (qi == 1) { ss = cp; cc = -sp; } else if (qi == 2) { ss = -sp; cc = -cp; } else { ss = -cp; cc = sp; }
    s = (float)ss; c = (float)cc;
}
__device__ __forceinline__ void build_cs(const Params& p, const int g_wv) {
    f32x2* cs = (f32x2*)(p.ws + WS_CS);
    int i0 = blockIdx.x * NTHR + TIDX; asm volatile("" : "+v"(i0));
    for (int i = i0; i < SEQ * 32; i += gridDim.x * NTHR) {
        const int pos = i >> 5, j = i & 31; double inv = 1.0; for (int k = 0; k < j; ++k) inv *= 0.7498942093324558;
        const float ang = (float)pos * (float)inv; float s, c; sincos_acc(ang, s, c); cs[i] = (f32x2){c, s};
    }
}
__device__ __forceinline__ void zero_ss(const Params& p, const int g_wv) {
    float* a = (float*)(p.ws + WS_SSQ);
    int i0 = blockIdx.x * NTHR + TIDX; asm volatile("" : "+v"(i0));
    for (int i = i0; i < 2 * T; i += gridDim.x * NTHR) a[i] = 0.f;
}
template <bool OUTBF> __device__ __forceinline__ void rmsnorm_rows(const float* x, const float* gain, bf16_t* hb, float* of, const int g_wv) {
    int tid = TIDX; asm volatile("" : "+v"(tid)); const int lane = tid & 63, gw = blockIdx.x * (NTHR / 64) + (tid >> 6), nw = gridDim.x * (NTHR / 64);
    for (int row = gw; row < T; row += nw) {
        const float* xr = x + (size_t)row * DM; f32x4 v[8]; float ss = 0.f;
#pragma unroll
        for (int i = 0; i < 8; ++i) { v[i] = *(const f32x4*)(xr + i * 256 + lane * 4); ss += (v[i][0] * v[i][0] + v[i][1] * v[i][1]) + (v[i][2] * v[i][2] + v[i][3] * v[i][3]); }
#pragma unroll
        for (int o = 1; o < 64; o <<= 1) ss += shx(ss, o, lane);
        const float rs = rsqrtf(ss * (1.0f / DM) + EPS);
#pragma unroll
        for (int i = 0; i < 8; ++i) {
            const f32x4 gn = *(const f32x4*)(gain + i * 256 + lane * 4); const f32x4 y = v[i] * rs * gn;
            if (OUTBF) { u32x2 w; w.x = cvt_pk_bf16(y[0], y[1]); w.y = cvt_pk_bf16(y[2], y[3]); *(u32x2*)(hb + (size_t)row * DM + i * 256 + lane * 4) = w; }
            else *(f32x4*)(of + (size_t)row * DM + i * 256 + lane * 4) = y;
        }
    }
}

__device__ __forceinline__ void kmean_phase(const Params& p, int l, const int g_wv) {
    const bf16_t* ka = (const bf16_t*)(p.ws + WS_KA); bf16_t* km = (bf16_t*)(p.ws + WS_KM); bf16_t* kml = (bf16_t*)(p.ws + WS_SSQ); int tid = TIDX; asm volatile("" : "+v"(tid));
    for (int u = (gridDim.x == 256) ? (int)blockIdx.x - 192 : (int)blockIdx.x; u < 64; u += gridDim.x) { if (u < 0) continue;
        const int b = u >> 4, j = u & 15; const unsigned* src = (const unsigned*)(ka + ((size_t)b * SEQ + j * 256) * 1024) + tid; float a0 = 0.f, a1 = 0.f;
#pragma unroll 8
        for (int r = 0; r < 256; ++r) { const unsigned w = src[(size_t)r * 512]; a0 += bflo(w); a1 += bfhi(w); }
        const int col = tid * 2, h = col >> 7, d = col & 127;
        const float m0 = a0 * (1.0f / 256.0f), m1 = a1 * (1.0f / 256.0f); const unsigned hi = cvt_pk_bf16(m0, m1);
        *(unsigned*)(km + ((size_t)((b * 8 + h) * 16 + j)) * 128 + d) = hi;
        *(unsigned*)(kml + ((size_t)((b * 8 + h) * 16 + j)) * 128 + d) = cvt_pk_bf16(m0 - bflo(hi), m1 - bfhi(hi));
    }
}

template <int MODE> __device__ __forceinline__ void attn_phase(unsigned char* lds, const Params& p, int l, const int g_wv) {
    constexpr int DQK = MODE ? 192 : 128, NC = DQK / 32, NCH = DQK / 8, KRS = DQK * 2 + 32, KBUF = 64 * KRS, VRS = 144, VBUF = 128 * VRS;
    constexpr int OFF_V = 2 * KBUF, OFF_LUT = OFF_V + 2 * VBUF, OFF_KM = OFF_LUT + 512, NKL = (64 * NCH) / NTHR;
    int tid = TIDX; asm volatile("" : "+v"(tid)); const int lane = tid & 63, w = tid >> 6, lr = lane & 15, g = lane >> 4; const int G = gridDim.x, c = blockIdx.x;
    unsigned char* ws = p.ws;
    const bf16_t* Qp = (const bf16_t*)(ws + (MODE ? WS_QC : WS_QA)); constexpr int LDQ = MODE ? 1536 : 1024;
    const bf16_t* Kp = (const bf16_t*)(ws + (MODE ? WS_KNC : WS_KA)); const bf16_t* KRp = (const bf16_t*)(ws + WS_KR);
    const bf16_t* VTp = (const bf16_t*)(ws + (MODE ? WS_VCT : WS_VAT)); bf16_t* Zp = (bf16_t*)(ws + WS_Z + (MODE ? 64 * MiB : 0));
    float* lut = (float*)(lds + OFF_LUT);
    for (int rd = 0; rd * G < 512; ++rd) {
        int qblk, bh;
        if (G == 256) {
            const int xq = c & 7, iq = c >> 3, qq = iq >> 1;
            bh = 2 * xq + (iq & 1) + 16 * rd; qblk = rd ? qq : 15 - qq;
        } else { const int idx = rd * G + ((rd & 1) ? (G - 1 - c) : c); if (idx >= 512) continue; qblk = 15 - (idx >> 5); bh = idx & 31; }
        const int b = bh >> 3, h = bh & 7;
        const int q0 = qblk * 256 + w * 32; const size_t tq = (size_t)b * SEQ + q0; const int nt = (qblk + 1) * 4;
        bf16x8 qf[2][NC];
#pragma unroll
        for (int qb = 0; qb < 2; ++qb)
#pragma unroll
            for (int c2 = 0; c2 < NC; ++c2) qf[qb][c2] = *(const bf16x8*)(Qp + (tq + qb * 16 + lr) * LDQ + h * DQK + c2 * 32 + g * 8);
        u32x4 kreg[NKL], vreg[2];
#define ATT_LOADK(t_) do { const int t__ = (t_); \
        _Pragma("unroll") for (int i = 0; i < NKL; ++i) { const int id = tid + NTHR * i; const int key = id / NCH, ch = id - key * NCH; const size_t tk = (size_t)b * SEQ + t__ * 64 + key; \
            const bf16_t* s_ = (!MODE || ch < 16) ? (Kp + tk * 1024 + h * 128 + ch * 8) : (KRp + tk * 64 + (ch - 16) * 8); kreg[i] = *(const u32x4*)s_; } } while (0)
#define ATT_LOADV(t_) do { const int t__ = (t_); \
        _Pragma("unroll") for (int i = 0; i < 2; ++i) { const int id = tid + NTHR * i; const int row = id >> 3, ch = id & 7; \
            vreg[i] = *(const u32x4*)(VTp + (size_t)(h * 128 + row) * T + (size_t)b * SEQ + t__ * 64 + ch * 8); } } while (0)
#define ATT_STOREK(buf_) do { unsigned char* kb_ = lds + (buf_) * KBUF; \
        _Pragma("unroll") for (int i = 0; i < NKL; ++i) { const int id = tid + NTHR * i; const int key = id / NCH, ch = id - key * NCH; *(u32x4*)(kb_ + key * KRS + ch * 16) = kreg[i]; } } while (0)
#define ATT_STOREV(buf_) do { unsigned char* vb_ = lds + OFF_V + (buf_) * VBUF; \
        _Pragma("unroll") for (int i = 0; i < 2; ++i) { const int id = tid + NTHR * i; const int row = id >> 3, ch = id & 7; *(u32x4*)(vb_ + row * VRS + ch * 16) = vreg[i]; } } while (0)
        ATT_LOADK(0); ATT_LOADV(0); ATT_STOREK(0); ATT_STOREV(0); ATT_LOADK(1); ATT_LOADV(1);
        unsigned sel[2] = {0u, 0u};
        if (MODE == 0) {
            if (tid < 128) { const int d = tid; int bk = d; if (d >= 16) { bk = 16 + (int)(logf((float)d * (1.0f / 16.0f)) / 2.0794415416798357f * 16.0f); bk = bk > 31 ? 31 : bk; } lut[d] = p.t5[bk * 8 + h] * LOG2E; }
            { const int half = tid >> 8, row = (tid >> 4) & 15, ch = tid & 15; *(u32x4*)(lds + OFF_KM + half * 4608 + row * 288 + ch * 16) = *(const u32x4*)((const bf16_t*)(ws + (half ? WS_SSQ : WS_KM)) + ((size_t)((b * 8 + h) * 16 + row)) * 128 + ch * 8); }
        }
        __syncthreads();
        if (MODE == 0) {
            f32x4 ga[2] = {zero4(), zero4()};
#pragma unroll
            for (int c2 = 0; c2 < NC; ++c2) { const bf16x8 kf = *(const bf16x8*)(lds + OFF_KM + lr * 288 + c2 * 64 + g * 16), kfl = *(const bf16x8*)(lds + OFF_KM + 4608 + lr * 288 + c2 * 64 + g * 16);
#pragma unroll
                for (int qb = 0; qb < 2; ++qb) { const bf16x8 ql = *(const bf16x8*)((const bf16_t*)(ws + WS_QAL) + (tq + qb * 16 + lr) * 1024 + h * 128 + c2 * 32 + g * 8);
                    ga[qb] = mfma16(kfl, qf[qb][c2], ga[qb]); ga[qb] = mfma16(kf, ql, ga[qb]); ga[qb] = mfma16(kf, qf[qb][c2], ga[qb]); } }
#pragma unroll
            for (int qb = 0; qb < 2; ++qb) {
                float gv[4];
#pragma unroll
                for (int r = 0; r < 4; ++r) gv[r] = (g * 4 + r < qblk) ? ga[qb][r] : -INFINITY;
                unsigned s = 0u;
#pragma unroll
                for (int it = 0; it < 3; ++it) {
                    float bv = -INFINITY; int bi = 99;
#pragma unroll
                    for (int r = 0; r < 4; ++r) if (gv[r] > bv) { bv = gv[r]; bi = g * 4 + r; }
#pragma unroll
                    for (int o = 16; o <= 32; o <<= 1) { const float ov = shx(bv, o, lane); const int oi = shxi(bi, o, lane); if (ov > bv || (ov == bv && oi < bi)) { bv = ov; bi = oi; } }
                    if (bv > -INFINITY) s |= 1u << bi;
#pragma unroll
                    for (int r = 0; r < 4; ++r) if (g * 4 + r == bi) gv[r] = -INFINITY;
                }
                sel[qb] = s;
            }
        }
        f32x4 oacc[8][2];
#pragma unroll
        for (int i = 0; i < 8; ++i) { oacc[i][0] = zero4(); oacc[i][1] = zero4(); }
        float mrow[2] = {NEGV, NEGV}, lrow[2] = {0.f, 0.f};
        for (int t = 0; t < nt; ++t) {
            const int buf = t & 1; const bool more = (t + 1 < nt);
            if (more) { ATT_STOREK(buf ^ 1); ATT_STOREV(buf ^ 1); }
            if (t + 2 < nt) { ATT_LOADK(t + 2); ATT_LOADV(t + 2); }
            const int k0 = t * 64;
            const unsigned char* kb_ = lds + buf * KBUF; const unsigned char* vb_ = lds + OFF_V + buf * VBUF;
#pragma unroll
            for (int hf = 0; hf < 2; ++hf) {
              const int kh = k0 + hf * 32;
              if (kh <= q0 + 31) {
                f32x4 sacc[2][2];
#pragma unroll
                for (int kb = 0; kb < 2; ++kb) { sacc[kb][0] = zero4(); sacc[kb][1] = zero4(); }
#pragma unroll
                for (int c2 = 0; c2 < NC; ++c2)
#pragma unroll
                    for (int kb = 0; kb < 2; ++kb) { const bf16x8 kf = *(const bf16x8*)(kb_ + (hf * 32 + kb * 16 + lr) * KRS + c2 * 64 + g * 16);
                        sacc[kb][0] = mfma16(kf, qf[0][c2], sacc[kb][0]); sacc[kb][1] = mfma16(kf, qf[1][c2], sacc[kb][1]); }
                if (MODE == 0) {
                    const int jblk = t >> 2; const bool far = (kh + 31 + 127 <= q0);
                    if (far) { const float bfar = lut[127];
#pragma unroll
                        for (int qb = 0; qb < 2; ++qb) { const bool al = (jblk < qblk) ? (((sel[qb] >> jblk) & 1u) != 0u) : true;
#pragma unroll
                            for (int kb = 0; kb < 2; ++kb)
#pragma unroll
                                for (int r = 0; r < 4; ++r) sacc[kb][qb][r] = al ? sacc[kb][qb][r] + bfar : NEGV; }
                    } else {
#pragma unroll
                        for (int qb = 0; qb < 2; ++qb) { const int qpos = q0 + qb * 16 + lr; const bool alp = (sel[qb] >> jblk) & 1u;
#pragma unroll
                            for (int kb = 0; kb < 2; ++kb)
#pragma unroll
                                for (int r = 0; r < 4; ++r) { const int d = qpos - (kh + kb * 16 + g * 4 + r); const int di = d < 0 ? 0 : (d > 127 ? 127 : d);
                                    const bool al = (jblk < qblk) ? alp : (d >= 0); sacc[kb][qb][r] = al ? sacc[kb][qb][r] + lut[di] : NEGV; } }
                    }
                } else {
                    if (kh + 31 > q0) {
#pragma unroll
                        for (int qb = 0; qb < 2; ++qb) { const int qpos = q0 + qb * 16 + lr;
#pragma unroll
                            for (int kb = 0; kb < 2; ++kb)
#pragma unroll
                                for (int r = 0; r < 4; ++r) if (kh + kb * 16 + g * 4 + r > qpos) sacc[kb][qb][r] = NEGV; }
                    }
                }
                bf16x8 pf[2];
#pragma unroll
                for (int qb = 0; qb < 2; ++qb) {
                    float mx = NEGV;
#pragma unroll
                    for (int kb = 0; kb < 2; ++kb)
#pragma unroll
                        for (int r = 0; r < 4; ++r) mx = fmaxf(mx, sacc[kb][qb][r]);
                    float mnew = mrow[qb];
                    if (__builtin_amdgcn_ballot_w64(mx > mrow[qb] + 8.0f) != 0ull) {
                        mx = fmaxf(mx, shx(mx, 16, lane)); mx = fmaxf(mx, shx(mx, 32, lane));
                        mnew = fmaxf(mrow[qb], mx); const float alpha = fexp2(mrow[qb] - mnew); mrow[qb] = mnew; lrow[qb] *= alpha;
#pragma unroll
                        for (int i = 0; i < 8; ++i) oacc[i][qb] = oacc[i][qb] * alpha;
                    }
                    float ps = 0.f;
#pragma unroll
                    for (int kb = 0; kb < 2; ++kb)
#pragma unroll
                        for (int r = 0; r < 4; ++r) { const float e = fexp2(sacc[kb][qb][r] - mnew); sacc[kb][qb][r] = e; ps += e; }
                    lrow[qb] += ps;
                    union { u32x4 u; bf16x8 v; } cvt;
                    cvt.u.x = cvt_pk_bf16(sacc[0][qb][0], sacc[0][qb][1]); cvt.u.y = cvt_pk_bf16(sacc[0][qb][2], sacc[0][qb][3]);
                    cvt.u.z = cvt_pk_bf16(sacc[1][qb][0], sacc[1][qb][1]); cvt.u.w = cvt_pk_bf16(sacc[1][qb][2], sacc[1][qb][3]); pf[qb] = cvt.v;
                }
#pragma unroll
                for (int dvb = 0; dvb < 8; ++dvb) { union { u32x2 u[2]; bf16x8 v; } vf; const unsigned char* vp = vb_ + (dvb * 16 + lr) * VRS + (hf * 32 + g * 4) * 2;
                    vf.u[0] = *(const u32x2*)vp; vf.u[1] = *(const u32x2*)(vp + 32);
                    oacc[dvb][0] = mfma16(vf.v, pf[0], oacc[dvb][0]); oacc[dvb][1] = mfma16(vf.v, pf[1], oacc[dvb][1]); }
              }
            }
            __syncthreads();
        }
#pragma unroll
        for (int qb = 0; qb < 2; ++qb) {
            float l = lrow[qb]; l += shx(l, 16, lane); l += shx(l, 32, lane); const float inv = 1.0f / l;
            bf16_t* zr = Zp + (tq + qb * 16 + lr) * 1024 + h * 128 + g * 4;
#pragma unroll
            for (int dvb = 0; dvb < 8; ++dvb) { const u32x2 zw = *(const u32x2*)(zr + dvb * 16); const f32x4 o = oacc[dvb][qb] * inv; u32x2 ow;
                ow.x = cvt_pk_bf16(o[0] * bflo(zw.x), o[1] * bfhi(zw.x)); ow.y = cvt_pk_bf16(o[2] * bflo(zw.y), o[3] * bfhi(zw.y)); *(u32x2*)(zr + dvb * 16) = ow; }
        }
#undef ATT_LOADK
#undef ATT_LOADV
#undef ATT_STOREK
#undef ATT_STOREV
    }
}

__device__ __forceinline__ void mlstm_a(unsigned char* lds, const Params& p, int l, const int g_wv) {
    constexpr int K2RS = 272, TRS = 160; constexpr int OFF_K2 = 0, OFF_WKT = 64 * K2RS, OFF_VT = OFF_WKT + 128 * TRS, OFF_WG = OFF_VT + 256 * TRS;
    unsigned char* ws = p.ws; int tid = TIDX; asm volatile("" : "+v"(tid)); const int lane = tid & 63, w = tid >> 6, lr = lane & 15, g = lane >> 4;
    const bf16_t* QB = (const bf16_t*)(ws + WS_QB); const bf16_t* KB = (const bf16_t*)(ws + WS_KB); const bf16_t* VB = (const bf16_t*)(ws + WS_VB);
    bf16_t* Q2 = (bf16_t*)(ws + WS_Q2); bf16_t* K2 = (bf16_t*)(ws + WS_K2); const float* gates = (const float*)(ws + WS_GATES);
    const float* cw = p.conv_w + (size_t)l * 4 * 1024; const float* cb = p.conv_b + (size_t)l * 1024;
    float* wg = (float*)(lds + OFF_WG);
    for (int ku = 0; ; ++ku) { int u; { const int cb_ = blockIdx.x; if (gridDim.x == 256) { if (ku >= (cb_ < 128 ? 3 : 5)) break; u = cb_ < 128 ? cb_ + 128 * ku : 384 + (cb_ - 128) + 128 * ku; } else { u = cb_ + ku * (int)gridDim.x; if (u >= 1024) break; } }
        const int bh = u >> 6, c = u & 63, b = bh >> 2, h = bh & 3; const size_t t0 = (size_t)b * SEQ + c * 64;
#pragma unroll 1
        for (int it = 0; it < 4; ++it) {
            const int item = tid + NTHR * it, which = item >> 10, s = (item >> 4) & 63, grp = item & 15; const int ch0 = h * 128 + grp * 8, cc0 = which * 512 + ch0;
            const bf16_t* src = which ? KB : QB; float a[8];
            { const f32x4 b0 = *(const f32x4*)(cb + cc0), b1 = *(const f32x4*)(cb + cc0 + 4); a[0] = b0[0]; a[1] = b0[1]; a[2] = b0[2]; a[3] = b0[3]; a[4] = b1[0]; a[5] = b1[1]; a[6] = b1[2]; a[7] = b1[3]; }
#pragma unroll
            for (int j = 0; j < 4; ++j) { const int tp = c * 64 + s - 3 + j;
                if (tp >= 0) { const u32x4 xw = *(const u32x4*)(src + ((size_t)b * SEQ + tp) * 512 + ch0); const f32x4 w0 = *(const f32x4*)(cw + j * 1024 + cc0), w1 = *(const f32x4*)(cw + j * 1024 + cc0 + 4);
                    a[0] += bflo(xw.x) * w0[0]; a[1] += bfhi(xw.x) * w0[1]; a[2] += bflo(xw.y) * w0[2]; a[3] += bfhi(xw.y) * w0[3];
                    a[4] += bflo(xw.z) * w1[0]; a[5] += bfhi(xw.z) * w1[1]; a[6] += bflo(xw.w) * w1[2]; a[7] += bfhi(xw.w) * w1[3]; } }
            const float ksc = which ? 0.08838834764831845f : 1.0f;
#pragma unroll
            for (int i = 0; i < 8; ++i) a[i] = fsilu(a[i]) * ksc;
            u32x4 ow; ow.x = cvt_pk_bf16(a[0], a[1]); ow.y = cvt_pk_bf16(a[2], a[3]); ow.z = cvt_pk_bf16(a[4], a[5]); ow.w = cvt_pk_bf16(a[6], a[7]);
            *(u32x4*)((which ? K2 : Q2) + (t0 + s) * 512 + ch0) = ow;
            if (which) *(u32x4*)(lds + OFF_K2 + s * K2RS + grp * 16) = ow;
        }
        if (w == 0) {
            const float fpre = gates[(t0 + lane) * 8 + 4 + h] + p.f_bias[l * 4 + h]; const float li = gates[(t0 + lane) * 8 + h] + p.i_bias[l * 4 + h];
            const float lf = fminf(fpre, 0.f) - log1pf(__expf(-fabsf(fpre)));
            float bc = lf;
#pragma unroll
            for (int o = 1; o < 64; o <<= 1) { const float v = shup(bc, o, lane); if (lane >= o) bc += v; }
            const float blast = __int_as_float(__builtin_amdgcn_readlane(__float_as_int(bc), 63)); const float gg = blast - bc + li; float gm = gg;
#pragma unroll
            for (int o = 1; o < 64; o <<= 1) gm = fmaxf(gm, shx(gm, o, lane));
            wg[lane] = __expf(gg - gm);
            ((float*)(ws + WS_BV))[(size_t)u * 64 + lane] = bc; ((float*)(ws + WS_LIV))[(size_t)u * 64 + lane] = li;
            if (lane == 0) { ((float*)(ws + WS_BLAST))[u] = blast; ((float*)(ws + WS_GMAX))[u] = gm; }
        }
#pragma unroll
        for (int it = 0; it < 4; ++it) { const int item = tid + NTHR * it, s = item & 63, eg = item >> 6; const u32x4 vw = *(const u32x4*)(VB + (t0 + s) * 1024 + h * 256 + eg * 8);
            bf16_t* d = (bf16_t*)(lds + OFF_VT + (eg * 8) * TRS + s * 2); const unsigned vv[4] = {vw.x, vw.y, vw.z, vw.w};
#pragma unroll
            for (int i = 0; i < 4; ++i) { *(bf16_t*)((unsigned char*)d + (2 * i) * TRS) = (bf16_t)(vv[i] & 0xffffu); *(bf16_t*)((unsigned char*)d + (2 * i + 1) * TRS) = (bf16_t)(vv[i] >> 16); } }
        __syncthreads();
#pragma unroll 1
        for (int it = 0; it < 2; ++it) { const int item = tid + NTHR * it, s = item & 63, dg = item >> 6; const u32x4 kw = *(const u32x4*)(lds + OFF_K2 + s * K2RS + dg * 16); const float ww = wg[s];
            const unsigned kv[4] = {kw.x, kw.y, kw.z, kw.w}; unsigned char* d = lds + OFF_WKT + (dg * 8) * TRS + s * 2;
#pragma unroll
            for (int i = 0; i < 4; ++i) { *(bf16_t*)(d + (2 * i) * TRS) = f2bf(bflo(kv[i]) * ww); *(bf16_t*)(d + (2 * i + 1) * TRS) = f2bf(bfhi(kv[i]) * ww); } }
        __syncthreads();
#if defined(MK_DEBUG_HASH)
        { unsigned char* dbg = ws + WS_END + MiB + (size_t)u * 40960; for (int i = tid; i < 2560; i += NTHR) *(u32x4*)(dbg + i * 16) = *(const u32x4*)(lds + OFF_VT + i * 16); }
#endif
        if (tid < 128) { float a = 0.f; const unsigned char* r = lds + OFF_WKT + tid * TRS;
#pragma unroll
            for (int i = 0; i < 8; ++i) { const u32x4 x = *(const u32x4*)(r + i * 16); a += (bflo(x.x) + bfhi(x.x)) + (bflo(x.y) + bfhi(x.y)) + (bflo(x.z) + bfhi(x.z)) + (bflo(x.w) + bfhi(x.w)); }
            ((float*)(ws + WS_NST))[(size_t)u * 128 + tid] = a; }
        f32x4 acc[8][2];
#pragma unroll
        for (int i = 0; i < 8; ++i) { acc[i][0] = zero4(); acc[i][1] = zero4(); }
#pragma unroll
        for (int kc = 0; kc < 2; ++kc) {
            const bf16x8 v0 = *(const bf16x8*)(lds + OFF_VT + (w * 32 + lr) * TRS + kc * 64 + g * 16), v1 = *(const bf16x8*)(lds + OFF_VT + (w * 32 + 16 + lr) * TRS + kc * 64 + g * 16);
#pragma unroll
            for (int db = 0; db < 8; ++db) { const bf16x8 kf = *(const bf16x8*)(lds + OFF_WKT + (db * 16 + lr) * TRS + kc * 64 + g * 16); acc[db][0] = mfma16(kf, v0, acc[db][0]); acc[db][1] = mfma16(kf, v1, acc[db][1]); }
        }
        bf16_t* cst = (bf16_t*)(ws + WS_CST) + (size_t)u * 32768; float one = 1.0f; asm volatile("" : "+v"(one));
#pragma unroll
        for (int eb = 0; eb < 2; ++eb)
#pragma unroll
            for (int db = 0; db < 8; ++db) { const f32x4 av = acc[db][eb] * one; u32x2 o; o.x = cvt_pk_bf16(av[0], av[1]); o.y = cvt_pk_bf16(av[2], av[3]); *(u32x2*)(cst + (size_t)(w * 32 + eb * 16 + lr) * 128 + db * 16 + g * 4) = o; }
        __syncthreads();
    }
}
__device__ __forceinline__ void mlstm_b(const Params& p, const int g_wv) {
    unsigned char* ws = p.ws; int tid = TIDX; asm volatile("" : "+v"(tid)); const float* blast = (const float*)(ws + WS_BLAST); const float* gmax = (const float*)(ws + WS_GMAX);
    for (int u = blockIdx.x; u < 256; u += gridDim.x) {
        const int bh = u >> 4, eb = u & 15; bf16_t* base = (bf16_t*)(ws + WS_CST) + (size_t)bh * 64 * 32768 + eb * 2048 + tid * 4;
        float* nb = (float*)(ws + WS_NST) + (size_t)bh * 64 * 128 + tid; const bool don = (eb == 0 && tid < 128);
        float m = 0.f, c0 = 0.f, c1 = 0.f, c2 = 0.f, c3 = 0.f, nn = 0.f;
#pragma unroll 16
        for (int c = 0; c < 64; ++c) {
            const float bl = blast[bh * 64 + c], gm = gmax[bh * 64 + c]; const float mn = fmaxf(bl + m, gm); const float dec = __expf(bl + m - mn), inw = __expf(gm - mn);
            u32x2* sp = (u32x2*)(base + (size_t)c * 32768); const u32x2 uw = *sp; u32x2 o; o.x = cvt_pk_bf16(c0, c1); o.y = cvt_pk_bf16(c2, c3); *sp = o;
            c0 = dec * c0 + inw * bflo(uw.x); c1 = dec * c1 + inw * bfhi(uw.x); c2 = dec * c2 + inw * bflo(uw.y); c3 = dec * c3 + inw * bfhi(uw.y);
            if (don) { const float nu = nb[c * 128]; nb[c * 128] = nn; nn = dec * nn + inw * nu; }
            if (eb == 0 && tid == 0) ((float*)(ws + WS_MST))[bh * 64 + c] = m;
            m = mn;
        }
        asm volatile("s_waitcnt vmcnt(0)" ::: "memory"); __syncthreads();
        if (tid == 0) { __builtin_amdgcn_fence(__ATOMIC_RELEASE, "agent"); asm volatile("s_waitcnt vmcnt(0)" ::: "memory");
            __hip_atomic_fetch_add((unsigned*)(ws + WS_CTR) + 16 + bh, 1u, __ATOMIC_RELAXED, __HIP_MEMORY_SCOPE_AGENT); }
    }
}
__device__ __forceinline__ void mlstm_c(unsigned char* lds, const Params& p, int l, const int g_wv) {
    constexpr int QRS = 288, TRS = 160; constexpr int OFF_Q = 0, OFF_K = 64 * QRS, OFF_VT = 2 * 64 * QRS, OFF_P = OFF_VT + 256 * TRS, OFF_F = OFF_P + 64 * TRS;
    unsigned char* ws = p.ws; int tid = TIDX; asm volatile("" : "+v"(tid)); const int lane = tid & 63, w = tid >> 6, lr = lane & 15, g = lane >> 4;
    const bf16_t* Q2 = (const bf16_t*)(ws + WS_Q2); const bf16_t* K2 = (const bf16_t*)(ws + WS_K2); const bf16_t* VB = (const bf16_t*)(ws + WS_VB);
    const bf16_t* OB = (const bf16_t*)(ws + WS_OB); bf16_t* ZB = (bf16_t*)(ws + WS_Z + 32 * MiB); const float* gn = p.out_norm + (size_t)l * 1024;
    float* fb = (float*)(lds + OFF_F); float* bvec = fb; float* livec = fb + 64; float* mt = fb + 128; float* wint = fb + 192; float* denV = fb + 256; float* denC = fb + 320; float* lsum = fb + 384; float* lsq = fb + 448; float* nvec = fb + 512;
    for (int u = blockIdx.x; u < 1024; u += gridDim.x) {
        const int bh = u >> 6, c = u & 63, b = bh >> 2, h = bh & 3; const size_t t0 = (size_t)b * SEQ + c * 64;
        if (tid == 0) { const unsigned want = 16u * (unsigned)(l + 1); while (__hip_atomic_load((unsigned*)(ws + WS_CTR) + 16 + bh, __ATOMIC_RELAXED, __HIP_MEMORY_SCOPE_AGENT) < want) __builtin_amdgcn_s_sleep(1);
            __builtin_amdgcn_fence(__ATOMIC_ACQUIRE, "agent"); asm volatile("s_waitcnt vmcnt(0)" ::: "memory"); }
        __syncthreads();
        const float mc = ((const float*)(ws + WS_MST))[u];
#pragma unroll
        for (int it = 0; it < 2; ++it) { const int id = tid + NTHR * it, s = id >> 4, ch = id & 15;
            *(u32x4*)(lds + OFF_Q + s * QRS + ch * 16) = *(const u32x4*)(Q2 + (t0 + s) * 512 + h * 128 + ch * 8); *(u32x4*)(lds + OFF_K + s * QRS + ch * 16) = *(const u32x4*)(K2 + (t0 + s) * 512 + h * 128 + ch * 8); }
#pragma unroll 2
        for (int it = 0; it < 4; ++it) { const int item = tid + NTHR * it, s = item & 63, eg = item >> 6; const u32x4 vw = *(const u32x4*)(VB + (t0 + s) * 1024 + h * 256 + eg * 8);
            unsigned char* d = lds + OFF_VT + (eg * 8) * TRS + s * 2; const unsigned vv[4] = {vw.x, vw.y, vw.z, vw.w};
#pragma unroll
            for (int i = 0; i < 4; ++i) { *(bf16_t*)(d + (2 * i) * TRS) = (bf16_t)(vv[i] & 0xffffu); *(bf16_t*)(d + (2 * i + 1) * TRS) = (bf16_t)(vv[i] >> 16); } }
        if (tid < 64) { bvec[tid] = ((const float*)(ws + WS_BV))[(size_t)u * 64 + tid]; livec[tid] = ((const float*)(ws + WS_LIV))[(size_t)u * 64 + tid]; lsum[tid] = 0.f; lsq[tid] = 0.f; }
        else if (tid < 192) nvec[tid - 64] = ((const float*)(ws + WS_NST))[(size_t)u * 128 + tid - 64];
        __syncthreads();
        if (w == 0) { float x = livec[lane] - bvec[lane];
#pragma unroll
            for (int o = 1; o < 64; o <<= 1) { const float v = shup(x, o, lane); if (lane >= o) x = fmaxf(x, v); }
            const float mtl = bvec[lane] + fmaxf(mc, x); mt[lane] = mtl; wint[lane] = __expf(bvec[lane] + mc - mtl); }
        __syncthreads();
        { const int lb = w >> 1;
#pragma unroll
          for (int si = 0; si < 2; ++si) { const int sb = (w & 1) * 2 + si; f32x4 a = zero4();
            if (sb <= lb) {
#pragma unroll
                for (int kc = 0; kc < 4; ++kc) { const bf16x8 qf = *(const bf16x8*)(lds + OFF_Q + (lb * 16 + lr) * QRS + kc * 64 + g * 16), kf = *(const bf16x8*)(lds + OFF_K + (sb * 16 + lr) * QRS + kc * 64 + g * 16); a = mfma16(qf, kf, a); }
            }
            const int s = sb * 16 + lr; const float bs = bvec[s] - livec[s];
#pragma unroll
            for (int r = 0; r < 4; ++r) { const int ll = lb * 16 + g * 4 + r; float v = 0.f; if (s <= ll) v = a[r] * __expf(bvec[ll] - bs - mt[ll]); *(bf16_t*)(lds + OFF_P + ll * TRS + s * 2) = f2bf(v); } } }
        __syncthreads();
        if (w == 0) { float a = 0.f; const unsigned char* r = lds + OFF_P + lane * TRS;
#pragma unroll
            for (int i = 0; i < 8; ++i) { const u32x4 x = *(const u32x4*)(r + i * 16); a += (bflo(x.x) + bfhi(x.x)) + (bflo(x.y) + bfhi(x.y)) + (bflo(x.z) + bfhi(x.z)) + (bflo(x.w) + bfhi(x.w)); }
            denV[lane] = a; }
        else if (w == 1) { float a = 0.f; const unsigned char* r = lds + OFF_Q + lane * QRS;
#pragma unroll
            for (int i = 0; i < 16; ++i) { const u32x4 x = *(const u32x4*)(r + i * 16); const float* nv = nvec + i * 8;
                a += bflo(x.x) * nv[0] + bfhi(x.x) * nv[1] + bflo(x.y) * nv[2] + bfhi(x.y) * nv[3] + bflo(x.z) * nv[4] + bfhi(x.z) * nv[5] + bflo(x.w) * nv[6] + bfhi(x.w) * nv[7]; }
            denC[lane] = a; }
        f32x4 accV[2][4], accC[2][4];
#pragma unroll
        for (int i = 0; i < 2; ++i)
#pragma unroll
            for (int j = 0; j < 4; ++j) { accV[i][j] = zero4(); accC[i][j] = zero4(); }
        const bf16_t* cst = (const bf16_t*)(ws + WS_CST) + (size_t)u * 32768;
#pragma unroll
        for (int kp = 0; kp < 2; ++kp) {
        bf16x8 ctf[2][2];
#pragma unroll
        for (int k2 = 0; k2 < 2; ++k2) { const int kc = kp * 2 + k2; ctf[k2][0] = *(const bf16x8*)(cst + (size_t)(w * 32 + lr) * 128 + kc * 32 + g * 8); ctf[k2][1] = *(const bf16x8*)(cst + (size_t)(w * 32 + 16 + lr) * 128 + kc * 32 + g * 8); }
#pragma unroll
        for (int k2 = 0; k2 < 2; ++k2) { const int kc = kp * 2 + k2;
            const bf16x8 c0 = ctf[k2][0], c1 = ctf[k2][1];
#pragma unroll
            for (int lb = 0; lb < 4; ++lb) { const bf16x8 qf = *(const bf16x8*)(lds + OFF_Q + (lb * 16 + lr) * QRS + kc * 64 + g * 16); accC[0][lb] = mfma16(c0, qf, accC[0][lb]); accC[1][lb] = mfma16(c1, qf, accC[1][lb]); }
        }
        }
#pragma unroll
        for (int kc = 0; kc < 2; ++kc) {
            const bf16x8 v0 = *(const bf16x8*)(lds + OFF_VT + (w * 32 + lr) * TRS + kc * 64 + g * 16), v1 = *(const bf16x8*)(lds + OFF_VT + (w * 32 + 16 + lr) * TRS + kc * 64 + g * 16);
#pragma unroll
            for (int lb = 0; lb < 4; ++lb) { const bf16x8 pf = *(const bf16x8*)(lds + OFF_P + (lb * 16 + lr) * TRS + kc * 64 + g * 16); accV[0][lb] = mfma16(v0, pf, accV[0][lb]); accV[1][lb] = mfma16(v1, pf, accV[1][lb]); }
        }
        __syncthreads();
#pragma unroll
        for (int lb = 0; lb < 4; ++lb) { const int ll = lb * 16 + lr; const float wi = wint[ll]; const float den = wi * denC[ll] + denV[ll]; const float dn = 1.0f / fmaxf(fabsf(den), __expf(-mt[ll])); float s1 = 0.f, s2 = 0.f;
#pragma unroll
            for (int eb = 0; eb < 2; ++eb) { const f32x4 hv = (accC[eb][lb] * wi + accV[eb][lb]) * dn; accV[eb][lb] = hv; s1 += (hv[0] + hv[1]) + (hv[2] + hv[3]); s2 += (hv[0] * hv[0] + hv[1] * hv[1]) + (hv[2] * hv[2] + hv[3] * hv[3]); }
            s1 += shx(s1, 16, lane); s1 += shx(s1, 32, lane); s2 += shx(s2, 16, lane); s2 += shx(s2, 32, lane);
            if (g == 0) { fb[640 + w * 64 + ll] = s1; fb[1152 + w * 64 + ll] = s2; } }
        __syncthreads();
#pragma unroll
        for (int lb = 0; lb < 4; ++lb) { const int ll = lb * 16 + lr; float t1 = 0.f, t2 = 0.f;
#pragma unroll
            for (int ww = 0; ww < 8; ++ww) { t1 += fb[640 + ww * 64 + ll]; t2 += fb[1152 + ww * 64 + ll]; }
            const float mu = t1 * (1.0f / 256.0f); const float var = fmaxf(t2 * (1.0f / 256.0f) - mu * mu, 0.f); const float rstd = rsqrtf(var + EPS);
#pragma unroll
            for (int eb = 0; eb < 2; ++eb) { const int e = w * 32 + eb * 16 + g * 4; const size_t off = (t0 + ll) * 1024 + h * 256 + e; const f32x4 gv = *(const f32x4*)(gn + h * 256 + e);
                const u32x2 ow = *(const u32x2*)(OB + off), zw = *(const u32x2*)(ZB + off); const f32x4 hv = accV[eb][lb]; u32x2 o;
                o.x = cvt_pk_bf16((hv[0] - mu) * rstd * gv[0] * bflo(ow.x) * bflo(zw.x), (hv[1] - mu) * rstd * gv[1] * bfhi(ow.x) * bfhi(zw.x));
                o.y = cvt_pk_bf16((hv[2] - mu) * rstd * gv[2] * bflo(ow.y) * bflo(zw.y), (hv[3] - mu) * rstd * gv[3] * bfhi(ow.y) * bfhi(zw.y)); *(u32x2*)(ZB + off) = o; } }
        __syncthreads();
    }
}

#ifndef PHM
#define PHM 4095
#endif
typedef const __attribute__((address_space(4))) Params* KParams;
#if defined(__HIP_DEVICE_COMPILE__)
__device__ __forceinline__ Params load_params() { KParams k = (KParams)__builtin_amdgcn_kernarg_segment_ptr(); asm volatile("" : "+s"(k)); return *k; }
#else
__device__ __forceinline__ Params load_params() { return Params{}; }
#endif
#define PP load_params()
#define GSYNC() do { asm volatile("s_waitcnt vmcnt(0) lgkmcnt(0)" ::: "memory"); __builtin_amdgcn_fence(__ATOMIC_RELEASE, "agent"); asm volatile("s_waitcnt vmcnt(0)" ::: "memory"); grid.sync(); \
    __builtin_amdgcn_fence(__ATOMIC_ACQUIRE, "agent"); asm volatile("s_waitcnt vmcnt(0) lgkmcnt(0)" ::: "memory"); } while (0)
__device__ __forceinline__ void gbar(unsigned* ctr, unsigned target, const int g_wv) {
    asm volatile("s_waitcnt vmcnt(0) lgkmcnt(0)" ::: "memory");
    __syncthreads();
    if (TIDX == 0) {
        __builtin_amdgcn_fence(__ATOMIC_RELEASE, "agent"); asm volatile("s_waitcnt vmcnt(0)" ::: "memory");
        __hip_atomic_fetch_add(ctr, 1u, __ATOMIC_RELAXED, __HIP_MEMORY_SCOPE_AGENT);
        while (__hip_atomic_load(ctr, __ATOMIC_RELAXED, __HIP_MEMORY_SCOPE_AGENT) < target) __builtin_amdgcn_s_sleep(1);
        __builtin_amdgcn_fence(__ATOMIC_ACQUIRE, "agent"); asm volatile("s_waitcnt vmcnt(0)" ::: "memory");
    }
    __syncthreads();
}
template <bool AL = true, bool SP = true, class Epi, class Sched> __device__ __forceinline__ void run_gemm(unsigned char* lds, const bf16_t* A, const bf16_t* Bt, int M, int N, int K, int lda, int ldb, const Sched& S, const Epi& E, const int g_wv) {
    pg8::Gemm g{A, Bt, M, N, K, lda, ldb};
    pg8::gemm_phase<Epi, Sched, AL, SP>((PG8_LAS unsigned char*)lds, g, S, E, g_wv);
    __syncthreads();
}

__global__ void __launch_bounds__(NTHR, 2) mega(Params p_arg) {
    extern __shared__ __attribute__((aligned(16))) unsigned char lds[];
    cg::grid_group grid = cg::this_grid();
    const int g_wv = __builtin_amdgcn_readfirstlane((int)(__builtin_amdgcn_workitem_id_x() >> 6));
    const int G = gridDim.x, cb = blockIdx.x; const int w_lo = p_arg.w_lo, w_hi = p_arg.w_hi;
#define WIN(k_) (w_lo <= (k_) && (k_) < w_hi)
    unsigned nbar = 0;
#define SEAM(k_) do { if (WIN(k_) && WIN((k_) + 1)) { ++nbar; gbar((unsigned*)(PP.ws + WS_CTR), nbar * (unsigned)G, g_wv); } } while (0)
    if (w_lo > 1000) GSYNC();
    if (WIN(0)) {
#if PHM & 1
    convert_weights(lds, PP, 0, g_wv); convert_weights(lds, PP, 1, g_wv);
#endif
#if PHM & 2
    build_cs(PP, g_wv);
    { const Params p = PP; rmsnorm_rows<true>(p.x, p.norm_gain, (bf16_t*)(p.ws + WS_H), nullptr, g_wv); }
#endif
    }
    SEAM(0);
#pragma unroll 1
    for (int l = 0; l < 2; ++l) {
        const int wb = 1 + 7 * l;
        if (WIN(wb)) {
#if PHM & 4
        { unsigned char* ws = PP.ws; unsigned char* wl = ws + WS_W0 + (size_t)l * WL_SIZE; const f32x2* cs = (const f32x2*)(ws + WS_CS); (void)cs; (void)wl; pg8::StaticOrder S; S.init(T, 15360, G, cb); EpiIn E{ws}; run_gemm(lds, (const bf16_t*)(ws + WS_H), (const bf16_t*)(wl + WL_WIN), T, 15360, DM, DM, DM, S, E, g_wv); }
        { unsigned char* ws = PP.ws; unsigned char* wl = ws + WS_W0 + (size_t)l * WL_SIZE; const f32x2* cs = (const f32x2*)(ws + WS_CS); (void)cs; (void)wl; pg8::StaticOrder S; S.init(1024, T, G, cb); EpiVT E{(bf16_t*)(ws + WS_VAT), T, nullptr, 0.f}; run_gemm(lds, (const bf16_t*)(wl + WL_WIN) + (size_t)15360 * DM, (const bf16_t*)(ws + WS_H), 1024, T, DM, DM, DM, S, E, g_wv); }
#endif
        }
        SEAM(wb);
        if (WIN(wb + 1)) {
#if PHM & 32
        mlstm_a(lds, PP, l, g_wv);
#endif
#if PHM & 16
        kmean_phase(PP, l, g_wv);
#endif
#if PHM & 8
        { unsigned char* ws = PP.ws; unsigned char* wl = ws + WS_W0 + (size_t)l * WL_SIZE; const f32x2* cs = (const f32x2*)(ws + WS_CS); (void)cs; (void)wl; pg8::StaticOrder S; S.init(T, 1536, G, cb); EpiRow<true> E{(bf16_t*)(ws + WS_QC), 1536, (const float*)(ws + WS_SSP), 1.0f / 512.0f, CC_SCALE, cs}; run_gemm(lds, (const bf16_t*)(ws + WS_CQ), (const bf16_t*)(wl + WL_WUQ), T, 1536, 512, 512, 512, S, E, g_wv); }
        { unsigned char* ws = PP.ws; unsigned char* wl = ws + WS_W0 + (size_t)l * WL_SIZE; const f32x2* cs = (const f32x2*)(ws + WS_CS); (void)cs; (void)wl; pg8::StaticOrder S; S.init(T, 1024, G, cb); EpiRow<false> E{(bf16_t*)(ws + WS_KNC), 1024, (const float*)(ws + WS_SSP), 1.0f / 256.0f, 1.0f, cs}; run_gemm(lds, (const bf16_t*)(ws + WS_CKV), (const bf16_t*)(wl + WL_WKN), T, 1024, 256, 256, 256, S, E, g_wv); }
        { unsigned char* ws = PP.ws; unsigned char* wl = ws + WS_W0 + (size_t)l * WL_SIZE; const f32x2* cs = (const f32x2*)(ws + WS_CS); (void)cs; (void)wl; pg8::StaticOrder S; S.init(1024, T, G, cb); EpiVT E{(bf16_t*)(ws + WS_VCT), T, (const float*)(ws + WS_SSP), 1.0f / 256.0f}; run_gemm(lds, (const bf16_t*)(wl + WL_WV), (const bf16_t*)(ws + WS_CKV), 1024, T, 256, 256, 256, S, E, g_wv); }
#endif
        }
        SEAM(wb + 1);
        if (WIN(wb + 2)) {
#if PHM & 128
        mlstm_b(PP, g_wv);
#endif
#if PHM & 64
        attn_phase<0>(lds, PP, l, g_wv);
#endif
        }
        if (WIN(wb + 3)) {
#if PHM & 256
        attn_phase<1>(lds, PP, l, g_wv);
#endif
#if PHM & 512
        mlstm_c(lds, PP, l, g_wv);
#endif
        }
        SEAM(wb + 3);
        if (WIN(wb + 4)) {
#if PHM & 1024
        { unsigned char* ws = PP.ws; unsigned char* wl = ws + WS_W0 + (size_t)l * WL_SIZE; MergeOrder S{G, cb}; EpiMerge E{(bf16_t*)(ws + WS_H), (const bf16_t*)(ws + WS_GT)}; run_gemm(lds, (const bf16_t*)(ws + WS_Z), (const bf16_t*)(wl + WL_WB), 3 * T, 2048, 1024, 1024, 1024, S, E, g_wv); }
#endif
        }
        SEAM(wb + 4);
        if (WIN(wb + 5)) {
#if PHM & 2048
        { unsigned char* ws = PP.ws; unsigned char* wl = ws + WS_W0 + (size_t)l * WL_SIZE; const f32x2* cs = (const f32x2*)(ws + WS_CS); (void)cs; (void)wl; pg8::StaticOrder S; S.init(T, DM, G, cb); const Params p = PP; EpiOut E{l == 0 ? p.x : p.out, p.out}; run_gemm(lds, (const bf16_t*)(ws + WS_H), (const bf16_t*)(wl + WL_WO), T, DM, DM, DM, DM, S, E, g_wv); }
#endif
        }
        SEAM(wb + 5);
        if (WIN(wb + 6)) {
            if (l == 0) { const Params p = PP; rmsnorm_rows<true>(p.out, p.norm_gain + DM, (bf16_t*)(p.ws + WS_H), nullptr, g_wv); }
            else { const Params p = PP; rmsnorm_rows<false>(p.out, p.final_norm, nullptr, p.out, g_wv); }
        }
        if (l == 0) SEAM(wb + 6);
    }
}


#if defined(MK_DEBUG_HASH)
__global__ void hash_buf(const unsigned* p, size_t nwords, unsigned long long* acc) {
    unsigned long long s = 0; const size_t stride = (size_t)gridDim.x * blockDim.x;
    for (size_t i = (size_t)blockIdx.x * blockDim.x + threadIdx.x; i < nwords; i += stride) s += (unsigned long long)p[i] * (unsigned long long)(((unsigned)i * 2654435761u) | 1u);
    atomicAdd(acc, s);
}
__global__ void dbg_final(float* out, size_t n, const unsigned long long* h, int R, int NK) {
    __shared__ float flag;
    if (threadIdx.x == 0) { float f = 1.0f; for (int k = NK - 1; k >= 0; --k) for (int r = 1; r < R; ++r) if (h[r * NK + k] != h[k]) { f = 100.0f; for (int q = 0; q < k; ++q) f *= 10.0f; } flag = f; }
    __syncthreads();
    for (size_t i = (size_t)blockIdx.x * blockDim.x + threadIdx.x; i < n; i += (size_t)gridDim.x * blockDim.x) out[i] = (i == 0) ? flag : 0.0f;
}
#endif
extern "C" void kernel_launch(void* const* d_in, const int* in_sizes, int n_in, void* d_out, int out_size, void* d_ws, size_t ws_size, hipStream_t stream) {
    static int grid = 0;
    if (grid == 0) {
        if (n_in != 16 || ws_size < WS_END) { fprintf(stderr, "kernel_launch: unexpected n_in %d or ws_size %zu < %zu\n", n_in, ws_size, (size_t)WS_END); grid = -1; return; }
        int dev = 0, cus = 0, per_cu = 0;
        hipGetDevice(&dev); hipDeviceGetAttribute(&cus, hipDeviceAttributeMultiprocessorCount, dev);
        if (hipFuncSetAttribute((const void*)mega, hipFuncAttributeMaxDynamicSharedMemorySize, LDS_BYTES) != hipSuccess) { fprintf(stderr, "kernel_launch: hipFuncSetAttribute failed\n"); grid = -1; return; }
        if (hipOccupancyMaxActiveBlocksPerMultiprocessor(&per_cu, (const void*)mega, NTHR, LDS_BYTES) != hipSuccess || per_cu < 1) { fprintf(stderr, "kernel_launch: occupancy query gave %d\n", per_cu); per_cu = 1; }
        (void)hipGetLastError();
        grid = cus * 1;
    }
    if (grid < 0) return;
    Params p{};
    p.x = (const float*)d_in[0]; p.norm_gain = (const float*)d_in[1]; p.w_in = (const float*)d_in[2]; p.t5 = (const float*)d_in[3]; p.conv_w = (const float*)d_in[4]; p.conv_b = (const float*)d_in[5];
    p.i_bias = (const float*)d_in[6]; p.f_bias = (const float*)d_in[7]; p.out_norm = (const float*)d_in[8]; p.q_norm = (const float*)d_in[9]; p.kv_norm = (const float*)d_in[10];
    p.w_uq = (const float*)d_in[11]; p.w_ukv = (const float*)d_in[12]; p.w_branch = (const float*)d_in[13]; p.w_out = (const float*)d_in[14]; p.final_norm = (const float*)d_in[15];
    p.out = (float*)d_out; p.ws = (unsigned char*)d_ws;
    (void)hipMemsetAsync((unsigned char*)d_ws + WS_CTR, 0, 256, stream);
    void* args[] = {&p};
#if defined(MK_DEBUG_HASH)
    {
        constexpr int R = 4, NK = 9; unsigned char* W = (unsigned char*)d_ws; unsigned long long* H = (unsigned long long*)(W + WS_END);
        hipMemsetAsync(H, 0, R * NK * 8, stream);
        struct HB { int win; size_t off; size_t bytes; };
        const HB hb[NK] = { {3, WS_Z, 32 * MiB}, {3, WS_CST, 64 * MiB}, {3, WS_NST, 524288}, {3, WS_MST, 4096},
                            {4, WS_Z + 64 * MiB, 32 * MiB}, {4, WS_Z + 32 * MiB, 32 * MiB}, {5, WS_H, 64 * MiB}, {6, WS_H, 64 * MiB}, {2, WS_CST, 64 * MiB} };
        for (int r = 0; r < R; ++r)
            for (int w = 0; w < 7; ++w) { p.w_lo = w; p.w_hi = w + 1;
                hipError_t e = hipLaunchCooperativeKernel((const void*)mega, dim3(grid), dim3(NTHR), args, LDS_BYTES, stream);
                if (e != hipSuccess) fprintf(stderr, "kernel_launch: cooperative launch failed: %s\n", hipGetErrorString(e));
                for (int k = 0; k < NK; ++k) if (hb[k].win == w) {
                    if (k == 7) hash_buf<<<256, 256, 0, stream>>>((const unsigned*)d_out, (size_t)T * DM, H + r * NK + k);
                    else hash_buf<<<256, 256, 0, stream>>>((const unsigned*)(W + hb[k].off), hb[k].bytes / 4, H + r * NK + k); } }
        dbg_final<<<256, 256, 0, stream>>>((float*)d_out, (size_t)T * DM, H, R, NK);
    }
    if (false) {
#elif defined(MK_MULTI)
    for (int w = 0; w < 15; ++w) { p.w_lo = w; p.w_hi = w + 1;
#else
    { p.w_lo = 0; p.w_hi = 15;
#endif
        hipError_t e = hipLaunchCooperativeKernel((const void*)mega, dim3(grid), dim3(NTHR), args, LDS_BYTES, stream);
        if (e != hipSuccess) fprintf(stderr, "kernel_launch: cooperative launch failed: %s (grid %d)\n", hipGetErrorString(e), grid);
    }
}
```

```cpp
#include <hip/hip_runtime.h>
#include <hip/hip_cooperative_groups.h>
#include <cstdio>
#include <cstdint>
namespace cg = cooperative_groups;
__device__ __forceinline__ int tidx_opaque(int g_wv) { int l; asm volatile("v_mbcnt_lo_u32_b32 %0, -1, 0\n\tv_mbcnt_hi_u32_b32 %0, -1, %0" : "=v"(l)); return g_wv * 64 + l; }
#define TIDX tidx_opaque(g_wv)
__device__ __forceinline__ float shx(float v, int o, int lane) { return __int_as_float(__builtin_amdgcn_ds_bpermute(((lane ^ o) & 63) << 2, __float_as_int(v))); }
__device__ __forceinline__ int shxi(int v, int o, int lane) { return __builtin_amdgcn_ds_bpermute(((lane ^ o) & 63) << 2, v); }
__device__ __forceinline__ float shup(float v, int o, int lane) { return __int_as_float(__builtin_amdgcn_ds_bpermute(((lane - o) & 63) << 2, __float_as_int(v))); }

namespace pg8 {
#define PG8_LAS __attribute__((address_space(3)))
typedef unsigned short bf16_t;
typedef short bf16x8 __attribute__((ext_vector_type(8)));
typedef float f32x4 __attribute__((ext_vector_type(4)));
typedef unsigned u32x4 __attribute__((ext_vector_type(4)));
constexpr int BM = 256, BK = 64, HALF = 128, HTB = HALF * BK * 2  , STAGE_BYTES = 8 * HTB, NXCD = 8, WGM = 8;

__host__ __device__ __forceinline__ int lds_byte(int r, int c) { const int st = (r >> 4) * 2 + (c >> 5), rr = r & 15, cc = c & 31, ob = rr * 64 + cc * 2; return st * 1024 + (ob ^ (((ob >> 9) & 1) << 5)); }
__host__ __device__ __forceinline__ void stage_rc(int b, int& R, int& C) { const int st = b / 1024, sb = b % 1024, swz = sb ^ (((sb >> 9) & 1) << 5); R = (st >> 1) * 16 + swz / 64; C = (st & 1) * 32 + (swz % 64) / 2; }
__host__ __device__ __forceinline__ int perm32(int rho) { const int n = rho >> 4, i = rho & 15; return 8 * (i >> 2) + 4 * n + (i & 3); }

struct Unit { int pm, pn, pb; };
struct Gemm { const bf16_t* A; const bf16_t* Bt; int M, N, K, lda, ldb; };

struct StaticOrder {
    int nM, nN, nwg, G, c;
    __host__ __device__ void init(int M, int N, int G_, int c_) { nM = M / BM; nN = N / BM; nwg = nM * nN; G = G_; c = c_; }
    __host__ __device__ bool next(int i, Unit& u) const {
        const long L = (long)i * G + c; if (L >= nwg) return false;
        int wgid = (int)L; { const int q = nwg / NXCD, r = nwg % NXCD, xcd = wgid % NXCD, off = wgid / NXCD; wgid = (xcd < r ? xcd * (q + 1) : r * (q + 1) + (xcd - r) * q) + off; }
        const int nig = WGM * nN, gid = wgid / nig, fm = gid * WGM, gsz = (nM - fm) < WGM ? (nM - fm) : WGM;
        u.pm = fm + ((wgid % nig) % gsz); u.pn = (wgid % nig) / gsz; u.pb = u.pn; return true;
    }
    __device__ __forceinline__ void a_ready(const Unit&) const {}
    __device__ __forceinline__ void done(const Unit&) const {}
};

__device__ __forceinline__ unsigned cvt_pk_bf16(float lo, float hi) { unsigned r; asm volatile("s_nop 1\n\tv_cvt_pk_bf16_f32 %0, %1, %2\n\ts_nop 1" : "=v"(r) : "v"(lo), "v"(hi)); return r; }
template <class Epi, class Sched, bool ALIGN_EPI = false, bool SP2 = false>
__device__ __forceinline__ void gemm_phase(PG8_LAS unsigned char* lds, const Gemm g, const Sched& S, const Epi& E, const int g_wv) {
    int tid = TIDX; asm volatile("" : "+v"(tid)); const int wid = __builtin_amdgcn_readfirstlane(tid >> 6), lane = tid & 63, wr = wid >> 2, wc = wid & 3, fr = lane & 15, fq = lane >> 4;
    const int K = g.K, nt = K / BK;
    unsigned voffA[2], voffB[2];
#pragma unroll
    for (int i = 0; i < 2; ++i) { int R, C; stage_rc(tid * 16 + i * 8192, R, C); const int Rb = Epi::PERM ? ((R & ~31) + perm32(R & 31)) : R;
        voffA[i] = (unsigned)(R * K + C) * 2u; voffB[i] = (unsigned)(Rb * K + C) * 2u; }
    const size_t kstep = (size_t)(BK * 2);
    const size_t hstepA = (size_t)HALF * K * 2; const size_t hstepB = hstepA;
    const size_t tstepA = 2 * hstepA; const size_t tstepB = tstepA;
    const unsigned ldsw = (unsigned)wid * 1024u;
    const int aoff = lds_byte(wr * 64 + fr, fq * 8), boff = lds_byte(wc * 32 + fr, fq * 8);
#define PG8_SA(b, h) (((b) * 2 + (h)) * HTB)
#define PG8_SB(b, h) ((4 + (b) * 2 + (h)) * HTB)
#define PG8_STAGE(bufoff, gbase, voff) do { _Pragma("unroll") for (int _i = 0; _i < 2; ++_i) \
        __builtin_amdgcn_global_load_lds((const unsigned*)((const char*)(gbase) + (voff)[_i]), (PG8_LAS unsigned*)(lds + (bufoff) + ldsw + _i * 8192), 16, 0, 0); } while (0)
#define PG8_LDA(dst, b, h) do { _Pragma("unroll") for (int m = 0; m < 4; ++m) _Pragma("unroll") for (int k = 0; k < 2; ++k) dst[m][k] = *(const PG8_LAS bf16x8*)(lds + PG8_SA(b, h) + aoff + m * 2048 + k * 1024); } while (0)
#define PG8_LDB(dst, b, h) do { _Pragma("unroll") for (int n = 0; n < 2; ++n) _Pragma("unroll") for (int k = 0; k < 2; ++k) dst[n][k] = *(const PG8_LAS bf16x8*)(lds + PG8_SB(b, h) + boff + n * 2048 + k * 1024); } while (0)
#define PG8_MMA(ai, bj, At, Bt) do { __builtin_amdgcn_s_setprio(1); _Pragma("unroll") for (int m = 0; m < 4; ++m) _Pragma("unroll") for (int n = 0; n < 2; ++n) _Pragma("unroll") for (int k = 0; k < 2; ++k) \
        acc[ai][bj][m][n] = __builtin_amdgcn_mfma_f32_16x16x32_bf16(Bt[n][k], At[m][k], acc[ai][bj][m][n], 0, 0, 0); __builtin_amdgcn_s_setprio(0); } while (0)
#define PG8_WAIT_V(n) asm volatile("s_waitcnt vmcnt(" #n ")" ::: "memory")
#define PG8_WAIT_L(n) asm volatile("s_waitcnt lgkmcnt(" #n ")" ::: "memory")
#define PG8_BAR __builtin_amdgcn_s_barrier()
#define PG8_SCHED __builtin_amdgcn_sched_barrier(0)
    Unit cur, nxt; int ui = 0;
    if (!S.next(0, cur)) return;
    f32x4 acc[2][2][4][2];
#pragma unroll
    for (int a = 0; a < 2; ++a)
#pragma unroll
        for (int b = 0; b < 2; ++b)
#pragma unroll
            for (int m = 0; m < 4; ++m)
#pragma unroll
                for (int n = 0; n < 2; ++n) acc[a][b][m][n] = (f32x4){0.f, 0.f, 0.f, 0.f};
    bf16x8 At[4][2], B0[2][2], B1[2][2];
    const char* cA = (const char*)g.A + (size_t)cur.pm * tstepA; const char* cB = (const char*)g.Bt + (size_t)cur.pb * tstepB;
    S.a_ready(cur);
    if constexpr (SP2) {
        PG8_STAGE(PG8_SB(0, 0), cB, voffB); PG8_STAGE(PG8_SB(0, 1), cB + hstepB, voffB); PG8_STAGE(PG8_SA(0, 0), cA, voffA); PG8_STAGE(PG8_SA(0, 1), cA + hstepA, voffA);
        if (wr == 1) PG8_BAR;
        PG8_WAIT_V(2); PG8_BAR;
        PG8_STAGE(PG8_SB(1, 0), cB + kstep, voffB); PG8_STAGE(PG8_SA(1, 0), cA + kstep, voffA); PG8_STAGE(PG8_SB(1, 1), cB + hstepB + kstep, voffB);
        PG8_WAIT_V(6); PG8_BAR;
    } else {
        PG8_STAGE(PG8_SB(0, 0), cB, voffB); PG8_STAGE(PG8_SA(0, 0), cA, voffA); PG8_STAGE(PG8_SB(0, 1), cB + hstepB, voffB); PG8_STAGE(PG8_SA(0, 1), cA + hstepA, voffA);
        if (wr == 1) PG8_BAR;
        PG8_WAIT_V(4); PG8_BAR;
        PG8_STAGE(PG8_SB(1, 0), cB + kstep, voffB); PG8_STAGE(PG8_SA(1, 0), cA + kstep, voffA); PG8_STAGE(PG8_SB(1, 1), cB + hstepB + kstep, voffB);
        PG8_WAIT_V(6); PG8_BAR;
    }
    for (;;) {
        const bool has_next = S.next(ui + 1, nxt);
        const char* nA = has_next ? (const char*)g.A + (size_t)nxt.pm * tstepA : cA; const char* nB = has_next ? (const char*)g.Bt + (size_t)nxt.pb * tstepB : cB;
        for (int t = 0; t < nt; t += 2) {
            const bool last = (t == nt - 2);
            const char* a1 = cA + (size_t)(t + 1) * kstep;
            const char* a2 = last ? nA : cA + (size_t)(t + 2) * kstep; const char* b2 = last ? nB : cB + (size_t)(t + 2) * kstep;
            const char* a3 = a2 + kstep; const char* b3 = b2 + kstep;
            if (last && has_next) S.a_ready(nxt);
            if constexpr (SP2) {
            PG8_LDB(B0, 0, 0); PG8_LDB(B1, 0, 1); PG8_SCHED; PG8_LDA(At, 0, 0); PG8_STAGE(PG8_SA(1, 1), a1 + hstepA, voffA);
            PG8_WAIT_V(8); PG8_WAIT_L(0); PG8_BAR; PG8_MMA(0, 0, At, B0); PG8_MMA(0, 1, At, B1); PG8_BAR; PG8_SCHED;
            PG8_LDA(At, 0, 1); PG8_STAGE(PG8_SB(0, 0), b2, voffB); PG8_STAGE(PG8_SB(0, 1), b2 + hstepB, voffB); PG8_STAGE(PG8_SA(0, 0), a2, voffA);
            PG8_WAIT_V(8); PG8_WAIT_L(0); PG8_BAR; PG8_MMA(1, 0, At, B0); PG8_MMA(1, 1, At, B1); PG8_BAR; PG8_SCHED;
            PG8_LDB(B0, 1, 0); PG8_LDB(B1, 1, 1); PG8_SCHED; PG8_LDA(At, 1, 0); PG8_STAGE(PG8_SA(0, 1), a2 + hstepA, voffA);
            PG8_WAIT_V(8); PG8_WAIT_L(0); PG8_BAR; PG8_MMA(0, 0, At, B0); PG8_MMA(0, 1, At, B1); PG8_BAR; PG8_SCHED;
            PG8_LDA(At, 1, 1); PG8_STAGE(PG8_SB(1, 0), b3, voffB); PG8_STAGE(PG8_SB(1, 1), b3 + hstepB, voffB); PG8_STAGE(PG8_SA(1, 0), a3, voffA);
            PG8_WAIT_V(8); PG8_WAIT_L(0); PG8_BAR; PG8_MMA(1, 0, At, B0); PG8_MMA(1, 1, At, B1); PG8_BAR; PG8_SCHED;
            } else {
            PG8_LDB(B0, 0, 0); PG8_SCHED; PG8_LDA(At, 0, 0); PG8_STAGE(PG8_SA(1, 1), a1 + hstepA, voffA);
            PG8_WAIT_L(8); PG8_BAR; PG8_WAIT_L(0); PG8_MMA(0, 0, At, B0); PG8_BAR; PG8_SCHED;
            PG8_LDB(B1, 0, 1); PG8_STAGE(PG8_SB(0, 0), b2, voffB);
            PG8_BAR; PG8_WAIT_L(0); PG8_MMA(0, 1, At, B1); PG8_BAR;
            PG8_LDA(At, 0, 1); PG8_STAGE(PG8_SA(0, 0), a2, voffA);
            PG8_BAR; PG8_WAIT_L(0); PG8_MMA(1, 0, At, B0); PG8_BAR; PG8_SCHED;
            PG8_STAGE(PG8_SB(0, 1), b2 + hstepB, voffB);
            PG8_WAIT_V(6); PG8_BAR; PG8_MMA(1, 1, At, B1); PG8_BAR;
            PG8_LDB(B0, 1, 0); PG8_SCHED; PG8_LDA(At, 1, 0); PG8_STAGE(PG8_SA(0, 1), a2 + hstepA, voffA);
            PG8_WAIT_L(8); PG8_BAR; PG8_WAIT_L(0); PG8_MMA(0, 0, At, B0); PG8_BAR; PG8_SCHED;
            PG8_LDB(B1, 1, 1); PG8_STAGE(PG8_SB(1, 0), b3, voffB);
            PG8_BAR; PG8_WAIT_L(0); PG8_MMA(0, 1, At, B1); PG8_BAR;
            PG8_LDA(At, 1, 1); PG8_STAGE(PG8_SA(1, 0), a3, voffA);
            PG8_BAR; PG8_WAIT_L(0); PG8_MMA(1, 0, At, B0); PG8_BAR; PG8_SCHED;
            PG8_STAGE(PG8_SB(1, 1), b3 + hstepB, voffB);
            PG8_WAIT_V(6); PG8_BAR; PG8_MMA(1, 1, At, B1); PG8_BAR;
            }
        }
        if constexpr (ALIGN_EPI) { if (wr == 0) PG8_BAR; }
        if constexpr (!Epi::AFTER_DRAIN) { E(acc, cur, wr, wc, fr, fq); S.done(cur); }
        if (!has_next) break;
#pragma unroll
        for (int a = 0; a < 2; ++a)
#pragma unroll
            for (int b = 0; b < 2; ++b)
#pragma unroll
                for (int m = 0; m < 4; ++m)
#pragma unroll
                    for (int n = 0; n < 2; ++n) acc[a][b][m][n] = (f32x4){0.f, 0.f, 0.f, 0.f};
        cur = nxt; cA = nA; cB = nB; ++ui;
        if constexpr (ALIGN_EPI) { if (wr == 1) PG8_BAR; }
    }
    PG8_WAIT_V(0);
    if constexpr (!ALIGN_EPI) { if (wr == 0) PG8_BAR; }
    PG8_BAR;
    if constexpr (Epi::AFTER_DRAIN) { E.fused(acc, cur, wr, wc, fr, fq, lds, wid, lane); S.done(cur); }
#undef PG8_SA
#undef PG8_SB
#undef PG8_STAGE
#undef PG8_LDA
#undef PG8_LDB
#undef PG8_MMA
#undef PG8_WAIT_V
#undef PG8_WAIT_L
#undef PG8_BAR
#undef PG8_SCHED
}
}

using pg8::bf16_t; using pg8::bf16x8; using pg8::f32x4; using pg8::u32x4; using pg8::Unit; using pg8::cvt_pk_bf16;
typedef unsigned u32x2 __attribute__((ext_vector_type(2)));
typedef float f32x2 __attribute__((ext_vector_type(2)));
constexpr int T = 16384, SEQ = 4096, DM = 2048, DIN = 16200;
constexpr float EPS = 1e-6f, NEGV = -1e30f, LOG2E = 1.4426950408889634f;
constexpr float CA_SCALE = 0.12751743082459868f;
constexpr float CC_SCALE = 0.10411754627697264f;
constexpr int NTHR = 512;
constexpr int LDS_BYTES = 131072;

constexpr size_t MiB = 1ull << 20;
constexpr size_t WS_CS = 0;
constexpr size_t WS_SSQ = WS_CS + MiB;
constexpr size_t WS_SSKV = WS_SSQ + 65536;
constexpr size_t WS_GATES = WS_SSKV + 65536;
constexpr size_t WS_KM = WS_GATES + 524288;
constexpr size_t WS_BV = WS_KM + 131072;
constexpr size_t WS_LIV = WS_BV + 262144;
constexpr size_t WS_BLAST = WS_LIV + 262144;
constexpr size_t WS_GMAX = WS_BLAST + 4096;
constexpr size_t WS_MST = WS_GMAX + 4096;
constexpr size_t WS_NST = WS_MST + 4096;
constexpr size_t WS_W0 = WS_NST + 524288;
constexpr size_t WL_WIN = 0;
constexpr size_t WL_WB = WL_WIN + 64 * MiB;
constexpr size_t WL_WO = WL_WB + 12 * MiB;
constexpr size_t WL_WUQ = WL_WO + 8 * MiB;
constexpr size_t WL_WKN = WL_WUQ + 1536 * 1024;
constexpr size_t WL_WV = WL_WKN + 512 * 1024;
constexpr size_t WL_SIZE = WL_WV + 512 * 1024;
constexpr size_t WS_H = WS_W0 + 2 * WL_SIZE;
constexpr size_t WS_QA = WS_H + 64 * MiB;
constexpr size_t WS_KA = WS_QA + 32 * MiB;
constexpr size_t WS_VAT = WS_KA + 32 * MiB;
constexpr size_t WS_Z = WS_VAT + 32 * MiB;
constexpr size_t WS_QB = WS_Z + 96 * MiB;
constexpr size_t WS_KB = WS_QB + 16 * MiB;
constexpr size_t WS_VB = WS_KB + 16 * MiB;
constexpr size_t WS_OB = WS_VB + 32 * MiB;
constexpr size_t WS_Q2 = WS_OB + 32 * MiB;
constexpr size_t WS_K2 = WS_Q2 + 16 * MiB;
constexpr size_t WS_CST = WS_K2 + 16 * MiB;
constexpr size_t WS_CQ = WS_CST + 64 * MiB;
constexpr size_t WS_CKV = WS_CQ + 16 * MiB;
constexpr size_t WS_KR = WS_CKV + 8 * MiB;
constexpr size_t WS_QC = WS_KR + 2 * MiB;
constexpr size_t WS_KNC = WS_QC + 48 * MiB;
constexpr size_t WS_VCT = WS_KNC + 32 * MiB;
constexpr size_t WS_GT = WS_VCT + 32 * MiB;
constexpr size_t WS_SSP = WS_GT + 192 * MiB;
constexpr size_t WS_QAL = WS_SSP + MiB;
constexpr size_t WS_CTR = WS_QAL + 32 * MiB;
constexpr size_t WS_END = WS_CTR + 256;

struct Params {
    const float* x; const float* norm_gain; const float* w_in; const float* t5; const float* conv_w; const float* conv_b; const float* i_bias; const float* f_bias;
    const float* out_norm; const float* q_norm; const float* kv_norm; const float* w_uq; const float* w_ukv; const float* w_branch; const float* w_out; const float* final_norm;
    float* out; unsigned char* ws; int w_lo, w_hi;
};

__device__ __forceinline__ float bf2f(unsigned v16) { return __uint_as_float(v16 << 16); }
__device__ __forceinline__ float bflo(unsigned w) { return __uint_as_float(w << 16); }
__device__ __forceinline__ float bfhi(unsigned w) { return __uint_as_float(w & 0xffff0000u); }
__device__ __forceinline__ bf16_t f2bf(float f) { return (bf16_t)(cvt_pk_bf16(f, 0.f) & 0xffffu); }
__device__ __forceinline__ float fsigmoid(float v) { return __builtin_amdgcn_rcpf(1.0f + __expf(-v)); }
__device__ __forceinline__ float fsilu(float v) { return v * __builtin_amdgcn_rcpf(1.0f + __expf(-v)); }
__device__ __forceinline__ float fexp2(float v) { return __builtin_amdgcn_exp2f(v); }
__device__ __forceinline__ f32x4 zero4() { f32x4 z = (f32x4){0.f, 0.f, 0.f, 0.f}; asm volatile("" : "+v"(z)); return z; }
__device__ __forceinline__ f32x4 mfma16(bf16x8 a, bf16x8 b, f32x4 c) { return __builtin_amdgcn_mfma_f32_16x16x32_bf16(a, b, c, 0, 0, 0); }

struct EpiIn {
    static constexpr bool PERM = true, AFTER_DRAIN = false;
    unsigned char* ws;
    __device__ __forceinline__ void operator()(const f32x4 (&acc)[2][2][4][2], const Unit& u, int wr, int wc, int fr, int fq) const {
        const int pn = u.pn; const int row0 = u.pm * 256 + wr * 64 + fr;
        if (pn == 59) {
            const int cb = wc * 32 + 8 * fq;
            if (cb >= 72) return;
            float* gates = (float*)(ws + WS_GATES); bf16_t* kr = (bf16_t*)(ws + WS_KR); const f32x2* cs = (const f32x2*)(ws + WS_CS);
#pragma unroll
            for (int ai = 0; ai < 2; ++ai)
#pragma unroll
                for (int m = 0; m < 4; ++m) {
                    const int row = row0 + ai * 128 + m * 16; const f32x4 v0 = acc[ai][0][m][0], v1 = acc[ai][0][m][1];
                    if (cb == 0) { *(f32x4*)(gates + (size_t)row * 8) = v0; *(f32x4*)(gates + (size_t)row * 8 + 4) = v1; }
                    else {
                        const int j0 = (cb - 8) >> 1, pos = row & (SEQ - 1);
                        const f32x2 c0 = cs[pos * 32 + j0], c1 = cs[pos * 32 + j0 + 1], c2 = cs[pos * 32 + j0 + 2], c3 = cs[pos * 32 + j0 + 3];
                        u32x4 w;
                        w.x = cvt_pk_bf16(v0[0] * c0.x - v0[1] * c0.y, v0[0] * c0.y + v0[1] * c0.x);
                        w.y = cvt_pk_bf16(v0[2] * c1.x - v0[3] * c1.y, v0[2] * c1.y + v0[3] * c1.x);
                        w.z = cvt_pk_bf16(v1[0] * c2.x - v1[1] * c2.y, v1[0] * c2.y + v1[1] * c2.x);
                        w.w = cvt_pk_bf16(v1[2] * c3.x - v1[3] * c3.y, v1[2] * c3.y + v1[3] * c3.x);
                        *(u32x4*)(kr + (size_t)row * 64 + (cb - 8)) = w;
                    }
                }
            return;
        }
        size_t off; int ld, c0, act = 0, ssk = 0; float sc = 1.f;
        if (pn < 4) { off = WS_QA; ld = 1024; c0 = pn * 256; sc = CA_SCALE; }
        else if (pn < 8) { off = WS_KA; ld = 1024; c0 = (pn - 4) * 256; }
        else if (pn < 12) { off = WS_Z; ld = 1024; c0 = (pn - 8) * 256; act = 1; }
        else if (pn < 14) { off = WS_QB; ld = 512; c0 = (pn - 12) * 256; }
        else if (pn < 16) { off = WS_KB; ld = 512; c0 = (pn - 14) * 256; }
        else if (pn < 20) { off = WS_VB; ld = 1024; c0 = (pn - 16) * 256; }
        else if (pn < 24) { off = WS_OB; ld = 1024; c0 = (pn - 20) * 256; act = 2; }
        else if (pn < 28) { off = WS_Z + 32 * MiB; ld = 1024; c0 = (pn - 24) * 256; act = 1; }
        else if (pn < 30) { off = WS_CQ; ld = 512; c0 = (pn - 28) * 256; ssk = 1; }
        else if (pn < 31) { off = WS_CKV; ld = 256; c0 = 0; ssk = 2; }
        else if (pn < 35) { off = WS_Z + 64 * MiB; ld = 1024; c0 = (pn - 31) * 256; act = 1; }
        else { off = WS_GT; ld = 6144; c0 = (pn - 35) * 256; act = 2; }
        bf16_t* dst = (bf16_t*)(ws + off); float* ssp = (float*)(ws + WS_SSP) + (ssk == 2 ? 8 : (pn - 28) * 4) + wc;
        const int col0 = c0 + wc * 32 + 8 * fq;
#pragma unroll
        for (int ai = 0; ai < 2; ++ai)
#pragma unroll
            for (int m = 0; m < 4; ++m) {
                const int row = row0 + ai * 128 + m * 16; bf16_t* rowp = dst + (size_t)row * ld + col0; float ss = 0.f;
#pragma unroll
                for (int bj = 0; bj < 2; ++bj) {
                    f32x4 v0 = acc[ai][bj][m][0], v1 = acc[ai][bj][m][1];
                    if (act == 1) {
#pragma unroll
                        for (int i = 0; i < 4; ++i) { v0[i] = fsilu(v0[i]); v1[i] = fsilu(v1[i]); }
                    } else if (act == 2) {
#pragma unroll
                        for (int i = 0; i < 4; ++i) { v0[i] = fsigmoid(v0[i]); v1[i] = fsigmoid(v1[i]); }
                    } else { v0 = v0 * sc; v1 = v1 * sc; }
                    if (ssk) ss += (v0[0] * v0[0] + v0[1] * v0[1]) + (v0[2] * v0[2] + v0[3] * v0[3]) + (v1[0] * v1[0] + v1[1] * v1[1]) + (v1[2] * v1[2] + v1[3] * v1[3]);
                    u32x4 w; w.x = cvt_pk_bf16(v0[0], v0[1]); w.y = cvt_pk_bf16(v0[2], v0[3]); w.z = cvt_pk_bf16(v1[0], v1[1]); w.w = cvt_pk_bf16(v1[2], v1[3]);
                    *(u32x4*)(rowp + bj * 128) = w;
                    if (pn < 4) {
                        u32x4 wl; wl.x = cvt_pk_bf16(v0[0] - bflo(w.x), v0[1] - bfhi(w.x)); wl.y = cvt_pk_bf16(v0[2] - bflo(w.y), v0[3] - bfhi(w.y));
                        wl.z = cvt_pk_bf16(v1[0] - bflo(w.z), v1[1] - bfhi(w.z)); wl.w = cvt_pk_bf16(v1[2] - bflo(w.w), v1[3] - bfhi(w.w));
                        *(u32x4*)((bf16_t*)(ws + WS_QAL) + (size_t)row * 1024 + col0 + bj * 128) = wl; }
                }
                if (ssk) { const int ln = fq * 16 + fr; ss += shx(ss, 16, ln); ss += shx(ss, 32, ln); if (fq == 0) ssp[(size_t)row * 16] = ss; }
            }
    }
};

struct EpiVT {
    static constexpr bool PERM = true, AFTER_DRAIN = false;
    bf16_t* dst; int ld; const float* ss; float inv_n;
    __device__ __forceinline__ void operator()(const f32x4 (&acc)[2][2][4][2], const Unit& u, int wr, int wc, int fr, int fq) const {
        const int row0 = u.pm * 256 + wr * 64 + fr, col0 = u.pn * 256 + wc * 32 + 8 * fq;
        f32x4 s0[2], s1[2];
#pragma unroll
        for (int bj = 0; bj < 2; ++bj) {
            if (ss) { f32x4 a, b;
#pragma unroll
                for (int i = 0; i < 4; ++i) { const f32x4 pa = *(const f32x4*)(ss + (size_t)(col0 + bj * 128 + i) * 16 + 8), pb = *(const f32x4*)(ss + (size_t)(col0 + bj * 128 + 4 + i) * 16 + 8);
                    a[i] = rsqrtf(((pa[0] + pa[1]) + (pa[2] + pa[3])) * inv_n + EPS); b[i] = rsqrtf(((pb[0] + pb[1]) + (pb[2] + pb[3])) * inv_n + EPS); }
                s0[bj] = a; s1[bj] = b; }
            else { s0[bj] = (f32x4){1.f, 1.f, 1.f, 1.f}; s1[bj] = s0[bj]; }
        }
#pragma unroll
        for (int ai = 0; ai < 2; ++ai)
#pragma unroll
            for (int m = 0; m < 4; ++m) {
                bf16_t* rowp = dst + (size_t)(row0 + ai * 128 + m * 16) * ld + col0;
#pragma unroll
                for (int bj = 0; bj < 2; ++bj) {
                    const f32x4 v0 = acc[ai][bj][m][0] * s0[bj], v1 = acc[ai][bj][m][1] * s1[bj];
                    u32x4 w; w.x = cvt_pk_bf16(v0[0], v0[1]); w.y = cvt_pk_bf16(v0[2], v0[3]); w.z = cvt_pk_bf16(v1[0], v1[1]); w.w = cvt_pk_bf16(v1[2], v1[3]);
                    *(u32x4*)(rowp + bj * 128) = w;
                }
            }
    }
};

template <bool ROPE> struct EpiRow {
    static constexpr bool PERM = true, AFTER_DRAIN = false;
    bf16_t* dst; int ld; const float* ss; float inv_n, sc; const f32x2* cs;
    __device__ __forceinline__ void operator()(const f32x4 (&acc)[2][2][4][2], const Unit& u, int wr, int wc, int fr, int fq) const {
        const int row0 = u.pm * 256 + wr * 64 + fr, col0 = u.pn * 256 + wc * 32 + 8 * fq;
#pragma unroll
        for (int ai = 0; ai < 2; ++ai)
#pragma unroll
            for (int m = 0; m < 4; ++m) {
                const int row = row0 + ai * 128 + m * 16; float sq;
                if (ROPE) { const f32x4 pa = *(const f32x4*)(ss + (size_t)row * 16), pb = *(const f32x4*)(ss + (size_t)row * 16 + 4); sq = ((pa[0] + pa[1]) + (pa[2] + pa[3])) + ((pb[0] + pb[1]) + (pb[2] + pb[3])); }
                else { const f32x4 pa = *(const f32x4*)(ss + (size_t)row * 16 + 8); sq = (pa[0] + pa[1]) + (pa[2] + pa[3]); }
                const float rs = rsqrtf(sq * inv_n + EPS) * sc; bf16_t* rowp = dst + (size_t)row * ld + col0;
#pragma unroll
                for (int bj = 0; bj < 2; ++bj) {
                    f32x4 v0 = acc[ai][bj][m][0] * rs, v1 = acc[ai][bj][m][1] * rs; u32x4 w;
                    const int hc = (col0 + bj * 128) % 192;
                    if (ROPE && hc >= 128) {
                        const int j0 = (hc - 128) >> 1, pos = row & (SEQ - 1);
                        const f32x2 c0 = cs[pos * 32 + j0], c1 = cs[pos * 32 + j0 + 1], c2 = cs[pos * 32 + j0 + 2], c3 = cs[pos * 32 + j0 + 3];
                        w.x = cvt_pk_bf16(v0[0] * c0.x - v0[1] * c0.y, v0[0] * c0.y + v0[1] * c0.x);
                        w.y = cvt_pk_bf16(v0[2] * c1.x - v0[3] * c1.y, v0[2] * c1.y + v0[3] * c1.x);
                        w.z = cvt_pk_bf16(v1[0] * c2.x - v1[1] * c2.y, v1[0] * c2.y + v1[1] * c2.x);
                        w.w = cvt_pk_bf16(v1[2] * c3.x - v1[3] * c3.y, v1[2] * c3.y + v1[3] * c3.x);
                    } else { w.x = cvt_pk_bf16(v0[0], v0[1]); w.y = cvt_pk_bf16(v0[2], v0[3]); w.z = cvt_pk_bf16(v1[0], v1[1]); w.w = cvt_pk_bf16(v1[2], v1[3]); }
                    *(u32x4*)(rowp + bj * 128) = w;
                }
            }
    }
};

struct EpiMerge {
    static constexpr bool PERM = true, AFTER_DRAIN = false;
    bf16_t* merged; const bf16_t* gt;
    __device__ __forceinline__ void operator()(const f32x4 (&acc)[2][2][4][2], const Unit& u, int wr, int wc, int fr, int fq) const {
        const int n = u.pm >> 6, pmr = u.pm & 63; const int row0 = pmr * 256 + wr * 64 + fr, col0 = u.pn * 256 + wc * 32 + 8 * fq;
#pragma unroll
        for (int ai = 0; ai < 2; ++ai)
#pragma unroll
            for (int m = 0; m < 4; ++m) {
                const int row = row0 + ai * 128 + m * 16;
#pragma unroll
                for (int bj = 0; bj < 2; ++bj) {
                    const u32x4 gw = *(const u32x4*)(gt + (size_t)row * 6144 + n * 2048 + col0 + bj * 128);
                    bf16_t* mp = merged + (size_t)row * 2048 + col0 + bj * 128;
                    u32x4 pw = (u32x4){0u, 0u, 0u, 0u}; if (n > 0) pw = __builtin_nontemporal_load((const u32x4*)mp);
                    const f32x4 v0 = acc[ai][bj][m][0], v1 = acc[ai][bj][m][1]; u32x4 w;
                    w.x = cvt_pk_bf16(bflo(pw.x) + bflo(gw.x) * v0[0], bfhi(pw.x) + bfhi(gw.x) * v0[1]);
                    w.y = cvt_pk_bf16(bflo(pw.y) + bflo(gw.y) * v0[2], bfhi(pw.y) + bfhi(gw.y) * v0[3]);
                    w.z = cvt_pk_bf16(bflo(pw.z) + bflo(gw.z) * v1[0], bfhi(pw.z) + bfhi(gw.z) * v1[1]);
                    w.w = cvt_pk_bf16(bflo(pw.w) + bflo(gw.w) * v1[2], bfhi(pw.w) + bfhi(gw.w) * v1[3]);
                    *(u32x4*)mp = w;
                }
            }
    }
};
struct MergeOrder {
    int G, c;
    __device__ bool next(int i, Unit& u) const {
        const int t3 = i / 3, n = i - 3 * t3; const long L = (long)t3 * G + c; if (L >= 512) return false;
        const int tm = (int)(L >> 3), tn = (int)(L & 7); u.pm = n * 64 + tm; u.pn = tn; u.pb = n * 8 + tn; return true;
    }
    __device__ __forceinline__ void a_ready(const Unit&) const {}
    __device__ __forceinline__ void done(const Unit&) const {}
};

struct EpiOut {
    static constexpr bool PERM = false, AFTER_DRAIN = false;
    const float* xin; float* xout;
    __device__ __forceinline__ void operator()(const f32x4 (&acc)[2][2][4][2], const Unit& u, int wr, int wc, int fr, int fq) const {
        const int row0 = u.pm * 256 + wr * 64 + fr, col0 = u.pn * 256 + wc * 32 + 4 * fq;
#pragma unroll
        for (int ai = 0; ai < 2; ++ai)
#pragma unroll
            for (int m = 0; m < 4; ++m) {
                const size_t ro = (size_t)(row0 + ai * 128 + m * 16) * DM + col0;
#pragma unroll
                for (int bj = 0; bj < 2; ++bj)
#pragma unroll
                    for (int n = 0; n < 2; ++n) { const f32x4 b = *(const f32x4*)(xin + ro + bj * 128 + n * 16); *(f32x4*)(xout + ro + bj * 128 + n * 16) = b + acc[ai][bj][m][n]; }
            }
    }
};

template <class F> __device__ __forceinline__ void tconv(unsigned char* lds, const float* src, int ldsrc, int K, bf16_t* dst, int N, const float* gain, F f, const int g_wv) {
    float* tile = (float*)lds; int tid = TIDX; asm volatile("" : "+v"(tid)); const int tilesK = K >> 6, ntile = tilesK * (N >> 8);
    const int nn4 = (tid & 63) * 4, kk0 = tid >> 6; f32x4 pre[8];
#define TCONV_LOAD(tt_) do { const int tn_ = (tt_) / tilesK, tk_ = (tt_) - tn_ * tilesK; const int c0 = f(tn_ * 256 + nn4), c1 = f(tn_ * 256 + nn4 + 1), c2 = f(tn_ * 256 + nn4 + 2), c3 = f(tn_ * 256 + nn4 + 3); \
        const bool vec = (c0 >= 0) && ((c0 & 3) == 0) && (c3 == c0 + 3); const float* sp = src + (size_t)(tk_ * 64 + kk0) * ldsrc; \
        _Pragma("unroll") for (int e = 0; e < 8; ++e) { const float* rp = sp + (size_t)(8 * e) * ldsrc; f32x4 v; \
            if (vec) v = *(const f32x4*)(rp + c0); \
            else { v[0] = c0 >= 0 ? rp[c0] : 0.f; v[1] = c1 >= 0 ? rp[c1] : 0.f; v[2] = c2 >= 0 ? rp[c2] : 0.f; v[3] = c3 >= 0 ? rp[c3] : 0.f; } \
            pre[e] = v; } } while (0)
    int t = blockIdx.x;
    if (t < ntile) TCONV_LOAD(t);
    for (; t < ntile; t += gridDim.x) {
        const int tn = t / tilesK, tk = t - tn * tilesK;
#pragma unroll
        for (int e = 0; e < 8; ++e) { f32x4 v = pre[e]; if (gain) v = v * gain[tk * 64 + kk0 + 8 * e]; *(f32x4*)(tile + (kk0 + 8 * e) * 260 + nn4) = v; }
        __syncthreads();
        { const int t2 = t + (int)gridDim.x; if (t2 < ntile) TCONV_LOAD(t2); }
        { const int nn = tid >> 1, kc = (tid & 1) * 32; bf16_t* dp = dst + (size_t)(tn * 256 + nn) * K + tk * 64 + kc;
#pragma unroll
          for (int q4 = 0; q4 < 4; ++q4) { float v[8];
#pragma unroll
              for (int i = 0; i < 8; ++i) v[i] = tile[(kc + q4 * 8 + i) * 260 + nn];
              u32x4 w; w.x = cvt_pk_bf16(v[0], v[1]); w.y = cvt_pk_bf16(v[2], v[3]); w.z = cvt_pk_bf16(v[4], v[5]); w.w = cvt_pk_bf16(v[6], v[7]);
              *(u32x4*)(dp + q4 * 8) = w; } }
        __syncthreads();
    }
#undef TCONV_LOAD
}
__device__ __forceinline__ int win_src_col(int n) {
    if (n < 1024) return n;
    if (n < 2048) return 1024 + (n - 1024);
    if (n < 3072) return 3072 + (n - 2048);
    if (n < 3584) return 4096 + (n - 3072);
    if (n < 4096) return 4608 + (n - 3584);
    if (n < 5120) return 5120 + (n - 4096);
    if (n < 6144) return 6152 + (n - 5120);
    if (n < 7168) return 7176 + (n - 6144);
    if (n < 7680) return 8200 + (n - 7168);
    if (n < 7936) return 8712 + (n - 7680);
    if (n < 8960) return 9032 + (n - 7936);
    if (n < 15104) return 10056 + (n - 8960);
    if (n < 15360) { const int r = n - 15104; if (r < 4) return 6144 + r; if (r < 8) return 6148 + (r - 4); if (r < 72) { const int j = (r - 8) >> 1, odd = (r - 8) & 1; return 8968 + j + 32 * odd; } return -1; }
    return 2048 + (n - 15360);
}
__device__ __forceinline__ void convert_weights(unsigned char* lds, const Params& p, int l, const int g_wv) {
    unsigned char* wl = p.ws + WS_W0 + (size_t)l * WL_SIZE;
    tconv(lds, p.w_in + (size_t)l * DM * DIN, DIN, DM, (bf16_t*)(wl + WL_WIN), 16384, nullptr, [](int n) { return win_src_col(n); }, g_wv);
#pragma unroll 1
    for (int n = 0; n < 3; ++n)
        tconv(lds, p.w_branch + ((size_t)l * 3 + n) * 1024 * DM, DM, 1024, (bf16_t*)(wl + WL_WB) + (size_t)n * 2048 * 1024, 2048, nullptr, [](int c) { return c; }, g_wv);
    tconv(lds, p.w_out + (size_t)l * DM * DM, DM, DM, (bf16_t*)(wl + WL_WO), DM, nullptr, [](int c) { return c; }, g_wv);
    tconv(lds, p.w_uq + (size_t)l * 512 * 1536, 1536, 512, (bf16_t*)(wl + WL_WUQ), 1536, p.q_norm + l * 512,
          [](int n) { const int h = n / 192, hc = n - h * 192; if (hc < 128) return n; const int r = hc - 128; return h * 192 + 128 + (r >> 1) + 32 * (r & 1); }, g_wv);
    tconv(lds, p.w_ukv + (size_t)l * 256 * 2048, 2048, 256, (bf16_t*)(wl + WL_WKN), 1024, p.kv_norm + l * 256, [](int n) { return (n >> 7) * 256 + (n & 127); }, g_wv);
    tconv(lds, p.w_ukv + (size_t)l * 256 * 2048, 2048, 256, (bf16_t*)(wl + WL_WV), 1024, p.kv_norm + l * 256, [](int n) { return (n >> 7) * 256 + 128 + (n & 127); }, g_wv);
}
__device__ __forceinline__ void sincos_acc(float ang, float& s, float& c) {
    const double x = (double)ang; const double q = rint(x * 0.63661977236758134308);
    double r = fma(-q, 1.57079632679489655800e+00, x); r = fma(-q, 6.12323399573676603587e-17, r);
    const int qi = ((int)q) & 3; const double r2 = r * r;
    const double sp = r + r * r2 * (-1.66666666666666324348e-01 + r2 * (8.33333333332248946124e-03 + r2 * (-1.98412698298579493134e-04 + r2 * (2.75573137070700676789e-06 + r2 * (-2.50507602534068634195e-08 + r2 * 1.58969099521155010221e-10)))));
    const double cp = 1.0 - 0.5 * r2 + r2 * r2 * (4.16666666666666019037e-02 + r2 * (-1.38888888888741095749e-03 + r2 * (2.48015872894767294178e-05 + r2 * (-2.75573143513906633035e-07 + r2 * (2.08757232129817482790e-09 + r2 * -1.13596475577881948265e-11)))));
    double ss, cc; if (qi == 0) { ss = sp; cc = cp; } else if (qi == 1) { ss = cp; cc = -sp; } else if (qi == 2) { ss = -sp; cc = -cp; } else { ss = -cp; cc = sp; }
    s = (float)ss; c = (float)cc;
}
__device__ __forceinline__ void build_cs(const Params& p, const int g_wv) {
    f32x2* cs = (f32x2*)(p.ws + WS_CS);
    int i0 = blockIdx.x * NTHR + TIDX; asm volatile("" : "+v"(i0));
    for (int i = i0; i < SEQ * 32; i += gridDim.x * NTHR) {
        const int pos = i >> 5, j = i & 31; double inv = 1.0; for (int k = 0; k < j; ++k) inv *= 0.7498942093324558;
        const float ang = (float)pos * (float)inv; float s, c; sincos_acc(ang, s, c); cs[i] = (f32x2){c, s};
    }
}
__device__ __forceinline__ void zero_ss(const Params& p, const int g_wv) {
    float* a = (float*)(p.ws + WS_SSQ);
    int i0 = blockIdx.x * NTHR + TIDX; asm volatile("" : "+v"(i0));
    for (int i = i0; i < 2 * T; i += gridDim.x * NTHR) a[i] = 0.f;
}
template <bool OUTBF> __device__ __forceinline__ void rmsnorm_rows(const float* x, const float* gain, bf16_t* hb, float* of, const int g_wv) {
    int tid = TIDX; asm volatile("" : "+v"(tid)); const int lane = tid & 63, gw = blockIdx.x * (NTHR / 64) + (tid >> 6), nw = gridDim.x * (NTHR / 64);
    for (int row = gw; row < T; row += nw) {
        const float* xr = x + (size_t)row * DM; f32x4 v[8]; float ss = 0.f;
#pragma unroll
        for (int i = 0; i < 8; ++i) { v[i] = *(const f32x4*)(xr + i * 256 + lane * 4); ss += (v[i][0] * v[i][0] + v[i][1] * v[i][1]) + (v[i][2] * v[i][2] + v[i][3] * v[i][3]); }
#pragma unroll
        for (int o = 1; o < 64; o <<= 1) ss += shx(ss, o, lane);
        const float rs = rsqrtf(ss * (1.0f / DM) + EPS);
#pragma unroll
        for (int i = 0; i < 8; ++i) {
            const f32x4 gn = *(const f32x4*)(gain + i * 256 + lane * 4); const f32x4 y = v[i] * rs * gn;
            if (OUTBF) { u32x2 w; w.x = cvt_pk_bf16(y[0], y[1]); w.y = cvt_pk_bf16(y[2], y[3]); *(u32x2*)(hb + (size_t)row * DM + i * 256 + lane * 4) = w; }
            else *(f32x4*)(of + (size_t)row * DM + i * 256 + lane * 4) = y;
        }
    }
}

__device__ __forceinline__ void kmean_phase(const Params& p, int l, const int g_wv) {
    const bf16_t* ka = (const bf16_t*)(p.ws + WS_KA); bf16_t* km = (bf16_t*)(p.ws + WS_KM); bf16_t* kml = (bf16_t*)(p.ws + WS_SSQ); int tid = TIDX; asm volatile("" : "+v"(tid));
    for (int u = (gridDim.x == 256) ? (int)blockIdx.x - 192 : (int)blockIdx.x; u < 64; u += gridDim.x) { if (u < 0) continue;
        const int b = u >> 4, j = u & 15; const unsigned* src = (const unsigned*)(ka + ((size_t)b * SEQ + j * 256) * 1024) + tid; float a0 = 0.f, a1 = 0.f;
#pragma unroll 8
        for (int r = 0; r < 256; ++r) { const unsigned w = src[(size_t)r * 512]; a0 += bflo(w); a1 += bfhi(w); }
        const int col = tid * 2, h = col >> 7, d = col & 127;
        const float m0 = a0 * (1.0f / 256.0f), m1 = a1 * (1.0f / 256.0f); const unsigned hi = cvt_pk_bf16(m0, m1);
        *(unsigned*)(km + ((size_t)((b * 8 + h) * 16 + j)) * 128 + d) = hi;
        *(unsigned*)(kml + ((size_t)((b * 8 + h) * 16 + j)) * 128 + d) = cvt_pk_bf16(m0 - bflo(hi), m1 - bfhi(hi));
    }
}

template <int MODE> __device__ __forceinline__ void attn_phase(unsigned char* lds, const Params& p, int l, const int g_wv) {
    constexpr int DQK = MODE ? 192 : 128, NC = DQK / 32, NCH = DQK / 8, KRS = DQK * 2 + 32, KBUF = 64 * KRS, VRS = 144, VBUF = 128 * VRS;
    constexpr int OFF_V = 2 * KBUF, OFF_LUT = OFF_V + 2 * VBUF, OFF_KM = OFF_LUT + 512, NKL = (64 * NCH) / NTHR;
    int tid = TIDX; asm volatile("" : "+v"(tid)); const int lane = tid & 63, w = tid >> 6, lr = lane & 15, g = lane >> 4; const int G = gridDim.x, c = blockIdx.x;
    unsigned char* ws = p.ws;
    const bf16_t* Qp = (const bf16_t*)(ws + (MODE ? WS_QC : WS_QA)); constexpr int LDQ = MODE ? 1536 : 1024;
    const bf16_t* Kp = (const bf16_t*)(ws + (MODE ? WS_KNC : WS_KA)); const bf16_t* KRp = (const bf16_t*)(ws + WS_KR);
    const bf16_t* VTp = (const bf16_t*)(ws + (MODE ? WS_VCT : WS_VAT)); bf16_t* Zp = (bf16_t*)(ws + WS_Z + (MODE ? 64 * MiB : 0));
    float* lut = (float*)(lds + OFF_LUT);
    for (int rd = 0; rd * G < 512; ++rd) {
        int qblk, bh;
        if (G == 256) {
            const int xq = c & 7, iq = c >> 3, qq = iq >> 1;
            bh = 2 * xq + (iq & 1) + 16 * rd; qblk = rd ? qq : 15 - qq;
        } else { const int idx = rd * G + ((rd & 1) ? (G - 1 - c) : c); if (idx >= 512) continue; qblk = 15 - (idx >> 5); bh = idx & 31; }
        const int b = bh >> 3, h = bh & 7;
        const int q0 = qblk * 256 + w * 32; const size_t tq = (size_t)b * SEQ + q0; const int nt = (qblk + 1) * 4;
        bf16x8 qf[2][NC];
#pragma unroll
        for (int qb = 0; qb < 2; ++qb)
#pragma unroll
            for (int c2 = 0; c2 < NC; ++c2) qf[qb][c2] = *(const bf16x8*)(Qp + (tq + qb * 16 + lr) * LDQ + h * DQK + c2 * 32 + g * 8);
        u32x4 kreg[NKL], vreg[2];
#define ATT_LOADK(t_) do { const int t__ = (t_); \
        _Pragma("unroll") for (int i = 0; i < NKL; ++i) { const int id = tid + NTHR * i; const int key = id / NCH, ch = id - key * NCH; const size_t tk = (size_t)b * SEQ + t__ * 64 + key; \
            const bf16_t* s_ = (!MODE || ch < 16) ? (Kp + tk * 1024 + h * 128 + ch * 8) : (KRp + tk * 64 + (ch - 16) * 8); kreg[i] = *(const u32x4*)s_; } } while (0)
#define ATT_LOADV(t_) do { const int t__ = (t_); \
        _Pragma("unroll") for (int i = 0; i < 2; ++i) { const int id = tid + NTHR * i; const int row = id >> 3, ch = id & 7; \
            vreg[i] = *(const u32x4*)(VTp + (size_t)(h * 128 + row) * T + (size_t)b * SEQ + t__ * 64 + ch * 8); } } while (0)
#define ATT_STOREK(buf_) do { unsigned char* kb_ = lds + (buf_) * KBUF; \
        _Pragma("unroll") for (int i = 0; i < NKL; ++i) { const int id = tid + NTHR * i; const int key = id / NCH, ch = id - key * NCH; *(u32x4*)(kb_ + key * KRS + ch * 16) = kreg[i]; } } while (0)
#define ATT_STOREV(buf_) do { unsigned char* vb_ = lds + OFF_V + (buf_) * VBUF; \
        _Pragma("unroll") for (int i = 0; i < 2; ++i) { const int id = tid + NTHR * i; const int row = id >> 3, ch = id & 7; *(u32x4*)(vb_ + row * VRS + ch * 16) = vreg[i]; } } while (0)
        ATT_LOADK(0); ATT_LOADV(0); ATT_STOREK(0); ATT_STOREV(0); ATT_LOADK(1); ATT_LOADV(1);
        unsigned sel[2] = {0u, 0u};
        if (MODE == 0) {
            if (tid < 128) { const int d = tid; int bk = d; if (d >= 16) { bk = 16 + (int)(logf((float)d * (1.0f / 16.0f)) / 2.0794415416798357f * 16.0f); bk = bk > 31 ? 31 : bk; } lut[d] = p.t5[bk * 8 + h] * LOG2E; }
            { const int half = tid >> 8, row = (tid >> 4) & 15, ch = tid & 15; *(u32x4*)(lds + OFF_KM + half * 4608 + row * 288 + ch * 16) = *(const u32x4*)((const bf16_t*)(ws + (half ? WS_SSQ : WS_KM)) + ((size_t)((b * 8 + h) * 16 + row)) * 128 + ch * 8); }
        }
        __syncthreads();
        if (MODE == 0) {
            f32x4 ga[2] = {zero4(), zero4()};
#pragma unroll
            for (int c2 = 0; c2 < NC; ++c2) { const bf16x8 kf = *(const bf16x8*)(lds + OFF_KM + lr * 288 + c2 * 64 + g * 16), kfl = *(const bf16x8*)(lds + OFF_KM + 4608 + lr * 288 + c2 * 64 + g * 16);
#pragma unroll
                for (int qb = 0; qb < 2; ++qb) { const bf16x8 ql = *(const bf16x8*)((const bf16_t*)(ws + WS_QAL) + (tq + qb * 16 + lr) * 1024 + h * 128 + c2 * 32 + g * 8);
                    ga[qb] = mfma16(kfl, qf[qb][c2], ga[qb]); ga[qb] = mfma16(kf, ql, ga[qb]); ga[qb] = mfma16(kf, qf[qb][c2], ga[qb]); } }
#pragma unroll
            for (int qb = 0; qb < 2; ++qb) {
                float gv[4];
#pragma unroll
                for (int r = 0; r < 4; ++r) gv[r] = (g * 4 + r < qblk) ? ga[qb][r] : -INFINITY;
                unsigned s = 0u;
#pragma unroll
                for (int it = 0; it < 3; ++it) {
                    float bv = -INFINITY; int bi = 99;
#pragma unroll
                    for (int r = 0; r < 4; ++r) if (gv[r] > bv) { bv = gv[r]; bi = g * 4 + r; }
#pragma unroll
                    for (int o = 16; o <= 32; o <<= 1) { const float ov = shx(bv, o, lane); const int oi = shxi(bi, o, lane); if (ov > bv || (ov == bv && oi < bi)) { bv = ov; bi = oi; } }
                    if (bv > -INFINITY) s |= 1u << bi;
#pragma unroll
                    for (int r = 0; r < 4; ++r) if (g * 4 + r == bi) gv[r] = -INFINITY;
                }
                sel[qb] = s;
            }
        }
        f32x4 oacc[8][2];
#pragma unroll
        for (int i = 0; i < 8; ++i) { oacc[i][0] = zero4(); oacc[i][1] = zero4(); }
        float mrow[2] = {NEGV, NEGV}, lrow[2] = {0.f, 0.f};
        for (int t = 0; t < nt; ++t) {
            const int buf = t & 1; const bool more = (t + 1 < nt);
            if (more) { ATT_STOREK(buf ^ 1); ATT_STOREV(buf ^ 1); }
            if (t + 2 < nt) { ATT_LOADK(t + 2); ATT_LOADV(t + 2); }
            const int k0 = t * 64;
            const unsigned char* kb_ = lds + buf * KBUF; const unsigned char* vb_ = lds + OFF_V + buf * VBUF;
#pragma unroll
            for (int hf = 0; hf < 2; ++hf) {
              const int kh = k0 + hf * 32;
              if (kh <= q0 + 31) {
                f32x4 sacc[2][2];
#pragma unroll
                for (int kb = 0; kb < 2; ++kb) { sacc[kb][0] = zero4(); sacc[kb][1] = zero4(); }
#pragma unroll
                for (int c2 = 0; c2 < NC; ++c2)
#pragma unroll
                    for (int kb = 0; kb < 2; ++kb) { const bf16x8 kf = *(const bf16x8*)(kb_ + (hf * 32 + kb * 16 + lr) * KRS + c2 * 64 + g * 16);
                        sacc[kb][0] = mfma16(kf, qf[0][c2], sacc[kb][0]); sacc[kb][1] = mfma16(kf, qf[1][c2], sacc[kb][1]); }
                if (MODE == 0) {
                    const int jblk = t >> 2; const bool far = (kh + 31 + 127 <= q0);
                    if (far) { const float bfar = lut[127];
#pragma unroll
                        for (int qb = 0; qb < 2; ++qb) { const bool al = (jblk < qblk) ? (((sel[qb] >> jblk) & 1u) != 0u) : true;
#pragma unroll
                            for (int kb = 0; kb < 2; ++kb)
#pragma unroll
                                for (int r = 0; r < 4; ++r) sacc[kb][qb][r] = al ? sacc[kb][qb][r] + bfar : NEGV; }
                    } else {
#pragma unroll
                        for (int qb = 0; qb < 2; ++qb) { const int qpos = q0 + qb * 16 + lr; const bool alp = (sel[qb] >> jblk) & 1u;
#pragma unroll
                            for (int kb = 0; kb < 2; ++kb)
#pragma unroll
                                for (int r = 0; r < 4; ++r) { const int d = qpos - (kh + kb * 16 + g * 4 + r); const int di = d < 0 ? 0 : (d > 127 ? 127 : d);
                                    const bool al = (jblk < qblk) ? alp : (d >= 0); sacc[kb][qb][r] = al ? sacc[kb][qb][r] + lut[di] : NEGV; } }
                    }
                } else {
                    if (kh + 31 > q0) {
#pragma unroll
                        for (int qb = 0; qb < 2; ++qb) { const int qpos = q0 + qb * 16 + lr;
#pragma unroll
                            for (int kb = 0; kb < 2; ++kb)
#pragma unroll
                                for (int r = 0; r < 4; ++r) if (kh + kb * 16 + g * 4 + r > qpos) sacc[kb][qb][r] = NEGV; }
                    }
                }
                bf16x8 pf[2];
#pragma unroll
                for (int qb = 0; qb < 2; ++qb) {
                    float mx = NEGV;
#pragma unroll
                    for (int kb = 0; kb < 2; ++kb)
#pragma unroll
                        for (int r = 0; r < 4; ++r) mx = fmaxf(mx, sacc[kb][qb][r]);
                    float mnew = mrow[qb];
                    if (__builtin_amdgcn_ballot_w64(mx > mrow[qb] + 8.0f) != 0ull) {
                        mx = fmaxf(mx, shx(mx, 16, lane)); mx = fmaxf(mx, shx(mx, 32, lane));
                        mnew = fmaxf(mrow[qb], mx); const float alpha = fexp2(mrow[qb] - mnew); mrow[qb] = mnew; lrow[qb] *= alpha;
#pragma unroll
                        for (int i = 0; i < 8; ++i) oacc[i][qb] = oacc[i][qb] * alpha;
                    }
                    float ps = 0.f;
#pragma unroll
                    for (int kb = 0; kb < 2; ++kb)
#pragma unroll
                        for (int r = 0; r < 4; ++r) { const float e = fexp2(sacc[kb][qb][r] - mnew); sacc[kb][qb][r] = e; ps += e; }
                    lrow[qb] += ps;
                    union { u32x4 u; bf16x8 v; } cvt;
                    cvt.u.x = cvt_pk_bf16(sacc[0][qb][0], sacc[0][qb][1]); cvt.u.y = cvt_pk_bf16(sacc[0][qb][2], sacc[0][qb][3]);
                    cvt.u.z = cvt_pk_bf16(sacc[1][qb][0], sacc[1][qb][1]); cvt.u.w = cvt_pk_bf16(sacc[1][qb][2], sacc[1][qb][3]); pf[qb] = cvt.v;
                }
#pragma unroll
                for (int dvb = 0; dvb < 8; ++dvb) { union { u32x2 u[2]; bf16x8 v; } vf; const unsigned char* vp = vb_ + (dvb * 16 + lr) * VRS + (hf * 32 + g * 4) * 2;
                    vf.u[0] = *(const u32x2*)vp; vf.u[1] = *(const u32x2*)(vp + 32);
                    oacc[dvb][0] = mfma16(vf.v, pf[0], oacc[dvb][0]); oacc[dvb][1] = mfma16(vf.v, pf[1], oacc[dvb][1]); }
              }
            }
            __syncthreads();
        }
#pragma unroll
        for (int qb = 0; qb < 2; ++qb) {
            float l = lrow[qb]; l += shx(l, 16, lane); l += shx(l, 32, lane); const float inv = 1.0f / l;
            bf16_t* zr = Zp + (tq + qb * 16 + lr) * 1024 + h * 128 + g * 4;
#pragma unroll
            for (int dvb = 0; dvb < 8; ++dvb) { const u32x2 zw = *(const u32x2*)(zr + dvb * 16); const f32x4 o = oacc[dvb][qb] * inv; u32x2 ow;
                ow.x = cvt_pk_bf16(o[0] * bflo(zw.x), o[1] * bfhi(zw.x)); ow.y = cvt_pk_bf16(o[2] * bflo(zw.y), o[3] * bfhi(zw.y)); *(u32x2*)(zr + dvb * 16) = ow; }
        }
#undef ATT_LOADK
#undef ATT_LOADV
#undef ATT_STOREK
#undef ATT_STOREV
    }
}

__device__ __forceinline__ void mlstm_a(unsigned char* lds, const Params& p, int l, const int g_wv) {
    constexpr int K2RS = 272, TRS = 160; constexpr int OFF_K2 = 0, OFF_WKT = 64 * K2RS, OFF_VT = OFF_WKT + 128 * TRS, OFF_WG = OFF_VT + 256 * TRS;
    unsigned char* ws = p.ws; int tid = TIDX; asm volatile("" : "+v"(tid)); const int lane = tid & 63, w = tid >> 6, lr = lane & 15, g = lane >> 4;
    const bf16_t* QB = (const bf16_t*)(ws + WS_QB); const bf16_t* KB = (const bf16_t*)(ws + WS_KB); const bf16_t* VB = (const bf16_t*)(ws + WS_VB);
    bf16_t* Q2 = (bf16_t*)(ws + WS_Q2); bf16_t* K2 = (bf16_t*)(ws + WS_K2); const float* gates = (const float*)(ws + WS_GATES);
    const float* cw = p.conv_w + (size_t)l * 4 * 1024; const float* cb = p.conv_b + (size_t)l * 1024;
    float* wg = (float*)(lds + OFF_WG);
    for (int ku = 0; ; ++ku) { int u; { const int cb_ = blockIdx.x; if (gridDim.x == 256) { if (ku >= (cb_ < 128 ? 3 : 5)) break; u = cb_ < 128 ? cb_ + 128 * ku : 384 + (cb_ - 128) + 128 * ku; } else { u = cb_ + ku * (int)gridDim.x; if (u >= 1024) break; } }
        const int bh = u >> 6, c = u & 63, b = bh >> 2, h = bh & 3; const size_t t0 = (size_t)b * SEQ + c * 64;
#pragma unroll 1
        for (int it = 0; it < 4; ++it) {
            const int item = tid + NTHR * it, which = item >> 10, s = (item >> 4) & 63, grp = item & 15; const int ch0 = h * 128 + grp * 8, cc0 = which * 512 + ch0;
            const bf16_t* src = which ? KB : QB; float a[8];
            { const f32x4 b0 = *(const f32x4*)(cb + cc0), b1 = *(const f32x4*)(cb + cc0 + 4); a[0] = b0[0]; a[1] = b0[1]; a[2] = b0[2]; a[3] = b0[3]; a[4] = b1[0]; a[5] = b1[1]; a[6] = b1[2]; a[7] = b1[3]; }
#pragma unroll
            for (int j = 0; j < 4; ++j) { const int tp = c * 64 + s - 3 + j;
                if (tp >= 0) { const u32x4 xw = *(const u32x4*)(src + ((size_t)b * SEQ + tp) * 512 + ch0); const f32x4 w0 = *(const f32x4*)(cw + j * 1024 + cc0), w1 = *(const f32x4*)(cw + j * 1024 + cc0 + 4);
                    a[0] += bflo(xw.x) * w0[0]; a[1] += bfhi(xw.x) * w0[1]; a[2] += bflo(xw.y) * w0[2]; a[3] += bfhi(xw.y) * w0[3];
                    a[4] += bflo(xw.z) * w1[0]; a[5] += bfhi(xw.z) * w1[1]; a[6] += bflo(xw.w) * w1[2]; a[7] += bfhi(xw.w) * w1[3]; } }
            const float ksc = which ? 0.08838834764831845f : 1.0f;
#pragma unroll
            for (int i = 0; i < 8; ++i) a[i] = fsilu(a[i]) * ksc;
            u32x4 ow; ow.x = cvt_pk_bf16(a[0], a[1]); ow.y = cvt_pk_bf16(a[2], a[3]); ow.z = cvt_pk_bf16(a[4], a[5]); ow.w = cvt_pk_bf16(a[6], a[7]);
            *(u32x4*)((which ? K2 : Q2) + (t0 + s) * 512 + ch0) = ow;
            if (which) *(u32x4*)(lds + OFF_K2 + s * K2RS + grp * 16) = ow;
        }
        if (w == 0) {
            const float fpre = gates[(t0 + lane) * 8 + 4 + h] + p.f_bias[l * 4 + h]; const float li = gates[(t0 + lane) * 8 + h] + p.i_bias[l * 4 + h];
            const float lf = fminf(fpre, 0.f) - log1pf(__expf(-fabsf(fpre)));
            float bc = lf;
#pragma unroll
            for (int o = 1; o < 64; o <<= 1) { const float v = shup(bc, o, lane); if (lane >= o) bc += v; }
            const float blast = __int_as_float(__builtin_amdgcn_readlane(__float_as_int(bc), 63)); const float gg = blast - bc + li; float gm = gg;
#pragma unroll
            for (int o = 1; o < 64; o <<= 1) gm = fmaxf(gm, shx(gm, o, lane));
            wg[lane] = __expf(gg - gm);
            ((float*)(ws + WS_BV))[(size_t)u * 64 + lane] = bc; ((float*)(ws + WS_LIV))[(size_t)u * 64 + lane] = li;
            if (lane == 0) { ((float*)(ws + WS_BLAST))[u] = blast; ((float*)(ws + WS_GMAX))[u] = gm; }
        }
#pragma unroll
        for (int it = 0; it < 4; ++it) { const int item = tid + NTHR * it, s = item & 63, eg = item >> 6; const u32x4 vw = *(const u32x4*)(VB + (t0 + s) * 1024 + h * 256 + eg * 8);
            bf16_t* d = (bf16_t*)(lds + OFF_VT + (eg * 8) * TRS + s * 2); const unsigned vv[4] = {vw.x, vw.y, vw.z, vw.w};
#pragma unroll
            for (int i = 0; i < 4; ++i) { *(bf16_t*)((unsigned char*)d + (2 * i) * TRS) = (bf16_t)(vv[i] & 0xffffu); *(bf16_t*)((unsigned char*)d + (2 * i + 1) * TRS) = (bf16_t)(vv[i] >> 16); } }
        __syncthreads();
#pragma unroll
        for (int it = 0; it < 2; ++it) { const int item = tid + NTHR * it, s = item & 63, dg = item >> 6; const u32x4 kw = *(const u32x4*)(lds + OFF_K2 + s * K2RS + dg * 16); const float ww = wg[s];
            const unsigned kv[4] = {kw.x, kw.y, kw.z, kw.w}; unsigned char* d = lds + OFF_WKT + (dg * 8) * TRS + s * 2;
#pragma unroll
            for (int i = 0; i < 4; ++i) { *(bf16_t*)(d + (2 * i) * TRS) = f2bf(bflo(kv[i]) * ww); *(bf16_t*)(d + (2 * i + 1) * TRS) = f2bf(bfhi(kv[i]) * ww); } }
        __syncthreads();
#if defined(MK_DEBUG_HASH)
        { unsigned char* dbg = ws + WS_END + MiB + (size_t)u * 40960; for (int i = tid; i < 2560; i += NTHR) *(u32x4*)(dbg + i * 16) = *(const u32x4*)(lds + OFF_VT + i * 16); }
#endif
        if (tid < 128) { float a = 0.f; const unsigned char* r = lds + OFF_WKT + tid * TRS;
#pragma unroll
            for (int i = 0; i < 8; ++i) { const u32x4 x = *(const u32x4*)(r + i * 16); a += (bflo(x.x) + bfhi(x.x)) + (bflo(x.y) + bfhi(x.y)) + (bflo(x.z) + bfhi(x.z)) + (bflo(x.w) + bfhi(x.w)); }
            ((float*)(ws + WS_NST))[(size_t)u * 128 + tid] = a; }
        f32x4 acc[8][2];
#pragma unroll
        for (int i = 0; i < 8; ++i) { acc[i][0] = zero4(); acc[i][1] = zero4(); }
#pragma unroll
        for (int kc = 0; kc < 2; ++kc) {
            const bf16x8 v0 = *(const bf16x8*)(lds + OFF_VT + (w * 32 + lr) * TRS + kc * 64 + g * 16), v1 = *(const bf16x8*)(lds + OFF_VT + (w * 32 + 16 + lr) * TRS + kc * 64 + g * 16);
#pragma unroll
            for (int db = 0; db < 8; ++db) { const bf16x8 kf = *(const bf16x8*)(lds + OFF_WKT + (db * 16 + lr) * TRS + kc * 64 + g * 16); acc[db][0] = mfma16(kf, v0, acc[db][0]); acc[db][1] = mfma16(kf, v1, acc[db][1]); }
        }
        bf16_t* cst = (bf16_t*)(ws + WS_CST) + (size_t)u * 32768; float one = 1.0f; asm volatile("" : "+v"(one));
#pragma unroll
        for (int eb = 0; eb < 2; ++eb)
#pragma unroll
            for (int db = 0; db < 8; ++db) { const f32x4 av = acc[db][eb] * one; u32x2 o; o.x = cvt_pk_bf16(av[0], av[1]); o.y = cvt_pk_bf16(av[2], av[3]); *(u32x2*)(cst + (size_t)(w * 32 + eb * 16 + lr) * 128 + db * 16 + g * 4) = o; }
        __syncthreads();
    }
}
__device__ __forceinline__ void mlstm_b(const Params& p, const int g_wv) {
    unsigned char* ws = p.ws; int tid = TIDX; asm volatile("" : "+v"(tid)); const float* blast = (const float*)(ws + WS_BLAST); const float* gmax = (const float*)(ws + WS_GMAX);
    for (int u = blockIdx.x; u < 256; u += gridDim.x) {
        const int bh = u >> 4, eb = u & 15; bf16_t* base = (bf16_t*)(ws + WS_CST) + (size_t)bh * 64 * 32768 + eb * 2048 + tid * 4;
        float* nb = (float*)(ws + WS_NST) + (size_t)bh * 64 * 128 + tid; const bool don = (eb == 0 && tid < 128);
        float m = 0.f, c0 = 0.f, c1 = 0.f, c2 = 0.f, c3 = 0.f, nn = 0.f;
#pragma unroll 16
        for (int c = 0; c < 64; ++c) {
            const float bl = blast[bh * 64 + c], gm = gmax[bh * 64 + c]; const float mn = fmaxf(bl + m, gm); const float dec = __expf(bl + m - mn), inw = __expf(gm - mn);
            u32x2* sp = (u32x2*)(base + (size_t)c * 32768); const u32x2 uw = *sp; u32x2 o; o.x = cvt_pk_bf16(c0, c1); o.y = cvt_pk_bf16(c2, c3); *sp = o;
            c0 = dec * c0 + inw * bflo(uw.x); c1 = dec * c1 + inw * bfhi(uw.x); c2 = dec * c2 + inw * bflo(uw.y); c3 = dec * c3 + inw * bfhi(uw.y);
            if (don) { const float nu = nb[c * 128]; nb[c * 128] = nn; nn = dec * nn + inw * nu; }
            if (eb == 0 && tid == 0) ((float*)(ws + WS_MST))[bh * 64 + c] = m;
            m = mn;
        }
        asm volatile("s_waitcnt vmcnt(0)" ::: "memory"); __syncthreads();
        if (tid == 0) { __builtin_amdgcn_fence(__ATOMIC_RELEASE, "agent"); asm volatile("s_waitcnt vmcnt(0)" ::: "memory");
            __hip_atomic_fetch_add((unsigned*)(ws + WS_CTR) + 16 + bh, 1u, __ATOMIC_RELAXED, __HIP_MEMORY_SCOPE_AGENT); }
    }
}
__device__ __forceinline__ void mlstm_c(unsigned char* lds, const Params& p, int l, const int g_wv) {
    constexpr int QRS = 288, TRS = 160; constexpr int OFF_Q = 0, OFF_K = 64 * QRS, OFF_VT = 2 * 64 * QRS, OFF_P = OFF_VT + 256 * TRS, OFF_F = OFF_P + 64 * TRS;
    unsigned char* ws = p.ws; int tid = TIDX; asm volatile("" : "+v"(tid)); const int lane = tid & 63, w = tid >> 6, lr = lane & 15, g = lane >> 4;
    const bf16_t* Q2 = (const bf16_t*)(ws + WS_Q2); const bf16_t* K2 = (const bf16_t*)(ws + WS_K2); const bf16_t* VB = (const bf16_t*)(ws + WS_VB);
    const bf16_t* OB = (const bf16_t*)(ws + WS_OB); bf16_t* ZB = (bf16_t*)(ws + WS_Z + 32 * MiB); const float* gn = p.out_norm + (size_t)l * 1024;
    float* fb = (float*)(lds + OFF_F); float* bvec = fb; float* livec = fb + 64; float* mt = fb + 128; float* wint = fb + 192; float* denV = fb + 256; float* denC = fb + 320; float* lsum = fb + 384; float* lsq = fb + 448; float* nvec = fb + 512;
    for (int u = blockIdx.x; u < 1024; u += gridDim.x) {
        const int bh = u >> 6, c = u & 63, b = bh >> 2, h = bh & 3; const size_t t0 = (size_t)b * SEQ + c * 64;
        if (tid == 0) { const unsigned want = 16u * (unsigned)(l + 1); while (__hip_atomic_load((unsigned*)(ws + WS_CTR) + 16 + bh, __ATOMIC_RELAXED, __HIP_MEMORY_SCOPE_AGENT) < want) __builtin_amdgcn_s_sleep(1);
            __builtin_amdgcn_fence(__ATOMIC_ACQUIRE, "agent"); asm volatile("s_waitcnt vmcnt(0)" ::: "memory"); }
        __syncthreads();
        const float mc = ((const float*)(ws + WS_MST))[u];
#pragma unroll
        for (int it = 0; it < 2; ++it) { const int id = tid + NTHR * it, s = id >> 4, ch = id & 15;
            *(u32x4*)(lds + OFF_Q + s * QRS + ch * 16) = *(const u32x4*)(Q2 + (t0 + s) * 512 + h * 128 + ch * 8); *(u32x4*)(lds + OFF_K + s * QRS + ch * 16) = *(const u32x4*)(K2 + (t0 + s) * 512 + h * 128 + ch * 8); }
#pragma unroll 2
        for (int it = 0; it < 4; ++it) { const int item = tid + NTHR * it, s = item & 63, eg = item >> 6; const u32x4 vw = *(const u32x4*)(VB + (t0 + s) * 1024 + h * 256 + eg * 8);
            unsigned char* d = lds + OFF_VT + (eg * 8) * TRS + s * 2; const unsigned vv[4] = {vw.x, vw.y, vw.z, vw.w};
#pragma unroll
            for (int i = 0; i < 4; ++i) { *(bf16_t*)(d + (2 * i) * TRS) = (bf16_t)(vv[i] & 0xffffu); *(bf16_t*)(d + (2 * i + 1) * TRS) = (bf16_t)(vv[i] >> 16); } }
        if (tid < 64) { bvec[tid] = ((const float*)(ws + WS_BV))[(size_t)u * 64 + tid]; livec[tid] = ((const float*)(ws + WS_LIV))[(size_t)u * 64 + tid]; lsum[tid] = 0.f; lsq[tid] = 0.f; }
        else if (tid < 192) nvec[tid - 64] = ((const float*)(ws + WS_NST))[(size_t)u * 128 + tid - 64];
        __syncthreads();
        if (w == 0) { float x = livec[lane] - bvec[lane];
#pragma unroll
            for (int o = 1; o < 64; o <<= 1) { const float v = shup(x, o, lane); if (lane >= o) x = fmaxf(x, v); }
            const float mtl = bvec[lane] + fmaxf(mc, x); mt[lane] = mtl; wint[lane] = __expf(bvec[lane] + mc - mtl); }
        __syncthreads();
        { const int lb = w >> 1;
#pragma unroll
          for (int si = 0; si < 2; ++si) { const int sb = (w & 1) * 2 + si; f32x4 a = zero4();
            if (sb <= lb) {
#pragma unroll
                for (int kc = 0; kc < 4; ++kc) { const bf16x8 qf = *(const bf16x8*)(lds + OFF_Q + (lb * 16 + lr) * QRS + kc * 64 + g * 16), kf = *(const bf16x8*)(lds + OFF_K + (sb * 16 + lr) * QRS + kc * 64 + g * 16); a = mfma16(qf, kf, a); }
            }
            const int s = sb * 16 + lr; const float bs = bvec[s] - livec[s];
#pragma unroll
            for (int r = 0; r < 4; ++r) { const int ll = lb * 16 + g * 4 + r; float v = 0.f; if (s <= ll) v = a[r] * __expf(bvec[ll] - bs - mt[ll]); *(bf16_t*)(lds + OFF_P + ll * TRS + s * 2) = f2bf(v); } } }
        __syncthreads();
        if (w == 0) { float a = 0.f; const unsigned char* r = lds + OFF_P + lane * TRS;
#pragma unroll
            for (int i = 0; i < 8; ++i) { const u32x4 x = *(const u32x4*)(r + i * 16); a += (bflo(x.x) + bfhi(x.x)) + (bflo(x.y) + bfhi(x.y)) + (bflo(x.z) + bfhi(x.z)) + (bflo(x.w) + bfhi(x.w)); }
            denV[lane] = a; }
        else if (w == 1) { float a = 0.f; const unsigned char* r = lds + OFF_Q + lane * QRS;
#pragma unroll
            for (int i = 0; i < 16; ++i) { const u32x4 x = *(const u32x4*)(r + i * 16); const float* nv = nvec + i * 8;
                a += bflo(x.x) * nv[0] + bfhi(x.x) * nv[1] + bflo(x.y) * nv[2] + bfhi(x.y) * nv[3] + bflo(x.z) * nv[4] + bfhi(x.z) * nv[5] + bflo(x.w) * nv[6] + bfhi(x.w) * nv[7]; }
            denC[lane] = a; }
        f32x4 accV[2][4], accC[2][4];
#pragma unroll
        for (int i = 0; i < 2; ++i)
#pragma unroll
            for (int j = 0; j < 4; ++j) { accV[i][j] = zero4(); accC[i][j] = zero4(); }
        const bf16_t* cst = (const bf16_t*)(ws + WS_CST) + (size_t)u * 32768;
#pragma unroll
        for (int kp = 0; kp < 2; ++kp) {
        bf16x8 ctf[2][2];
#pragma unroll
        for (int k2 = 0; k2 < 2; ++k2) { const int kc = kp * 2 + k2; ctf[k2][0] = *(const bf16x8*)(cst + (size_t)(w * 32 + lr) * 128 + kc * 32 + g * 8); ctf[k2][1] = *(const bf16x8*)(cst + (size_t)(w * 32 + 16 + lr) * 128 + kc * 32 + g * 8); }
#pragma unroll
        for (int k2 = 0; k2 < 2; ++k2) { const int kc = kp * 2 + k2;
            const bf16x8 c0 = ctf[k2][0], c1 = ctf[k2][1];
#pragma unroll
            for (int lb = 0; lb < 4; ++lb) { const bf16x8 qf = *(const bf16x8*)(lds + OFF_Q + (lb * 16 + lr) * QRS + kc * 64 + g * 16); accC[0][lb] = mfma16(c0, qf, accC[0][lb]); accC[1][lb] = mfma16(c1, qf, accC[1][lb]); }
        }
        }
#pragma unroll
        for (int kc = 0; kc < 2; ++kc) {
            const bf16x8 v0 = *(const bf16x8*)(lds + OFF_VT + (w * 32 + lr) * TRS + kc * 64 + g * 16), v1 = *(const bf16x8*)(lds + OFF_VT + (w * 32 + 16 + lr) * TRS + kc * 64 + g * 16);
#pragma unroll
            for (int lb = 0; lb < 4; ++lb) { const bf16x8 pf = *(const bf16x8*)(lds + OFF_P + (lb * 16 + lr) * TRS + kc * 64 + g * 16); accV[0][lb] = mfma16(v0, pf, accV[0][lb]); accV[1][lb] = mfma16(v1, pf, accV[1][lb]); }
        }
        __syncthreads();
#pragma unroll
        for (int lb = 0; lb < 4; ++lb) { const int ll = lb * 16 + lr; const float wi = wint[ll]; const float den = wi * denC[ll] + denV[ll]; const float dn = 1.0f / fmaxf(fabsf(den), __expf(-mt[ll])); float s1 = 0.f, s2 = 0.f;
#pragma unroll
            for (int eb = 0; eb < 2; ++eb) { const f32x4 hv = (accC[eb][lb] * wi + accV[eb][lb]) * dn; accV[eb][lb] = hv; s1 += (hv[0] + hv[1]) + (hv[2] + hv[3]); s2 += (hv[0] * hv[0] + hv[1] * hv[1]) + (hv[2] * hv[2] + hv[3] * hv[3]); }
            s1 += shx(s1, 16, lane); s1 += shx(s1, 32, lane); s2 += shx(s2, 16, lane); s2 += shx(s2, 32, lane);
            if (g == 0) { fb[640 + w * 64 + ll] = s1; fb[1152 + w * 64 + ll] = s2; } }
        __syncthreads();
#pragma unroll
        for (int lb = 0; lb < 4; ++lb) { const int ll = lb * 16 + lr; float t1 = 0.f, t2 = 0.f;
#pragma unroll
            for (int ww = 0; ww < 8; ++ww) { t1 += fb[640 + ww * 64 + ll]; t2 += fb[1152 + ww * 64 + ll]; }
            const float mu = t1 * (1.0f / 256.0f); const float var = fmaxf(t2 * (1.0f / 256.0f) - mu * mu, 0.f); const float rstd = rsqrtf(var + EPS);
#pragma unroll
            for (int eb = 0; eb < 2; ++eb) { const int e = w * 32 + eb * 16 + g * 4; const size_t off = (t0 + ll) * 1024 + h * 256 + e; const f32x4 gv = *(const f32x4*)(gn + h * 256 + e);
                const u32x2 ow = *(const u32x2*)(OB + off), zw = *(const u32x2*)(ZB + off); const f32x4 hv = accV[eb][lb]; u32x2 o;
                o.x = cvt_pk_bf16((hv[0] - mu) * rstd * gv[0] * bflo(ow.x) * bflo(zw.x), (hv[1] - mu) * rstd * gv[1] * bfhi(ow.x) * bfhi(zw.x));
                o.y = cvt_pk_bf16((hv[2] - mu) * rstd * gv[2] * bflo(ow.y) * bflo(zw.y), (hv[3] - mu) * rstd * gv[3] * bfhi(ow.y) * bfhi(zw.y)); *(u32x2*)(ZB + off) = o; } }
        __syncthreads();
    }
}

#ifndef PHM
#define PHM 4095
#endif
typedef const __attribute__((address_space(4))) Params* KParams;
#if defined(__HIP_DEVICE_COMPILE__)
__device__ __forceinline__ Params load_params() { KParams k = (KParams)__builtin_amdgcn_kernarg_segment_ptr(); asm volatile("" : "+s"(k)); return *k; }
#else
__device__ __forceinline__ Params load_params() { return Params{}; }
#endif
#define PP load_params()
#define GSYNC() do { asm volatile("s_waitcnt vmcnt(0) lgkmcnt(0)" ::: "memory"); __builtin_amdgcn_fence(__ATOMIC_RELEASE, "agent"); asm volatile("s_waitcnt vmcnt(0)" ::: "memory"); grid.sync(); \
    __builtin_amdgcn_fence(__ATOMIC_ACQUIRE, "agent"); asm volatile("s_waitcnt vmcnt(0) lgkmcnt(0)" ::: "memory"); } while (0)
__device__ __forceinline__ void gbar(unsigned* ctr, unsigned target, const int g_wv) {
    asm volatile("s_waitcnt vmcnt(0) lgkmcnt(0)" ::: "memory");
    __syncthreads();
    if (TIDX == 0) {
        __builtin_amdgcn_fence(__ATOMIC_RELEASE, "agent"); asm volatile("s_waitcnt vmcnt(0)" ::: "memory");
        __hip_atomic_fetch_add(ctr, 1u, __ATOMIC_RELAXED, __HIP_MEMORY_SCOPE_AGENT);
        while (__hip_atomic_load(ctr, __ATOMIC_RELAXED, __HIP_MEMORY_SCOPE_AGENT) < target) __builtin_amdgcn_s_sleep(1);
        __builtin_amdgcn_fence(__ATOMIC_ACQUIRE, "agent"); asm volatile("s_waitcnt vmcnt(0)" ::: "memory");
    }
    __syncthreads();
}
template <bool AL = true, bool SP = true, class Epi, class Sched> __device__ __forceinline__ void run_gemm(unsigned char* lds, const bf16_t* A, const bf16_t* Bt, int M, int N, int K, int lda, int ldb, const Sched& S, const Epi& E, const int g_wv) {
    pg8::Gemm g{A, Bt, M, N, K, lda, ldb};
    pg8::gemm_phase<Epi, Sched, AL, SP>((PG8_LAS unsigned char*)lds, g, S, E, g_wv);
    __syncthreads();
}

__global__ void __launch_bounds__(NTHR, 2) mega(Params p_arg) {
    extern __shared__ __attribute__((aligned(16))) unsigned char lds[];
    cg::grid_group grid = cg::this_grid();
    const int g_wv = __builtin_amdgcn_readfirstlane((int)(__builtin_amdgcn_workitem_id_x() >> 6));
    const int G = gridDim.x, cb = blockIdx.x; const int w_lo = p_arg.w_lo, w_hi = p_arg.w_hi;
#define WIN(k_) (w_lo <= (k_) && (k_) < w_hi)
    unsigned nbar = 0;
#define SEAM(k_) do { if (WIN(k_) && WIN((k_) + 1)) { ++nbar; gbar((unsigned*)(PP.ws + WS_CTR), nbar * (unsigned)G, g_wv); } } while (0)
    if (w_lo > 1000) GSYNC();
    if (WIN(0)) {
#if PHM & 1
    convert_weights(lds, PP, 0, g_wv); convert_weights(lds, PP, 1, g_wv);
#endif
#if PHM & 2
    build_cs(PP, g_wv);
    { const Params p = PP; rmsnorm_rows<true>(p.x, p.norm_gain, (bf16_t*)(p.ws + WS_H), nullptr, g_wv); }
#endif
    }
    SEAM(0);
#pragma unroll 1
    for (int l = 0; l < 2; ++l) {
        const int wb = 1 + 7 * l;
        if (WIN(wb)) {
#if PHM & 4
        { unsigned char* ws = PP.ws; unsigned char* wl = ws + WS_W0 + (size_t)l * WL_SIZE; const f32x2* cs = (const f32x2*)(ws + WS_CS); (void)cs; (void)wl; pg8::StaticOrder S; S.init(T, 15360, G, cb); EpiIn E{ws}; run_gemm(lds, (const bf16_t*)(ws + WS_H), (const bf16_t*)(wl + WL_WIN), T, 15360, DM, DM, DM, S, E, g_wv); }
        { unsigned char* ws = PP.ws; unsigned char* wl = ws + WS_W0 + (size_t)l * WL_SIZE; const f32x2* cs = (const f32x2*)(ws + WS_CS); (void)cs; (void)wl; pg8::StaticOrder S; S.init(1024, T, G, cb); EpiVT E{(bf16_t*)(ws + WS_VAT), T, nullptr, 0.f}; run_gemm(lds, (const bf16_t*)(wl + WL_WIN) + (size_t)15360 * DM, (const bf16_t*)(ws + WS_H), 1024, T, DM, DM, DM, S, E, g_wv); }
#endif
        }
        SEAM(wb);
        if (WIN(wb + 1)) {
#if PHM & 32
        mlstm_a(lds, PP, l, g_wv);
#endif
#if PHM & 16
        kmean_phase(PP, l, g_wv);
#endif
#if PHM & 8
        { unsigned char* ws = PP.ws; unsigned char* wl = ws + WS_W0 + (size_t)l * WL_SIZE; const f32x2* cs = (const f32x2*)(ws + WS_CS); (void)cs; (void)wl; pg8::StaticOrder S; S.init(T, 1536, G, cb); EpiRow<true> E{(bf16_t*)(ws + WS_QC), 1536, (const float*)(ws + WS_SSP), 1.0f / 512.0f, CC_SCALE, cs}; run_gemm(lds, (const bf16_t*)(ws + WS_CQ), (const bf16_t*)(wl + WL_WUQ), T, 1536, 512, 512, 512, S, E, g_wv); }
        { unsigned char* ws = PP.ws; unsigned char* wl = ws + WS_W0 + (size_t)l * WL_SIZE; const f32x2* cs = (const f32x2*)(ws + WS_CS); (void)cs; (void)wl; pg8::StaticOrder S; S.init(T, 1024, G, cb); EpiRow<false> E{(bf16_t*)(ws + WS_KNC), 1024, (const float*)(ws + WS_SSP), 1.0f / 256.0f, 1.0f, cs}; run_gemm(lds, (const bf16_t*)(ws + WS_CKV), (const bf16_t*)(wl + WL_WKN), T, 1024, 256, 256, 256, S, E, g_wv); }
        { unsigned char* ws = PP.ws; unsigned char* wl = ws + WS_W0 + (size_t)l * WL_SIZE; const f32x2* cs = (const f32x2*)(ws + WS_CS); (void)cs; (void)wl; pg8::StaticOrder S; S.init(1024, T, G, cb); EpiVT E{(bf16_t*)(ws + WS_VCT), T, (const float*)(ws + WS_SSP), 1.0f / 256.0f}; run_gemm(lds, (const bf16_t*)(wl + WL_WV), (const bf16_t*)(ws + WS_CKV), 1024, T, 256, 256, 256, S, E, g_wv); }
#endif
        }
        SEAM(wb + 1);
        if (WIN(wb + 2)) {
#if PHM & 128
        mlstm_b(PP, g_wv);
#endif
#if PHM & 64
        attn_phase<0>(lds, PP, l, g_wv);
#endif
        }
        if (WIN(wb + 3)) {
#if PHM & 256
        attn_phase<1>(lds, PP, l, g_wv);
#endif
#if PHM & 512
        mlstm_c(lds, PP, l, g_wv);
#endif
        }
        SEAM(wb + 3);
        if (WIN(wb + 4)) {
#if PHM & 1024
        { unsigned char* ws = PP.ws; unsigned char* wl = ws + WS_W0 + (size_t)l * WL_SIZE; MergeOrder S{G, cb}; EpiMerge E{(bf16_t*)(ws + WS_H), (const bf16_t*)(ws + WS_GT)}; run_gemm(lds, (const bf16_t*)(ws + WS_Z), (const bf16_t*)(wl + WL_WB), 3 * T, 2048, 1024, 1024, 1024, S, E, g_wv); }
#endif
        }
        SEAM(wb + 4);
        if (WIN(wb + 5)) {
#if PHM & 2048
        { unsigned char* ws = PP.ws; unsigned char* wl = ws + WS_W0 + (size_t)l * WL_SIZE; const f32x2* cs = (const f32x2*)(ws + WS_CS); (void)cs; (void)wl; pg8::StaticOrder S; S.init(T, DM, G, cb); const Params p = PP; EpiOut E{l == 0 ? p.x : p.out, p.out}; run_gemm(lds, (const bf16_t*)(ws + WS_H), (const bf16_t*)(wl + WL_WO), T, DM, DM, DM, DM, S, E, g_wv); }
#endif
        }
        SEAM(wb + 5);
        if (WIN(wb + 6)) {
            if (l == 0) { const Params p = PP; rmsnorm_rows<true>(p.out, p.norm_gain + DM, (bf16_t*)(p.ws + WS_H), nullptr, g_wv); }
            else { const Params p = PP; rmsnorm_rows<false>(p.out, p.final_norm, nullptr, p.out, g_wv); }
        }
        if (l == 0) SEAM(wb + 6);
    }
}


#if defined(MK_DEBUG_HASH)
__global__ void hash_buf(const unsigned* p, size_t nwords, unsigned long long* acc) {
    unsigned long long s = 0; const size_t stride = (size_t)gridDim.x * blockDim.x;
    for (size_t i = (size_t)blockIdx.x * blockDim.x + threadIdx.x; i < nwords; i += stride) s += (unsigned long long)p[i] * (unsigned long long)(((unsigned)i * 2654435761u) | 1u);
    atomicAdd(acc, s);
}
__global__ void dbg_final(float* out, size_t n, const unsigned long long* h, int R, int NK) {
    __shared__ float flag;
    if (threadIdx.x == 0) { float f = 1.0f; for (int k = NK - 1; k >= 0; --k) for (int r = 1; r < R; ++r) if (h[r * NK + k] != h[k]) { f = 100.0f; for (int q = 0; q < k; ++q) f *= 10.0f; } flag = f; }
    __syncthreads();
    for (size_t i = (size_t)blockIdx.x * blockDim.x + threadIdx.x; i < n; i += (size_t)gridDim.x * blockDim.x) out[i] = (i == 0) ? flag : 0.0f;
}
#endif
extern "C" void kernel_launch(void* const* d_in, const int* in_sizes, int n_in, void* d_out, int out_size, void* d_ws, size_t ws_size, hipStream_t stream) {
    static int grid = 0;
    if (grid == 0) {
        if (n_in != 16 || ws_size < WS_END) { fprintf(stderr, "kernel_launch: unexpected n_in %d or ws_size %zu < %zu\n", n_in, ws_size, (size_t)WS_END); grid = -1; return; }
        int dev = 0, cus = 0, per_cu = 0;
        hipGetDevice(&dev); hipDeviceGetAttribute(&cus, hipDeviceAttributeMultiprocessorCount, dev);
        if (hipFuncSetAttribute((const void*)mega, hipFuncAttributeMaxDynamicSharedMemorySize, LDS_BYTES) != hipSuccess) { fprintf(stderr, "kernel_launch: hipFuncSetAttribute failed\n"); grid = -1; return; }
        if (hipOccupancyMaxActiveBlocksPerMultiprocessor(&per_cu, (const void*)mega, NTHR, LDS_BYTES) != hipSuccess || per_cu < 1) { fprintf(stderr, "kernel_launch: occupancy query gave %d\n", per_cu); per_cu = 1; }
        (void)hipGetLastError();
        grid = cus * 1;
    }
    if (grid < 0) return;
    Params p{};
    p.x = (const float*)d_in[0]; p.norm_gain = (const float*)d_in[1]; p.w_in = (const float*)d_in[2]; p.t5 = (const float*)d_in[3]; p.conv_w = (const float*)d_in[4]; p.conv_b = (const float*)d_in[5];
    p.i_bias = (const float*)d_in[6]; p.f_bias = (const float*)d_in[7]; p.out_norm = (const float*)d_in[8]; p.q_norm = (const float*)d_in[9]; p.kv_norm = (const float*)d_in[10];
    p.w_uq = (const float*)d_in[11]; p.w_ukv = (const float*)d_in[12]; p.w_branch = (const float*)d_in[13]; p.w_out = (const float*)d_in[14]; p.final_norm = (const float*)d_in[15];
    p.out = (float*)d_out; p.ws = (unsigned char*)d_ws;
    (void)hipMemsetAsync((unsigned char*)d_ws + WS_CTR, 0, 256, stream);
    void* args[] = {&p};
#if defined(MK_DEBUG_HASH)
    {
        constexpr int R = 4, NK = 9; unsigned char* W = (unsigned char*)d_ws; unsigned long long* H = (unsigned long long*)(W + WS_END);
        hipMemsetAsync(H, 0, R * NK * 8, stream);
        struct HB { int win; size_t off; size_t bytes; };
        const HB hb[NK] = { {3, WS_Z, 32 * MiB}, {3, WS_CST, 64 * MiB}, {3, WS_NST, 524288}, {3, WS_MST, 4096},
                            {4, WS_Z + 64 * MiB, 32 * MiB}, {4, WS_Z + 32 * MiB, 32 * MiB}, {5, WS_H, 64 * MiB}, {6, WS_H, 64 * MiB}, {2, WS_CST, 64 * MiB} };
        for (int r = 0; r < R; ++r)
            for (int w = 0; w < 7; ++w) { p.w_lo = w; p.w_hi = w + 1;
                hipError_t e = hipLaunchCooperativeKernel((const void*)mega, dim3(grid), dim3(NTHR), args, LDS_BYTES, stream);
                if (e != hipSuccess) fprintf(stderr, "kernel_launch: cooperative launch failed: %s\n", hipGetErrorString(e));
                for (int k = 0; k < NK; ++k) if (hb[k].win == w) {
                    if (k == 7) hash_buf<<<256, 256, 0, stream>>>((const unsigned*)d_out, (size_t)T * DM, H + r * NK + k);
                    else hash_buf<<<256, 256, 0, stream>>>((const unsigned*)(W + hb[k].off), hb[k].bytes / 4, H + r * NK + k); } }
        dbg_final<<<256, 256, 0, stream>>>((float*)d_out, (size_t)T * DM, H, R, NK);
    }
    if (false) {
#elif defined(MK_MULTI)
    for (int w = 0; w < 15; ++w) { p.w_lo = w; p.w_hi = w + 1;
#else
    { p.w_lo = 0; p.w_hi = 15;
#endif
        hipError_t e = hipLaunchCooperativeKernel((const void*)mega, dim3(grid), dim3(NTHR), args, LDS_BYTES, stream);
        if (e != hipSuccess) fprintf(stderr, "kernel_launch: cooperative launch failed: %s (grid %d)\n", hipGetErrorString(e), grid);
    }
}
```

```cpp
#include <hip/hip_runtime.h>
#include <hip/hip_cooperative_groups.h>
#include <cstdio>
#include <cstdint>
namespace cg = cooperative_groups;
__device__ __forceinline__ int tidx_opaque(int g_wv) { int l; asm volatile("v_mbcnt_lo_u32_b32 %0, -1, 0\n\tv_mbcnt_hi_u32_b32 %0, -1, %0" : "=v"(l)); return g_wv * 64 + l; }
#define TIDX tidx_opaque(g_wv)
__device__ __forceinline__ float shx(float v, int o, int lane) { return __int_as_float(__builtin_amdgcn_ds_bpermute(((lane ^ o) & 63) << 2, __float_as_int(v))); }
__device__ __forceinline__ int shxi(int v, int o, int lane) { return __builtin_amdgcn_ds_bpermute(((lane ^ o) & 63) << 2, v); }
__device__ __forceinline__ float shup(float v, int o, int lane) { return __int_as_float(__builtin_amdgcn_ds_bpermute(((lane - o) & 63) << 2, __float_as_int(v))); }

namespace pg8 {
#define PG8_LAS __attribute__((address_space(3)))
typedef unsigned short bf16_t;
typedef short bf16x8 __attribute__((ext_vector_type(8)));
typedef float f32x4 __attribute__((ext_vector_type(4)));
typedef unsigned u32x4 __attribute__((ext_vector_type(4)));
constexpr int BM = 256, BK = 64, HALF = 128, HTB = HALF * BK * 2  , STAGE_BYTES = 8 * HTB, NXCD = 8, WGM = 8;

__host__ __device__ __forceinline__ int lds_byte(int r, int c) { const int st = (r >> 4) * 2 + (c >> 5), rr = r & 15, cc = c & 31, ob = rr * 64 + cc * 2; return st * 1024 + (ob ^ (((ob >> 9) & 1) << 5)); }
__host__ __device__ __forceinline__ void stage_rc(int b, int& R, int& C) { const int st = b / 1024, sb = b % 1024, swz = sb ^ (((sb >> 9) & 1) << 5); R = (st >> 1) * 16 + swz / 64; C = (st & 1) * 32 + (swz % 64) / 2; }
__host__ __device__ __forceinline__ int perm32(int rho) { const int n = rho >> 4, i = rho & 15; return 8 * (i >> 2) + 4 * n + (i & 3); }

struct Unit { int pm, pn, pb; };
struct Gemm { const bf16_t* A; const bf16_t* Bt; int M, N, K, lda, ldb; };

struct StaticOrder {
    int nM, nN, nwg, G, c;
    __host__ __device__ void init(int M, int N, int G_, int c_) { nM = M / BM; nN = N / BM; nwg = nM * nN; G = G_; c = c_; }
    __host__ __device__ bool next(int i, Unit& u) const {
        const long L = (long)i * G + c; if (L >= nwg) return false;
        int wgid = (int)L; { const int q = nwg / NXCD, r = nwg % NXCD, xcd = wgid % NXCD, off = wgid / NXCD; wgid = (xcd < r ? xcd * (q + 1) : r * (q + 1) + (xcd - r) * q) + off; }
        const int nig = WGM * nN, gid = wgid / nig, fm = gid * WGM, gsz = (nM - fm) < WGM ? (nM - fm) : WGM;
        u.pm = fm + ((wgid % nig) % gsz); u.pn = (wgid % nig) / gsz; u.pb = u.pn; return true;
    }
    __device__ __forceinline__ void a_ready(const Unit&) const {}
    __device__ __forceinline__ void done(const Unit&) const {}
};

__device__ __forceinline__ unsigned cvt_pk_bf16(float lo, float hi) { unsigned r; asm volatile("s_nop 1\n\tv_cvt_pk_bf16_f32 %0, %1, %2\n\ts_nop 1" : "=v"(r) : "v"(lo), "v"(hi)); return r; }
template <class Epi, class Sched, bool ALIGN_EPI = false, bool SP2 = false>
__device__ __forceinline__ void gemm_phase(PG8_LAS unsigned char* lds, const Gemm g, const Sched& S, const Epi& E, const int g_wv) {
    int tid = TIDX; asm volatile("" : "+v"(tid)); const int wid = __builtin_amdgcn_readfirstlane(tid >> 6), lane = tid & 63, wr = wid >> 2, wc = wid & 3, fr = lane & 15, fq = lane >> 4;
    const int K = g.K, nt = K / BK;
    unsigned voffA[2], voffB[2];
#pragma unroll
    for (int i = 0; i < 2; ++i) { int R, C; stage_rc(tid * 16 + i * 8192, R, C); const int Rb = Epi::PERM ? ((R & ~31) + perm32(R & 31)) : R;
        voffA[i] = (unsigned)(R * K + C) * 2u; voffB[i] = (unsigned)(Rb * K + C) * 2u; }
    const size_t kstep = (size_t)(BK * 2);
    const size_t hstepA = (size_t)HALF * K * 2; const size_t hstepB = hstepA;
    const size_t tstepA = 2 * hstepA; const size_t tstepB = tstepA;
    const unsigned ldsw = (unsigned)wid * 1024u;
    const int aoff = lds_byte(wr * 64 + fr, fq * 8), boff = lds_byte(wc * 32 + fr, fq * 8);
#define PG8_SA(b, h) (((b) * 2 + (h)) * HTB)
#define PG8_SB(b, h) ((4 + (b) * 2 + (h)) * HTB)
#define PG8_STAGE(bufoff, gbase, voff) do { _Pragma("unroll") for (int _i = 0; _i < 2; ++_i) \
        __builtin_amdgcn_global_load_lds((const unsigned*)((const char*)(gbase) + (voff)[_i]), (PG8_LAS unsigned*)(lds + (bufoff) + ldsw + _i * 8192), 16, 0, 0); } while (0)
#define PG8_LDA(dst, b, h) do { _Pragma("unroll") for (int m = 0; m < 4; ++m) _Pragma("unroll") for (int k = 0; k < 2; ++k) dst[m][k] = *(const PG8_LAS bf16x8*)(lds + PG8_SA(b, h) + aoff + m * 2048 + k * 1024); } while (0)
#define PG8_LDB(dst, b, h) do { _Pragma("unroll") for (int n = 0; n < 2; ++n) _Pragma("unroll") for (int k = 0; k < 2; ++k) dst[n][k] = *(const PG8_LAS bf16x8*)(lds + PG8_SB(b, h) + boff + n * 2048 + k * 1024); } while (0)
#define PG8_MMA(ai, bj, At, Bt) do { __builtin_amdgcn_s_setprio(1); _Pragma("unroll") for (int m = 0; m < 4; ++m) _Pragma("unroll") for (int n = 0; n < 2; ++n) _Pragma("unroll") for (int k = 0; k < 2; ++k) \
        acc[ai][bj][m][n] = __builtin_amdgcn_mfma_f32_16x16x32_bf16(Bt[n][k], At[m][k], acc[ai][bj][m][n], 0, 0, 0); __builtin_amdgcn_s_setprio(0); } while (0)
#define PG8_WAIT_V(n) asm volatile("s_waitcnt vmcnt(" #n ")" ::: "memory")
#define PG8_WAIT_L(n) asm volatile("s_waitcnt lgkmcnt(" #n ")" ::: "memory")
#define PG8_BAR __builtin_amdgcn_s_barrier()
#define PG8_SCHED __builtin_amdgcn_sched_barrier(0)
    Unit cur, nxt; int ui = 0;
    if (!S.next(0, cur)) return;
    f32x4 acc[2][2][4][2];
#pragma unroll
    for (int a = 0; a < 2; ++a)
#pragma unroll
        for (int b = 0; b < 2; ++b)
#pragma unroll
            for (int m = 0; m < 4; ++m)
#pragma unroll
                for (int n = 0; n < 2; ++n) acc[a][b][m][n] = (f32x4){0.f, 0.f, 0.f, 0.f};
    bf16x8 At[4][2], B0[2][2], B1[2][2];
    const char* cA = (const char*)g.A + (size_t)cur.pm * tstepA; const char* cB = (const char*)g.Bt + (size_t)cur.pb * tstepB;
    S.a_ready(cur);
    if constexpr (SP2) {
        PG8_STAGE(PG8_SB(0, 0), cB, voffB); PG8_STAGE(PG8_SB(0, 1), cB + hstepB, voffB); PG8_STAGE(PG8_SA(0, 0), cA, voffA); PG8_STAGE(PG8_SA(0, 1), cA + hstepA, voffA);
        if (wr == 1) PG8_BAR;
        PG8_WAIT_V(2); PG8_BAR;
        PG8_STAGE(PG8_SB(1, 0), cB + kstep, voffB); PG8_STAGE(PG8_SA(1, 0), cA + kstep, voffA); PG8_STAGE(PG8_SB(1, 1), cB + hstepB + kstep, voffB);
        PG8_WAIT_V(6); PG8_BAR;
    } else {
        PG8_STAGE(PG8_SB(0, 0), cB, voffB); PG8_STAGE(PG8_SA(0, 0), cA, voffA); PG8_STAGE(PG8_SB(0, 1), cB + hstepB, voffB); PG8_STAGE(PG8_SA(0, 1), cA + hstepA, voffA);
        if (wr == 1) PG8_BAR;
        PG8_WAIT_V(4); PG8_BAR;
        PG8_STAGE(PG8_SB(1, 0), cB + kstep, voffB); PG8_STAGE(PG8_SA(1, 0), cA + kstep, voffA); PG8_STAGE(PG8_SB(1, 1), cB + hstepB + kstep, voffB);
        PG8_WAIT_V(6); PG8_BAR;
    }
    for (;;) {
        const bool has_next = S.next(ui + 1, nxt);
        const char* nA = has_next ? (const char*)g.A + (size_t)nxt.pm * tstepA : cA; const char* nB = has_next ? (const char*)g.Bt + (size_t)nxt.pb * tstepB : cB;
        for (int t = 0; t < nt; t += 2) {
            const bool last = (t == nt - 2);
            const char* a1 = cA + (size_t)(t + 1) * kstep;
            const char* a2 = last ? nA : cA + (size_t)(t + 2) * kstep; const char* b2 = last ? nB : cB + (size_t)(t + 2) * kstep;
            const char* a3 = a2 + kstep; const char* b3 = b2 + kstep;
            if (last && has_next) S.a_ready(nxt);
            if constexpr (SP2) {
            PG8_LDB(B0, 0, 0); PG8_LDB(B1, 0, 1); PG8_SCHED; PG8_LDA(At, 0, 0); PG8_STAGE(PG8_SA(1, 1), a1 + hstepA, voffA);
            PG8_WAIT_V(8); PG8_WAIT_L(0); PG8_BAR; PG8_MMA(0, 0, At, B0); PG8_MMA(0, 1, At, B1); PG8_BAR; PG8_SCHED;
            PG8_LDA(At, 0, 1); PG8_STAGE(PG8_SB(0, 0), b2, voffB); PG8_STAGE(PG8_SB(0, 1), b2 + hstepB, voffB); PG8_STAGE(PG8_SA(0, 0), a2, voffA);
            PG8_WAIT_V(8); PG8_WAIT_L(0); PG8_BAR; PG8_MMA(1, 0, At, B0); PG8_MMA(1, 1, At, B1); PG8_BAR; PG8_SCHED;
            PG8_LDB(B0, 1, 0); PG8_LDB(B1, 1, 1); PG8_SCHED; PG8_LDA(At, 1, 0); PG8_STAGE(PG8_SA(0, 1), a2 + hstepA, voffA);
            PG8_WAIT_V(8); PG8_WAIT_L(0); PG8_BAR; PG8_MMA(0, 0, At, B0); PG8_MMA(0, 1, At, B1); PG8_BAR; PG8_SCHED;
            PG8_LDA(At, 1, 1); PG8_STAGE(PG8_SB(1, 0), b3, voffB); PG8_STAGE(PG8_SB(1, 1), b3 + hstepB, voffB); PG8_STAGE(PG8_SA(1, 0), a3, voffA);
            PG8_WAIT_V(8); PG8_WAIT_L(0); PG8_BAR; PG8_MMA(1, 0, At, B0); PG8_MMA(1, 1, At, B1); PG8_BAR; PG8_SCHED;
            } else {
            PG8_LDB(B0, 0, 0); PG8_SCHED; PG8_LDA(At, 0, 0); PG8_STAGE(PG8_SA(1, 1), a1 + hstepA, voffA);
            PG8_WAIT_L(8); PG8_BAR; PG8_WAIT_L(0); PG8_MMA(0, 0, At, B0); PG8_BAR; PG8_SCHED;
            PG8_LDB(B1, 0, 1); PG8_STAGE(PG8_SB(0, 0), b2, voffB);
            PG8_BAR; PG8_WAIT_L(0); PG8_MMA(0, 1, At, B1); PG8_BAR;
            PG8_LDA(At, 0, 1); PG8_STAGE(PG8_SA(0, 0), a2, voffA);
            PG8_BAR; PG8_WAIT_L(0); PG8_MMA(1, 0, At, B0); PG8_BAR; PG8_SCHED;
            PG8_STAGE(PG8_SB(0, 1), b2 + hstepB, voffB);
            PG8_WAIT_V(6); PG8_BAR; PG8_MMA(1, 1, At, B1); PG8_BAR;
            PG8_LDB(B0, 1, 0); PG8_SCHED; PG8_LDA(At, 1, 0); PG8_STAGE(PG8_SA(0, 1), a2 + hstepA, voffA);
            PG8_WAIT_L(8); PG8_BAR; PG8_WAIT_L(0); PG8_MMA(0, 0, At, B0); PG8_BAR; PG8_SCHED;
            PG8_LDB(B1, 1, 1); PG8_STAGE(PG8_SB(1, 0), b3, voffB);
            PG8_BAR; PG8_WAIT_L(0); PG8_MMA(0, 1, At, B1); PG8_BAR;
            PG8_LDA(At, 1, 1); PG8_STAGE(PG8_SA(1, 0), a3, voffA);
            PG8_BAR; PG8_WAIT_L(0); PG8_MMA(1, 0, At, B0); PG8_BAR; PG8_SCHED;
            PG8_STAGE(PG8_SB(1, 1), b3 + hstepB, voffB);
            PG8_WAIT_V(6); PG8_BAR; PG8_MMA(1, 1, At, B1); PG8_BAR;
            }
        }
        if constexpr (ALIGN_EPI) { if (wr == 0) PG8_BAR; }
        if constexpr (!Epi::AFTER_DRAIN) { E(acc, cur, wr, wc, fr, fq); S.done(cur); }
        if (!has_next) break;
#pragma unroll
        for (int a = 0; a < 2; ++a)
#pragma unroll
            for (int b = 0; b < 2; ++b)
#pragma unroll
                for (int m = 0; m < 4; ++m)
#pragma unroll
                    for (int n = 0; n < 2; ++n) acc[a][b][m][n] = (f32x4){0.f, 0.f, 0.f, 0.f};
        cur = nxt; cA = nA; cB = nB; ++ui;
        if constexpr (ALIGN_EPI) { if (wr == 1) PG8_BAR; }
    }
    PG8_WAIT_V(0);
    if constexpr (!ALIGN_EPI) { if (wr == 0) PG8_BAR; }
    PG8_BAR;
    if constexpr (Epi::AFTER_DRAIN) { E.fused(acc, cur, wr, wc, fr, fq, lds, wid, lane); S.done(cur); }
#undef PG8_SA
#undef PG8_SB
#undef PG8_STAGE
#undef PG8_LDA
#undef PG8_LDB
#undef PG8_MMA
#undef PG8_WAIT_V
#undef PG8_WAIT_L
#undef PG8_BAR
#undef PG8_SCHED
}
}

using pg8::bf16_t; using pg8::bf16x8; using pg8::f32x4; using pg8::u32x4; using pg8::Unit; using pg8::cvt_pk_bf16;
typedef unsigned u32x2 __attribute__((ext_vector_type(2)));
typedef float f32x2 __attribute__((ext_vector_type(2)));
constexpr int T = 16384, SEQ = 4096, DM = 2048, DIN = 16200;
constexpr float EPS = 1e-6f, NEGV = -1e30f, LOG2E = 1.4426950408889634f;
constexpr float CA_SCALE = 0.12751743082459868f;
constexpr float CC_SCALE = 0.10411754627697264f;
constexpr int NTHR = 512;
constexpr int LDS_BYTES = 131072;

constexpr size_t MiB = 1ull << 20;
constexpr size_t WS_CS = 0;
constexpr size_t WS_SSQ = WS_CS + MiB;
constexpr size_t WS_SSKV = WS_SSQ + 65536;
constexpr size_t WS_GATES = WS_SSKV + 65536;
constexpr size_t WS_KM = WS_GATES + 524288;
constexpr size_t WS_BV = WS_KM + 131072;
constexpr size_t WS_LIV = WS_BV + 262144;
constexpr size_t WS_BLAST = WS_LIV + 262144;
constexpr size_t WS_GMAX = WS_BLAST + 4096;
constexpr size_t WS_MST = WS_GMAX + 4096;
constexpr size_t WS_NST = WS_MST + 4096;
constexpr size_t WS_W0 = WS_NST + 524288;
constexpr size_t WL_WIN = 0;
constexpr size_t WL_WB = WL_WIN + 64 * MiB;
constexpr size_t WL_WO = WL_WB + 12 * MiB;
constexpr size_t WL_WUQ = WL_WO + 8 * MiB;
constexpr size_t WL_WKN = WL_WUQ + 1536 * 1024;
constexpr size_t WL_WV = WL_WKN + 512 * 1024;
constexpr size_t WL_SIZE = WL_WV + 512 * 1024;
constexpr size_t WS_H = WS_W0 + 2 * WL_SIZE;
constexpr size_t WS_QA = WS_H + 64 * MiB;
constexpr size_t WS_KA = WS_QA + 32 * MiB;
constexpr size_t WS_VAT = WS_KA + 32 * MiB;
constexpr size_t WS_Z = WS_VAT + 32 * MiB;
constexpr size_t WS_QB = WS_Z + 96 * MiB;
constexpr size_t WS_KB = WS_QB + 16 * MiB;
constexpr size_t WS_VB = WS_KB + 16 * MiB;
constexpr size_t WS_OB = WS_VB + 32 * MiB;
constexpr size_t WS_Q2 = WS_OB + 32 * MiB;
constexpr size_t WS_K2 = WS_Q2 + 16 * MiB;
constexpr size_t WS_CST = WS_K2 + 16 * MiB;
constexpr size_t WS_CQ = WS_CST + 64 * MiB;
constexpr size_t WS_CKV = WS_CQ + 16 * MiB;
constexpr size_t WS_KR = WS_CKV + 8 * MiB;
constexpr size_t WS_QC = WS_KR + 2 * MiB;
constexpr size_t WS_KNC = WS_QC + 48 * MiB;
constexpr size_t WS_VCT = WS_KNC + 32 * MiB;
constexpr size_t WS_GT = WS_VCT + 32 * MiB;
constexpr size_t WS_SSP = WS_GT + 192 * MiB;
constexpr size_t WS_QAL = WS_SSP + MiB;
constexpr size_t WS_CTR = WS_QAL + 32 * MiB;
constexpr size_t WS_END = WS_CTR + 256;

struct Params {
    const float* x; const float* norm_gain; const float* w_in; const float* t5; const float* conv_w; const float* conv_b; const float* i_bias; const float* f_bias;
    const float* out_norm; const float* q_norm; const float* kv_norm; const float* w_uq; const float* w_ukv; const float* w_branch; const float* w_out; const float* final_norm;
    float* out; unsigned char* ws; int w_lo, w_hi;
};

__device__ __forceinline__ float bf2f(unsigned v16) { return __uint_as_float(v16 << 16); }
__device__ __forceinline__ float bflo(unsigned w) { return __uint_as_float(w << 16); }
__device__ __forceinline__ float bfhi(unsigned w) { return __uint_as_float(w & 0xffff0000u); }
__device__ __forceinline__ bf16_t f2bf(float f) { return (bf16_t)(cvt_pk_bf16(f, 0.f) & 0xffffu); }
__device__ __forceinline__ float fsigmoid(float v) { return __builtin_amdgcn_rcpf(1.0f + __expf(-v)); }
__device__ __forceinline__ float fsilu(float v) { return v * __builtin_amdgcn_rcpf(1.0f + __expf(-v)); }
__device__ __forceinline__ float fexp2(float v) { return __builtin_amdgcn_exp2f(v); }
__device__ __forceinline__ f32x4 zero4() { f32x4 z = (f32x4){0.f, 0.f, 0.f, 0.f}; asm volatile("" : "+v"(z)); return z; }
__device__ __forceinline__ f32x4 mfma16(bf16x8 a, bf16x8 b, f32x4 c) { return __builtin_amdgcn_mfma_f32_16x16x32_bf16(a, b, c, 0, 0, 0); }

struct EpiIn {
    static constexpr bool PERM = true, AFTER_DRAIN = false;
    unsigned char* ws;
    __device__ __forceinline__ void operator()(const f32x4 (&acc)[2][2][4][2], const Unit& u, int wr, int wc, int fr, int fq) const {
        const int pn = u.pn; const int row0 = u.pm * 256 + wr * 64 + fr;
        if (pn == 59) {
            const int cb = wc * 32 + 8 * fq;
            if (cb >= 72) return;
            float* gates = (float*)(ws + WS_GATES); bf16_t* kr = (bf16_t*)(ws + WS_KR); const f32x2* cs = (const f32x2*)(ws + WS_CS);
#pragma unroll
            for (int ai = 0; ai < 2; ++ai)
#pragma unroll
                for (int m = 0; m < 4; ++m) {
                    const int row = row0 + ai * 128 + m * 16; const f32x4 v0 = acc[ai][0][m][0], v1 = acc[ai][0][m][1];
                    if (cb == 0) { *(f32x4*)(gates + (size_t)row * 8) = v0; *(f32x4*)(gates + (size_t)row * 8 + 4) = v1; }
                    else {
                        const int j0 = (cb - 8) >> 1, pos = row & (SEQ - 1);
                        const f32x2 c0 = cs[pos * 32 + j0], c1 = cs[pos * 32 + j0 + 1], c2 = cs[pos * 32 + j0 + 2], c3 = cs[pos * 32 + j0 + 3];
                        u32x4 w;
                        w.x = cvt_pk_bf16(v0[0] * c0.x - v0[1] * c0.y, v0[0] * c0.y + v0[1] * c0.x);
                        w.y = cvt_pk_bf16(v0[2] * c1.x - v0[3] * c1.y, v0[2] * c1.y + v0[3] * c1.x);
                        w.z = cvt_pk_bf16(v1[0] * c2.x - v1[1] * c2.y, v1[0] * c2.y + v1[1] * c2.x);
                        w.w = cvt_pk_bf16(v1[2] * c3.x - v1[3] * c3.y, v1[2] * c3.y + v1[3] * c3.x);
                        *(u32x4*)(kr + (size_t)row * 64 + (cb - 8)) = w;
                    }
                }
            return;
        }
        size_t off; int ld, c0, act = 0, ssk = 0; float sc = 1.f;
        if (pn < 4) { off = WS_QA; ld = 1024; c0 = pn * 256; sc = CA_SCALE; }
        else if (pn < 8) { off = WS_KA; ld = 1024; c0 = (pn - 4) * 256; }
        else if (pn < 12) { off = WS_Z; ld = 1024; c0 = (pn - 8) * 256; act = 1; }
        else if (pn < 14) { off = WS_QB; ld = 512; c0 = (pn - 12) * 256; }
        else if (pn < 16) { off = WS_KB; ld = 512; c0 = (pn - 14) * 256; }
        else if (pn < 20) { off = WS_VB; ld = 1024; c0 = (pn - 16) * 256; }
        else if (pn < 24) { off = WS_OB; ld = 1024; c0 = (pn - 20) * 256; act = 2; }
        else if (pn < 28) { off = WS_Z + 32 * MiB; ld = 1024; c0 = (pn - 24) * 256; act = 1; }
        else if (pn < 30) { off = WS_CQ; ld = 512; c0 = (pn - 28) * 256; ssk = 1; }
        else if (pn < 31) { off = WS_CKV; ld = 256; c0 = 0; ssk = 2; }
        else if (pn < 35) { off = WS_Z + 64 * MiB; ld = 1024; c0 = (pn - 31) * 256; act = 1; }
        else { off = WS_GT; ld = 6144; c0 = (pn - 35) * 256; act = 2; }
        bf16_t* dst = (bf16_t*)(ws + off); float* ssp = (float*)(ws + WS_SSP) + (ssk == 2 ? 8 : (pn - 28) * 4) + wc;
        const int col0 = c0 + wc * 32 + 8 * fq;
#pragma unroll
        for (int ai = 0; ai < 2; ++ai)
#pragma unroll
            for (int m = 0; m < 4; ++m) {
                const int row = row0 + ai * 128 + m * 16; bf16_t* rowp = dst + (size_t)row * ld + col0; float ss = 0.f;
#pragma unroll
                for (int bj = 0; bj < 2; ++bj) {
                    f32x4 v0 = acc[ai][bj][m][0], v1 = acc[ai][bj][m][1];
                    if (act == 1) {
#pragma unroll
                        for (int i = 0; i < 4; ++i) { v0[i] = fsilu(v0[i]); v1[i] = fsilu(v1[i]); }
                    } else if (act == 2) {
#pragma unroll
                        for (int i = 0; i < 4; ++i) { v0[i] = fsigmoid(v0[i]); v1[i] = fsigmoid(v1[i]); }
                    } else { v0 = v0 * sc; v1 = v1 * sc; }
                    if (ssk) ss += (v0[0] * v0[0] + v0[1] * v0[1]) + (v0[2] * v0[2] + v0[3] * v0[3]) + (v1[0] * v1[0] + v1[1] * v1[1]) + (v1[2] * v1[2] + v1[3] * v1[3]);
                    u32x4 w; w.x = cvt_pk_bf16(v0[0], v0[1]); w.y = cvt_pk_bf16(v0[2], v0[3]); w.z = cvt_pk_bf16(v1[0], v1[1]); w.w = cvt_pk_bf16(v1[2], v1[3]);
                    *(u32x4*)(rowp + bj * 128) = w;
                }
                if (ssk) { const int ln = fq * 16 + fr; ss += shx(ss, 16, ln); ss += shx(ss, 32, ln); if (fq == 0) ssp[(size_t)row * 16] = ss; }
            }
    }
};

struct EpiVT {
    static constexpr bool PERM = true, AFTER_DRAIN = false;
    bf16_t* dst; int ld; const float* ss; float inv_n;
    __device__ __forceinline__ void operator()(const f32x4 (&acc)[2][2][4][2], const Unit& u, int wr, int wc, int fr, int fq) const {
        const int row0 = u.pm * 256 + wr * 64 + fr, col0 = u.pn * 256 + wc * 32 + 8 * fq;
        f32x4 s0[2], s1[2];
#pragma unroll
        for (int bj = 0; bj < 2; ++bj) {
            if (ss) { f32x4 a, b;
#pragma unroll
                for (int i = 0; i < 4; ++i) { const f32x4 pa = *(const f32x4*)(ss + (size_t)(col0 + bj * 128 + i) * 16 + 8), pb = *(const f32x4*)(ss + (size_t)(col0 + bj * 128 + 4 + i) * 16 + 8);
                    a[i] = rsqrtf(((pa[0] + pa[1]) + (pa[2] + pa[3])) * inv_n + EPS); b[i] = rsqrtf(((pb[0] + pb[1]) + (pb[2] + pb[3])) * inv_n + EPS); }
                s0[bj] = a; s1[bj] = b; }
            else { s0[bj] = (f32x4){1.f, 1.f, 1.f, 1.f}; s1[bj] = s0[bj]; }
        }
#pragma unroll
        for (int ai = 0; ai < 2; ++ai)
#pragma unroll
            for (int m = 0; m < 4; ++m) {
                bf16_t* rowp = dst + (size_t)(row0 + ai * 128 + m * 16) * ld + col0;
#pragma unroll
                for (int bj = 0; bj < 2; ++bj) {
                    const f32x4 v0 = acc[ai][bj][m][0] * s0[bj], v1 = acc[ai][bj][m][1] * s1[bj];
                    u32x4 w; w.x = cvt_pk_bf16(v0[0], v0[1]); w.y = cvt_pk_bf16(v0[2], v0[3]); w.z = cvt_pk_bf16(v1[0], v1[1]); w.w = cvt_pk_bf16(v1[2], v1[3]);
                    *(u32x4*)(rowp + bj * 128) = w;
                }
            }
    }
};

template <bool ROPE> struct EpiRow {
    static constexpr bool PERM = true, AFTER_DRAIN = false;
    bf16_t* dst; int ld; const float* ss; float inv_n, sc; const f32x2* cs;
    __device__ __forceinline__ void operator()(const f32x4 (&acc)[2][2][4][2], const Unit& u, int wr, int wc, int fr, int fq) const {
        const int row0 = u.pm * 256 + wr * 64 + fr, col0 = u.pn * 256 + wc * 32 + 8 * fq;
#pragma unroll
        for (int ai = 0; ai < 2; ++ai)
#pragma unroll
            for (int m = 0; m < 4; ++m) {
                const int row = row0 + ai * 128 + m * 16; float sq;
                if (ROPE) { const f32x4 pa = *(const f32x4*)(ss + (size_t)row * 16), pb = *(const f32x4*)(ss + (size_t)row * 16 + 4); sq = ((pa[0] + pa[1]) + (pa[2] + pa[3])) + ((pb[0] + pb[1]) + (pb[2] + pb[3])); }
                else { const f32x4 pa = *(const f32x4*)(ss + (size_t)row * 16 + 8); sq = (pa[0] + pa[1]) + (pa[2] + pa[3]); }
                const float rs = rsqrtf(sq * inv_n + EPS) * sc; bf16_t* rowp = dst + (size_t)row * ld + col0;
#pragma unroll
                for (int bj = 0; bj < 2; ++bj) {
                    f32x4 v0 = acc[ai][bj][m][0] * rs, v1 = acc[ai][bj][m][1] * rs; u32x4 w;
                    const int hc = (col0 + bj * 128) % 192;
                    if (ROPE && hc >= 128) {
                        const int j0 = (hc - 128) >> 1, pos = row & (SEQ - 1);
                        const f32x2 c0 = cs[pos * 32 + j0], c1 = cs[pos * 32 + j0 + 1], c2 = cs[pos * 32 + j0 + 2], c3 = cs[pos * 32 + j0 + 3];
                        w.x = cvt_pk_bf16(v0[0] * c0.x - v0[1] * c0.y, v0[0] * c0.y + v0[1] * c0.x);
                        w.y = cvt_pk_bf16(v0[2] * c1.x - v0[3] * c1.y, v0[2] * c1.y + v0[3] * c1.x);
                        w.z = cvt_pk_bf16(v1[0] * c2.x - v1[1] * c2.y, v1[0] * c2.y + v1[1] * c2.x);
                        w.w = cvt_pk_bf16(v1[2] * c3.x - v1[3] * c3.y, v1[2] * c3.y + v1[3] * c3.x);
                    } else { w.x = cvt_pk_bf16(v0[0], v0[1]); w.y = cvt_pk_bf16(v0[2], v0[3]); w.z = cvt_pk_bf16(v1[0], v1[1]); w.w = cvt_pk_bf16(v1[2], v1[3]); }
                    *(u32x4*)(rowp + bj * 128) = w;
                }
            }
    }
};

struct EpiMerge {
    static constexpr bool PERM = true, AFTER_DRAIN = false;
    bf16_t* merged; const bf16_t* gt;
    __device__ __forceinline__ void operator()(const f32x4 (&acc)[2][2][4][2], const Unit& u, int wr, int wc, int fr, int fq) const {
        const int n = u.pm >> 6, pmr = u.pm & 63; const int row0 = pmr * 256 + wr * 64 + fr, col0 = u.pn * 256 + wc * 32 + 8 * fq;
#pragma unroll
        for (int ai = 0; ai < 2; ++ai)
#pragma unroll
            for (int m = 0; m < 4; ++m) {
                const int row = row0 + ai * 128 + m * 16;
#pragma unroll
                for (int bj = 0; bj < 2; ++bj) {
                    const u32x4 gw = *(const u32x4*)(gt + (size_t)row * 6144 + n * 2048 + col0 + bj * 128);
                    bf16_t* mp = merged + (size_t)row * 2048 + col0 + bj * 128;
                    u32x4 pw = (u32x4){0u, 0u, 0u, 0u}; if (n > 0) pw = __builtin_nontemporal_load((const u32x4*)mp);
                    const f32x4 v0 = acc[ai][bj][m][0], v1 = acc[ai][bj][m][1]; u32x4 w;
                    w.x = cvt_pk_bf16(bflo(pw.x) + bflo(gw.x) * v0[0], bfhi(pw.x) + bfhi(gw.x) * v0[1]);
                    w.y = cvt_pk_bf16(bflo(pw.y) + bflo(gw.y) * v0[2], bfhi(pw.y) + bfhi(gw.y) * v0[3]);
                    w.z = cvt_pk_bf16(bflo(pw.z) + bflo(gw.z) * v1[0], bfhi(pw.z) + bfhi(gw.z) * v1[1]);
                    w.w = cvt_pk_bf16(bflo(pw.w) + bflo(gw.w) * v1[2], bfhi(pw.w) + bfhi(gw.w) * v1[3]);
                    *(u32x4*)mp = w;
                }
            }
    }
};
struct MergeOrder {
    int G, c;
    __device__ bool next(int i, Unit& u) const {
        const int t3 = i / 3, n = i - 3 * t3; const long L = (long)t3 * G + c; if (L >= 512) return false;
        const int tm = (int)(L >> 3), tn = (int)(L & 7); u.pm = n * 64 + tm; u.pn = tn; u.pb = n * 8 + tn; return true;
    }
    __device__ __forceinline__ void a_ready(const Unit&) const {}
    __device__ __forceinline__ void done(const Unit&) const {}
};

struct EpiOut {
    static constexpr bool PERM = false, AFTER_DRAIN = false;
    const float* xin; float* xout;
    __device__ __forceinline__ void operator()(const f32x4 (&acc)[2][2][4][2], const Unit& u, int wr, int wc, int fr, int fq) const {
        const int row0 = u.pm * 256 + wr * 64 + fr, col0 = u.pn * 256 + wc * 32 + 4 * fq;
#pragma unroll
        for (int ai = 0; ai < 2; ++ai)
#pragma unroll
            for (int m = 0; m < 4; ++m) {
                const size_t ro = (size_t)(row0 + ai * 128 + m * 16) * DM + col0;
#pragma unroll
                for (int bj = 0; bj < 2; ++bj)
#pragma unroll
                    for (int n = 0; n < 2; ++n) { const f32x4 b = *(const f32x4*)(xin + ro + bj * 128 + n * 16); *(f32x4*)(xout + ro + bj * 128 + n * 16) = b + acc[ai][bj][m][n]; }
            }
    }
};

template <class F> __device__ __forceinline__ void tconv(unsigned char* lds, const float* src, int ldsrc, int K, bf16_t* dst, int N, const float* gain, F f, const int g_wv) {
    float* tile = (float*)lds; int tid = TIDX; asm volatile("" : "+v"(tid)); const int tilesK = K >> 6, ntile = tilesK * (N >> 8);
    const int nn4 = (tid & 63) * 4, kk0 = tid >> 6; f32x4 pre[8];
#define TCONV_LOAD(tt_) do { const int tn_ = (tt_) / tilesK, tk_ = (tt_) - tn_ * tilesK; const int c0 = f(tn_ * 256 + nn4), c1 = f(tn_ * 256 + nn4 + 1), c2 = f(tn_ * 256 + nn4 + 2), c3 = f(tn_ * 256 + nn4 + 3); \
        const bool vec = (c0 >= 0) && ((c0 & 3) == 0) && (c3 == c0 + 3); const float* sp = src + (size_t)(tk_ * 64 + kk0) * ldsrc; \
        _Pragma("unroll") for (int e = 0; e < 8; ++e) { const float* rp = sp + (size_t)(8 * e) * ldsrc; f32x4 v; \
            if (vec) v = *(const f32x4*)(rp + c0); \
            else { v[0] = c0 >= 0 ? rp[c0] : 0.f; v[1] = c1 >= 0 ? rp[c1] : 0.f; v[2] = c2 >= 0 ? rp[c2] : 0.f; v[3] = c3 >= 0 ? rp[c3] : 0.f; } \
            pre[e] = v; } } while (0)
    int t = blockIdx.x;
    if (t < ntile) TCONV_LOAD(t);
    for (; t < ntile; t += gridDim.x) {
        const int tn = t / tilesK, tk = t - tn * tilesK;
#pragma unroll
        for (int e = 0; e < 8; ++e) { f32x4 v = pre[e]; if (gain) v = v * gain[tk * 64 + kk0 + 8 * e]; *(f32x4*)(tile + (kk0 + 8 * e) * 260 + nn4) = v; }
        __syncthreads();
        { const int t2 = t + (int)gridDim.x; if (t2 < ntile) TCONV_LOAD(t2); }
        { const int nn = tid >> 1, kc = (tid & 1) * 32; bf16_t* dp = dst + (size_t)(tn * 256 + nn) * K + tk * 64 + kc;
#pragma unroll
          for (int q4 = 0; q4 < 4; ++q4) { float v[8];
#pragma unroll
              for (int i = 0; i < 8; ++i) v[i] = tile[(kc + q4 * 8 + i) * 260 + nn];
              u32x4 w; w.x = cvt_pk_bf16(v[0], v[1]); w.y = cvt_pk_bf16(v[2], v[3]); w.z = cvt_pk_bf16(v[4], v[5]); w.w = cvt_pk_bf16(v[6], v[7]);
              *(u32x4*)(dp + q4 * 8) = w; } }
        __syncthreads();
    }
#undef TCONV_LOAD
}
__device__ __forceinline__ int win_src_col(int n) {
    if (n < 1024) return n;
    if (n < 2048) return 1024 + (n - 1024);
    if (n < 3072) return 3072 + (n - 2048);
    if (n < 3584) return 4096 + (n - 3072);
    if (n < 4096) return 4608 + (n - 3584);
    if (n < 5120) return 5120 + (n - 4096);
    if (n < 6144) return 6152 + (n - 5120);
    if (n < 7168) return 7176 + (n - 6144);
    if (n < 7680) return 8200 + (n - 7168);
    if (n < 7936) return 8712 + (n - 7680);
    if (n < 8960) return 9032 + (n - 7936);
    if (n < 15104) return 10056 + (n - 8960);
    if (n < 15360) { const int r = n - 15104; if (r < 4) return 6144 + r; if (r < 8) return 6148 + (r - 4); if (r < 72) { const int j = (r - 8) >> 1, odd = (r - 8) & 1; return 8968 + j + 32 * odd; } return -1; }
    return 2048 + (n - 15360);
}
__device__ __forceinline__ void convert_weights(unsigned char* lds, const Params& p, int l, const int g_wv) {
    unsigned char* wl = p.ws + WS_W0 + (size_t)l * WL_SIZE;
    tconv(lds, p.w_in + (size_t)l * DM * DIN, DIN, DM, (bf16_t*)(wl + WL_WIN), 16384, nullptr, [](int n) { return win_src_col(n); }, g_wv);
#pragma unroll 1
    for (int n = 0; n < 3; ++n)
        tconv(lds, p.w_branch + ((size_t)l * 3 + n) * 1024 * DM, DM, 1024, (bf16_t*)(wl + WL_WB) + (size_t)n * 2048 * 1024, 2048, nullptr, [](int c) { return c; }, g_wv);
    tconv(lds, p.w_out + (size_t)l * DM * DM, DM, DM, (bf16_t*)(wl + WL_WO), DM, nullptr, [](int c) { return c; }, g_wv);
    tconv(lds, p.w_uq + (size_t)l * 512 * 1536, 1536, 512, (bf16_t*)(wl + WL_WUQ), 1536, p.q_norm + l * 512,
          [](int n) { const int h = n / 192, hc = n - h * 192; if (hc < 128) return n; const int r = hc - 128; return h * 192 + 128 + (r >> 1) + 32 * (r & 1); }, g_wv);
    tconv(lds, p.w_ukv + (size_t)l * 256 * 2048, 2048, 256, (bf16_t*)(wl + WL_WKN), 1024, p.kv_norm + l * 256, [](int n) { return (n >> 7) * 256 + (n & 127); }, g_wv);
    tconv(lds, p.w_ukv + (size_t)l * 256 * 2048, 2048, 256, (bf16_t*)(wl + WL_WV), 1024, p.kv_norm + l * 256, [](int n) { return (n >> 7) * 256 + 128 + (n & 127); }, g_wv);
}
__device__ __forceinline__ void sincos_acc(float ang, float& s, float& c) {
    const double x = (double)ang; const double q = rint(x * 0.63661977236758134308);
    double r = fma(-q, 1.57079632679489655800e+00, x); r = fma(-q, 6.12323399573676603587e-17, r);
    const int qi = ((int)q) & 3; const double r2 = r * r;
    const double sp = r + r * r2 * (-1.66666666666666324348e-01 + r2 * (8.33333333332248946124e-03 + r2 * (-1.98412698298579493134e-04 + r2 * (2.75573137070700676789e-06 + r2 * (-2.50507602534068634195e-08 + r2 * 1.58969099521155010221e-10)))));
    const double cp = 1.0 - 0.5 * r2 + r2 * r2 * (4.16666666666666019037e-02 + r2 * (-1.38888888888741095749e-03 + r2 * (2.48015872894767294178e-05 + r2 * (-2.75573143513906633035e-07 + r2 * (2.08757232129817482790e-09 + r2 * -1.13596475577881948265e-11)))));
    double ss, cc; if (qi == 0) { ss = sp; cc = cp; } else if (qi == 1) { ss = cp; cc = -sp; } else if (qi == 2) { ss = -sp; cc = -cp; } else { ss = -cp; cc = sp; }
    s = (float)ss; c = (float)cc;
}
__device__ __forceinline__ void build_cs(const Params& p, const int g_wv) {
    f32x2* cs = (f32x2*)(p.ws + WS_CS);
    int i0 = blockIdx.x * NTHR + TIDX; asm volatile("" : "+v"(i0));
    for (int i = i0; i < SEQ * 32; i += gridDim.x * NTHR) {
        const int pos = i >> 5, j = i & 31; double inv = 1.0; for (int k = 0; k < j; ++k) inv *= 0.7498942093324558;
        const float ang = (float)pos * (float)inv; float s, c; sincos_acc(ang, s, c); cs[i] = (f32x2){c, s};
    }
}
__device__ __forceinline__ void zero_ss(const Params& p, const int g_wv) {
    float* a = (float*)(p.ws + WS_SSQ);
    int i0 = blockIdx.x * NTHR + TIDX; asm volatile("" : "+v"(i0));
    for (int i = i0; i < 2 * T; i += gridDim.x * NTHR) a[i] = 0.f;
}
template <bool OUTBF> __device__ __forceinline__ void rmsnorm_rows(const float* x, const float* gain, bf16_t* hb, float* of, const int g_wv) {
    int tid = TIDX; asm volatile("" : "+v"(tid)); const int lane = tid & 63, gw = blockIdx.x * (NTHR / 64) + (tid >> 6), nw = gridDim.x * (NTHR / 64);
    for (int row = gw; row < T; row += nw) {
        const float* xr = x + (size_t)row * DM; f32x4 v[8]; float ss = 0.f;
#pragma unroll
        for (int i = 0; i < 8; ++i) { v[i] = *(const f32x4*)(xr + i * 256 + lane * 4); ss += (v[i][0] * v[i][0] + v[i][1] * v[i][1]) + (v[i][2] * v[i][2] + v[i][3] * v[i][3]); }
#pragma unroll
        for (int o = 1; o < 64; o <<= 1) ss += shx(ss, o, lane);
        const float rs = rsqrtf(ss * (1.0f / DM) + EPS);
#pragma unroll
        for (int i = 0; i < 8; ++i) {
            const f32x4 gn = *(const f32x4*)(gain + i * 256 + lane * 4); const f32x4 y = v[i] * rs * gn;
            if (OUTBF) { u32x2 w; w.x = cvt_pk_bf16(y[0], y[1]); w.y = cvt_pk_bf16(y[2], y[3]); *(u32x2*)(hb + (size_t)row * DM + i * 256 + lane * 4) = w; }
            else *(f32x4*)(of + (size_t)row * DM + i * 256 + lane * 4) = y;
        }
    }
}

__device__ __forceinline__ void kmean_phase(const Params& p, int l, const int g_wv) {
    const bf16_t* ka = (const bf16_t*)(p.ws + WS_KA); bf16_t* km = (bf16_t*)(p.ws + WS_KM); bf16_t* kml = (bf16_t*)(p.ws + WS_SSQ); int tid = TIDX; asm volatile("" : "+v"(tid));
    for (int u = (gridDim.x == 256) ? (int)blockIdx.x - 192 : (int)blockIdx.x; u < 64; u += gridDim.x) { if (u < 0) continue;
        const int b = u >> 4, j = u & 15; const unsigned* src = (const unsigned*)(ka + ((size_t)b * SEQ + j * 256) * 1024) + tid; float a0 = 0.f, a1 = 0.f;
#pragma unroll 8
        for (int r = 0; r < 256; ++r) { const unsigned w = src[(size_t)r * 512]; a0 += bflo(w); a1 += bfhi(w); }
        const int col = tid * 2, h = col >> 7, d = col & 127;
        const float m0 = a0 * (1.0f / 256.0f), m1 = a1 * (1.0f / 256.0f); const unsigned hi = cvt_pk_bf16(m0, m1);
        *(unsigned*)(km + ((size_t)((b * 8 + h) * 16 + j)) * 128 + d) = hi;
        *(unsigned*)(kml + ((size_t)((b * 8 + h) * 16 + j)) * 128 + d) = cvt_pk_bf16(m0 - bflo(hi), m1 - bfhi(hi));
    }
}

template <int MODE> __device__ __forceinline__ void attn_phase(unsigned char* lds, const Params& p, int l, const int g_wv) {
    constexpr int DQK = MODE ? 192 : 128, NC = DQK / 32, NCH = DQK / 8, KRS = DQK * 2 + 32, KBUF = 64 * KRS, VRS = 144, VBUF = 128 * VRS;
    constexpr int OFF_V = 2 * KBUF, OFF_LUT = OFF_V + 2 * VBUF, OFF_KM = OFF_LUT + 512, NKL = (64 * NCH) / NTHR;
    int tid = TIDX; asm volatile("" : "+v"(tid)); const int lane = tid & 63, w = tid >> 6, lr = lane & 15, g = lane >> 4; const int G = gridDim.x, c = blockIdx.x;
    unsigned char* ws = p.ws;
    const bf16_t* Qp = (const bf16_t*)(ws + (MODE ? WS_QC : WS_QA)); constexpr int LDQ = MODE ? 1536 : 1024;
    const bf16_t* Kp = (const bf16_t*)(ws + (MODE ? WS_KNC : WS_KA)); const bf16_t* KRp = (const bf16_t*)(ws + WS_KR);
    const bf16_t* VTp = (const bf16_t*)(ws + (MODE ? WS_VCT : WS_VAT)); bf16_t* Zp = (bf16_t*)(ws + WS_Z + (MODE ? 64 * MiB : 0));
    float* lut = (float*)(lds + OFF_LUT);
    for (int rd = 0; rd * G < 512; ++rd) {
        int qblk, bh;
        if (G == 256) {
            const int xq = c & 7, iq = c >> 3, qq = iq >> 1;
            bh = 2 * xq + (iq & 1) + 16 * rd; qblk = rd ? qq : 15 - qq;
        } else { const int idx = rd * G + ((rd & 1) ? (G - 1 - c) : c); if (idx >= 512) continue; qblk = 15 - (idx >> 5); bh = idx & 31; }
        const int b = bh >> 3, h = bh & 7;
        const int q0 = qblk * 256 + w * 32; const size_t tq = (size_t)b * SEQ + q0; const int nt = (qblk + 1) * 4;
        bf16x8 qf[2][NC];
#pragma unroll
        for (int qb = 0; qb < 2; ++qb)
#pragma unroll
            for (int c2 = 0; c2 < NC; ++c2) qf[qb][c2] = *(const bf16x8*)(Qp + (tq + qb * 16 + lr) * LDQ + h * DQK + c2 * 32 + g * 8);
        u32x4 kreg[NKL], vreg[2];
#define ATT_LOADK(t_) do { const int t__ = (t_); \
        _Pragma("unroll") for (int i = 0; i < NKL; ++i) { const int id = tid + NTHR * i; const int key = id / NCH, ch = id - key * NCH; const size_t tk = (size_t)b * SEQ + t__ * 64 + key; \
            const bf16_t* s_ = (!MODE || ch < 16) ? (Kp + tk * 1024 + h * 128 + ch * 8) : (KRp + tk * 64 + (ch - 16) * 8); kreg[i] = *(const u32x4*)s_; } } while (0)
#define ATT_LOADV(t_) do { const int t__ = (t_); \
        _Pragma("unroll") for (int i = 0; i < 2; ++i) { const int id = tid + NTHR * i; const int row = id >> 3, ch = id & 7; \
            vreg[i] = *(const u32x4*)(VTp + (size_t)(h * 128 + row) * T + (size_t)b * SEQ + t__ * 64 + ch * 8); } } while (0)
#define ATT_STOREK(buf_) do { unsigned char* kb_ = lds + (buf_) * KBUF; \
        _Pragma("unroll") for (int i = 0; i < NKL; ++i) { const int id = tid + NTHR * i; const int key = id / NCH, ch = id - key * NCH; *(u32x4*)(kb_ + key * KRS + ch * 16) = kreg[i]; } } while (0)
#define ATT_STOREV(buf_) do { unsigned char* vb_ = lds + OFF_V + (buf_) * VBUF; \
        _Pragma("unroll") for (int i = 0; i < 2; ++i) { const int id = tid + NTHR * i; const int row = id >> 3, ch = id & 7; *(u32x4*)(vb_ + row * VRS + ch * 16) = vreg[i]; } } while (0)
        ATT_LOADK(0); ATT_LOADV(0); ATT_STOREK(0); ATT_STOREV(0); ATT_LOADK(1); ATT_LOADV(1);
        unsigned sel[2] = {0u, 0u};
        if (MODE == 0) {
            if (tid < 128) { const int d = tid; int bk = d; if (d >= 16) { bk = 16 + (int)(logf((float)d * (1.0f / 16.0f)) / 2.0794415416798357f * 16.0f); bk = bk > 31 ? 31 : bk; } lut[d] = p.t5[bk * 8 + h] * LOG2E; }
            { const int half = tid >> 8, row = (tid >> 4) & 15, ch = tid & 15; *(u32x4*)(lds + OFF_KM + half * 4608 + row * 288 + ch * 16) = *(const u32x4*)((const bf16_t*)(ws + (half ? WS_SSQ : WS_KM)) + ((size_t)((b * 8 + h) * 16 + row)) * 128 + ch * 8); }
        }
        __syncthreads();
        if (MODE == 0) {
            f32x4 ga[2] = {zero4(), zero4()};
#pragma unroll
            for (int c2 = 0; c2 < NC; ++c2) { const bf16x8 kf = *(const bf16x8*)(lds + OFF_KM + lr * 288 + c2 * 64 + g * 16), kfl = *(const bf16x8*)(lds + OFF_KM + 4608 + lr * 288 + c2 * 64 + g * 16);
#pragma unroll
                for (int qb = 0; qb < 2; ++qb) { ga[qb] = mfma16(kfl, qf[qb][c2], ga[qb]); ga[qb] = mfma16(kf, qf[qb][c2], ga[qb]); } }
#pragma unroll
            for (int qb = 0; qb < 2; ++qb) {
                float gv[4];
#pragma unroll
                for (int r = 0; r < 4; ++r) gv[r] = (g * 4 + r < qblk) ? ga[qb][r] : -INFINITY;
                unsigned s = 0u;
#pragma unroll
                for (int it = 0; it < 3; ++it) {
                    float bv = -INFINITY; int bi = 99;
#pragma unroll
                    for (int r = 0; r < 4; ++r) if (gv[r] > bv) { bv = gv[r]; bi = g * 4 + r; }
#pragma unroll
                    for (int o = 16; o <= 32; o <<= 1) { const float ov = shx(bv, o, lane); const int oi = shxi(bi, o, lane); if (ov > bv || (ov == bv && oi < bi)) { bv = ov; bi = oi; } }
                    if (bv > -INFINITY) s |= 1u << bi;
#pragma unroll
                    for (int r = 0; r < 4; ++r) if (g * 4 + r == bi) gv[r] = -INFINITY;
                }
                sel[qb] = s;
            }
        }
        f32x4 oacc[8][2];
#pragma unroll
        for (int i = 0; i < 8; ++i) { oacc[i][0] = zero4(); oacc[i][1] = zero4(); }
        float mrow[2] = {NEGV, NEGV}, lrow[2] = {0.f, 0.f};
        for (int t = 0; t < nt; ++t) {
            const int buf = t & 1; const bool more = (t + 1 < nt);
            if (more) { ATT_STOREK(buf ^ 1); ATT_STOREV(buf ^ 1); }
            if (t + 2 < nt) { ATT_LOADK(t + 2); ATT_LOADV(t + 2); }
            const int k0 = t * 64;
            const unsigned char* kb_ = lds + buf * KBUF; const unsigned char* vb_ = lds + OFF_V + buf * VBUF;
#pragma unroll
            for (int hf = 0; hf < 2; ++hf) {
              const int kh = k0 + hf * 32;
              if (kh <= q0 + 31) {
                f32x4 sacc[2][2];
#pragma unroll
                for (int kb = 0; kb < 2; ++kb) { sacc[kb][0] = zero4(); sacc[kb][1] = zero4(); }
#pragma unroll
                for (int c2 = 0; c2 < NC; ++c2)
#pragma unroll
                    for (int kb = 0; kb < 2; ++kb) { const bf16x8 kf = *(const bf16x8*)(kb_ + (hf * 32 + kb * 16 + lr) * KRS + c2 * 64 + g * 16);
                        sacc[kb][0] = mfma16(kf, qf[0][c2], sacc[kb][0]); sacc[kb][1] = mfma16(kf, qf[1][c2], sacc[kb][1]); }
                if (MODE == 0) {
                    const int jblk = t >> 2; const bool far = (kh + 31 + 127 <= q0);
                    if (far) { const float bfar = lut[127];
#pragma unroll
                        for (int qb = 0; qb < 2; ++qb) { const bool al = (jblk < qblk) ? (((sel[qb] >> jblk) & 1u) != 0u) : true;
#pragma unroll
                            for (int kb = 0; kb < 2; ++kb)
#pragma unroll
                                for (int r = 0; r < 4; ++r) sacc[kb][qb][r] = al ? sacc[kb][qb][r] + bfar : NEGV; }
                    } else {
#pragma unroll
                        for (int qb = 0; qb < 2; ++qb) { const int qpos = q0 + qb * 16 + lr; const bool alp = (sel[qb] >> jblk) & 1u;
#pragma unroll
                            for (int kb = 0; kb < 2; ++kb)
#pragma unroll
                                for (int r = 0; r < 4; ++r) { const int d = qpos - (kh + kb * 16 + g * 4 + r); const int di = d < 0 ? 0 : (d > 127 ? 127 : d);
                                    const bool al = (jblk < qblk) ? alp : (d >= 0); sacc[kb][qb][r] = al ? sacc[kb][qb][r] + lut[di] : NEGV; } }
                    }
                } else {
                    if (kh + 31 > q0) {
#pragma unroll
                        for (int qb = 0; qb < 2; ++qb) { const int qpos = q0 + qb * 16 + lr;
#pragma unroll
                            for (int kb = 0; kb < 2; ++kb)
#pragma unroll
                                for (int r = 0; r < 4; ++r) if (kh + kb * 16 + g * 4 + r > qpos) sacc[kb][qb][r] = NEGV; }
                    }
                }
                bf16x8 pf[2];
#pragma unroll
                for (int qb = 0; qb < 2; ++qb) {
                    float mx = NEGV;
#pragma unroll
                    for (int kb = 0; kb < 2; ++kb)
#pragma unroll
                        for (int r = 0; r < 4; ++r) mx = fmaxf(mx, sacc[kb][qb][r]);
                    float mnew = mrow[qb];
                    if (__builtin_amdgcn_ballot_w64(mx > mrow[qb] + 8.0f) != 0ull) {
                        mx = fmaxf(mx, shx(mx, 16, lane)); mx = fmaxf(mx, shx(mx, 32, lane));
                        mnew = fmaxf(mrow[qb], mx); const float alpha = fexp2(mrow[qb] - mnew); mrow[qb] = mnew; lrow[qb] *= alpha;
#pragma unroll
                        for (int i = 0; i < 8; ++i) oacc[i][qb] = oacc[i][qb] * alpha;
                    }
                    float ps = 0.f;
#pragma unroll
                    for (int kb = 0; kb < 2; ++kb)
#pragma unroll
                        for (int r = 0; r < 4; ++r) { const float e = fexp2(sacc[kb][qb][r] - mnew); sacc[kb][qb][r] = e; ps += e; }
                    lrow[qb] += ps;
                    union { u32x4 u; bf16x8 v; } cvt;
                    cvt.u.x = cvt_pk_bf16(sacc[0][qb][0], sacc[0][qb][1]); cvt.u.y = cvt_pk_bf16(sacc[0][qb][2], sacc[0][qb][3]);
                    cvt.u.z = cvt_pk_bf16(sacc[1][qb][0], sacc[1][qb][1]); cvt.u.w = cvt_pk_bf16(sacc[1][qb][2], sacc[1][qb][3]); pf[qb] = cvt.v;
                }
#pragma unroll
                for (int dvb = 0; dvb < 8; ++dvb) { union { u32x2 u[2]; bf16x8 v; } vf; const unsigned char* vp = vb_ + (dvb * 16 + lr) * VRS + (hf * 32 + g * 4) * 2;
                    vf.u[0] = *(const u32x2*)vp; vf.u[1] = *(const u32x2*)(vp + 32);
                    oacc[dvb][0] = mfma16(vf.v, pf[0], oacc[dvb][0]); oacc[dvb][1] = mfma16(vf.v, pf[1], oacc[dvb][1]); }
              }
            }
            __syncthreads();
        }
#pragma unroll
        for (int qb = 0; qb < 2; ++qb) {
            float l = lrow[qb]; l += shx(l, 16, lane); l += shx(l, 32, lane); const float inv = 1.0f / l;
            bf16_t* zr = Zp + (tq + qb * 16 + lr) * 1024 + h * 128 + g * 4;
#pragma unroll
            for (int dvb = 0; dvb < 8; ++dvb) { const u32x2 zw = *(const u32x2*)(zr + dvb * 16); const f32x4 o = oacc[dvb][qb] * inv; u32x2 ow;
                ow.x = cvt_pk_bf16(o[0] * bflo(zw.x), o[1] * bfhi(zw.x)); ow.y = cvt_pk_bf16(o[2] * bflo(zw.y), o[3] * bfhi(zw.y)); *(u32x2*)(zr + dvb * 16) = ow; }
        }
#undef ATT_LOADK
#undef ATT_LOADV
#undef ATT_STOREK
#undef ATT_STOREV
    }
}

__device__ __forceinline__ void mlstm_a(unsigned char* lds, const Params& p, int l, const int g_wv) {
    constexpr int K2RS = 272, TRS = 160; constexpr int OFF_K2 = 0, OFF_WKT = 64 * K2RS, OFF_VT = OFF_WKT + 128 * TRS, OFF_WG = OFF_VT + 256 * TRS;
    unsigned char* ws = p.ws; int tid = TIDX; asm volatile("" : "+v"(tid)); const int lane = tid & 63, w = tid >> 6, lr = lane & 15, g = lane >> 4;
    const bf16_t* QB = (const bf16_t*)(ws + WS_QB); const bf16_t* KB = (const bf16_t*)(ws + WS_KB); const bf16_t* VB = (const bf16_t*)(ws + WS_VB);
    bf16_t* Q2 = (bf16_t*)(ws + WS_Q2); bf16_t* K2 = (bf16_t*)(ws + WS_K2); const float* gates = (const float*)(ws + WS_GATES);
    const float* cw = p.conv_w + (size_t)l * 4 * 1024; const float* cb = p.conv_b + (size_t)l * 1024;
    float* wg = (float*)(lds + OFF_WG);
    for (int ku = 0; ; ++ku) { int u; { const int cb_ = blockIdx.x; if (gridDim.x == 256) { if (ku >= (cb_ < 128 ? 3 : 5)) break; u = cb_ < 128 ? cb_ + 128 * ku : 384 + (cb_ - 128) + 128 * ku; } else { u = cb_ + ku * (int)gridDim.x; if (u >= 1024) break; } }
        const int bh = u >> 6, c = u & 63, b = bh >> 2, h = bh & 3; const size_t t0 = (size_t)b * SEQ + c * 64;
#pragma unroll 1
        for (int it = 0; it < 4; ++it) {
            const int item = tid + NTHR * it, which = item >> 10, s = (item >> 4) & 63, grp = item & 15; const int ch0 = h * 128 + grp * 8, cc0 = which * 512 + ch0;
            const bf16_t* src = which ? KB : QB; float a[8];
            { const f32x4 b0 = *(const f32x4*)(cb + cc0), b1 = *(const f32x4*)(cb + cc0 + 4); a[0] = b0[0]; a[1] = b0[1]; a[2] = b0[2]; a[3] = b0[3]; a[4] = b1[0]; a[5] = b1[1]; a[6] = b1[2]; a[7] = b1[3]; }
#pragma unroll
            for (int j = 0; j < 4; ++j) { const int tp = c * 64 + s - 3 + j;
                if (tp >= 0) { const u32x4 xw = *(const u32x4*)(src + ((size_t)b * SEQ + tp) * 512 + ch0); const f32x4 w0 = *(const f32x4*)(cw + j * 1024 + cc0), w1 = *(const f32x4*)(cw + j * 1024 + cc0 + 4);
                    a[0] += bflo(xw.x) * w0[0]; a[1] += bfhi(xw.x) * w0[1]; a[2] += bflo(xw.y) * w0[2]; a[3] += bfhi(xw.y) * w0[3];
                    a[4] += bflo(xw.z) * w1[0]; a[5] += bfhi(xw.z) * w1[1]; a[6] += bflo(xw.w) * w1[2]; a[7] += bfhi(xw.w) * w1[3]; } }
            const float ksc = which ? 0.08838834764831845f : 1.0f;
#pragma unroll
            for (int i = 0; i < 8; ++i) a[i] = fsilu(a[i]) * ksc;
            u32x4 ow; ow.x = cvt_pk_bf16(a[0], a[1]); ow.y = cvt_pk_bf16(a[2], a[3]); ow.z = cvt_pk_bf16(a[4], a[5]); ow.w = cvt_pk_bf16(a[6], a[7]);
            *(u32x4*)((which ? K2 : Q2) + (t0 + s) * 512 + ch0) = ow;
            if (which) *(u32x4*)(lds + OFF_K2 + s * K2RS + grp * 16) = ow;
        }
        if (w == 0) {
            const float fpre = gates[(t0 + lane) * 8 + 4 + h] + p.f_bias[l * 4 + h]; const float li = gates[(t0 + lane) * 8 + h] + p.i_bias[l * 4 + h];
            const float lf = fminf(fpre, 0.f) - log1pf(__expf(-fabsf(fpre)));
            float bc = lf;
#pragma unroll
            for (int o = 1; o < 64; o <<= 1) { const float v = shup(bc, o, lane); if (lane >= o) bc += v; }
            const float blast = __int_as_float(__builtin_amdgcn_readlane(__float_as_int(bc), 63)); const float gg = blast - bc + li; float gm = gg;
#pragma unroll
            for (int o = 1; o < 64; o <<= 1) gm = fmaxf(gm, shx(gm, o, lane));
            wg[lane] = __expf(gg - gm);
            ((float*)(ws + WS_BV))[(size_t)u * 64 + lane] = bc; ((float*)(ws + WS_LIV))[(size_t)u * 64 + lane] = li;
            if (lane == 0) { ((float*)(ws + WS_BLAST))[u] = blast; ((float*)(ws + WS_GMAX))[u] = gm; }
        }
#pragma unroll
        for (int it = 0; it < 4; ++it) { const int item = tid + NTHR * it, s = item & 63, eg = item >> 6; const u32x4 vw = *(const u32x4*)(VB + (t0 + s) * 1024 + h * 256 + eg * 8);
            bf16_t* d = (bf16_t*)(lds + OFF_VT + (eg * 8) * TRS + s * 2); const unsigned vv[4] = {vw.x, vw.y, vw.z, vw.w};
#pragma unroll
            for (int i = 0; i < 4; ++i) { *(bf16_t*)((unsigned char*)d + (2 * i) * TRS) = (bf16_t)(vv[i] & 0xffffu); *(bf16_t*)((unsigned char*)d + (2 * i + 1) * TRS) = (bf16_t)(vv[i] >> 16); } }
        __syncthreads();
#pragma unroll
        for (int it = 0; it < 2; ++it) { const int item = tid + NTHR * it, s = item & 63, dg = item >> 6; const u32x4 kw = *(const u32x4*)(lds + OFF_K2 + s * K2RS + dg * 16); const float ww = wg[s];
            const unsigned kv[4] = {kw.x, kw.y, kw.z, kw.w}; unsigned char* d = lds + OFF_WKT + (dg * 8) * TRS + s * 2;
#pragma unroll
            for (int i = 0; i < 4; ++i) { *(bf16_t*)(d + (2 * i) * TRS) = f2bf(bflo(kv[i]) * ww); *(bf16_t*)(d + (2 * i + 1) * TRS) = f2bf(bfhi(kv[i]) * ww); } }
        __syncthreads();
#if defined(MK_DEBUG_HASH)
        { unsigned char* dbg = ws + WS_END + MiB + (size_t)u * 40960; for (int i = tid; i < 2560; i += NTHR) *(u32x4*)(dbg + i * 16) = *(const u32x4*)(lds + OFF_VT + i * 16); }
#endif
        if (tid < 128) { float a = 0.f; const unsigned char* r = lds + OFF_WKT + tid * TRS;
#pragma unroll
            for (int i = 0; i < 8; ++i) { const u32x4 x = *(const u32x4*)(r + i * 16); a += (bflo(x.x) + bfhi(x.x)) + (bflo(x.y) + bfhi(x.y)) + (bflo(x.z) + bfhi(x.z)) + (bflo(x.w) + bfhi(x.w)); }
            ((float*)(ws + WS_NST))[(size_t)u * 128 + tid] = a; }
        f32x4 acc[8][2];
#pragma unroll
        for (int i = 0; i < 8; ++i) { acc[i][0] = zero4(); acc[i][1] = zero4(); }
#pragma unroll
        for (int kc = 0; kc < 2; ++kc) {
            const bf16x8 v0 = *(const bf16x8*)(lds + OFF_VT + (w * 32 + lr) * TRS + kc * 64 + g * 16), v1 = *(const bf16x8*)(lds + OFF_VT + (w * 32 + 16 + lr) * TRS + kc * 64 + g * 16);
#pragma unroll
            for (int db = 0; db < 8; ++db) { const bf16x8 kf = *(const bf16x8*)(lds + OFF_WKT + (db * 16 + lr) * TRS + kc * 64 + g * 16); acc[db][0] = mfma16(kf, v0, acc[db][0]); acc[db][1] = mfma16(kf, v1, acc[db][1]); }
        }
        bf16_t* cst = (bf16_t*)(ws + WS_CST) + (size_t)u * 32768; float one = 1.0f; asm volatile("" : "+v"(one));
#pragma unroll
        for (int eb = 0; eb < 2; ++eb)
#pragma unroll
            for (int db = 0; db < 8; ++db) { const f32x4 av = acc[db][eb] * one; u32x2 o; o.x = cvt_pk_bf16(av[0], av[1]); o.y = cvt_pk_bf16(av[2], av[3]); *(u32x2*)(cst + (size_t)(w * 32 + eb * 16 + lr) * 128 + db * 16 + g * 4) = o; }
        __syncthreads();
    }
}
__device__ __forceinline__ void mlstm_b(const Params& p, const int g_wv) {
    unsigned char* ws = p.ws; int tid = TIDX; asm volatile("" : "+v"(tid)); const float* blast = (const float*)(ws + WS_BLAST); const float* gmax = (const float*)(ws + WS_GMAX);
    for (int u = blockIdx.x; u < 256; u += gridDim.x) {
        const int bh = u >> 4, eb = u & 15; bf16_t* base = (bf16_t*)(ws + WS_CST) + (size_t)bh * 64 * 32768 + eb * 2048 + tid * 4;
        float* nb = (float*)(ws + WS_NST) + (size_t)bh * 64 * 128 + tid; const bool don = (eb == 0 && tid < 128);
        float m = 0.f, c0 = 0.f, c1 = 0.f, c2 = 0.f, c3 = 0.f, nn = 0.f;
#pragma unroll 16
        for (int c = 0; c < 64; ++c) {
            const float bl = blast[bh * 64 + c], gm = gmax[bh * 64 + c]; const float mn = fmaxf(bl + m, gm); const float dec = __expf(bl + m - mn), inw = __expf(gm - mn);
            u32x2* sp = (u32x2*)(base + (size_t)c * 32768); const u32x2 uw = *sp; u32x2 o; o.x = cvt_pk_bf16(c0, c1); o.y = cvt_pk_bf16(c2, c3); *sp = o;
            c0 = dec * c0 + inw * bflo(uw.x); c1 = dec * c1 + inw * bfhi(uw.x); c2 = dec * c2 + inw * bflo(uw.y); c3 = dec * c3 + inw * bfhi(uw.y);
            if (don) { const float nu = nb[c * 128]; nb[c * 128] = nn; nn = dec * nn + inw * nu; }
            if (eb == 0 && tid == 0) ((float*)(ws + WS_MST))[bh * 64 + c] = m;
            m = mn;
        }
        asm volatile("s_waitcnt vmcnt(0)" ::: "memory"); __syncthreads();
        if (tid == 0) { __builtin_amdgcn_fence(__ATOMIC_RELEASE, "agent"); asm volatile("s_waitcnt vmcnt(0)" ::: "memory");
            __hip_atomic_fetch_add((unsigned*)(ws + WS_CTR) + 16 + bh, 1u, __ATOMIC_RELAXED, __HIP_MEMORY_SCOPE_AGENT); }
    }
}
__device__ __forceinline__ void mlstm_c(unsigned char* lds, const Params& p, int l, const int g_wv) {
    constexpr int QRS = 288, TRS = 160; constexpr int OFF_Q = 0, OFF_K = 64 * QRS, OFF_VT = 2 * 64 * QRS, OFF_P = OFF_VT + 256 * TRS, OFF_F = OFF_P + 64 * TRS;
    unsigned char* ws = p.ws; int tid = TIDX; asm volatile("" : "+v"(tid)); const int lane = tid & 63, w = tid >> 6, lr = lane & 15, g = lane >> 4;
    const bf16_t* Q2 = (const bf16_t*)(ws + WS_Q2); const bf16_t* K2 = (const bf16_t*)(ws + WS_K2); const bf16_t* VB = (const bf16_t*)(ws + WS_VB);
    const bf16_t* OB = (const bf16_t*)(ws + WS_OB); bf16_t* ZB = (bf16_t*)(ws + WS_Z + 32 * MiB); const float* gn = p.out_norm + (size_t)l * 1024;
    float* fb = (float*)(lds + OFF_F); float* bvec = fb; float* livec = fb + 64; float* mt = fb + 128; float* wint = fb + 192; float* denV = fb + 256; float* denC = fb + 320; float* lsum = fb + 384; float* lsq = fb + 448; float* nvec = fb + 512;
    for (int u = blockIdx.x; u < 1024; u += gridDim.x) {
        const int bh = u >> 6, c = u & 63, b = bh >> 2, h = bh & 3; const size_t t0 = (size_t)b * SEQ + c * 64;
        if (tid == 0) { const unsigned want = 16u * (unsigned)(l + 1); while (__hip_atomic_load((unsigned*)(ws + WS_CTR) + 16 + bh, __ATOMIC_RELAXED, __HIP_MEMORY_SCOPE_AGENT) < want) __builtin_amdgcn_s_sleep(1);
            __builtin_amdgcn_fence(__ATOMIC_ACQUIRE, "agent"); asm volatile("s_waitcnt vmcnt(0)" ::: "memory"); }
        __syncthreads();
        const float mc = ((const float*)(ws + WS_MST))[u];
#pragma unroll
        for (int it = 0; it < 2; ++it) { const int id = tid + NTHR * it, s = id >> 4, ch = id & 15;
            *(u32x4*)(lds + OFF_Q + s * QRS + ch * 16) = *(const u32x4*)(Q2 + (t0 + s) * 512 + h * 128 + ch * 8); *(u32x4*)(lds + OFF_K + s * QRS + ch * 16) = *(const u32x4*)(K2 + (t0 + s) * 512 + h * 128 + ch * 8); }
#pragma unroll 2
        for (int it = 0; it < 4; ++it) { const int item = tid + NTHR * it, s = item & 63, eg = item >> 6; const u32x4 vw = *(const u32x4*)(VB + (t0 + s) * 1024 + h * 256 + eg * 8);
            unsigned char* d = lds + OFF_VT + (eg * 8) * TRS + s * 2; const unsigned vv[4] = {vw.x, vw.y, vw.z, vw.w};
#pragma unroll
            for (int i = 0; i < 4; ++i) { *(bf16_t*)(d + (2 * i) * TRS) = (bf16_t)(vv[i] & 0xffffu); *(bf16_t*)(d + (2 * i + 1) * TRS) = (bf16_t)(vv[i] >> 16); } }
        if (tid < 64) { bvec[tid] = ((const float*)(ws + WS_BV))[(size_t)u * 64 + tid]; livec[tid] = ((const float*)(ws + WS_LIV))[(size_t)u * 64 + tid]; lsum[tid] = 0.f; lsq[tid] = 0.f; }
        else if (tid < 192) nvec[tid - 64] = ((const float*)(ws + WS_NST))[(size_t)u * 128 + tid - 64];
        __syncthreads();
        if (w == 0) { float x = livec[lane] - bvec[lane];
#pragma unroll
            for (int o = 1; o < 64; o <<= 1) { const float v = shup(x, o, lane); if (lane >= o) x = fmaxf(x, v); }
            const float mtl = bvec[lane] + fmaxf(mc, x); mt[lane] = mtl; wint[lane] = __expf(bvec[lane] + mc - mtl); }
        __syncthreads();
        { const int lb = w >> 1;
#pragma unroll
          for (int si = 0; si < 2; ++si) { const int sb = (w & 1) * 2 + si; f32x4 a = zero4();
            if (sb <= lb) {
#pragma unroll
                for (int kc = 0; kc < 4; ++kc) { const bf16x8 qf = *(const bf16x8*)(lds + OFF_Q + (lb * 16 + lr) * QRS + kc * 64 + g * 16), kf = *(const bf16x8*)(lds + OFF_K + (sb * 16 + lr) * QRS + kc * 64 + g * 16); a = mfma16(qf, kf, a); }
            }
            const int s = sb * 16 + lr; const float bs = bvec[s] - livec[s];
#pragma unroll
            for (int r = 0; r < 4; ++r) { const int ll = lb * 16 + g * 4 + r; float v = 0.f; if (s <= ll) v = a[r] * __expf(bvec[ll] - bs - mt[ll]); *(bf16_t*)(lds + OFF_P + ll * TRS + s * 2) = f2bf(v); } } }
        __syncthreads();
        if (w == 0) { float a = 0.f; const unsigned char* r = lds + OFF_P + lane * TRS;
#pragma unroll
            for (int i = 0; i < 8; ++i) { const u32x4 x = *(const u32x4*)(r + i * 16); a += (bflo(x.x) + bfhi(x.x)) + (bflo(x.y) + bfhi(x.y)) + (bflo(x.z) + bfhi(x.z)) + (bflo(x.w) + bfhi(x.w)); }
            denV[lane] = a; }
        else if (w == 1) { float a = 0.f; const unsigned char* r = lds + OFF_Q + lane * QRS;
#pragma unroll
            for (int i = 0; i < 16; ++i) { const u32x4 x = *(const u32x4*)(r + i * 16); const float* nv = nvec + i * 8;
                a += bflo(x.x) * nv[0] + bfhi(x.x) * nv[1] + bflo(x.y) * nv[2] + bfhi(x.y) * nv[3] + bflo(x.z) * nv[4] + bfhi(x.z) * nv[5] + bflo(x.w) * nv[6] + bfhi(x.w) * nv[7]; }
            denC[lane] = a; }
        f32x4 accV[2][4], accC[2][4];
#pragma unroll
        for (int i = 0; i < 2; ++i)
#pragma unroll
            for (int j = 0; j < 4; ++j) { accV[i][j] = zero4(); accC[i][j] = zero4(); }
        const bf16_t* cst = (const bf16_t*)(ws + WS_CST) + (size_t)u * 32768;
#pragma unroll
        for (int kp = 0; kp < 2; ++kp) {
        bf16x8 ctf[2][2];
#pragma unroll
        for (int k2 = 0; k2 < 2; ++k2) { const int kc = kp * 2 + k2; ctf[k2][0] = *(const bf16x8*)(cst + (size_t)(w * 32 + lr) * 128 + kc * 32 + g * 8); ctf[k2][1] = *(const bf16x8*)(cst + (size_t)(w * 32 + 16 + lr) * 128 + kc * 32 + g * 8); }
#pragma unroll
        for (int k2 = 0; k2 < 2; ++k2) { const int kc = kp * 2 + k2;
            const bf16x8 c0 = ctf[k2][0], c1 = ctf[k2][1];
#pragma unroll
            for (int lb = 0; lb < 4; ++lb) { const bf16x8 qf = *(const bf16x8*)(lds + OFF_Q + (lb * 16 + lr) * QRS + kc * 64 + g * 16); accC[0][lb] = mfma16(c0, qf, accC[0][lb]); accC[1][lb] = mfma16(c1, qf, accC[1][lb]); }
        }
        }
#pragma unroll
        for (int kc = 0; kc < 2; ++kc) {
            const bf16x8 v0 = *(const bf16x8*)(lds + OFF_VT + (w * 32 + lr) * TRS + kc * 64 + g * 16), v1 = *(const bf16x8*)(lds + OFF_VT + (w * 32 + 16 + lr) * TRS + kc * 64 + g * 16);
#pragma unroll
            for (int lb = 0; lb < 4; ++lb) { const bf16x8 pf = *(const bf16x8*)(lds + OFF_P + (lb * 16 + lr) * TRS + kc * 64 + g * 16); accV[0][lb] = mfma16(v0, pf, accV[0][lb]); accV[1][lb] = mfma16(v1, pf, accV[1][lb]); }
        }
        __syncthreads();
#pragma unroll
        for (int lb = 0; lb < 4; ++lb) { const int ll = lb * 16 + lr; const float wi = wint[ll]; const float den = wi * denC[ll] + denV[ll]; const float dn = 1.0f / fmaxf(fabsf(den), __expf(-mt[ll])); float s1 = 0.f, s2 = 0.f;
#pragma unroll
            for (int eb = 0; eb < 2; ++eb) { const f32x4 hv = (accC[eb][lb] * wi + accV[eb][lb]) * dn; accV[eb][lb] = hv; s1 += (hv[0] + hv[1]) + (hv[2] + hv[3]); s2 += (hv[0] * hv[0] + hv[1] * hv[1]) + (hv[2] * hv[2] + hv[3] * hv[3]); }
            s1 += shx(s1, 16, lane); s1 += shx(s1, 32, lane); s2 += shx(s2, 16, lane); s2 += shx(s2, 32, lane);
            if (g == 0) { fb[640 + w * 64 + ll] = s1; fb[1152 + w * 64 + ll] = s2; } }
        __syncthreads();
#pragma unroll
        for (int lb = 0; lb < 4; ++lb) { const int ll = lb * 16 + lr; float t1 = 0.f, t2 = 0.f;
#pragma unroll
            for (int ww = 0; ww < 8; ++ww) { t1 += fb[640 + ww * 64 + ll]; t2 += fb[1152 + ww * 64 + ll]; }
            const float mu = t1 * (1.0f / 256.0f); const float var = fmaxf(t2 * (1.0f / 256.0f) - mu * mu, 0.f); const float rstd = rsqrtf(var + EPS);
#pragma unroll
            for (int eb = 0; eb < 2; ++eb) { const int e = w * 32 + eb * 16 + g * 4; const size_t off = (t0 + ll) * 1024 + h * 256 + e; const f32x4 gv = *(const f32x4*)(gn + h * 256 + e);
                const u32x2 ow = *(const u32x2*)(OB + off), zw = *(const u32x2*)(ZB + off); const f32x4 hv = accV[eb][lb]; u32x2 o;
                o.x = cvt_pk_bf16((hv[0] - mu) * rstd * gv[0] * bflo(ow.x) * bflo(zw.x), (hv[1] - mu) * rstd * gv[1] * bfhi(ow.x) * bfhi(zw.x));
                o.y = cvt_pk_bf16((hv[2] - mu) * rstd * gv[2] * bflo(ow.y) * bflo(zw.y), (hv[3] - mu) * rstd * gv[3] * bfhi(ow.y) * bfhi(zw.y)); *(u32x2*)(ZB + off) = o; } }
        __syncthreads();
    }
}

#ifndef PHM
#define PHM 4095
#endif
typedef const __attribute__((address_space(4))) Params* KParams;
#if defined(__HIP_DEVICE_COMPILE__)
__device__ __forceinline__ Params load_params() { KParams k = (KParams)__builtin_amdgcn_kernarg_segment_ptr(); asm volatile("" : "+s"(k)); return *k; }
#else
__device__ __forceinline__ Params load_params() { return Params{}; }
#endif
#define PP load_params()
#define GSYNC() do { asm volatile("s_waitcnt vmcnt(0) lgkmcnt(0)" ::: "memory"); __builtin_amdgcn_fence(__ATOMIC_RELEASE, "agent"); asm volatile("s_waitcnt vmcnt(0)" ::: "memory"); grid.sync(); \
    __builtin_amdgcn_fence(__ATOMIC_ACQUIRE, "agent"); asm volatile("s_waitcnt vmcnt(0) lgkmcnt(0)" ::: "memory"); } while (0)
__device__ __forceinline__ void gbar(unsigned* ctr, unsigned target, const int g_wv) {
    asm volatile("s_waitcnt vmcnt(0) lgkmcnt(0)" ::: "memory");
    __syncthreads();
    if (TIDX == 0) {
        __builtin_amdgcn_fence(__ATOMIC_RELEASE, "agent"); asm volatile("s_waitcnt vmcnt(0)" ::: "memory");
        __hip_atomic_fetch_add(ctr, 1u, __ATOMIC_RELAXED, __HIP_MEMORY_SCOPE_AGENT);
        while (__hip_atomic_load(ctr, __ATOMIC_RELAXED, __HIP_MEMORY_SCOPE_AGENT) < target) __builtin_amdgcn_s_sleep(1);
        __builtin_amdgcn_fence(__ATOMIC_ACQUIRE, "agent"); asm volatile("s_waitcnt vmcnt(0)" ::: "memory");
    }
    __syncthreads();
}
template <bool AL = true, bool SP = true, class Epi, class Sched> __device__ __forceinline__ void run_gemm(unsigned char* lds, const bf16_t* A, const bf16_t* Bt, int M, int N, int K, int lda, int ldb, const Sched& S, const Epi& E, const int g_wv) {
    pg8::Gemm g{A, Bt, M, N, K, lda, ldb};
    pg8::gemm_phase<Epi, Sched, AL, SP>((PG8_LAS unsigned char*)lds, g, S, E, g_wv);
    __syncthreads();
}

__global__ void __launch_bounds__(NTHR, 2) mega(Params p_arg) {
    extern __shared__ __attribute__((aligned(16))) unsigned char lds[];
    cg::grid_group grid = cg::this_grid();
    const int g_wv = __builtin_amdgcn_readfirstlane((int)(__builtin_amdgcn_workitem_id_x() >> 6));
    const int G = gridDim.x, cb = blockIdx.x; const int w_lo = p_arg.w_lo, w_hi = p_arg.w_hi;
#define WIN(k_) (w_lo <= (k_) && (k_) < w_hi)
    unsigned nbar = 0;
#define SEAM(k_) do { if (WIN(k_) && WIN((k_) + 1)) { ++nbar; gbar((unsigned*)(PP.ws + WS_CTR), nbar * (unsigned)G, g_wv); } } while (0)
    if (w_lo > 1000) GSYNC();
    if (WIN(0)) {
#if PHM & 1
    convert_weights(lds, PP, 0, g_wv); convert_weights(lds, PP, 1, g_wv);
#endif
#if PHM & 2
    build_cs(PP, g_wv);
    { const Params p = PP; rmsnorm_rows<true>(p.x, p.norm_gain, (bf16_t*)(p.ws + WS_H), nullptr, g_wv); }
#endif
    }
    SEAM(0);
#pragma unroll 1
    for (int l = 0; l < 2; ++l) {
        const int wb = 1 + 7 * l;
        if (WIN(wb)) {
#if PHM & 4
        { unsigned char* ws = PP.ws; unsigned char* wl = ws + WS_W0 + (size_t)l * WL_SIZE; const f32x2* cs = (const f32x2*)(ws + WS_CS); (void)cs; (void)wl; pg8::StaticOrder S; S.init(T, 15360, G, cb); EpiIn E{ws}; run_gemm(lds, (const bf16_t*)(ws + WS_H), (const bf16_t*)(wl + WL_WIN), T, 15360, DM, DM, DM, S, E, g_wv); }
        { unsigned char* ws = PP.ws; unsigned char* wl = ws + WS_W0 + (size_t)l * WL_SIZE; const f32x2* cs = (const f32x2*)(ws + WS_CS); (void)cs; (void)wl; pg8::StaticOrder S; S.init(1024, T, G, cb); EpiVT E{(bf16_t*)(ws + WS_VAT), T, nullptr, 0.f}; run_gemm(lds, (const bf16_t*)(wl + WL_WIN) + (size_t)15360 * DM, (const bf16_t*)(ws + WS_H), 1024, T, DM, DM, DM, S, E, g_wv); }
#endif
        }
        SEAM(wb);
        if (WIN(wb + 1)) {
#if PHM & 32
        mlstm_a(lds, PP, l, g_wv);
#endif
#if PHM & 16
        kmean_phase(PP, l, g_wv);
#endif
#if PHM & 8
        { unsigned char* ws = PP.ws; unsigned char* wl = ws + WS_W0 + (size_t)l * WL_SIZE; const f32x2* cs = (const f32x2*)(ws + WS_CS); (void)cs; (void)wl; pg8::StaticOrder S; S.init(T, 1536, G, cb); EpiRow<true> E{(bf16_t*)(ws + WS_QC), 1536, (const float*)(ws + WS_SSP), 1.0f / 512.0f, CC_SCALE, cs}; run_gemm(lds, (const bf16_t*)(ws + WS_CQ), (const bf16_t*)(wl + WL_WUQ), T, 1536, 512, 512, 512, S, E, g_wv); }
        { unsigned char* ws = PP.ws; unsigned char* wl = ws + WS_W0 + (size_t)l * WL_SIZE; const f32x2* cs = (const f32x2*)(ws + WS_CS); (void)cs; (void)wl; pg8::StaticOrder S; S.init(T, 1024, G, cb); EpiRow<false> E{(bf16_t*)(ws + WS_KNC), 1024, (const float*)(ws + WS_SSP), 1.0f / 256.0f, 1.0f, cs}; run_gemm(lds, (const bf16_t*)(ws + WS_CKV), (const bf16_t*)(wl + WL_WKN), T, 1024, 256, 256, 256, S, E, g_wv); }
        { unsigned char* ws = PP.ws; unsigned char* wl = ws + WS_W0 + (size_t)l * WL_SIZE; const f32x2* cs = (const f32x2*)(ws + WS_CS); (void)cs; (void)wl; pg8::StaticOrder S; S.init(1024, T, G, cb); EpiVT E{(bf16_t*)(ws + WS_VCT), T, (const float*)(ws + WS_SSP), 1.0f / 256.0f}; run_gemm(lds, (const bf16_t*)(wl + WL_WV), (const bf16_t*)(ws + WS_CKV), 1024, T, 256, 256, 256, S, E, g_wv); }
#endif
        }
        SEAM(wb + 1);
        if (WIN(wb + 2)) {
#if PHM & 128
        mlstm_b(PP, g_wv);
#endif
#if PHM & 64
        attn_phase<0>(lds, PP, l, g_wv);
#endif
        }
        if (WIN(wb + 3)) {
#if PHM & 256
        attn_phase<1>(lds, PP, l, g_wv);
#endif
#if PHM & 512
        mlstm_c(lds, PP, l, g_wv);
#endif
        }
        SEAM(wb + 3);
        if (WIN(wb + 4)) {
#if PHM & 1024
        { unsigned char* ws = PP.ws; unsigned char* wl = ws + WS_W0 + (size_t)l * WL_SIZE; MergeOrder S{G, cb}; EpiMerge E{(bf16_t*)(ws + WS_H), (const bf16_t*)(ws + WS_GT)}; run_gemm(lds, (const bf16_t*)(ws + WS_Z), (const bf16_t*)(wl + WL_WB), 3 * T, 2048, 1024, 1024, 1024, S, E, g_wv); }
#endif
        }
        SEAM(wb + 4);
        if (WIN(wb + 5)) {
#if PHM & 2048
        { unsigned char* ws = PP.ws; unsigned char* wl = ws + WS_W0 + (size_t)l * WL_SIZE; const f32x2* cs = (const f32x2*)(ws + WS_CS); (void)cs; (void)wl; pg8::StaticOrder S; S.init(T, DM, G, cb); const Params p = PP; EpiOut E{l == 0 ? p.x : p.out, p.out}; run_gemm(lds, (const bf16_t*)(ws + WS_H), (const bf16_t*)(wl + WL_WO), T, DM, DM, DM, DM, S, E, g_wv); }
#endif
        }
        SEAM(wb + 5);
        if (WIN(wb + 6)) {
            if (l == 0) { const Params p = PP; rmsnorm_rows<true>(p.out, p.norm_gain + DM, (bf16_t*)(p.ws + WS_H), nullptr, g_wv); }
            else { const Params p = PP; rmsnorm_rows<false>(p.out, p.final_norm, nullptr, p.out, g_wv); }
        }
        if (l == 0) SEAM(wb + 6);
    }
}


#if defined(MK_DEBUG_HASH)
__global__ void hash_buf(const unsigned* p, size_t nwords, unsigned long long* acc) {
    unsigned long long s = 0; const size_t stride = (size_t)gridDim.x * blockDim.x;
    for (size_t i = (size_t)blockIdx.x * blockDim.x + threadIdx.x; i < nwords; i += stride) s += (unsigned long long)p[i] * (unsigned long long)(((unsigned)i * 2654435761u) | 1u);
    atomicAdd(acc, s);
}
__global__ void dbg_final(float* out, size_t n, const unsigned long long* h, int R, int NK) {
    __shared__ float flag;
    if (threadIdx.x == 0) { float f = 1.0f; for (int k = NK - 1; k >= 0; --k) for (int r = 1; r < R; ++r) if (h[r * NK + k] != h[k]) { f = 100.0f; for (int q = 0; q < k; ++q) f *= 10.0f; } flag = f; }
    __syncthreads();
    for (size_t i = (size_t)blockIdx.x * blockDim.x + threadIdx.x; i < n; i += (size_t)gridDim.x * blockDim.x) out[i] = (i == 0) ? flag : 0.0f;
}
#endif
extern "C" void kernel_launch(void* const* d_in, const int* in_sizes, int n_in, void* d_out, int out_size, void* d_ws, size_t ws_size, hipStream_t stream) {
    static int grid = 0;
    if (grid == 0) {
        if (n_in != 16 || ws_size < WS_END) { fprintf(stderr, "kernel_launch: unexpected n_in %d or ws_size %zu < %zu\n", n_in, ws_size, (size_t)WS_END); grid = -1; return; }
        int dev = 0, cus = 0, per_cu = 0;
        hipGetDevice(&dev); hipDeviceGetAttribute(&cus, hipDeviceAttributeMultiprocessorCount, dev);
        if (hipFuncSetAttribute((const void*)mega, hipFuncAttributeMaxDynamicSharedMemorySize, LDS_BYTES) != hipSuccess) { fprintf(stderr, "kernel_launch: hipFuncSetAttribute failed\n"); grid = -1; return; }
        if (hipOccupancyMaxActiveBlocksPerMultiprocessor(&per_cu, (const void*)mega, NTHR, LDS_BYTES) != hipSuccess || per_cu < 1) { fprintf(stderr, "kernel_launch: occupancy query gave %d\n", per_cu); per_cu = 1; }
        (void)hipGetLastError();
        grid = cus * 1;
    }
    if (grid < 0) return;
    Params p{};
    p.x = (const float*)d_in[0]; p.norm_gain = (const float*)d_in[1]; p.w_in = (const float*)d_in[2]; p.t5 = (const float*)d_in[3]; p.conv_w = (const float*)d_in[4]; p.conv_b = (const float*)d_in[5];
    p.i_bias = (const float*)d_in[6]; p.f_bias = (const float*)d_in[7]; p.out_norm = (const float*)d_in[8]; p.q_norm = (const float*)d_in[9]; p.kv_norm = (const float*)d_in[10];
    p.w_uq = (const float*)d_in[11]; p.w_ukv = (const float*)d_in[12]; p.w_branch = (const float*)d_in[13]; p.w_out = (const float*)d_in[14]; p.final_norm = (const float*)d_in[15];
    p.out = (float*)d_out; p.ws = (unsigned char*)d_ws;
    (void)hipMemsetAsync((unsigned char*)d_ws + WS_CTR, 0, 256, stream);
    void* args[] = {&p};
#if defined(MK_DEBUG_HASH)
    {
        constexpr int R = 4, NK = 9; unsigned char* W = (unsigned char*)d_ws; unsigned long long* H = (unsigned long long*)(W + WS_END);
        hipMemsetAsync(H, 0, R * NK * 8, stream);
        struct HB { int win; size_t off; size_t bytes; };
        const HB hb[NK] = { {3, WS_Z, 32 * MiB}, {3, WS_CST, 64 * MiB}, {3, WS_NST, 524288}, {3, WS_MST, 4096},
                            {4, WS_Z + 64 * MiB, 32 * MiB}, {4, WS_Z + 32 * MiB, 32 * MiB}, {5, WS_H, 64 * MiB}, {6, WS_H, 64 * MiB}, {2, WS_CST, 64 * MiB} };
        for (int r = 0; r < R; ++r)
            for (int w = 0; w < 7; ++w) { p.w_lo = w; p.w_hi = w + 1;
                hipError_t e = hipLaunchCooperativeKernel((const void*)mega, dim3(grid), dim3(NTHR), args, LDS_BYTES, stream);
                if (e != hipSuccess) fprintf(stderr, "kernel_launch: cooperative launch failed: %s\n", hipGetErrorString(e));
                for (int k = 0; k < NK; ++k) if (hb[k].win == w) {
                    if (k == 7) hash_buf<<<256, 256, 0, stream>>>((const unsigned*)d_out, (size_t)T * DM, H + r * NK + k);
                    else hash_buf<<<256, 256, 0, stream>>>((const unsigned*)(W + hb[k].off), hb[k].bytes / 4, H + r * NK + k); } }
        dbg_final<<<256, 256, 0, stream>>>((float*)d_out, (size_t)T * DM, H, R, NK);
    }
    if (false) {
#elif defined(MK_MULTI)
    for (int w = 0; w < 15; ++w) { p.w_lo = w; p.w_hi = w + 1;
#else
    { p.w_lo = 0; p.w_hi = 15;
#endif
        hipError_t e = hipLaunchCooperativeKernel((const void*)mega, dim3(grid), dim3(NTHR), args, LDS_BYTES, stream);
        if (e != hipSuccess) fprintf(stderr, "kernel_launch: cooperative launch failed: %s (grid %d)\n", hipGetErrorString(e), grid);
    }
}
```
